# Optimizing an MI355X kernel written in HIP

```python
import math
import jax, jax.numpy as jnp
from jax import lax
import numpy as np

D_MODEL = 1024
BATCH = 1
SEQ = 16384
DEPTH = 2

DA_HEADS = 4
DA_WIDTH = D_MODEL // 2
DA_HEAD_DIM = DA_WIDTH // (2 * DA_HEADS)
HG_HEADS = 4
HG_WIDTH = D_MODEL // 4
HG_KEY_DIM = HG_WIDTH // HG_HEADS
HG_VAL_DIM = HG_WIDTH // HG_HEADS
HG_CHUNK = 64
POOL_WINDOWS = (2, 4, 8, 16)
POOL_WIDTH = D_MODEL // 4
POOL_GROUP = POOL_WIDTH // len(POOL_WINDOWS)
D_MIX = DA_WIDTH + HG_WIDTH + POOL_WIDTH
PROJ_SIZES = (DA_WIDTH, DA_WIDTH, DA_WIDTH, HG_HEADS * HG_KEY_DIM, HG_HEADS * HG_KEY_DIM, HG_WIDTH, HG_WIDTH, POOL_WIDTH)
D_IN = sum(PROJ_SIZES)
ATTN_BLOCK = 128
ROPE_THETA = 10000.0
MASK_VALUE = -1e30
TINY = 1e-30
FFN_DIM = 11 * D_MODEL // 4
N_EXPERTS = 8
TOP_K = 2
EXPERT_DIM = 7 * D_MODEL // 2
N_DENSE = (DEPTH + 1) // 2
N_MOE = DEPTH // 2
ALPHA = (2 * DEPTH) ** 0.25
BETA = (8 * DEPTH) ** -0.25
EPS = 1e-5

kernel_name = 'hybrid_diffattn_hgrn2_pool_moe_deepnorm_adaln'


def layer_norm(x, g, b):
    xf = x.astype(jnp.float32)
    mu = jnp.mean(xf, axis=-1, keepdims=True)
    var = jnp.mean(jnp.square(xf - mu), axis=-1, keepdims=True)
    return ((xf - mu) * lax.rsqrt(var + EPS)).astype(x.dtype) * g + b


def rms_norm(x, g):
    xf = x.astype(jnp.float32)
    return (xf * lax.rsqrt(jnp.mean(xf * xf, axis=-1, keepdims=True) + EPS)).astype(x.dtype) * g


def rotary(x, pos):
    d = x.shape[-1]
    inv_freq = 1.0 / (ROPE_THETA ** (jnp.arange(0, d, 2, dtype=jnp.float32) / d))
    ang = pos.astype(jnp.float32)[:, None] * inv_freq[None, :]
    cos = jnp.cos(ang)[None, :, None, :]
    sin = jnp.sin(ang)[None, :, None, :]
    xf = x.astype(jnp.float32)
    x1, x2 = xf[..., : d // 2], xf[..., d // 2:]
    return jnp.concatenate([x1 * cos - x2 * sin, x2 * cos + x1 * sin], axis=-1).astype(x.dtype)


def diff_attention(q, k, v, lam, lam_init, norm_g):
    B, S, NH2, d = q.shape
    H = NH2 // 2
    nblk = S // ATTN_BLOCK
    kT = k.transpose(0, 2, 1, 3)
    vT = v.transpose(0, 2, 1, 3)
    qb = (q * (d ** -0.5)).reshape(B, nblk, ATTN_BLOCK, NH2, d).transpose(1, 0, 3, 2, 4)
    key_pos = jnp.arange(S)

    def block(args):
        q_blk, start = args
        s = jnp.einsum('bnqd,bnkd->bnqk', q_blk, kT).astype(jnp.float32)
        q_pos = start + jnp.arange(ATTN_BLOCK)
        s = jnp.where(key_pos[None, :] <= q_pos[:, None], s, MASK_VALUE)
        p = jax.nn.softmax(s, axis=-1).reshape(B, H, 2, ATTN_BLOCK, S)
        a = p[:, :, 0] - lam * p[:, :, 1]
        return jnp.einsum('bhqk,bhkd->bhqd', a.astype(v.dtype), vT)

    starts = jnp.arange(nblk) * ATTN_BLOCK
    o = lax.map(block, (qb, starts))
    o = o.transpose(1, 0, 3, 2, 4).reshape(B, S, H, 2 * d)
    o = rms_norm(o, norm_g) * (1.0 - lam_init)
    return o.reshape(B, S, H * 2 * d)


def hgrn2(q, f_logit, i, g, lb, norm_g):
    B, S, H, dk = q.shape
    dv = i.shape[-1]
    C = HG_CHUNK
    nc = S // C
    zf = f_logit.astype(jnp.float32)
    lbh = lb.reshape(H, dk).astype(jnp.float32)
    f = lbh + (1.0 - lbh) * jax.nn.sigmoid(zf)
    log_f = jnp.log(jnp.maximum(f, TINY))
    key = (1.0 - lbh) * jax.nn.sigmoid(-zf)
    val = jax.nn.silu(i.astype(jnp.float32))
    qf = q.astype(jnp.float32)

    def to_chunks(t):
        return t.reshape(B, nc, C, H, t.shape[-1]).transpose(1, 0, 3, 2, 4)

    causal = jnp.tril(jnp.ones((C, C), dtype=bool))[None, None, :, :, None]

    def step(state, inp):
        qc, kc, vc, lfc = inp
        b = jnp.cumsum(lfc, axis=2)
        diff = b[:, :, :, None, :] - b[:, :, None, :, :]
        decay = jnp.where(causal, jnp.exp(jnp.where(causal, diff, 0.0)), 0.0)
        scores = jnp.sum(qc[:, :, :, None, :] * kc[:, :, None, :, :] * decay, axis=-1)
        o = jnp.einsum('bhts,bhsv->bhtv', scores, vc) + jnp.einsum('bhtk,bhkv->bhtv', qc * jnp.exp(b), state)
        b_last = b[:, :, -1:, :]
        new_state = jnp.exp(b_last[:, :, 0, :])[..., None] * state + jnp.einsum('bhsk,bhsv->bhkv', kc * jnp.exp(b_last - b), vc)
        return new_state, o

    state0 = jnp.zeros((B, H, dk, dv), jnp.float32)
    _, o = lax.scan(step, state0, (to_chunks(qf), to_chunks(key), to_chunks(val), to_chunks(log_f)))
    o = o.transpose(1, 0, 3, 2, 4).reshape(B, S, H, dv).astype(g.dtype)
    o = rms_norm(o, norm_g) * jax.nn.silu(g)
    return o.reshape(B, S, H * dv)


def multiscale_pool(u, w, scale):
    B, S, _ = u.shape
    uf = u.astype(jnp.float32)
    csum = jnp.pad(jnp.cumsum(uf, axis=1), ((0, 0), (1, 0), (0, 0)))
    t = jnp.arange(S)
    outs = []
    for gi, win in enumerate(POOL_WINDOWS):
        sl = slice(gi * POOL_GROUP, (gi + 1) * POOL_GROUP)
        cs = csum[:, :, sl]
        lo = jnp.maximum(t + 1 - win, 0)
        total = cs[:, 1:] - cs[:, lo]
        count = (t + 1 - lo).astype(jnp.float32)
        outs.append(total / count[None, :, None] - uf[:, :, sl])
    pooled = jnp.stack(outs, axis=2).astype(u.dtype)
    y = jnp.einsum('bsgc,gcd->bsgd', pooled, w)
    return y.reshape(B, S, POOL_WIDTH) * scale


def token_mixer(h, w_in, lam_qk, attn_g, lb, hg_g, pool_w, pool_scale, w_out, layer_idx, pos):
    B, S, _ = h.shape
    proj = h @ w_in
    splits = [int(v) for v in np.cumsum(PROJ_SIZES)[:-1]]
    q, k, v, hq, hf, hi, hgate, pu = jnp.split(proj, splits, axis=-1)
    q = rotary(q.reshape(B, S, 2 * DA_HEADS, DA_HEAD_DIM), pos)
    k = rotary(k.reshape(B, S, 2 * DA_HEADS, DA_HEAD_DIM), pos)
    v = v.reshape(B, S, DA_HEADS, 2 * DA_HEAD_DIM)
    lam_init = 0.8 - 0.6 * math.exp(-0.3 * layer_idx)
    lq = lam_qk.astype(jnp.float32)
    lam = jnp.exp(jnp.sum(lq[0] * lq[1])) - jnp.exp(jnp.sum(lq[2] * lq[3])) + lam_init
    a = diff_attention(q, k, v, lam, lam_init, attn_g)
    r = hgrn2(hq.reshape(B, S, HG_HEADS, HG_KEY_DIM), hf.reshape(B, S, HG_HEADS, HG_KEY_DIM),
              hi.reshape(B, S, HG_HEADS, HG_VAL_DIM), hgate.reshape(B, S, HG_HEADS, HG_VAL_DIM), lb, hg_g)
    p = multiscale_pool(pu, pool_w, pool_scale)
    return jnp.concatenate([a, r, p], axis=-1) @ w_out


def swiglu(h, w1, w3, w2):
    return (jax.nn.silu(h @ w1) * (h @ w3)) @ w2


def moe_ffn(h, router_w, w1, w3, w2):
    logits = (h @ router_w).astype(jnp.float32)
    top_v, top_i = lax.top_k(logits, TOP_K)
    gates = jax.nn.softmax(top_v, axis=-1)
    combine = jnp.sum(jax.nn.one_hot(top_i, N_EXPERTS, dtype=jnp.float32) * gates[..., None], axis=-2)
    y = jnp.zeros_like(h)
    for e in range(N_EXPERTS):
        y = y + combine[..., e:e + 1].astype(h.dtype) * swiglu(h, w1[e], w3[e], w2[e])
    return y


def setup_inputs(seed: int = 0) -> dict:
    key = jax.random.key(seed)
    ks = jax.random.split(key, 24)
    D = D_MODEL

    def nrm(k, shape, std):
        return jax.random.normal(k, shape, jnp.float32) * std

    return {
        'x': nrm(ks[0], (BATCH, SEQ, D), 1.0),
        'c': nrm(ks[1], (BATCH, D), 1.0),
        'w_ada': nrm(ks[2], (DEPTH, D, 6 * D), 0.1 * D ** -0.5),
        'b_ada': nrm(ks[3], (DEPTH, 6 * D), 0.02),
        'w_in': nrm(ks[4], (DEPTH, D, D_IN), D ** -0.5),
        'lam_qk': nrm(ks[5], (DEPTH, 4, DA_HEAD_DIM), 0.1),
        'attn_norm_g': 1.0 + nrm(ks[6], (DEPTH, 2 * DA_HEAD_DIM), 0.02),
        'hg_lb_logits': nrm(ks[7], (DEPTH, HG_HEADS * HG_KEY_DIM), 0.5),
        'hg_norm_g': 1.0 + nrm(ks[8], (DEPTH, HG_VAL_DIM), 0.02),
        'pool_w': nrm(ks[9], (DEPTH, len(POOL_WINDOWS), POOL_GROUP, POOL_GROUP), POOL_GROUP ** -0.5),
        'pool_scale': 1.0 + nrm(ks[10], (DEPTH, POOL_WIDTH), 0.02),
        'w_out': nrm(ks[11], (DEPTH, D_MIX, D), BETA * D_MIX ** -0.5),
        'ln1_g': 1.0 + nrm(ks[12], (DEPTH, D), 0.02),
        'ln1_b': nrm(ks[13], (DEPTH, D), 0.02),
        'ln2_g': 1.0 + nrm(ks[14], (DEPTH, D), 0.02),
        'ln2_b': nrm(ks[15], (DEPTH, D), 0.02),
        'ffn_w1': nrm(ks[16], (N_DENSE, D, FFN_DIM), D ** -0.5),
        'ffn_w3': nrm(ks[17], (N_DENSE, D, FFN_DIM), D ** -0.5),
        'ffn_w2': nrm(ks[18], (N_DENSE, FFN_DIM, D), BETA * FFN_DIM ** -0.5),
        'router_w': nrm(ks[19], (N_MOE, D, N_EXPERTS), D ** -0.5),
        'exp_w1': nrm(ks[20], (N_MOE, N_EXPERTS, D, EXPERT_DIM), D ** -0.5),
        'exp_w3': nrm(ks[21], (N_MOE, N_EXPERTS, D, EXPERT_DIM), D ** -0.5),
        'exp_w2': nrm(ks[22], (N_MOE, N_EXPERTS, EXPERT_DIM, D), BETA * EXPERT_DIM ** -0.5),
    }


def reference(x, c, w_ada, b_ada, w_in, lam_qk, attn_norm_g, hg_lb_logits, hg_norm_g, pool_w, pool_scale,
              w_out, ln1_g, ln1_b, ln2_g, ln2_b, ffn_w1, ffn_w3, ffn_w2, router_w, exp_w1, exp_w3, exp_w2):
    S = x.shape[1]
    pos = jnp.arange(S)
    P = jax.nn.softmax(hg_lb_logits.astype(jnp.float32), axis=0)
    lbs = jnp.cumsum(P, axis=0) - P[0:1]
    cond = jax.nn.silu(c)
    for l in range(DEPTH):
        mod = (cond @ w_ada[l] + b_ada[l])[:, None, :]
        sh1, sc1, g1, sh2, sc2, g2 = jnp.split(mod, 6, axis=-1)
        h = x * (1.0 + sc1) + sh1
        m = token_mixer(h, w_in[l], lam_qk[l], attn_norm_g[l], lbs[l], hg_norm_g[l], pool_w[l], pool_scale[l],
                        w_out[l], l, pos)
        x = layer_norm(ALPHA * x + (1.0 + g1) * m, ln1_g[l], ln1_b[l])
        h = x * (1.0 + sc2) + sh2
        if l % 2 == 0:
            f = swiglu(h, ffn_w1[l // 2], ffn_w3[l // 2], ffn_w2[l // 2])
        else:
            f = moe_ffn(h, router_w[l // 2], exp_w1[l // 2], exp_w3[l // 2], exp_w2[l // 2])
        x = layer_norm(ALPHA * x + (1.0 + g2) * f, ln2_g[l], ln2_b[l])
    return x
```

```cpp
#define MK_N_LAUNCHES 1
#include <hip/hip_runtime.h>
#include <hip/hip_bf16.h>
#include <cstdio>
#include <cstdint>
#include <cmath>
namespace pg8 {
#define PG8_LAS __attribute__((address_space(3)))
typedef unsigned short bf16_t;
typedef short bf16x8 __attribute__((ext_vector_type(8)));
typedef float f32x4 __attribute__((ext_vector_type(4)));
typedef unsigned u32x4 __attribute__((ext_vector_type(4)));
constexpr int BM = 256, BK = 64, HALF = 128, HTB = HALF * BK * 2  , STAGE_BYTES = 8 * HTB, NXCD = 8, WGM = 8;

__host__ __device__ __forceinline__ int lds_byte(int r, int c) { const int st = (r >> 4) * 2 + (c >> 5), rr = r & 15, cc = c & 31, ob = rr * 64 + cc * 2; return st * 1024 + (ob ^ (((ob >> 9) & 1) << 5)); }
__host__ __device__ __forceinline__ void stage_rc(int b, int& R, int& C) { const int st = b / 1024, sb = b % 1024, swz = sb ^ (((sb >> 9) & 1) << 5); R = (st >> 1) * 16 + swz / 64; C = (st & 1) * 32 + (swz % 64) / 2; }
__host__ __device__ __forceinline__ int perm32(int rho) { const int n = rho >> 4, i = rho & 15; return 8 * (i >> 2) + 4 * n + (i & 3); }

struct Unit { int pm, pn, pb; };
struct Gemm { const bf16_t* A; const bf16_t* Bt; int K; };

struct StaticOrder {
    int nM, nN, nwg, G, c;
    __host__ __device__ void init(int M, int N, int G_, int c_) { nM = M / BM; nN = N / BM; nwg = nM * nN; G = G_; c = c_; }
    __host__ __device__ bool next(int i, Unit& u) const {
        const long L = (long)i * G + c; if (L >= nwg) return false;
        int wgid = (int)L; { const int q = nwg / NXCD, r = nwg % NXCD, xcd = wgid % NXCD, off = wgid / NXCD; wgid = (xcd < r ? xcd * (q + 1) : r * (q + 1) + (xcd - r) * q) + off; }
        const int nig = WGM * nN, gid = wgid / nig, fm = gid * WGM, gsz = (nM - fm) < WGM ? (nM - fm) : WGM;
        u.pm = fm + ((wgid % nig) % gsz); u.pn = (wgid % nig) / gsz; u.pb = u.pn; return true;
    }
};

struct MoeOrder {
    int tb1, tb2, tb3, tb4, tb5, tb6, tb7, tb8;
    int nN, G, c;
    __device__ __forceinline__ void init(const unsigned* cnt, int nN_, int G_, int c_) {
        tb1 = ((int)cnt[0] + 255) >> 8; tb2 = tb1 + (((int)cnt[64] + 255) >> 8); tb3 = tb2 + (((int)cnt[128] + 255) >> 8); tb4 = tb3 + (((int)cnt[192] + 255) >> 8);
        tb5 = tb4 + (((int)cnt[256] + 255) >> 8); tb6 = tb5 + (((int)cnt[320] + 255) >> 8); tb7 = tb6 + (((int)cnt[384] + 255) >> 8); tb8 = tb7 + (((int)cnt[448] + 255) >> 8);
        nN = nN_; G = G_; c = c_;
    }
    __device__ __forceinline__ bool next(int i, Unit& u) const {
        const int L = i * G + c; const int T = L / nN; if (T >= tb8) return false;
        const int pn = L - T * nN;
        const int e = (T >= tb1) + (T >= tb2) + (T >= tb3) + (T >= tb4) + (T >= tb5) + (T >= tb6) + (T >= tb7);
        u.pm = T; u.pn = pn; u.pb = e * nN + pn; return true;
    }
};

__device__ __forceinline__ unsigned cvt_pk_bf16(float lo, float hi) { unsigned r; asm volatile("v_cvt_pk_bf16_f32 %0, %1, %2" : "=v"(r) : "v"(lo), "v"(hi)); return r; }

struct EpiBf16 {
    static constexpr bool PERM = true;
    bf16_t* O; int ldc;
    __device__ __forceinline__ void operator()(const f32x4 (&acc)[2][2][4][2], const Unit& u, int wr, int wc, int fr, int fq) const {
        const int row0 = u.pm * BM + wr * 64 + fr; const int col0 = u.pn * BM + wc * 32 + 8 * fq;
#pragma unroll
        for (int ai = 0; ai < 2; ++ai)
#pragma unroll
            for (int m = 0; m < 4; ++m) { bf16_t* rowp = O + (size_t)(row0 + ai * HALF + m * 16) * ldc + col0;
#pragma unroll
                for (int bj = 0; bj < 2; ++bj) { const f32x4 v0 = acc[ai][bj][m][0], v1 = acc[ai][bj][m][1];
                    u32x4 w; w.x = cvt_pk_bf16(v0[0], v0[1]); w.y = cvt_pk_bf16(v0[2], v0[3]); w.z = cvt_pk_bf16(v1[0], v1[1]); w.w = cvt_pk_bf16(v1[2], v1[3]);
                    *(u32x4*)(rowp + bj * HALF) = w; } }
    }
};

struct EpiProj {
    static constexpr bool PERM = true;
    bf16_t* O; int ldc; const float* cosT; const float* sinT; float qscale;
    __device__ __forceinline__ void operator()(const f32x4 (&acc)[2][2][4][2], const Unit& u, int wr, int wc, int fr, int fq) const {
        const int row0 = u.pm * BM + wr * 64 + fr; const int col0 = u.pn * BM + wc * 32 + 8 * fq;
        if (u.pn < 4) {
            const int i0 = 16 * (wc & 1) + 4 * fq; const float sc = (u.pn < 2) ? qscale : 1.0f;
#pragma unroll
            for (int ai = 0; ai < 2; ++ai)
#pragma unroll
                for (int m = 0; m < 4; ++m) { const int row = row0 + ai * HALF + m * 16; bf16_t* rowp = O + (size_t)row * ldc + col0;
                    f32x4 c4 = *(const f32x4*)(cosT + (size_t)row * 32 + i0), s4 = *(const f32x4*)(sinT + (size_t)row * 32 + i0);
                    c4 = c4 * sc; s4 = s4 * sc;
#pragma unroll
                    for (int bj = 0; bj < 2; ++bj) { const f32x4 v0 = acc[ai][bj][m][0], v1 = acc[ai][bj][m][1];
                        const float o0 = v0[0] * c4[0] - v0[1] * s4[0], o1 = v0[1] * c4[0] + v0[0] * s4[0];
                        const float o2 = v0[2] * c4[1] - v0[3] * s4[1], o3 = v0[3] * c4[1] + v0[2] * s4[1];
                        const float o4 = v1[0] * c4[2] - v1[1] * s4[2], o5 = v1[1] * c4[2] + v1[0] * s4[2];
                        const float o6 = v1[2] * c4[3] - v1[3] * s4[3], o7 = v1[3] * c4[3] + v1[2] * s4[3];
                        u32x4 w; w.x = cvt_pk_bf16(o0, o1); w.y = cvt_pk_bf16(o2, o3); w.z = cvt_pk_bf16(o4, o5); w.w = cvt_pk_bf16(o6, o7);
                        *(u32x4*)(rowp + bj * HALF) = w; } }
        } else {
#pragma unroll
            for (int ai = 0; ai < 2; ++ai)
#pragma unroll
                for (int m = 0; m < 4; ++m) { bf16_t* rowp = O + (size_t)(row0 + ai * HALF + m * 16) * ldc + col0;
#pragma unroll
                    for (int bj = 0; bj < 2; ++bj) { const f32x4 v0 = acc[ai][bj][m][0], v1 = acc[ai][bj][m][1];
                        u32x4 w; w.x = cvt_pk_bf16(v0[0], v0[1]); w.y = cvt_pk_bf16(v0[2], v0[3]); w.z = cvt_pk_bf16(v1[0], v1[1]); w.w = cvt_pk_bf16(v1[2], v1[3]);
                        *(u32x4*)(rowp + bj * HALF) = w; } }
        }
    }
};

__device__ __forceinline__ float silu_f(float a) { return a * __builtin_amdgcn_rcpf(1.0f + __builtin_amdgcn_exp2f(-1.4426950408889634f * a)); }
struct EpiSwiglu {
    static constexpr bool PERM = true;
    bf16_t* O; int ldc;
    __device__ __forceinline__ void operator()(const f32x4 (&acc)[2][2][4][2], const Unit& u, int wr, int wc, int fr, int fq) const {
        const int row0 = u.pm * BM + wr * 64 + fr; const int col0 = u.pn * HALF + wc * 32 + 8 * fq;
#pragma unroll
        for (int ai = 0; ai < 2; ++ai)
#pragma unroll
            for (int m = 0; m < 4; ++m) { bf16_t* rowp = O + (size_t)(row0 + ai * HALF + m * 16) * ldc + col0;
                const f32x4 a0 = acc[ai][0][m][0], a1 = acc[ai][0][m][1], b0 = acc[ai][1][m][0], b1 = acc[ai][1][m][1];
                u32x4 w;
                w.x = cvt_pk_bf16(silu_f(a0[0]) * b0[0], silu_f(a0[1]) * b0[1]); w.y = cvt_pk_bf16(silu_f(a0[2]) * b0[2], silu_f(a0[3]) * b0[3]);
                w.z = cvt_pk_bf16(silu_f(a1[0]) * b1[0], silu_f(a1[1]) * b1[1]); w.w = cvt_pk_bf16(silu_f(a1[2]) * b1[2], silu_f(a1[3]) * b1[3]);
                *(u32x4*)rowp = w; }
    }
};

struct EpiResid {
    static constexpr bool PERM = false;
    const float* xin; float* out; int ldc; const float* gate; float alpha;
    __device__ __forceinline__ void operator()(const f32x4 (&acc)[2][2][4][2], const Unit& u, int wr, int wc, int fr, int fq) const {
        const int col0 = u.pn * BM + wc * 32 + 4 * fq;
        f32x4 gv[2][2];
#pragma unroll
        for (int bj = 0; bj < 2; ++bj)
#pragma unroll
            for (int n = 0; n < 2; ++n) gv[bj][n] = *(const f32x4*)(gate + col0 + bj * HALF + n * 16) + 1.0f;
#pragma unroll
        for (int ai = 0; ai < 2; ++ai)
#pragma unroll
            for (int m = 0; m < 4; ++m) { const size_t off = (size_t)(u.pm * BM + ai * HALF + wr * 64 + m * 16 + fr) * ldc + col0;
#pragma unroll
                for (int bj = 0; bj < 2; ++bj)
#pragma unroll
                    for (int n = 0; n < 2; ++n) { const f32x4 x = *(const f32x4*)(xin + off + bj * HALF + n * 16);
                        *(f32x4*)(out + off + bj * HALF + n * 16) = x * alpha + gv[bj][n] * acc[ai][bj][m][n]; }
                if (m & 1) asm volatile("" ::: "memory"); }
    }
};

template <class Epi, class Sched, bool ALIGN_EPI>
__device__ __forceinline__ void gemm_phase(PG8_LAS unsigned char* lds, const Gemm g, const Sched& S, const Epi& E, const int tid) {
    const int wid = __builtin_amdgcn_readfirstlane(tid >> 6), lane = tid & 63, wr = wid >> 2, wc = wid & 3, fr = lane & 15, fq = lane >> 4;
    const int K = g.K, nt = K / BK;
    unsigned voffA[2], voffB[2];
#pragma unroll
    for (int i = 0; i < 2; ++i) { int R, C; stage_rc(tid * 16 + i * 8192, R, C); const int Rb = Epi::PERM ? ((R & ~31) + perm32(R & 31)) : R;
        voffA[i] = (unsigned)(R * K + C) * 2u; voffB[i] = (unsigned)(Rb * K + C) * 2u; }
    const size_t kstep = (size_t)(BK * 2);
    const size_t hstep = (size_t)HALF * K * 2;
    const size_t tstep = 2 * hstep;
    const unsigned ldsw = (unsigned)wid * 1024u;
    const int aoff = lds_byte(wr * 64 + fr, fq * 8), boff = lds_byte(wc * 32 + fr, fq * 8);
#define PG8_SA(b, h) (((b) * 2 + (h)) * HTB)
#define PG8_SB(b, h) ((4 + (b) * 2 + (h)) * HTB)
#define PG8_STAGE(bufoff, gbase, voff) do { _Pragma("unroll") for (int _i = 0; _i < 2; ++_i) \
        __builtin_amdgcn_global_load_lds((const unsigned*)((const char*)(gbase) + (voff)[_i]), (PG8_LAS unsigned*)(lds + (bufoff) + ldsw + _i * 8192), 16, 0, 0); } while (0)
#define PG8_LDA(dst, b, h) do { _Pragma("unroll") for (int m = 0; m < 4; ++m) _Pragma("unroll") for (int k = 0; k < 2; ++k) dst[m][k] = *(const PG8_LAS bf16x8*)(lds + PG8_SA(b, h) + aoff + m * 2048 + k * 1024); } while (0)
#define PG8_LDB(dst, b, h) do { _Pragma("unroll") for (int n = 0; n < 2; ++n) _Pragma("unroll") for (int k = 0; k < 2; ++k) dst[n][k] = *(const PG8_LAS bf16x8*)(lds + PG8_SB(b, h) + boff + n * 2048 + k * 1024); } while (0)
#define PG8_MMA(ai, bj, At, Bt) do { __builtin_amdgcn_s_setprio(1); _Pragma("unroll") for (int m = 0; m < 4; ++m) _Pragma("unroll") for (int n = 0; n < 2; ++n) _Pragma("unroll") for (int k = 0; k < 2; ++k) \
        acc[ai][bj][m][n] = __builtin_amdgcn_mfma_f32_16x16x32_bf16(Bt[n][k], At[m][k], acc[ai][bj][m][n], 0, 0, 0); __builtin_amdgcn_s_setprio(0); } while (0)
#define PG8_WAIT_V(n) asm volatile("s_waitcnt vmcnt(" #n ")" ::: "memory")
#define PG8_WAIT_L(n) asm volatile("s_waitcnt lgkmcnt(" #n ")" ::: "memory")
#define PG8_BAR __builtin_amdgcn_s_barrier()
#define PG8_SCHED __builtin_amdgcn_sched_barrier(0)
    Unit cur, nxt; int ui = 0;
    if (!S.next(0, cur)) return;
    f32x4 acc[2][2][4][2];
#pragma unroll
    for (int a = 0; a < 2; ++a)
#pragma unroll
        for (int b = 0; b < 2; ++b)
#pragma unroll
            for (int m = 0; m < 4; ++m)
#pragma unroll
                for (int n = 0; n < 2; ++n) acc[a][b][m][n] = (f32x4){0.f, 0.f, 0.f, 0.f};
    bf16x8 At[4][2], B0[2][2], B1[2][2];
    const char* cA = (const char*)g.A + (size_t)cur.pm * tstep; const char* cB = (const char*)g.Bt + (size_t)cur.pb * tstep;
    PG8_STAGE(PG8_SB(0, 0), cB, voffB); PG8_STAGE(PG8_SB(0, 1), cB + hstep, voffB); PG8_STAGE(PG8_SA(0, 0), cA, voffA); PG8_STAGE(PG8_SA(0, 1), cA + hstep, voffA);
    if (wr == 1) PG8_BAR;
    PG8_WAIT_V(2); PG8_BAR;
    PG8_STAGE(PG8_SB(1, 0), cB + kstep, voffB); PG8_STAGE(PG8_SA(1, 0), cA + kstep, voffA); PG8_STAGE(PG8_SB(1, 1), cB + hstep + kstep, voffB);
    PG8_WAIT_V(6); PG8_BAR;
    for (;;) {
        const bool has_next = S.next(ui + 1, nxt);
        const char* nA = has_next ? (const char*)g.A + (size_t)nxt.pm * tstep : cA; const char* nB = has_next ? (const char*)g.Bt + (size_t)nxt.pb * tstep : cB;
        for (int t = 0; t < nt; t += 2) {
            const bool last = (t == nt - 2);
            const char* a1 = cA + (size_t)(t + 1) * kstep;
            const char* a2 = last ? nA : cA + (size_t)(t + 2) * kstep; const char* b2 = last ? nB : cB + (size_t)(t + 2) * kstep;
            const char* a3 = a2 + kstep; const char* b3 = b2 + kstep;
            PG8_LDB(B0, 0, 0); PG8_LDB(B1, 0, 1); PG8_SCHED; PG8_LDA(At, 0, 0); PG8_STAGE(PG8_SA(1, 1), a1 + hstep, voffA);
            PG8_WAIT_V(8); PG8_WAIT_L(0); PG8_BAR; PG8_MMA(0, 0, At, B0); PG8_MMA(0, 1, At, B1); PG8_BAR; PG8_SCHED;
            PG8_LDA(At, 0, 1); PG8_STAGE(PG8_SB(0, 0), b2, voffB); PG8_STAGE(PG8_SB(0, 1), b2 + hstep, voffB); PG8_STAGE(PG8_SA(0, 0), a2, voffA);
            PG8_WAIT_V(8); PG8_WAIT_L(0); PG8_BAR; PG8_MMA(1, 0, At, B0); PG8_MMA(1, 1, At, B1); PG8_BAR; PG8_SCHED;
            PG8_LDB(B0, 1, 0); PG8_LDB(B1, 1, 1); PG8_SCHED; PG8_LDA(At, 1, 0); PG8_STAGE(PG8_SA(0, 1), a2 + hstep, voffA);
            PG8_WAIT_V(8); PG8_WAIT_L(0); PG8_BAR; PG8_MMA(0, 0, At, B0); PG8_MMA(0, 1, At, B1); PG8_BAR; PG8_SCHED;
            PG8_LDA(At, 1, 1); PG8_STAGE(PG8_SB(1, 0), b3, voffB); PG8_STAGE(PG8_SB(1, 1), b3 + hstep, voffB); PG8_STAGE(PG8_SA(1, 0), a3, voffA);
            PG8_WAIT_V(8); PG8_WAIT_L(0); PG8_BAR; PG8_MMA(1, 0, At, B0); PG8_MMA(1, 1, At, B1); PG8_BAR; PG8_SCHED;
        }
        if constexpr (ALIGN_EPI) { if (wr == 0) PG8_BAR; }
        E(acc, cur, wr, wc, fr, fq);
        if (!has_next) break;
#pragma unroll
        for (int a = 0; a < 2; ++a)
#pragma unroll
            for (int b = 0; b < 2; ++b)
#pragma unroll
                for (int m = 0; m < 4; ++m)
#pragma unroll
                    for (int n = 0; n < 2; ++n) acc[a][b][m][n] = (f32x4){0.f, 0.f, 0.f, 0.f};
        cur = nxt; cA = nA; cB = nB; ++ui;
        if constexpr (ALIGN_EPI) { if (wr == 1) PG8_BAR; }
    }
    PG8_WAIT_V(0);
    if constexpr (!ALIGN_EPI) { if (wr == 0) PG8_BAR; }
    PG8_BAR;
#undef PG8_SA
#undef PG8_SB
#undef PG8_STAGE
#undef PG8_LDA
#undef PG8_LDB
#undef PG8_MMA
#undef PG8_WAIT_V
#undef PG8_WAIT_L
#undef PG8_BAR
#undef PG8_SCHED
}
}
namespace attn_body {
using bf16=__hip_bfloat16;
using bf16x8=__attribute__((ext_vector_type(8)))short;
using s16x4=__attribute__((ext_vector_type(4)))short;
using f32x16=__attribute__((ext_vector_type(16)))float;
using u32x4=__attribute__((ext_vector_type(4)))unsigned;
constexpr int SEQ=16384,D=64,PQ=2816,PO=512;
constexpr int NW=8,QBLK=32,QB=QBLK*NW,KVBLK=64,NQB=SEQ/QB;
constexpr int ATTN_UNIT_ROWS=QB;
__device__ __forceinline__ int crow(int r,int hi){return (r&3)+8*(r>>2)+4*hi;}
#define SBAR() __builtin_amdgcn_sched_barrier(0)
__device__ __forceinline__ void cmask(f32x16&p0,f32x16&p1,int jb,int qrel,int hi){
  const float NEG=-INFINITY; int kb=64*jb+4*hi;
  #pragma unroll
  for(int r=0;r<16;++r){int kv=kb+(r&3)+8*(r>>2); if(kv>qrel)p0[r]=NEG; if(kv+32>qrel)p1[r]=NEG;}
}

constexpr int NSLOT=3, SLOTB=8192;
constexpr int LDS_K=0, LDS_V=NSLOT*SLOTB, LDS_WS=2*NSLOT*SLOTB, LDS_OST=LDS_WS+NW*64*4, LDS_BYTES=LDS_OST+NW*4096;
constexpr float C2=0.125f*1.4426950408889634f;
__device__ __forceinline__ void glds16(const void*gsrc,unsigned lds_dst){unsigned keep;
  asm volatile("s_mov_b32 %0, m0\n\ts_mov_b32 m0, %2\n\ts_nop 0\n\tglobal_load_lds_dwordx4 %1, off\n\ts_mov_b32 m0, %0":"=&s"(keep):"v"(gsrc),"s"(lds_dst):"memory");}
__device__ __forceinline__ float max3f(float a,float b,float c){float r;asm("v_max3_f32 %0, %1, %2, %3":"=v"(r):"v"(a),"v"(b),"v"(c));return r;}
__device__ __forceinline__ float max2f(float a,float b){float r;asm("v_max_f32_e32 %0, %1, %2":"=v"(r):"v"(a),"v"(b));return r;}
__device__ __forceinline__ float fadd_s(float a,float b){float r;asm("v_add_f32_e32 %0, %1, %2":"=v"(r):"v"(a),"v"(b));return r;}
__device__ __forceinline__ float fsub_s(float a,float b){float r;asm("v_sub_f32_e32 %0, %1, %2":"=v"(r):"v"(a),"v"(b));return r;}
typedef float f32x2_t __attribute__((ext_vector_type(2))); typedef __bf16 bf16x2_t __attribute__((ext_vector_type(2)));
__device__ __forceinline__ unsigned cvtpk_s(float lo,float hi){f32x2_t v={lo,hi};bf16x2_t b=__builtin_convertvector(v,bf16x2_t);return __builtin_bit_cast(unsigned,b);}
#define WAIT_BAR(N) asm volatile("s_waitcnt vmcnt(" #N ") lgkmcnt(0)\n\ts_barrier":::"memory")

__device__ __forceinline__ void qkt(f32x16&p0,f32x16&p1,const char*Kslot,const bf16x8*qr,const f32x16&negm,int r32,int hi){
  const char*kb=Kslot+hi*1024+r32*16;
  #pragma unroll
  for(int d0=0;d0<4;++d0){
    const bf16x8 b0=*reinterpret_cast<const bf16x8*>(kb+d0*2048);
    const bf16x8 b1=*reinterpret_cast<const bf16x8*>(kb+d0*2048+512);
    if(d0==0){p0=__builtin_amdgcn_mfma_f32_32x32x16_bf16(b0,qr[0],negm,0,0,0);p1=__builtin_amdgcn_mfma_f32_32x32x16_bf16(b1,qr[0],negm,0,0,0);}
    else{p0=__builtin_amdgcn_mfma_f32_32x32x16_bf16(b0,qr[d0],p0,0,0,0);p1=__builtin_amdgcn_mfma_f32_32x32x16_bf16(b1,qr[d0],p1,0,0,0);}}
}
typedef __attribute__((address_space(3))) const char* lds_cptr;
typedef short v4i16_t __attribute__((ext_vector_type(4)));
__device__ __forceinline__ void kload8(bf16x8*kf,lds_cptr kp){
  kf[0]=*(const __attribute__((address_space(3))) bf16x8*)(kp);      kf[1]=*(const __attribute__((address_space(3))) bf16x8*)(kp+512);
  kf[2]=*(const __attribute__((address_space(3))) bf16x8*)(kp+2048); kf[3]=*(const __attribute__((address_space(3))) bf16x8*)(kp+2560);
  kf[4]=*(const __attribute__((address_space(3))) bf16x8*)(kp+4096); kf[5]=*(const __attribute__((address_space(3))) bf16x8*)(kp+4608);
  kf[6]=*(const __attribute__((address_space(3))) bf16x8*)(kp+6144); kf[7]=*(const __attribute__((address_space(3))) bf16x8*)(kp+6656);
}
__device__ __forceinline__ void kload2(bf16x8*kf,lds_cptr kp,int j){ kf[2*j]=*(const __attribute__((address_space(3))) bf16x8*)(kp+j*2048); kf[2*j+1]=*(const __attribute__((address_space(3))) bf16x8*)(kp+j*2048+512); }
__device__ __forceinline__ s16x4 vtr(lds_cptr p){ return __builtin_bit_cast(s16x4,__builtin_amdgcn_ds_read_tr16_b64_v4i16((__attribute__((address_space(3))) v4i16_t*)p)); }
__device__ __forceinline__ float rowmax(const f32x16&p0,const f32x16&p1){
  float a=max3f(p0[0],p0[1],p1[0]),b=max3f(p0[2],p0[3],p1[1]);a=max3f(a,p1[2],p1[3]);
  #pragma unroll
  for(int r=4;r<16;r+=4){a=max3f(a,p0[r],p0[r+1]);b=max3f(b,p0[r+2],p0[r+3]);a=max3f(a,p1[r],p1[r+1]);b=max3f(b,p1[r+2],p1[r+3]);}
  const float m=max2f(a,b);
  auto rr=__builtin_amdgcn_permlane32_swap(__float_as_uint(m),__float_as_uint(m),false,false);
  return max2f(__uint_as_float(rr[0]),__uint_as_float(rr[1]));
}
__device__ __forceinline__ void pv(f32x16*o,int vb,bf16x8 pa0,bf16x8 pa1,bf16x8 pa2,bf16x8 pa3){
  #pragma unroll
  for(int d0=0;d0<2;++d0){s16x4 lo[4],hi[4];
    #pragma unroll
    for(int ks=0;ks<4;++ks){
      asm volatile("ds_read_b64_tr_b16 %0,%1 offset:%c2":"=&v"(lo[ks]):"v"(vb),"i"(d0*4096+ks*1024):"memory");
      asm volatile("ds_read_b64_tr_b16 %0,%1 offset:%c2":"=&v"(hi[ks]):"v"(vb),"i"(d0*4096+ks*1024+512):"memory");}
    asm volatile("s_waitcnt lgkmcnt(0)":::"memory");SBAR();
    #define PK(k) (bf16x8){lo[k][0],lo[k][1],lo[k][2],lo[k][3],hi[k][0],hi[k][1],hi[k][2],hi[k][3]}
    o[d0]=__builtin_amdgcn_mfma_f32_32x32x16_bf16(pa0,PK(0),o[d0],0,0,0);
    o[d0]=__builtin_amdgcn_mfma_f32_32x32x16_bf16(pa1,PK(1),o[d0],0,0,0);
    o[d0]=__builtin_amdgcn_mfma_f32_32x32x16_bf16(pa2,PK(2),o[d0],0,0,0);
    o[d0]=__builtin_amdgcn_mfma_f32_32x32x16_bf16(pa3,PK(3),o[d0],0,0,0);
    #undef PK
  }
}

#ifndef ATTN_STORE16
#define ATTN_STORE16(p,v) (*(u32x4*)(p)=(v))
#endif
template<int THRL> __device__ __forceinline__ void attn_unit(const int tid,int qb,const bf16*Qh,const bf16*__restrict__ Kh,const bf16*__restrict__ Vh,bf16*Oh,char*shm){
  const int lane=tid&63,r32=lane&31,hi=lane>>5; const int wid=__builtin_amdgcn_readfirstlane(tid>>6);
  const int q0=qb*QB;
  const bf16*Qw=Qh+(long)(q0+wid*QBLK)*PQ;
  const unsigned lds0=(unsigned)(uintptr_t)shm;
  float*wsf=(float*)(shm+LDS_WS)+wid*64;
  const bf16*ksrc=Kh+(long)lane*PQ+wid*8;
  const bf16*vsrc=Vh+(long)(16*(wid&3)+(lane>>2))*PQ+(wid>>2)*32+(lane&3)*8;
  const unsigned kdst=lds0+LDS_K+wid*1024, vdst=lds0+LDS_V+wid*1024;
  #define DMA_K(t,slot) glds16(ksrc+(long)(t)*KVBLK*PQ,(unsigned)__builtin_amdgcn_readfirstlane(kdst+(slot)))
  #define DMA_V(t,slot) glds16(vsrc+(long)(t)*KVBLK*PQ,(unsigned)__builtin_amdgcn_readfirstlane(vdst+(slot)))
  const int vb0=(int)(lds0+LDS_V)+((lane>>4)&1)*32+(lane&3)*8+(4*hi+((lane&15)>>2))*64;
  const char*Kbase=shm+LDS_K; bf16x8 kf[8];
  const lds_cptr shm3=(lds_cptr)shm; const lds_cptr kp0=shm3+LDS_K+hi*1024+r32*16; const lds_cptr vp0=shm3+LDS_V+((lane>>4)&1)*32+(lane&3)*8+(4*hi+((lane&15)>>2))*64;
  const int NT=(q0+QB)/KVBLK;
  DMA_K(0,0);DMA_V(0,0);DMA_K(1,SLOTB);
  bf16x8 qr[4];
  #pragma unroll
  for(int d0=0;d0<4;++d0)qr[d0]=*reinterpret_cast<const bf16x8*>(&Qw[(long)r32*PQ+d0*16+hi*8]);
  float mhat=0.f,l_reg=0.f;f32x16 o[2];o[0]=f32x16{};o[1]=f32x16{};const f32x16 negm=f32x16{};
  const int qrel=wid*QBLK+r32;
  #define CMASK(P0,P1,t) do{int jb_=(t)-(NT-4); if(jb_>=0)cmask(P0,P1,jb_,qrel,hi);}while(0)
  bool resc=false;
  #define START(P0,P1) do{ const float rm=rowmax(P0,P1); resc=false; \
    { const float dl=rm; mhat=fadd_s(mhat,dl); \
      _Pragma("unroll") for(int r=0;r<16;++r){P0[r]=fsub_s(P0[r],dl);P1[r]=fsub_s(P1[r],dl);} \
      } \
    _Pragma("unroll") for(int r=0;r<16;++r)P0[r]=__builtin_amdgcn_exp2f(P0[r]); }while(0)
  #define RESC() do{ if(resc){ asm volatile("s_waitcnt lgkmcnt(0)":::"memory"); \
      _Pragma("unroll") for(int d_=0;d_<2;++d_) _Pragma("unroll") for(int r=0;r<16;++r)o[d_][r]*=wsf[crow(r,hi)]; } }while(0)
  f32x16 pA0,pA1,pB0,pB1;
  int sl_prev=0,sl_cur=0,sl_next=SLOTB;
  #define ROT() do{sl_prev=sl_cur;sl_cur=sl_next;sl_next=(sl_next==(NSLOT-1)*SLOTB)?0:sl_next+SLOTB;}while(0)
  DMA_K(2,2*SLOTB);
  WAIT_BAR(3);
  qkt(pA0,pA1,Kbase,qr,negm,r32,hi);asm volatile("s_nop 15\n\ts_nop 7":"+v"(pA0),"+v"(pA1));CMASK(pA0,pA1,0);
  START(pA0,pA1);
  _Pragma("unroll") for(int r=0;r<16;++r)pA1[r]=__builtin_amdgcn_exp2f(pA1[r]);
  WAIT_BAR(0);
  DMA_K(3,0);DMA_V(1,SLOTB);
  ROT();
  kload8(kf,kp0+sl_cur);
  WAIT_BAR(2);
  s16x4 vlo[8],vhi[8]; u32x4 pw0,pw1,pw2,pw3;
  #define PKW(P,B) cvtpk_s(P[B],P[B+1])
  #define PAF(k) __builtin_bit_cast(bf16x8,pw##k)
  #define VFR(i) (bf16x8){vlo[i][0],vlo[i][1],vlo[i][2],vlo[i][3],vhi[i][0],vhi[i][1],vhi[i][2],vhi[i][3]}
  #define PIN(x) asm volatile("":"+v"(x))
  #define MX3(a,b,c) __builtin_fmaxf(__builtin_fmaxf((a),(b)),(c))
  #define GAPA(MF,A0,A1,A2,A3,W0,W1,PW) do{ MF; sacc+=A0; sacc+=A1; sacc+=A2; sacc+=A3; PIN(sacc); W0; W1; PIN(PW); SBAR(); }while(0)
  #define EX(v) __builtin_amdgcn_exp2f(v)
  #define GAPB(MF,X,B) do{ MF; X[B]=EX(X[B]-mhat); X[B+1]=EX(X[B+1]-mhat); X[B+2]=EX(X[B+2]-mhat); X[B+3]=EX(X[B+3]-mhat); PIN(X); SBAR(); }while(0)
  #define VRD(i) do{ vlo[i]=vtr(vp_+(((i)>>2)*4096+((i)&3)*1024)); vhi[i]=vtr(vp_+(((i)>>2)*4096+((i)&3)*1024+512)); }while(0)
  #define KRD(G,j) do{ if(G){ kload2(kf,kp0+sl_next,j); SBAR(); } }while(0)
  #define STEP(C0,C1,P0,P1,t,GK,GV,GL) do{ SBAR(); \
    const lds_cptr vp_=vp0+sl_prev; \
    VRD(0); SBAR(); float sacc=(P0[0]+P0[1]); \
    GAPA(C0=__builtin_amdgcn_mfma_f32_32x32x16_bf16(kf[0],qr[0],negm,0,0,0), P0[2],P0[3],P0[4],P0[5],     pw0[0]=PKW(P0,0), pw0[1]=PKW(P0,2), pw0); \
    VRD(4); SBAR(); GAPA(C1=__builtin_amdgcn_mfma_f32_32x32x16_bf16(kf[1],qr[0],negm,0,0,0), P0[6],P0[7],P0[8],P0[9],     pw0[2]=PKW(P0,4), pw0[3]=PKW(P0,6), pw0); \
    VRD(1); SBAR(); GAPA(C0=__builtin_amdgcn_mfma_f32_32x32x16_bf16(kf[2],qr[1],C0,0,0,0),   P0[10],P0[11],P0[12],P0[13], pw1[0]=PKW(P0,8), pw1[1]=PKW(P0,10), pw1); \
    VRD(5); SBAR(); GAPA(C1=__builtin_amdgcn_mfma_f32_32x32x16_bf16(kf[3],qr[1],C1,0,0,0),   P0[14],P0[15],P1[0],P1[1],   pw1[2]=PKW(P0,12),pw1[3]=PKW(P0,14), pw1); \
    VRD(2); SBAR(); GAPA(C0=__builtin_amdgcn_mfma_f32_32x32x16_bf16(kf[4],qr[2],C0,0,0,0),   P1[2],P1[3],P1[4],P1[5],     pw2[0]=PKW(P1,0), pw2[1]=PKW(P1,2), pw2); \
    VRD(6); SBAR(); GAPA(C1=__builtin_amdgcn_mfma_f32_32x32x16_bf16(kf[5],qr[2],C1,0,0,0),   P1[6],P1[7],P1[8],P1[9],     pw2[2]=PKW(P1,4), pw2[3]=PKW(P1,6), pw2); \
    VRD(3); SBAR(); GAPA(C0=__builtin_amdgcn_mfma_f32_32x32x16_bf16(kf[6],qr[3],C0,0,0,0),   P1[10],P1[11],P1[12],P1[13], pw3[0]=PKW(P1,8), pw3[1]=PKW(P1,10), pw3); \
    VRD(7); SBAR(); GAPA(C1=__builtin_amdgcn_mfma_f32_32x32x16_bf16(kf[7],qr[3],C1,0,0,0),   P1[14],P1[15],0.f,0.f,       pw3[2]=PKW(P1,12),pw3[3]=PKW(P1,14), pw3); \
    l_reg+=sacc; \
    if(GK){DMA_K((t)+3,sl_cur);} if(GV){DMA_V((t)+1,sl_next);} \
    CMASK(C0,C1,t); \
    { float a=MX3(C0[0],C0[1],C1[0]),b=MX3(C0[2],C0[3],C1[1]); a=MX3(a,C1[2],C1[3]); \
      _Pragma("unroll") for(int r=4;r<16;r+=4){a=MX3(a,C0[r],C0[r+1]);b=MX3(b,C0[r+2],C0[r+3]);a=MX3(a,C1[r],C1[r+1]);b=MX3(b,C1[r+2],C1[r+3]);} \
      float rm=__builtin_fmaxf(a,b); { auto rr=__builtin_amdgcn_permlane32_swap(__float_as_uint(rm),__float_as_uint(rm),false,false); rm=__builtin_fmaxf(__uint_as_float(rr[0]),__uint_as_float(rr[1])); } \
      resc=false; \
      rm-=mhat; \
      if(__builtin_expect(__any(rm>(float)THRL),0)){ const float dl=__builtin_fmaxf(rm,0.f); mhat+=dl; \
        const float f=__builtin_amdgcn_exp2f(-dl); l_reg*=f; if(hi==0)wsf[r32]=f; resc=true; } } \
    SBAR(); \
    GAPB(o[0]=__builtin_amdgcn_mfma_f32_32x32x16_bf16(PAF(0),VFR(0),o[0],0,0,0), C0,0); \
    GAPB(o[1]=__builtin_amdgcn_mfma_f32_32x32x16_bf16(PAF(0),VFR(4),o[1],0,0,0), C0,4); \
    KRD(GL,0); GAPB(o[0]=__builtin_amdgcn_mfma_f32_32x32x16_bf16(PAF(1),VFR(1),o[0],0,0,0), C0,8); \
    KRD(GL,1); GAPB(o[1]=__builtin_amdgcn_mfma_f32_32x32x16_bf16(PAF(1),VFR(5),o[1],0,0,0), C0,12); \
    KRD(GL,2); GAPB(o[0]=__builtin_amdgcn_mfma_f32_32x32x16_bf16(PAF(2),VFR(2),o[0],0,0,0), C1,0); \
    KRD(GL,3); GAPB(o[1]=__builtin_amdgcn_mfma_f32_32x32x16_bf16(PAF(2),VFR(6),o[1],0,0,0), C1,4); \
    GAPB(o[0]=__builtin_amdgcn_mfma_f32_32x32x16_bf16(PAF(3),VFR(3),o[0],0,0,0), C1,8); \
    GAPB(o[1]=__builtin_amdgcn_mfma_f32_32x32x16_bf16(PAF(3),VFR(7),o[1],0,0,0), C1,12); \
    }while(0)
  int t=1;
  #undef CMASK
  #define CMASK(P0,P1,t) do{}while(0)
  for(;t+5<NT;t+=2){
    STEP(pB0,pB1,pA0,pA1,t,true,true,true);     WAIT_BAR(2); RESC(); ROT();
    STEP(pA0,pA1,pB0,pB1,t+1,true,true,true);   WAIT_BAR(2); RESC(); ROT();
  }
  #undef CMASK
  #define CMASK(P0,P1,t) do{int jb_=(t)-(NT-4); if(jb_>=0)cmask(P0,P1,jb_,qrel,hi);}while(0)
  #define ENDW(tt) do{ if((tt)+3<NT){WAIT_BAR(2);} else if((tt)+2<NT){WAIT_BAR(1);} else {WAIT_BAR(0);} }while(0)
  for(;t+1<NT;t+=2){
    STEP(pB0,pB1,pA0,pA1,t,(t+3<NT),(t+1<NT),(t+1<NT));       ENDW(t);   RESC(); ROT();
    STEP(pA0,pA1,pB0,pB1,t+1,(t+4<NT),(t+2<NT),(t+2<NT));     ENDW(t+1); RESC(); ROT();
  }
  STEP(pB0,pB1,pA0,pA1,NT-1,false,false,false); RESC();
  { float sacc=pB0[0]+pB0[1]; _Pragma("unroll") for(int r=2;r<16;++r)sacc+=pB0[r]; _Pragma("unroll") for(int r=0;r<16;++r)sacc+=pB1[r]; l_reg+=sacc;
    pw0=(u32x4){PKW(pB0,0),PKW(pB0,2),PKW(pB0,4),PKW(pB0,6)};pw1=(u32x4){PKW(pB0,8),PKW(pB0,10),PKW(pB0,12),PKW(pB0,14)};pw2=(u32x4){PKW(pB1,0),PKW(pB1,2),PKW(pB1,4),PKW(pB1,6)};pw3=(u32x4){PKW(pB1,8),PKW(pB1,10),PKW(pB1,12),PKW(pB1,14)};
    SBAR(); pv(o,vb0+sl_cur,PAF(0),PAF(1),PAF(2),PAF(3)); }
  #undef PKW
  #undef PAF
  #undef VFR
  #undef PIN
  #undef MX3
  #undef GAPA
  #undef GAPB
  #undef EX
  #undef VRD
  #undef KRD
  #undef STEP
  #undef ENDW
  {auto rr=__builtin_amdgcn_permlane32_swap(__float_as_uint(l_reg),__float_as_uint(l_reg),false,false);l_reg=__uint_as_float(rr[0])+__uint_as_float(rr[1]);}
  if(hi==0)wsf[32+r32]=l_reg;asm volatile("s_waitcnt lgkmcnt(0)":::"memory");
  float rli[16];
  #pragma unroll
  for(int r=0;r<16;++r)rli[r]=__builtin_amdgcn_rcpf(wsf[32+crow(r,hi)]);
  bf16*Ow=Oh+(long)(q0+wid*QBLK)*PO;
  { bf16*stg=(bf16*)(shm+LDS_OST)+wid*2048;
    #pragma unroll
    for(int r=0;r<16;++r){const int orow=crow(r,hi);
      #pragma unroll
      for(int d0=0;d0<2;++d0)stg[orow*64+d0*32+r32]=__float2bfloat16(o[d0][r]*rli[r]);}
    asm volatile("s_waitcnt lgkmcnt(0)":::"memory");
    #pragma unroll
    for(int i=0;i<4;++i){const int row=i*8+(lane>>3),ch=lane&7; const u32x4 v=*(const u32x4*)(stg+row*64+ch*8); ATTN_STORE16(Ow+(long)row*PO+ch*8,v);} }
  asm volatile("s_waitcnt lgkmcnt(0)\n\ts_barrier":::"memory");
  #undef DMA_K
  #undef DMA_V
  #undef CMASK
  #undef START
  #undef RESC
  #undef ROT
}
constexpr int ATTN_LDS_BYTES=LDS_BYTES;
#undef SBAR
#undef WAIT_BAR
}
#define GAS __attribute__((address_space(1)))
#define LAS __attribute__((address_space(3)))
typedef unsigned short bf16;
typedef unsigned v4u __attribute__((ext_vector_type(4)));
typedef float f32x4 __attribute__((ext_vector_type(4)));
typedef short bf16x8 __attribute__((ext_vector_type(8)));
typedef GAS unsigned gu32;
typedef GAS unsigned long long gu64;
#define RLX_AGENT __ATOMIC_RELAXED, __HIP_MEMORY_SCOPE_AGENT
#define LDS_WAIT() asm volatile("s_waitcnt lgkmcnt(0)" ::: "memory")
#define VM_WAIT() asm volatile("s_waitcnt vmcnt(0)" ::: "memory")
__device__ __forceinline__ unsigned long long rt() { return __builtin_amdgcn_s_memrealtime(); }
__device__ __forceinline__ unsigned f2bf(float f) { unsigned u = __builtin_bit_cast(unsigned, f); return (u + 0x7fffu + ((u >> 16) & 1u)) >> 16; }
__device__ __forceinline__ unsigned pk2(float lo, float hi) { return f2bf(lo) | (f2bf(hi) << 16); }

#define XB_TMO      128
#define XB_XCNT(j)  (256  + 64 * (j))
#define XB_XSUB(j)  (1280 + 64 * (j))
#define XB_XGEN(j)  (2304 + 64 * (j))
#define XB_TOP      3328
#define XB_TOPGEN   3392
#define XCD_BAR_WORDS 3456
#define XB_SPIN_CAP (1u << 18)

__device__ __forceinline__ unsigned xb_ld(unsigned* p)              { return __hip_atomic_load(p, __ATOMIC_RELAXED, __HIP_MEMORY_SCOPE_AGENT); }
__device__ __forceinline__ unsigned xb_add(unsigned* p, unsigned v) { return __hip_atomic_fetch_add(p, v, __ATOMIC_RELAXED, __HIP_MEMORY_SCOPE_AGENT); }
__device__ __forceinline__ unsigned xb_xcc_id() { return (unsigned)__builtin_amdgcn_s_getreg((3 << 11) | 20) & 0xFu; }
#define XB_SPIN(cond, bar) do { unsigned _sp = 0; while (cond) { __builtin_amdgcn_s_sleep(1); \
    if ((++_sp & 255u) == 0u) { if (xb_ld(&(bar)[XB_TMO])) break; if (_sp > XB_SPIN_CAP) { atomicAdd(&(bar)[XB_TMO], 1u); break; } } } } while (0)

struct XcdBarrier {
    unsigned* bar; unsigned x;
    volatile LAS unsigned* st;
};

__device__ __forceinline__ XcdBarrier xcd_barrier_post(unsigned* bar, volatile LAS unsigned* st, const int tid) {
    XcdBarrier b; b.bar = bar; b.x = xb_xcc_id(); b.st = st;
    if (tid == 0) (void)xb_add(&bar[XB_XCNT(b.x)], 1u);
    return b;
}
__device__ __forceinline__ void xcd_barrier_complete(unsigned* bar, unsigned x, unsigned& nloc, unsigned& nx) {
    const unsigned G = gridDim.x * gridDim.y * gridDim.z;
    unsigned sum, cnt, mine, sp = 0u;
    for (;;) {
        sum = 0u; cnt = 0u; mine = 0u;
#pragma unroll
        for (unsigned j = 0; j < 16; ++j) { const unsigned c = xb_ld(&bar[XB_XCNT(j)]); sum += c; cnt += (c > 0u) ? 1u : 0u; mine = (j == x) ? c : mine; }
        if (sum == G) break;
        __builtin_amdgcn_s_sleep(1);
        if ((++sp & 255u) == 0u) { if (xb_ld(&bar[XB_TMO])) break; if (sp > XB_SPIN_CAP) { atomicAdd(&bar[XB_TMO], 1u); break; } }
    }
    nloc = mine > 0u ? mine : 1u; nx = cnt > 0u ? cnt : 1u;
}

__device__ __forceinline__ void xcd_barrier(const XcdBarrier& b, const int tid) {
    asm volatile("s_waitcnt vmcnt(0)" ::: "memory");
    __syncthreads();
    if (tid == 0) {
        unsigned* bar = b.bar;
        __builtin_amdgcn_s_waitcnt(0);
        unsigned nloc = b.st[0], nx = b.st[1];
        if (nloc == 0u) { xcd_barrier_complete(bar, b.x, nloc, nx); b.st[0] = nloc; b.st[1] = nx; }
        const unsigned old = xb_add(&bar[XB_XSUB(b.x)], 1u);
        const unsigned gen = old / nloc;
        if (old + 1u == (gen + 1u) * nloc) {
            __builtin_amdgcn_fence(__ATOMIC_RELEASE, "agent");
            asm volatile("s_waitcnt vmcnt(0)" ::: "memory");
            const unsigned og = xb_add(&bar[XB_TOP], 1u);
            const unsigned tg = og / nx;
            if (og + 1u == (tg + 1u) * nx) xb_add(&bar[XB_TOPGEN], 1u);
            else XB_SPIN(xb_ld(&bar[XB_TOPGEN]) == tg, bar);
            __builtin_amdgcn_fence(__ATOMIC_ACQUIRE, "agent");
            xb_add(&bar[XB_XGEN(b.x)], 1u);
            asm volatile("s_waitcnt vmcnt(0)" ::: "memory");
        } else {
            XB_SPIN(xb_ld(&bar[XB_XGEN(b.x)]) == gen, bar);
            __builtin_amdgcn_fence(__ATOMIC_ACQUIRE, "agent");
            asm volatile("s_waitcnt vmcnt(0)" ::: "memory");
        }
    }
    __syncthreads();
}
constexpr int NWAVES = 8;
#ifndef MK_N_LAUNCHES
#define MK_N_LAUNCHES 1
#endif
constexpr int NPH_LAYER = 11, NPH = 2 + 2 * NPH_LAYER;
constexpr int N_LAUNCHES = MK_N_LAUNCHES;
static_assert(N_LAUNCHES == 1 || N_LAUNCHES == NPH, "MK_N_LAUNCHES is 1 or NPH");

constexpr int SEQ = 16384, DMODEL = 1024, DIN = 2816, FFD = 2816, NEXP = 8, EDIM = 3584, DEPTH = 2;
constexpr int M = SEQ;
constexpr float LN_EPS = 1e-5f;
constexpr float ALPHA = 1.4142135623730951f;
constexpr int MAXSLOT = 135 * 256;

constexpr size_t MiB = 1u << 20;
constexpr size_t WS_CTL = 0, CTL_ZERO_BYTES = 1 * MiB;
constexpr size_t WS_SMALL = 1 * MiB;
constexpr size_t SM_MOD = 0, SM_LBS = 49152, SM_LAM = 51200, SM_TOK = 65536, SM_PERM = 327680;
constexpr size_t WS_ROPE = 2 * MiB;
constexpr size_t WS_EXP13 = 6 * MiB, WS_EXP2 = 118 * MiB;
constexpr size_t WS_HPERM = 174 * MiB;
constexpr size_t WS_YSLOT = 174 * MiB;
constexpr size_t WS_HID = 242 * MiB;
constexpr size_t WS_PROJ = 242 * MiB, WS_DHID = 242 * MiB;
constexpr size_t WS_ATTNO = 330 * MiB, WS_HBUF = 330 * MiB;
constexpr size_t WS_MIX = 362 * MiB, WS_HGS = 394 * MiB, WS_HGD = 410 * MiB;
constexpr size_t WS_WIN = 411 * MiB, WS_WOUT = 422 * MiB, WS_FFN13 = 426 * MiB, WS_FFN2 = 437 * MiB;
constexpr size_t WS_END = 479 * MiB;
static_assert(WS_YSLOT + (size_t)MAXSLOT * 1024 * 2 <= WS_HID && WS_HID + (size_t)MAXSLOT * 3584 * 2 <= WS_END && WS_FFN2 + (size_t)1024 * 2816 * 2 <= WS_END, "d_ws map");
constexpr int CW_TMO = 0, CW_CODE = 1;
constexpr int CW_CNT = 64;
constexpr int CW_BAR = 4096;

constexpr int RING_OFF = 0, RING_BYTES = 131072;
constexpr int LDSCTL_OFF = RING_BYTES, MISC_OFF = LDSCTL_OFF + 320;
constexpr int XTRA_OFF = LDSCTL_OFF + 1024;
constexpr int LDS_BYTES = 147456;

__device__ __forceinline__ float bf2f(unsigned short b) { return __uint_as_float((unsigned)b << 16); }
template <int O> __device__ __forceinline__ float swzx(float v) { return __int_as_float(__builtin_amdgcn_ds_swizzle(__float_as_int(v), (O << 10) | 0x1f)); }
__device__ __forceinline__ float wave_sum(float v) {
    v += swzx<1>(v); v += swzx<2>(v); v += swzx<4>(v); v += swzx<8>(v); v += swzx<16>(v);
    auto rr = __builtin_amdgcn_permlane32_swap(__float_as_uint(v), __float_as_uint(v), false, false);
    return __uint_as_float(rr[0]) + __uint_as_float(rr[1]);
}
__device__ __forceinline__ float sigmoid_f(float z) { return __builtin_amdgcn_rcpf(1.0f + __builtin_amdgcn_exp2f(-1.4426950408889634f * z)); }
__device__ __forceinline__ float silu_ff(float a) { return a * sigmoid_f(a); }

struct Args { const float* in[23]; float* out; unsigned char* ws; int ph_lo, ph_hi, li, pad; };
enum { I_X = 0, I_C, I_WADA, I_BADA, I_WIN, I_LAMQK, I_ATTNG, I_HGLB, I_HGG, I_POOLW, I_POOLS, I_WOUT, I_LN1G, I_LN1B, I_LN2G, I_LN2B, I_FW1, I_FW3, I_FW2, I_RW, I_EW1, I_EW3, I_EW2 };

struct Frame {
    LAS unsigned char* lds; volatile LAS unsigned* MISC; gu32* ctl; unsigned char* ws;
    int tid, lane, wave, vcu, G, bid;
};

__device__ const float kInvFreq[32] = {1.f, 0.749894202f, 0.562341332f, 0.421696514f, 0.316227764f, 0.237137392f, 0.177827939f, 0.133352146f, 0.100000001f, 0.0749894157f, 0.0562341288f, 0.0421696492f,
    0.0316227786f, 0.0237137359f, 0.0177827943f, 0.0133352149f, 0.00999999978f, 0.00749894232f, 0.00562341325f, 0.00421696482f, 0.00316227786f, 0.00237137382f, 0.00177827943f, 0.00133352145f,
    0.00100000005f, 0.000749894185f, 0.000562341302f, 0.000421696546f, 0.000316227786f, 0.000237137385f, 0.00017782794f, 0.00013335215f};

template <int KIND> __device__ __forceinline__ int rowmap(int n) {
    if (KIND == 0) { if (n >= 1024) return n; const int d = n & 63; return (n & ~63) + ((d < 32) ? 2 * d : 2 * (d - 32) + 1); }
    if (KIND == 2) return ((n >> 7) << 8) + (n & 127);
    if (KIND == 3) return ((n >> 7) << 8) + 128 + (n & 127);
    return n;
}
template <int KIND> __device__ __forceinline__ void transpose_item(const float* W, int K, int N, bf16* WT, LAS float* scr, int item, int lane) {
    const int nblk = N / 32, kb = item / nblk, nb = item % nblk, k0 = 64 * kb, n0 = 32 * nb;
#pragma unroll 8
    for (int i = 0; i < 32; ++i) { const int kk = 2 * i + (lane >> 5); scr[kk * 33 + (lane & 31)] = W[(size_t)(k0 + kk) * N + n0 + (lane & 31)]; }
    LDS_WAIT(); asm volatile("" ::: "memory");
    const int c = lane & 7;
#pragma unroll
    for (int j = 0; j < 4; ++j) { const int n = (lane >> 3) + 8 * j; const LAS float* s = scr + (8 * c) * 33 + n;
        v4u o; o.x = pk2(s[0 * 33], s[1 * 33]); o.y = pk2(s[2 * 33], s[3 * 33]); o.z = pk2(s[4 * 33], s[5 * 33]); o.w = pk2(s[6 * 33], s[7 * 33]);
        *(GAS v4u*)(WT + (size_t)rowmap<KIND>(n0 + n) * K + k0 + 8 * c) = o; }
    LDS_WAIT(); asm volatile("" ::: "memory");
}
__device__ __forceinline__ void sincos_acc(float ang, float& s, float& c) {
    const double a = (double)ang; const double n = __builtin_rint(a * 0.63661977236758134308);
    double r = __builtin_fma(-n, 1.57079632679489655800, a); r = __builtin_fma(-n, 6.12323399573676603587e-17, r);
    const double r2 = r * r;
    double sp = -1.0 / 1307674368000.0; sp = sp * r2 + 1.0 / 6227020800.0; sp = sp * r2 - 1.0 / 39916800.0; sp = sp * r2 + 1.0 / 362880.0; sp = sp * r2 - 1.0 / 5040.0; sp = sp * r2 + 1.0 / 120.0; sp = sp * r2 - 1.0 / 6.0;
    const double sr = r + r * r2 * sp;
    double cp = 1.0 / 20922789888000.0; cp = cp * r2 - 1.0 / 87178291200.0; cp = cp * r2 + 1.0 / 479001600.0; cp = cp * r2 - 1.0 / 3628800.0; cp = cp * r2 + 1.0 / 40320.0; cp = cp * r2 - 1.0 / 720.0; cp = cp * r2 + 1.0 / 24.0; cp = cp * r2 - 0.5;
    const double cr = 1.0 + r2 * cp;
    const int q = ((int)n) & 3;
    const double ss = (q == 0) ? sr : (q == 1) ? cr : (q == 2) ? -sr : -cr;
    const double cc = (q == 0) ? cr : (q == 1) ? -sr : (q == 2) ? -cr : sr;
    s = (float)ss; c = (float)cc;
}
__device__ __forceinline__ void p0a_prologue(Frame& F, const Args& A) {
    const int gw = F.vcu * NWAVES + F.wave, NGW = F.G * NWAVES;
    {
        LAS float* red = (LAS float*)(F.lds + XTRA_OFF);
        for (int cb = F.bid; cb < 256; cb += F.G) {
            const int fc = cb * 48 + F.lane; const int l = fc / 6144, j = fc % 6144; float acc = 0.f;
            if (F.lane < 48) {
                const float* w = A.in[I_WADA] + (size_t)l * 1024 * 6144 + j; const float* c = A.in[I_C];
#pragma unroll 8
                for (int k = F.wave * 128; k < F.wave * 128 + 128; ++k) acc += silu_ff(c[k]) * w[(size_t)k * 6144];
            }
            red[F.wave * 64 + F.lane] = acc;
            __syncthreads();
            if (F.wave == 0 && F.lane < 48) { float s = 0.f;
#pragma unroll
                for (int w8 = 0; w8 < 8; ++w8) s += red[w8 * 64 + F.lane];
                ((float*)(F.ws + WS_SMALL + SM_MOD))[fc] = s + A.in[I_BADA][fc]; }
            __syncthreads();
        }
    }
    {
        float* cosT = (float*)(F.ws + WS_ROPE); float* sinT = cosT + (size_t)SEQ * 32;
        for (int idx = F.bid * (NWAVES * 64) + F.tid; idx < SEQ * 32; idx += F.G * NWAVES * 64) {
            const int pos = idx >> 5, i = idx & 31; const float ang = (float)pos * kInvFreq[i]; float s, c; sincos_acc(ang, s, c);
            cosT[idx] = c; sinT[idx] = s; }
    }
    if (F.bid == 0) {
        float* lbs = (float*)(F.ws + WS_SMALL + SM_LBS); float* lam = (float*)(F.ws + WS_SMALL + SM_LAM);
        if (F.tid < 256) { const float a0 = A.in[I_HGLB][F.tid], a1 = A.in[I_HGLB][256 + F.tid]; const float mx = fmaxf(a0, a1); const float e0 = __expf(a0 - mx), e1 = __expf(a1 - mx);
            lbs[F.tid] = 0.f; lbs[256 + F.tid] = e1 / (e0 + e1); }
        if (F.tid >= 256 && F.tid < 258) { const int l = F.tid - 256; const float* q = A.in[I_LAMQK] + l * 256; float s1 = 0.f, s2 = 0.f;
            for (int j = 0; j < 64; ++j) { s1 += q[j] * q[64 + j]; s2 += q[128 + j] * q[192 + j]; }
            const float li = 0.8f - 0.6f * expf(-0.3f * (float)l); lam[l] = expf(s1) - expf(s2) + li; lam[2 + l] = li; }
    }
    LAS float* scr = (LAS float*)(F.lds + RING_OFF + F.wave * 16384);
    constexpr int I_WI = 16 * 88, I_WO = 16 * 32, I_F13 = 16 * 88, I_F2 = 44 * 32, I_E13 = 16 * 112, I_E2 = 56 * 32;
    constexpr int NITEMS = 2 * I_WI + 2 * I_WO + 2 * I_F13 + I_F2 + 16 * I_E13 + 8 * I_E2;
    for (int it = gw; it < NITEMS; it += NGW) {
        int r = it;
        if (r < 2 * I_WI) { const int l = r / I_WI; transpose_item<0>(A.in[I_WIN] + (size_t)l * 1024 * DIN, 1024, DIN, (bf16*)(F.ws + WS_WIN) + (size_t)l * DIN * 1024, scr, r % I_WI, F.lane); continue; } r -= 2 * I_WI;
        if (r < 2 * I_WO) { const int l = r / I_WO; transpose_item<1>(A.in[I_WOUT] + (size_t)l * 1024 * 1024, 1024, 1024, (bf16*)(F.ws + WS_WOUT) + (size_t)l * 1024 * 1024, scr, r % I_WO, F.lane); continue; } r -= 2 * I_WO;
        if (r < I_F13) { transpose_item<2>(A.in[I_FW1], 1024, FFD, (bf16*)(F.ws + WS_FFN13), scr, r, F.lane); continue; } r -= I_F13;
        if (r < I_F13) { transpose_item<3>(A.in[I_FW3], 1024, FFD, (bf16*)(F.ws + WS_FFN13), scr, r, F.lane); continue; } r -= I_F13;
        if (r < I_F2) { transpose_item<1>(A.in[I_FW2], FFD, 1024, (bf16*)(F.ws + WS_FFN2), scr, r, F.lane); continue; } r -= I_F2;
        if (r < 8 * I_E13) { const int e = r / I_E13; transpose_item<2>(A.in[I_EW1] + (size_t)e * 1024 * EDIM, 1024, EDIM, (bf16*)(F.ws + WS_EXP13) + (size_t)e * 2 * EDIM * 1024, scr, r % I_E13, F.lane); continue; } r -= 8 * I_E13;
        if (r < 8 * I_E13) { const int e = r / I_E13; transpose_item<3>(A.in[I_EW3] + (size_t)e * 1024 * EDIM, 1024, EDIM, (bf16*)(F.ws + WS_EXP13) + (size_t)e * 2 * EDIM * 1024, scr, r % I_E13, F.lane); continue; } r -= 8 * I_E13;
        { const int e = r / I_E2; transpose_item<1>(A.in[I_EW2] + (size_t)e * EDIM * 1024, EDIM, 1024, (bf16*)(F.ws + WS_EXP2) + (size_t)e * 1024 * EDIM, scr, r % I_E2, F.lane); }
    }
}

__device__ __forceinline__ void load4(f32x4 (&v)[4], const float* p, int lane) { const GAS f32x4* q = (const GAS f32x4*)p + lane;
#pragma unroll
    for (int j = 0; j < 4; ++j) v[j] = q[64 * j]; }
__device__ __forceinline__ void store_bf16_row(bf16* orow, const f32x4 (&v)[4], int lane) {
    GAS unsigned long long* o8 = (GAS unsigned long long*)orow + lane;
#pragma unroll
    for (int j = 0; j < 4; ++j) o8[64 * j] = (unsigned long long)pk2(v[j].x, v[j].y) | ((unsigned long long)pk2(v[j].z, v[j].w) << 32);
}
__device__ __forceinline__ void store_f32_row(float* orow, const f32x4 (&v)[4], int lane) { GAS f32x4* o = (GAS f32x4*)orow + lane;
#pragma unroll
    for (int j = 0; j < 4; ++j) o[64 * j] = v[j]; }
__device__ __forceinline__ void ln_row(f32x4 (&v)[4], const f32x4 (&g)[4], const f32x4 (&b)[4]) {
    float s = 0.f;
#pragma unroll
    for (int j = 0; j < 4; ++j) s += (v[j].x + v[j].y) + (v[j].z + v[j].w);
    const float mean = wave_sum(s) * (1.f / DMODEL); float s2 = 0.f;
#pragma unroll
    for (int j = 0; j < 4; ++j) { v[j] = v[j] - mean; s2 += (v[j].x * v[j].x + v[j].y * v[j].y) + (v[j].z * v[j].z + v[j].w * v[j].w); }
    const float rstd = 1.f / sqrtf(wave_sum(s2) * (1.f / DMODEL) + LN_EPS);
#pragma unroll
    for (int j = 0; j < 4; ++j) v[j] = v[j] * rstd * g[j] + b[j];
}
__device__ __forceinline__ void p_modulate(Frame& F, const float* x, const float* mod  , bf16* H) {
    const int gw = F.vcu * NWAVES + F.wave, NGW = F.G * NWAVES;
    f32x4 sh[4], sc[4]; load4(sh, mod, F.lane); load4(sc, mod + 1024, F.lane);
    for (int m = gw; m < M; m += NGW) { f32x4 v[4]; load4(v, x + (size_t)m * DMODEL, F.lane);
#pragma unroll
        for (int j = 0; j < 4; ++j) v[j] = v[j] * (sc[j] + 1.0f) + sh[j];
        store_bf16_row(H + (size_t)m * DMODEL, v, F.lane); }
}
template <bool ROUTE> __device__ __forceinline__ void p_ln(Frame& F, float* xio, const float* lg, const float* lb, const float* mod, bf16* H, const float* rw) {
    const int gw = F.vcu * NWAVES + F.wave, NGW = F.G * NWAVES;
    f32x4 g[4], b[4], sh[4], sc[4]; load4(g, lg, F.lane); load4(b, lb, F.lane);
    if (mod) { load4(sh, mod, F.lane); load4(sc, mod + 1024, F.lane); }
    LAS float* rwT = (LAS float*)(F.lds + RING_OFF);
    LAS int* lcnt = (LAS int*)(F.lds + RING_OFF + 32768);
    LAS int* rinfo = (LAS int*)(F.lds + RING_OFF + 32768 + 256) + F.wave * 64;
    if (ROUTE) {
        for (int i = F.tid; i < 8192; i += NWAVES * 64) { const int k = i >> 3, e = i & 7; rwT[e * 1024 + k] = rw[i]; }
        if (F.tid < 16) lcnt[F.tid] = 0;
        __syncthreads();
    }
    int nr = 0;
    for (int m = gw; m < M; m += NGW) { f32x4 v[4]; load4(v, xio + (size_t)m * DMODEL, F.lane);
        ln_row(v, g, b);
        store_f32_row(xio + (size_t)m * DMODEL, v, F.lane);
        if (mod) {
#pragma unroll
            for (int j = 0; j < 4; ++j) v[j] = v[j] * (sc[j] + 1.0f) + sh[j];
            store_bf16_row(H + (size_t)m * DMODEL, v, F.lane);
        }
        if (ROUTE) {
            float lgt[8];
#pragma unroll
            for (int e = 0; e < 8; ++e) { float s = 0.f;
#pragma unroll
                for (int j = 0; j < 4; ++j) { const f32x4 w = *(const LAS f32x4*)(rwT + e * 1024 + 256 * j + 4 * F.lane); s += (v[j].x * w.x + v[j].y * w.y) + (v[j].z * w.z + v[j].w * w.w); }
                lgt[e] = wave_sum(s); }
            int e0 = 0; float v0 = lgt[0];
#pragma unroll
            for (int e = 1; e < 8; ++e) if (lgt[e] > v0) { v0 = lgt[e]; e0 = e; }
            int e1 = -1; float v1 = -INFINITY;
#pragma unroll
            for (int e = 0; e < 8; ++e) if (e != e0 && (e1 < 0 || lgt[e] > v1)) { v1 = lgt[e]; e1 = e; }
            const float g0 = 1.0f / (1.0f + __expf(v1 - v0));
            if (F.lane == 0) { const int p0 = atomicAdd((int*)&lcnt[e0], 1), p1 = atomicAdd((int*)&lcnt[e1], 1);
                rinfo[nr * 8 + 0] = m; rinfo[nr * 8 + 1] = e0; rinfo[nr * 8 + 2] = e1; rinfo[nr * 8 + 3] = p0; rinfo[nr * 8 + 4] = p1; rinfo[nr * 8 + 5] = __float_as_int(g0); }
            ++nr;
        }
    }
    if (ROUTE) {
        __syncthreads();
        if (F.tid < 8) lcnt[8 + F.tid] = (int)__hip_atomic_fetch_add((unsigned*)(F.ctl + CW_CNT + 64 * F.tid), (unsigned)lcnt[F.tid], __ATOMIC_RELAXED, __HIP_MEMORY_SCOPE_AGENT);
        __syncthreads();
        int* perm = (int*)(F.ws + WS_SMALL + SM_PERM); int* tok = (int*)(F.ws + WS_SMALL + SM_TOK);
        if (F.lane == 0) for (int i = 0; i < nr; ++i) { const int m = rinfo[i * 8 + 0], e0 = rinfo[i * 8 + 1], e1 = rinfo[i * 8 + 2];
            const int p0 = lcnt[8 + e0] + rinfo[i * 8 + 3], p1 = lcnt[8 + e1] + rinfo[i * 8 + 4];
            perm[e0 * SEQ + p0] = m; perm[e1 * SEQ + p1] = m;
            tok[m * 4 + 0] = e0 | (e1 << 8); tok[m * 4 + 1] = p0; tok[m * 4 + 2] = p1; tok[m * 4 + 3] = rinfo[i * 8 + 5]; }
    }
}
__device__ __forceinline__ void p_ln_moe(Frame& F, float* xio, const float* lg, const float* lb, const float* g2v) {
    const int gw = F.vcu * NWAVES + F.wave, NGW = F.G * NWAVES;
    f32x4 g[4], b[4], gg[4]; load4(g, lg, F.lane); load4(b, lb, F.lane); load4(gg, g2v, F.lane);
    int tb[8]; { int acc = 0;
#pragma unroll
        for (int e = 0; e < 8; ++e) { tb[e] = acc; acc += ((int)__hip_atomic_load(F.ctl + CW_CNT + 64 * e, RLX_AGENT) + 255) >> 8; } }
    const int* tok = (const int*)(F.ws + WS_SMALL + SM_TOK); const bf16* Y = (const bf16*)(F.ws + WS_YSLOT);
    for (int m = gw; m < M; m += NGW) {
        const int ee = tok[m * 4 + 0], p0 = tok[m * 4 + 1], p1 = tok[m * 4 + 2]; const float g0 = __int_as_float(tok[m * 4 + 3]), g1 = 1.0f - g0;
        const int e0 = ee & 255, e1 = ee >> 8; int t0 = 0, t1 = 0;
#pragma unroll
        for (int e = 0; e < 8; ++e) { t0 = (e0 == e) ? tb[e] : t0; t1 = (e1 == e) ? tb[e] : t1; }
        const size_t s0 = (size_t)(t0 * 256 + p0), s1 = (size_t)(t1 * 256 + p1);
        f32x4 v[4]; load4(v, xio + (size_t)m * DMODEL, F.lane);
        const GAS unsigned long long* y0 = (const GAS unsigned long long*)(Y + s0 * DMODEL) + F.lane; const GAS unsigned long long* y1 = (const GAS unsigned long long*)(Y + s1 * DMODEL) + F.lane;
#pragma unroll
        for (int j = 0; j < 4; ++j) { const unsigned long long a = y0[64 * j], c = y1[64 * j];
            f32x4 f; f.x = g0 * bf2f((unsigned short)a) + g1 * bf2f((unsigned short)c); f.y = g0 * bf2f((unsigned short)(a >> 16)) + g1 * bf2f((unsigned short)(c >> 16));
            f.z = g0 * bf2f((unsigned short)(a >> 32)) + g1 * bf2f((unsigned short)(c >> 32)); f.w = g0 * bf2f((unsigned short)(a >> 48)) + g1 * bf2f((unsigned short)(c >> 48));
            v[j] = v[j] * ALPHA + (gg[j] + 1.0f) * f; }
        ln_row(v, g, b);
        store_f32_row(xio + (size_t)m * DMODEL, v, F.lane);
    }
}

__device__ __forceinline__ void hg_pass1(Frame& F, int l) {
    const bf16* P = (const bf16*)(F.ws + WS_PROJ); const float* lbs = (const float*)(F.ws + WS_SMALL + SM_LBS) + l * 256;
    float* HGS = (float*)(F.ws + WS_HGS); float* HGD = (float*)(F.ws + WS_HGD);
    LAS float* fk = (LAS float*)(F.lds + RING_OFF + F.wave * 16384);
    LAS float* vl = fk + 1024;
    const int kh = F.wave & 1;
    for (int tk = F.bid * 4 + (F.wave >> 1); tk < 1024; tk += F.G * 4) {
        const int c = tk >> 2, h = tk & 3;
        float S[32];
#pragma unroll
        for (int k = 0; k < 32; ++k) S[k] = 0.f;
        float dp = 1.f;
        for (int sb = 0; sb < 4; ++sb) {
            const int row0 = c * 64 + sb * 16;
#pragma unroll
            for (int j = 0; j < 8; ++j) { const int p = j * 64 + F.lane, tt = p >> 5, kk = p & 31, k = h * 64 + kh * 32 + kk;
                const float z = bf2f(P[(size_t)(row0 + tt) * DIN + 1792 + k]); const float lbv = lbs[k];
                const float f = lbv + (1.0f - lbv) * sigmoid_f(z), key = (1.0f - lbv) * sigmoid_f(-z);
                fk[(tt * 32 + kk) * 2] = f; fk[(tt * 32 + kk) * 2 + 1] = key; }
#pragma unroll
            for (int tt = 0; tt < 16; ++tt) vl[tt * 64 + F.lane] = silu_ff(bf2f(P[(size_t)(row0 + tt) * DIN + 2048 + h * 64 + F.lane]));
            for (int tt = 0; tt < 16; ++tt) {
                const float v = vl[tt * 64 + F.lane];
#pragma unroll
                for (int kk = 0; kk < 32; kk += 2) { const f32x4 q = *(const LAS f32x4*)(fk + (tt * 32 + kk) * 2);
                    S[kk] = q.x * S[kk] + q.y * v; S[kk + 1] = q.z * S[kk + 1] + q.w * v; }
            }
            if (F.lane < 32) {
#pragma unroll
                for (int tt = 0; tt < 16; ++tt) dp *= fk[(tt * 32 + F.lane) * 2]; }
        }
        float* Lp = HGS + ((size_t)(c * 4 + h) * 64 + kh * 32) * 64 + F.lane;
#pragma unroll
        for (int k = 0; k < 32; ++k) Lp[k * 64] = S[k];
        if (F.lane < 32) HGD[c * 256 + h * 64 + kh * 32 + F.lane] = dp;
    }
}
__device__ __forceinline__ void hg_pass2(Frame& F) {
    float* HGS = (float*)(F.ws + WS_HGS); const float* HGD = (const float*)(F.ws + WS_HGD);
    if (F.wave == 0) for (int b = F.bid; b < 256; b += F.G) {
        float carry = 0.f;
        for (int c0 = 0; c0 < 256; c0 += 16) { float Lv[16], Dv[16];
#pragma unroll
            for (int u = 0; u < 16; ++u) { Lv[u] = HGS[(size_t)(c0 + u) * 16384 + b * 64 + F.lane]; Dv[u] = HGD[(c0 + u) * 256 + b]; }
#pragma unroll
            for (int u = 0; u < 16; ++u) { HGS[(size_t)(c0 + u) * 16384 + b * 64 + F.lane] = carry; carry = Dv[u] * carry + Lv[u]; }
        }
    }
}
__device__ __forceinline__ void hg_pass3(Frame& F, int l, const float* hgg) {
    const bf16* P = (const bf16*)(F.ws + WS_PROJ); const float* lbs = (const float*)(F.ws + WS_SMALL + SM_LBS) + l * 256;
    const float* HGS = (const float*)(F.ws + WS_HGS); bf16* MIX = (bf16*)(F.ws + WS_MIX);
    LAS float* fk = (LAS float*)(F.lds + RING_OFF + F.wave * 16384);
    LAS float* vl = fk + 2048;
    LAS float* op = fk + 3072;
    LAS float* opp = (LAS float*)(F.lds + RING_OFF + (F.wave ^ 1) * 16384) + 3072;
    const int kh = F.wave & 1; const float gn = hgg[F.lane];
    for (int tk0 = F.bid * 4; tk0 < 1024; tk0 += F.G * 4) {
        const int tk = tk0 + (F.wave >> 1); const int c = tk >> 2, h = tk & 3;
        float S[32];
        { const float* Sp = HGS + ((size_t)(c * 4 + h) * 64 + kh * 32) * 64 + F.lane;
#pragma unroll
          for (int k = 0; k < 32; ++k) S[k] = Sp[k * 64]; }
        for (int sb = 0; sb < 4; ++sb) {
            const int row0 = c * 64 + sb * 16;
#pragma unroll
            for (int j = 0; j < 8; ++j) { const int p = j * 64 + F.lane, tt = p >> 5, kk = p & 31, k = h * 64 + kh * 32 + kk;
                const float z = bf2f(P[(size_t)(row0 + tt) * DIN + 1792 + k]); const float qv = bf2f(P[(size_t)(row0 + tt) * DIN + 1536 + k]); const float lbv = lbs[k];
                const float f = lbv + (1.0f - lbv) * sigmoid_f(z), key = (1.0f - lbv) * sigmoid_f(-z);
                *(LAS f32x4*)(fk + (tt * 32 + kk) * 4) = (f32x4){f, key, qv, 0.f}; }
#pragma unroll
            for (int tt = 0; tt < 16; ++tt) vl[tt * 64 + F.lane] = silu_ff(bf2f(P[(size_t)(row0 + tt) * DIN + 2048 + h * 64 + F.lane]));
            for (int tt = 0; tt < 16; ++tt) {
                const float v = vl[tt * 64 + F.lane]; float o = 0.f;
#pragma unroll
                for (int kk = 0; kk < 32; ++kk) { const f32x4 q = *(const LAS f32x4*)(fk + (tt * 32 + kk) * 4);
                    S[kk] = q.x * S[kk] + q.y * v; o += q.z * S[kk]; }
                op[tt * 64 + F.lane] = o;
            }
            __syncthreads();
#pragma unroll
            for (int t8 = 0; t8 < 8; ++t8) { const int tt = kh * 8 + t8; const float o = op[tt * 64 + F.lane] + opp[tt * 64 + F.lane];
                const float ss = wave_sum(o * o); const float rstd = 1.0f / sqrtf(ss * (1.0f / 64.0f) + LN_EPS);
                const float gt = bf2f(P[(size_t)(row0 + tt) * DIN + 2304 + h * 64 + F.lane]);
                MIX[(size_t)(row0 + tt) * DMODEL + 512 + h * 64 + F.lane] = (bf16)f2bf(o * rstd * gn * silu_ff(gt)); }
            __syncthreads();
        }
    }
}
__device__ __forceinline__ void pool_phase(Frame& F, const float* pw, const float* ps) {
    const bf16* P = (const bf16*)(F.ws + WS_PROJ); bf16* MIX = (bf16*)(F.ws + WS_MIX);
    LAS float* U = (LAS float*)(F.lds + RING_OFF + F.wave * 16384);
    LAS float* PL = U + 2048;
    const int gw = F.vcu * NWAVES + F.wave, NGW = F.G * NWAVES;
    for (int task = gw; task < 4096; task += NGW) {
        const int tg = task >> 2, gi = task & 3, t0 = tg * 16, win = 2 << gi;
        float wcol[64];
#pragma unroll
        for (int c = 0; c < 64; ++c) wcol[c] = pw[(size_t)(gi * 64 + c) * 64 + F.lane];
        const float scl = ps[gi * 64 + F.lane];
        for (int r = 0; r < 31; ++r) { const int t = t0 - 15 + r; U[r * 64 + F.lane] = (t >= 0) ? bf2f(P[(size_t)t * DIN + 2560 + gi * 64 + F.lane]) : 0.f; }
        for (int tt = 0; tt < 16; ++tt) { float s = 0.f;
            for (int j = 0; j < win; ++j) s += U[(15 + tt - j) * 64 + F.lane];
            const int t = t0 + tt; const float cntw = (float)((t + 1 < win) ? (t + 1) : win);
            PL[tt * 64 + F.lane] = s / cntw - U[(15 + tt) * 64 + F.lane]; }
        for (int tt = 0; tt < 16; ++tt) { float acc = 0.f;
#pragma unroll
            for (int c = 0; c < 64; c += 4) { const f32x4 p4 = *(const LAS f32x4*)(PL + tt * 64 + c);
                acc += p4.x * wcol[c]; acc += p4.y * wcol[c + 1]; acc += p4.z * wcol[c + 2]; acc += p4.w * wcol[c + 3]; }
            MIX[(size_t)(t0 + tt) * DMODEL + 768 + gi * 64 + F.lane] = (bf16)f2bf(acc * scl); }
    }
}
__device__ __forceinline__ void moe_gather(Frame& F) {
    const int gw = F.vcu * NWAVES + F.wave, NGW = F.G * NWAVES;
    int cn[8], tb[9]; tb[0] = 0;
#pragma unroll
    for (int e = 0; e < 8; ++e) { cn[e] = (int)__hip_atomic_load(F.ctl + CW_CNT + 64 * e, RLX_AGENT); tb[e + 1] = tb[e] + ((cn[e] + 255) >> 8); }
    const int* perm = (const int*)(F.ws + WS_SMALL + SM_PERM); const bf16* H = (const bf16*)(F.ws + WS_HBUF); bf16* HP = (bf16*)(F.ws + WS_HPERM);
    for (int slot = gw; slot < tb[8] * 256; slot += NGW) {
        const int T = slot >> 8; int e = 0, tbe = 0, ce = cn[0];
#pragma unroll
        for (int j = 1; j < 8; ++j) if (T >= tb[j]) { e = j; tbe = tb[j]; ce = cn[j]; }
        const int pos = ((T - tbe) << 8) + (slot & 255);
        const int tokn = (pos < ce) ? perm[e * SEQ + pos] : 0;
        const GAS v4u* src = (const GAS v4u*)(H + (size_t)tokn * DMODEL) + F.lane; GAS v4u* dst = (GAS v4u*)(HP + (size_t)slot * DMODEL) + F.lane;
        const v4u a = src[0], b = src[64]; dst[0] = a; dst[64] = b;
    }
}
__device__ __forceinline__ void attn_finalize(Frame& F, int l, const float* ag) {
    const bf16* O1 = (const bf16*)(F.ws + WS_ATTNO); const bf16* O2 = O1 + (size_t)SEQ * 512; bf16* MIX = (bf16*)(F.ws + WS_MIX);
    const float* lamv = (const float*)(F.ws + WS_SMALL + SM_LAM); const float lam = lamv[l], osc = 1.0f - lamv[2 + l];
    const int gw = F.vcu * NWAVES + F.wave, NGW = F.G * NWAVES;
    float gv[8];
#pragma unroll
    for (int j = 0; j < 8; ++j) gv[j] = ag[(F.lane & 15) * 8 + j] * osc;
    for (int m = gw; m < M; m += NGW) {
        const v4u a = *(const GAS v4u*)(O1 + (size_t)m * 512 + F.lane * 8), b = *(const GAS v4u*)(O2 + (size_t)m * 512 + F.lane * 8);
        float d[8];
        d[0] = __uint_as_float(a.x << 16) - lam * __uint_as_float(b.x << 16); d[1] = __uint_as_float(a.x & 0xffff0000u) - lam * __uint_as_float(b.x & 0xffff0000u);
        d[2] = __uint_as_float(a.y << 16) - lam * __uint_as_float(b.y << 16); d[3] = __uint_as_float(a.y & 0xffff0000u) - lam * __uint_as_float(b.y & 0xffff0000u);
        d[4] = __uint_as_float(a.z << 16) - lam * __uint_as_float(b.z << 16); d[5] = __uint_as_float(a.z & 0xffff0000u) - lam * __uint_as_float(b.z & 0xffff0000u);
        d[6] = __uint_as_float(a.w << 16) - lam * __uint_as_float(b.w << 16); d[7] = __uint_as_float(a.w & 0xffff0000u) - lam * __uint_as_float(b.w & 0xffff0000u);
        float ss = 0.f;
#pragma unroll
        for (int j = 0; j < 8; ++j) ss += d[j] * d[j];
        ss += swzx<1>(ss); ss += swzx<2>(ss); ss += swzx<4>(ss); ss += swzx<8>(ss);
        const float rstd = 1.0f / sqrtf(ss * (1.0f / 128.0f) + LN_EPS);
        v4u o; o.x = pk2(d[0] * rstd * gv[0], d[1] * rstd * gv[1]); o.y = pk2(d[2] * rstd * gv[2], d[3] * rstd * gv[3]);
        o.z = pk2(d[4] * rstd * gv[4], d[5] * rstd * gv[5]); o.w = pk2(d[6] * rstd * gv[6], d[7] * rstd * gv[7]);
        *(GAS v4u*)(MIX + (size_t)m * DMODEL + F.lane * 8) = o;
    }
}

#ifndef DIS
#define DIS 0
#endif
#define RELOAD_ARGS() do { asm volatile("" : "+s"(argp), "+s"(F.ws), "+s"(F.ctl), "+s"(bar.bar), "+s"(bar.x), "+s"(F.G), "+s"(F.vcu), "+s"(F.bid)); { unsigned z_ = 0u; asm volatile("" : "+s"(z_)); F.lane = (int)__builtin_amdgcn_mbcnt_hi(~0u, __builtin_amdgcn_mbcnt_lo(~0u, z_)); } asm volatile("" : "+v"(F.lane)); F.tid = F.wave * 64 + F.lane; } while (0)
#define args (*argp)
__global__ void __launch_bounds__(NWAVES * 64, 2) mk_fwd(Args args_) {
    const Args* argp = (const Args*)__builtin_amdgcn_kernarg_segment_ptr();
    extern __shared__ __attribute__((aligned(16))) unsigned char lds[];
    Frame F;
    F.lds = (LAS unsigned char*)lds;
    F.MISC = (volatile LAS unsigned*)(F.lds + MISC_OFF);
    F.tid = threadIdx.x; F.lane = F.tid & 63; F.wave = __builtin_amdgcn_readfirstlane(F.tid >> 6);
    F.G = gridDim.x; F.bid = blockIdx.x; { const int bx = blockIdx.x; F.vcu = (F.G % 8 == 0) ? (bx % 8) * (F.G / 8) + bx / 8 : bx; }
    F.ws = args.ws; F.ctl = (gu32*)(args.ws + WS_CTL);
    for (int u = F.tid; u < (LDS_BYTES - LDSCTL_OFF) / 4; u += NWAVES * 64) ((LAS unsigned*)(F.lds + LDSCTL_OFF))[u] = 0u;
    __syncthreads();
    XcdBarrier bar; bar.bar = (unsigned*)(F.ctl + CW_BAR); bar.x = 0; bar.st = nullptr;
    if (N_LAUNCHES == 1) bar = xcd_barrier_post((unsigned*)(F.ctl + CW_BAR), F.MISC + 8, F.tid);
    const int lo = (N_LAUNCHES == 1) ? 0 : args.ph_lo, hi = (N_LAUNCHES == 1) ? NPH : args.ph_hi;
#define IN(k) (lo <= (k) && (k) < hi)
#define SEAM(k) do { if (IN(k) && IN((k) + 1)) xcd_barrier(bar, F.tid); RELOAD_ARGS(); } while (0)
#define MOD ((const float*)(F.ws + WS_SMALL + SM_MOD))
#define HB ((bf16*)(F.ws + WS_HBUF))

    if (IN(0)) {
#if !(DIS&1)
        p0a_prologue(F, args);
#endif
    } SEAM(0);
    if (IN(1)) { p_modulate(F, args.in[I_X], MOD, HB); } SEAM(1);

    for (int l = 0; l < DEPTH; ++l) {
        const int pb = 2 + NPH_LAYER * l;
#define mod (MOD + l * 6144)
#define xin ((l == 0) ? args.in[I_X] : (const float*)args.out)
        if (IN(pb + 0)) {
            pg8::Gemm g{HB, (const bf16*)(F.ws + WS_WIN) + (size_t)l * DIN * 1024, 1024}; pg8::StaticOrder S; S.init(M, DIN, F.G, F.bid);
            pg8::EpiProj E{(bf16*)(F.ws + WS_PROJ), DIN, (const float*)(F.ws + WS_ROPE), (const float*)(F.ws + WS_ROPE) + (size_t)SEQ * 32, attn_body::C2};
#if !(DIS&2)
            pg8::gemm_phase<pg8::EpiProj, pg8::StaticOrder, true>(F.lds + RING_OFF, g, S, E, F.tid);
#endif
        } SEAM(pb + 0);
        if (IN(pb + 1)) {
#if !(DIS&4)
            hg_pass1(F, l);
#endif
            __syncthreads();
#if !(DIS&8)
            pool_phase(F, args.in[I_POOLW] + (size_t)l * 4 * 64 * 64, args.in[I_POOLS] + l * 256);
#endif
        } SEAM(pb + 1);
        if (IN(pb + 2)) {
#if !(DIS&16)
            hg_pass2(F);
#endif
        } SEAM(pb + 2);
        if (IN(pb + 3)) {
            const attn_body::bf16* PJ = (const attn_body::bf16*)(F.ws + WS_PROJ); attn_body::bf16* AO = (attn_body::bf16*)(F.ws + WS_ATTNO);
            for (int i = 0; i < 4; ++i) { const int j = i * F.G + F.vcu; if (j >= 1024) break;
                const int v = j & 255, ii = j >> 8, vh = v >> 4, s = v & 15; const int qb = (ii == 0) ? s : (ii == 1) ? 31 - s : (ii == 2) ? 32 + s : 63 - s;
                const int h = vh >> 2, mp = (vh >> 1) & 1, vf = vh & 1;
#if !(DIS&32)
                attn_body::attn_unit<8>(F.tid, qb, PJ + (h * 2 + mp) * 64, PJ + 512 + (h * 2 + mp) * 64, PJ + 1024 + h * 128 + vf * 64, AO + (size_t)mp * SEQ * 512 + h * 128 + vf * 64, (char*)lds + RING_OFF);
#endif
            }
            __syncthreads();
#if !(DIS&64)
            hg_pass3(F, l, args.in[I_HGG] + l * 64);
#endif
        } SEAM(pb + 3);
        if (IN(pb + 4)) {
#if !(DIS&128)
            attn_finalize(F, l, args.in[I_ATTNG] + l * 128);
#endif
        } SEAM(pb + 4);
        if (IN(pb + 5)) {
            pg8::Gemm g{(const bf16*)(F.ws + WS_MIX), (const bf16*)(F.ws + WS_WOUT) + (size_t)l * 1024 * 1024, 1024}; pg8::StaticOrder S; S.init(M, DMODEL, F.G, F.bid);
            pg8::EpiResid E{xin, args.out, DMODEL, mod + 2048, ALPHA};
#if !(DIS&256)
            pg8::gemm_phase<pg8::EpiResid, pg8::StaticOrder, false>(F.lds + RING_OFF, g, S, E, F.tid);
#endif
        } SEAM(pb + 5);
        if (IN(pb + 6)) {
#if !(DIS&512)
            if (l & 1) p_ln<true>(F, args.out, args.in[I_LN1G] + l * 1024, args.in[I_LN1B] + l * 1024, mod + 3072, HB, args.in[I_RW] + (size_t)(l >> 1) * 1024 * 8);
#endif
#if !(DIS&1024)
            if (!(l & 1)) p_ln<false>(F, args.out, args.in[I_LN1G] + l * 1024, args.in[I_LN1B] + l * 1024, mod + 3072, HB, nullptr);
#endif
        } SEAM(pb + 6);
        if (!(l & 1)) {
            if (IN(pb + 8)) {
                pg8::Gemm g{HB, (const bf16*)(F.ws + WS_FFN13), 1024}; pg8::StaticOrder S; S.init(M, 2 * FFD, F.G, F.bid);
                pg8::EpiSwiglu E{(bf16*)(F.ws + WS_DHID), FFD};
#if !(DIS&2048)
                pg8::gemm_phase<pg8::EpiSwiglu, pg8::StaticOrder, true>(F.lds + RING_OFF, g, S, E, F.tid);
#endif
            } SEAM(pb + 8);
            if (IN(pb + 9)) {
                pg8::Gemm g{(const bf16*)(F.ws + WS_DHID), (const bf16*)(F.ws + WS_FFN2), FFD}; pg8::StaticOrder S; S.init(M, DMODEL, F.G, F.bid);
                pg8::EpiResid E{args.out, args.out, DMODEL, mod + 5120, ALPHA};
#if !(DIS&4096)
                pg8::gemm_phase<pg8::EpiResid, pg8::StaticOrder, false>(F.lds + RING_OFF, g, S, E, F.tid);
#endif
            } SEAM(pb + 9);
            if (IN(pb + 10)) {
                p_ln<false>(F, args.out, args.in[I_LN2G] + l * 1024, args.in[I_LN2B] + l * 1024, (l + 1 < DEPTH) ? MOD + (l + 1) * 6144 : nullptr, HB, nullptr);
            } SEAM(pb + 10);
        } else {
            const unsigned* cnt = (const unsigned*)(F.ctl + CW_CNT);
            if (IN(pb + 7)) {
#if !(DIS&65536)
                moe_gather(F);
#endif
            } SEAM(pb + 7);
            if (IN(pb + 8)) {
                pg8::Gemm g{(const bf16*)(F.ws + WS_HPERM), (const bf16*)(F.ws + WS_EXP13), 1024}; pg8::MoeOrder S; S.init(cnt, 2 * EDIM / 256, F.G, F.bid);
                pg8::EpiSwiglu E{(bf16*)(F.ws + WS_HID), EDIM};
#if !(DIS&8192)
                pg8::gemm_phase<pg8::EpiSwiglu, pg8::MoeOrder, true>(F.lds + RING_OFF, g, S, E, F.tid);
#endif
            } SEAM(pb + 8);
            if (IN(pb + 9)) {
                pg8::Gemm g{(const bf16*)(F.ws + WS_HID), (const bf16*)(F.ws + WS_EXP2), EDIM}; pg8::MoeOrder S; S.init(cnt, DMODEL / 256, F.G, F.bid);
                pg8::EpiBf16 E{(bf16*)(F.ws + WS_YSLOT), DMODEL};
#if !(DIS&16384)
                pg8::gemm_phase<pg8::EpiBf16, pg8::MoeOrder, true>(F.lds + RING_OFF, g, S, E, F.tid);
#endif
            } SEAM(pb + 9);
            if (IN(pb + 10)) {
#if !(DIS&32768)
                p_ln_moe(F, args.out, args.in[I_LN2G] + l * 1024, args.in[I_LN2B] + l * 1024, mod + 5120);
#endif
            } SEAM(pb + 10);
        }
    }
#undef IN
#undef SEAM
#undef args
#undef MOD
#undef HB
#undef mod
#undef xin
}

extern "C" void kernel_launch(void* const* d_in, const int* in_sizes, int n_in, void* d_out, int out_size, void* d_ws, size_t ws_size, hipStream_t stream) {
    static int grid = 0;
    if (grid == 0) {
        if (n_in != 23 || in_sizes[0] != M * DMODEL || out_size != M * DMODEL || ws_size < WS_END) { fprintf(stderr, "kernel_launch: unexpected shapes (n_in %d, out %d, ws %zu); nothing launched\n", n_in, out_size, ws_size); grid = -1; return; }
        int dev = 0, cus = 0, per_cu = 0;
        if (hipGetDevice(&dev) != hipSuccess || hipDeviceGetAttribute(&cus, hipDeviceAttributeMultiprocessorCount, dev) != hipSuccess) { grid = -1; return; }
        if (hipFuncSetAttribute((const void*)mk_fwd, hipFuncAttributeMaxDynamicSharedMemorySize, LDS_BYTES) != hipSuccess) { fprintf(stderr, "kernel_launch: hipFuncSetAttribute failed\n"); grid = -1; return; }
        if (hipOccupancyMaxActiveBlocksPerMultiprocessor(&per_cu, (const void*)mk_fwd, NWAVES * 64, LDS_BYTES) != hipSuccess || per_cu < 1) { fprintf(stderr, "kernel_launch: occupancy query says %d\n", per_cu); }
        (void)hipGetLastError();
        grid = cus;
    }
    if (grid < 0) return;
    if (hipMemsetAsync((char*)d_ws + WS_CTL, 0, CTL_ZERO_BYTES, stream) != hipSuccess) return;
    Args a{};
    for (int i = 0; i < 23; ++i) a.in[i] = (const float*)d_in[i];
    a.out = (float*)d_out; a.ws = (unsigned char*)d_ws;
    for (int li = 0; li < N_LAUNCHES; ++li) {
        a.ph_lo = (N_LAUNCHES == 1) ? 0 : li; a.ph_hi = (N_LAUNCHES == 1) ? NPH : li + 1; a.li = li; a.pad = 0;
        hipLaunchKernelGGL(mk_fwd, dim3(grid), dim3(NWAVES * 64), LDS_BYTES, stream, a);
    }
}
```

```cpp
#define MK_N_LAUNCHES 1
#include <hip/hip_runtime.h>
#include <hip/hip_bf16.h>
#include <cstdio>
#include <cstdint>
#include <cmath>
namespace pg8 {
#define PG8_LAS __attribute__((address_space(3)))
typedef unsigned short bf16_t;
typedef short bf16x8 __attribute__((ext_vector_type(8)));
typedef float f32x4 __attribute__((ext_vector_type(4)));
typedef unsigned u32x4 __attribute__((ext_vector_type(4)));
constexpr int BM = 256, BK = 64, HALF = 128, HTB = HALF * BK * 2  , STAGE_BYTES = 8 * HTB, NXCD = 8, WGM = 8;

__host__ __device__ __forceinline__ int lds_byte(int r, int c) { const int st = (r >> 4) * 2 + (c >> 5), rr = r & 15, cc = c & 31, ob = rr * 64 + cc * 2; return st * 1024 + (ob ^ (((ob >> 9) & 1) << 5)); }
__host__ __device__ __forceinline__ void stage_rc(int b, int& R, int& C) { const int st = b / 1024, sb = b % 1024, swz = sb ^ (((sb >> 9) & 1) << 5); R = (st >> 1) * 16 + swz / 64; C = (st & 1) * 32 + (swz % 64) / 2; }
__host__ __device__ __forceinline__ int perm32(int rho) { const int n = rho >> 4, i = rho & 15; return 8 * (i >> 2) + 4 * n + (i & 3); }

struct Unit { int pm, pn, pb; };
struct Gemm { const bf16_t* A; const bf16_t* Bt; int K; };

struct StaticOrder {
    int nM, nN, nwg, G, c;
    __host__ __device__ void init(int M, int N, int G_, int c_) { nM = M / BM; nN = N / BM; nwg = nM * nN; G = G_; c = c_; }
    __host__ __device__ bool next(int i, Unit& u) const {
        const long L = (long)i * G + c; if (L >= nwg) return false;
        int wgid = (int)L; { const int q = nwg / NXCD, r = nwg % NXCD, xcd = wgid % NXCD, off = wgid / NXCD; wgid = (xcd < r ? xcd * (q + 1) : r * (q + 1) + (xcd - r) * q) + off; }
        const int nig = WGM * nN, gid = wgid / nig, fm = gid * WGM, gsz = (nM - fm) < WGM ? (nM - fm) : WGM;
        u.pm = fm + ((wgid % nig) % gsz); u.pn = (wgid % nig) / gsz; u.pb = u.pn; return true;
    }
};

struct MoeOrder {
    int tb1, tb2, tb3, tb4, tb5, tb6, tb7, tb8;
    int nN, G, c;
    __device__ __forceinline__ void init(const unsigned* cnt, int nN_, int G_, int c_) {
        tb1 = ((int)cnt[0] + 255) >> 8; tb2 = tb1 + (((int)cnt[64] + 255) >> 8); tb3 = tb2 + (((int)cnt[128] + 255) >> 8); tb4 = tb3 + (((int)cnt[192] + 255) >> 8);
        tb5 = tb4 + (((int)cnt[256] + 255) >> 8); tb6 = tb5 + (((int)cnt[320] + 255) >> 8); tb7 = tb6 + (((int)cnt[384] + 255) >> 8); tb8 = tb7 + (((int)cnt[448] + 255) >> 8);
        nN = nN_; G = G_; c = c_;
    }
    __device__ __forceinline__ bool next(int i, Unit& u) const {
        const int L = i * G + c; const int T = L / nN; if (T >= tb8) return false;
        const int pn = L - T * nN;
        const int e = (T >= tb1) + (T >= tb2) + (T >= tb3) + (T >= tb4) + (T >= tb5) + (T >= tb6) + (T >= tb7);
        u.pm = T; u.pn = pn; u.pb = e * nN + pn; return true;
    }
};

__device__ __forceinline__ unsigned cvt_pk_bf16(float lo, float hi) { unsigned r; asm volatile("v_cvt_pk_bf16_f32 %0, %1, %2" : "=v"(r) : "v"(lo), "v"(hi)); return r; }

struct EpiBf16 {
    static constexpr bool PERM = true;
    bf16_t* O; int ldc;
    __device__ __forceinline__ void operator()(const f32x4 (&acc)[2][2][4][2], const Unit& u, int wr, int wc, int fr, int fq) const {
        const int row0 = u.pm * BM + wr * 64 + fr; const int col0 = u.pn * BM + wc * 32 + 8 * fq;
#pragma unroll
        for (int ai = 0; ai < 2; ++ai)
#pragma unroll
            for (int m = 0; m < 4; ++m) { bf16_t* rowp = O + (size_t)(row0 + ai * HALF + m * 16) * ldc + col0;
#pragma unroll
                for (int bj = 0; bj < 2; ++bj) { const f32x4 v0 = acc[ai][bj][m][0], v1 = acc[ai][bj][m][1];
                    u32x4 w; w.x = cvt_pk_bf16(v0[0], v0[1]); w.y = cvt_pk_bf16(v0[2], v0[3]); w.z = cvt_pk_bf16(v1[0], v1[1]); w.w = cvt_pk_bf16(v1[2], v1[3]);
                    *(u32x4*)(rowp + bj * HALF) = w; } }
    }
};

struct EpiProj {
    static constexpr bool PERM = true;
    bf16_t* O; int ldc; const float* cosT; const float* sinT; float qscale;
    __device__ __forceinline__ void operator()(const f32x4 (&acc)[2][2][4][2], const Unit& u, int wr, int wc, int fr, int fq) const {
        const int row0 = u.pm * BM + wr * 64 + fr; const int col0 = u.pn * BM + wc * 32 + 8 * fq;
        if (u.pn < 4) {
            const int i0 = 16 * (wc & 1) + 4 * fq; const float sc = (u.pn < 2) ? qscale : 1.0f;
#pragma unroll
            for (int ai = 0; ai < 2; ++ai)
#pragma unroll
                for (int m = 0; m < 4; ++m) { const int row = row0 + ai * HALF + m * 16; bf16_t* rowp = O + (size_t)row * ldc + col0;
                    f32x4 c4 = *(const f32x4*)(cosT + (size_t)row * 32 + i0), s4 = *(const f32x4*)(sinT + (size_t)row * 32 + i0);
                    c4 = c4 * sc; s4 = s4 * sc;
#pragma unroll
                    for (int bj = 0; bj < 2; ++bj) { const f32x4 v0 = acc[ai][bj][m][0], v1 = acc[ai][bj][m][1];
                        const float o0 = v0[0] * c4[0] - v0[1] * s4[0], o1 = v0[1] * c4[0] + v0[0] * s4[0];
                        const float o2 = v0[2] * c4[1] - v0[3] * s4[1], o3 = v0[3] * c4[1] + v0[2] * s4[1];
                        const float o4 = v1[0] * c4[2] - v1[1] * s4[2], o5 = v1[1] * c4[2] + v1[0] * s4[2];
                        const float o6 = v1[2] * c4[3] - v1[3] * s4[3], o7 = v1[3] * c4[3] + v1[2] * s4[3];
                        u32x4 w; w.x = cvt_pk_bf16(o0, o1); w.y = cvt_pk_bf16(o2, o3); w.z = cvt_pk_bf16(o4, o5); w.w = cvt_pk_bf16(o6, o7);
                        *(u32x4*)(rowp + bj * HALF) = w; } }
        } else {
#pragma unroll
            for (int ai = 0; ai < 2; ++ai)
#pragma unroll
                for (int m = 0; m < 4; ++m) { bf16_t* rowp = O + (size_t)(row0 + ai * HALF + m * 16) * ldc + col0;
#pragma unroll
                    for (int bj = 0; bj < 2; ++bj) { const f32x4 v0 = acc[ai][bj][m][0], v1 = acc[ai][bj][m][1];
                        u32x4 w; w.x = cvt_pk_bf16(v0[0], v0[1]); w.y = cvt_pk_bf16(v0[2], v0[3]); w.z = cvt_pk_bf16(v1[0], v1[1]); w.w = cvt_pk_bf16(v1[2], v1[3]);
                        *(u32x4*)(rowp + bj * HALF) = w; } }
        }
    }
};

__device__ __forceinline__ float silu_f(float a) { return a * __builtin_amdgcn_rcpf(1.0f + __builtin_amdgcn_exp2f(-1.4426950408889634f * a)); }
struct EpiSwiglu {
    static constexpr bool PERM = true;
    bf16_t* O; int ldc;
    __device__ __forceinline__ void operator()(const f32x4 (&acc)[2][2][4][2], const Unit& u, int wr, int wc, int fr, int fq) const {
        const int row0 = u.pm * BM + wr * 64 + fr; const int col0 = u.pn * HALF + wc * 32 + 8 * fq;
#pragma unroll
        for (int ai = 0; ai < 2; ++ai)
#pragma unroll
            for (int m = 0; m < 4; ++m) { bf16_t* rowp = O + (size_t)(row0 + ai * HALF + m * 16) * ldc + col0;
                const f32x4 a0 = acc[ai][0][m][0], a1 = acc[ai][0][m][1], b0 = acc[ai][1][m][0], b1 = acc[ai][1][m][1];
                u32x4 w;
                w.x = cvt_pk_bf16(silu_f(a0[0]) * b0[0], silu_f(a0[1]) * b0[1]); w.y = cvt_pk_bf16(silu_f(a0[2]) * b0[2], silu_f(a0[3]) * b0[3]);
                w.z = cvt_pk_bf16(silu_f(a1[0]) * b1[0], silu_f(a1[1]) * b1[1]); w.w = cvt_pk_bf16(silu_f(a1[2]) * b1[2], silu_f(a1[3]) * b1[3]);
                *(u32x4*)rowp = w; }
    }
};

struct EpiResid {
    static constexpr bool PERM = false;
    const float* xin; float* out; int ldc; const float* gate; float alpha;
    __device__ __forceinline__ void operator()(const f32x4 (&acc)[2][2][4][2], const Unit& u, int wr, int wc, int fr, int fq) const {
        const int col0 = u.pn * BM + wc * 32 + 4 * fq;
        f32x4 gv[2][2];
#pragma unroll
        for (int bj = 0; bj < 2; ++bj)
#pragma unroll
            for (int n = 0; n < 2; ++n) gv[bj][n] = *(const f32x4*)(gate + col0 + bj * HALF + n * 16) + 1.0f;
#pragma unroll
        for (int ai = 0; ai < 2; ++ai)
#pragma unroll
            for (int m = 0; m < 4; ++m) { const size_t off = (size_t)(u.pm * BM + ai * HALF + wr * 64 + m * 16 + fr) * ldc + col0;
#pragma unroll
                for (int bj = 0; bj < 2; ++bj)
#pragma unroll
                    for (int n = 0; n < 2; ++n) { const f32x4 x = *(const f32x4*)(xin + off + bj * HALF + n * 16);
                        *(f32x4*)(out + off + bj * HALF + n * 16) = x * alpha + gv[bj][n] * acc[ai][bj][m][n]; }
                if (m & 1) asm volatile("" ::: "memory"); }
    }
};

template <class Epi, class Sched, bool ALIGN_EPI>
__device__ __forceinline__ void gemm_phase(PG8_LAS unsigned char* lds, const Gemm g, const Sched& S, const Epi& E, const int tid) {
    const int wid = __builtin_amdgcn_readfirstlane(tid >> 6), lane = tid & 63, wr = wid >> 2, wc = wid & 3, fr = lane & 15, fq = lane >> 4;
    const int K = g.K, nt = K / BK;
    unsigned voffA[2], voffB[2];
#pragma unroll
    for (int i = 0; i < 2; ++i) { int R, C; stage_rc(tid * 16 + i * 8192, R, C); const int Rb = Epi::PERM ? ((R & ~31) + perm32(R & 31)) : R;
        voffA[i] = (unsigned)(R * K + C) * 2u; voffB[i] = (unsigned)(Rb * K + C) * 2u; }
    const size_t kstep = (size_t)(BK * 2);
    const size_t hstep = (size_t)HALF * K * 2;
    const size_t tstep = 2 * hstep;
    const unsigned ldsw = (unsigned)wid * 1024u;
    const int aoff = lds_byte(wr * 64 + fr, fq * 8), boff = lds_byte(wc * 32 + fr, fq * 8);
#define PG8_SA(b, h) (((b) * 2 + (h)) * HTB)
#define PG8_SB(b, h) ((4 + (b) * 2 + (h)) * HTB)
#define PG8_STAGE(bufoff, gbase, voff) do { _Pragma("unroll") for (int _i = 0; _i < 2; ++_i) \
        __builtin_amdgcn_global_load_lds((const unsigned*)((const char*)(gbase) + (voff)[_i]), (PG8_LAS unsigned*)(lds + (bufoff) + ldsw + _i * 8192), 16, 0, 0); } while (0)
#define PG8_LDA(dst, b, h) do { _Pragma("unroll") for (int m = 0; m < 4; ++m) _Pragma("unroll") for (int k = 0; k < 2; ++k) dst[m][k] = *(const PG8_LAS bf16x8*)(lds + PG8_SA(b, h) + aoff + m * 2048 + k * 1024); } while (0)
#define PG8_LDB(dst, b, h) do { _Pragma("unroll") for (int n = 0; n < 2; ++n) _Pragma("unroll") for (int k = 0; k < 2; ++k) dst[n][k] = *(const PG8_LAS bf16x8*)(lds + PG8_SB(b, h) + boff + n * 2048 + k * 1024); } while (0)
#define PG8_MMA(ai, bj, At, Bt) do { __builtin_amdgcn_s_setprio(1); _Pragma("unroll") for (int m = 0; m < 4; ++m) _Pragma("unroll") for (int n = 0; n < 2; ++n) _Pragma("unroll") for (int k = 0; k < 2; ++k) \
        acc[ai][bj][m][n] = __builtin_amdgcn_mfma_f32_16x16x32_bf16(Bt[n][k], At[m][k], acc[ai][bj][m][n], 0, 0, 0); __builtin_amdgcn_s_setprio(0); } while (0)
#define PG8_WAIT_V(n) asm volatile("s_waitcnt vmcnt(" #n ")" ::: "memory")
#define PG8_WAIT_L(n) asm volatile("s_waitcnt lgkmcnt(" #n ")" ::: "memory")
#define PG8_BAR __builtin_amdgcn_s_barrier()
#define PG8_SCHED __builtin_amdgcn_sched_barrier(0)
    Unit cur, nxt; int ui = 0;
    if (!S.next(0, cur)) return;
    f32x4 acc[2][2][4][2];
#pragma unroll
    for (int a = 0; a < 2; ++a)
#pragma unroll
        for (int b = 0; b < 2; ++b)
#pragma unroll
            for (int m = 0; m < 4; ++m)
#pragma unroll
                for (int n = 0; n < 2; ++n) acc[a][b][m][n] = (f32x4){0.f, 0.f, 0.f, 0.f};
    bf16x8 At[4][2], B0[2][2], B1[2][2];
    const char* cA = (const char*)g.A + (size_t)cur.pm * tstep; const char* cB = (const char*)g.Bt + (size_t)cur.pb * tstep;
    PG8_STAGE(PG8_SB(0, 0), cB, voffB); PG8_STAGE(PG8_SB(0, 1), cB + hstep, voffB); PG8_STAGE(PG8_SA(0, 0), cA, voffA); PG8_STAGE(PG8_SA(0, 1), cA + hstep, voffA);
    if (wr == 1) PG8_BAR;
    PG8_WAIT_V(2); PG8_BAR;
    PG8_STAGE(PG8_SB(1, 0), cB + kstep, voffB); PG8_STAGE(PG8_SA(1, 0), cA + kstep, voffA); PG8_STAGE(PG8_SB(1, 1), cB + hstep + kstep, voffB);
    PG8_WAIT_V(6); PG8_BAR;
    for (;;) {
        const bool has_next = S.next(ui + 1, nxt);
        const char* nA = has_next ? (const char*)g.A + (size_t)nxt.pm * tstep : cA; const char* nB = has_next ? (const char*)g.Bt + (size_t)nxt.pb * tstep : cB;
        for (int t = 0; t < nt; t += 2) {
            const bool last = (t == nt - 2);
            const char* a1 = cA + (size_t)(t + 1) * kstep;
            const char* a2 = last ? nA : cA + (size_t)(t + 2) * kstep; const char* b2 = last ? nB : cB + (size_t)(t + 2) * kstep;
            const char* a3 = a2 + kstep; const char* b3 = b2 + kstep;
            PG8_LDB(B0, 0, 0); PG8_LDB(B1, 0, 1); PG8_SCHED; PG8_LDA(At, 0, 0); PG8_STAGE(PG8_SA(1, 1), a1 + hstep, voffA);
            PG8_WAIT_V(8); PG8_WAIT_L(0); PG8_BAR; PG8_MMA(0, 0, At, B0); PG8_MMA(0, 1, At, B1); PG8_BAR; PG8_SCHED;
            PG8_LDA(At, 0, 1); PG8_STAGE(PG8_SB(0, 0), b2, voffB); PG8_STAGE(PG8_SB(0, 1), b2 + hstep, voffB); PG8_STAGE(PG8_SA(0, 0), a2, voffA);
            PG8_WAIT_V(8); PG8_WAIT_L(0); PG8_BAR; PG8_MMA(1, 0, At, B0); PG8_MMA(1, 1, At, B1); PG8_BAR; PG8_SCHED;
            PG8_LDB(B0, 1, 0); PG8_LDB(B1, 1, 1); PG8_SCHED; PG8_LDA(At, 1, 0); PG8_STAGE(PG8_SA(0, 1), a2 + hstep, voffA);
            PG8_WAIT_V(8); PG8_WAIT_L(0); PG8_BAR; PG8_MMA(0, 0, At, B0); PG8_MMA(0, 1, At, B1); PG8_BAR; PG8_SCHED;
            PG8_LDA(At, 1, 1); PG8_STAGE(PG8_SB(1, 0), b3, voffB); PG8_STAGE(PG8_SB(1, 1), b3 + hstep, voffB); PG8_STAGE(PG8_SA(1, 0), a3, voffA);
            PG8_WAIT_V(8); PG8_WAIT_L(0); PG8_BAR; PG8_MMA(1, 0, At, B0); PG8_MMA(1, 1, At, B1); PG8_BAR; PG8_SCHED;
        }
        if constexpr (ALIGN_EPI) { if (wr == 0) PG8_BAR; }
        E(acc, cur, wr, wc, fr, fq);
        if (!has_next) break;
#pragma unroll
        for (int a = 0; a < 2; ++a)
#pragma unroll
            for (int b = 0; b < 2; ++b)
#pragma unroll
                for (int m = 0; m < 4; ++m)
#pragma unroll
                    for (int n = 0; n < 2; ++n) acc[a][b][m][n] = (f32x4){0.f, 0.f, 0.f, 0.f};
        cur = nxt; cA = nA; cB = nB; ++ui;
        if constexpr (ALIGN_EPI) { if (wr == 1) PG8_BAR; }
    }
    PG8_WAIT_V(0);
    if constexpr (!ALIGN_EPI) { if (wr == 0) PG8_BAR; }
    PG8_BAR;
#undef PG8_SA
#undef PG8_SB
#undef PG8_STAGE
#undef PG8_LDA
#undef PG8_LDB
#undef PG8_MMA
#undef PG8_WAIT_V
#undef PG8_WAIT_L
#undef PG8_BAR
#undef PG8_SCHED
}
}
namespace attn_body {
using bf16=__hip_bfloat16;
using bf16x8=__attribute__((ext_vector_type(8)))short;
using s16x4=__attribute__((ext_vector_type(4)))short;
using f32x16=__attribute__((ext_vector_type(16)))float;
using u32x4=__attribute__((ext_vector_type(4)))unsigned;
constexpr int SEQ=16384,D=64,PQ=2816,PO=512;
constexpr int NW=8,QBLK=32,QB=QBLK*NW,KVBLK=64,NQB=SEQ/QB;
constexpr int ATTN_UNIT_ROWS=QB;
__device__ __forceinline__ int crow(int r,int hi){return (r&3)+8*(r>>2)+4*hi;}
#define SBAR() __builtin_amdgcn_sched_barrier(0)
__device__ __forceinline__ void cmask(f32x16&p0,f32x16&p1,int jb,int qrel,int hi){
  const float NEG=-INFINITY; int kb=64*jb+4*hi;
  #pragma unroll
  for(int r=0;r<16;++r){int kv=kb+(r&3)+8*(r>>2); if(kv>qrel)p0[r]=NEG; if(kv+32>qrel)p1[r]=NEG;}
}

constexpr int NSLOT=3, SLOTB=8192;
constexpr int LDS_K=0, LDS_V=NSLOT*SLOTB, LDS_WS=2*NSLOT*SLOTB, LDS_OST=LDS_WS+NW*64*4, LDS_BYTES=LDS_OST+NW*4096;
constexpr float C2=0.125f*1.4426950408889634f;
__device__ __forceinline__ void glds16(const void*gsrc,unsigned lds_dst){unsigned keep;
  asm volatile("s_mov_b32 %0, m0\n\ts_mov_b32 m0, %2\n\ts_nop 0\n\tglobal_load_lds_dwordx4 %1, off\n\ts_mov_b32 m0, %0":"=&s"(keep):"v"(gsrc),"s"(lds_dst):"memory");}
__device__ __forceinline__ float max3f(float a,float b,float c){float r;asm("v_max3_f32 %0, %1, %2, %3":"=v"(r):"v"(a),"v"(b),"v"(c));return r;}
__device__ __forceinline__ float max2f(float a,float b){float r;asm("v_max_f32_e32 %0, %1, %2":"=v"(r):"v"(a),"v"(b));return r;}
__device__ __forceinline__ float fadd_s(float a,float b){float r;asm("v_add_f32_e32 %0, %1, %2":"=v"(r):"v"(a),"v"(b));return r;}
__device__ __forceinline__ float fsub_s(float a,float b){float r;asm("v_sub_f32_e32 %0, %1, %2":"=v"(r):"v"(a),"v"(b));return r;}
typedef float f32x2_t __attribute__((ext_vector_type(2))); typedef __bf16 bf16x2_t __attribute__((ext_vector_type(2)));
__device__ __forceinline__ unsigned cvtpk_s(float lo,float hi){f32x2_t v={lo,hi};bf16x2_t b=__builtin_convertvector(v,bf16x2_t);return __builtin_bit_cast(unsigned,b);}
#define WAIT_BAR(N) asm volatile("s_waitcnt vmcnt(" #N ") lgkmcnt(0)\n\ts_barrier":::"memory")

__device__ __forceinline__ void qkt(f32x16&p0,f32x16&p1,const char*Kslot,const bf16x8*qr,const f32x16&negm,int r32,int hi){
  const char*kb=Kslot+hi*1024+r32*16;
  #pragma unroll
  for(int d0=0;d0<4;++d0){
    const bf16x8 b0=*reinterpret_cast<const bf16x8*>(kb+d0*2048);
    const bf16x8 b1=*reinterpret_cast<const bf16x8*>(kb+d0*2048+512);
    if(d0==0){p0=__builtin_amdgcn_mfma_f32_32x32x16_bf16(b0,qr[0],negm,0,0,0);p1=__builtin_amdgcn_mfma_f32_32x32x16_bf16(b1,qr[0],negm,0,0,0);}
    else{p0=__builtin_amdgcn_mfma_f32_32x32x16_bf16(b0,qr[d0],p0,0,0,0);p1=__builtin_amdgcn_mfma_f32_32x32x16_bf16(b1,qr[d0],p1,0,0,0);}}
}
typedef __attribute__((address_space(3))) const char* lds_cptr;
typedef short v4i16_t __attribute__((ext_vector_type(4)));
__device__ __forceinline__ void kload8(bf16x8*kf,lds_cptr kp){
  kf[0]=*(const __attribute__((address_space(3))) bf16x8*)(kp);      kf[1]=*(const __attribute__((address_space(3))) bf16x8*)(kp+512);
  kf[2]=*(const __attribute__((address_space(3))) bf16x8*)(kp+2048); kf[3]=*(const __attribute__((address_space(3))) bf16x8*)(kp+2560);
  kf[4]=*(const __attribute__((address_space(3))) bf16x8*)(kp+4096); kf[5]=*(const __attribute__((address_space(3))) bf16x8*)(kp+4608);
  kf[6]=*(const __attribute__((address_space(3))) bf16x8*)(kp+6144); kf[7]=*(const __attribute__((address_space(3))) bf16x8*)(kp+6656);
}
__device__ __forceinline__ void kload2(bf16x8*kf,lds_cptr kp,int j){ kf[2*j]=*(const __attribute__((address_space(3))) bf16x8*)(kp+j*2048); kf[2*j+1]=*(const __attribute__((address_space(3))) bf16x8*)(kp+j*2048+512); }
__device__ __forceinline__ s16x4 vtr(lds_cptr p){ return __builtin_bit_cast(s16x4,__builtin_amdgcn_ds_read_tr16_b64_v4i16((__attribute__((address_space(3))) v4i16_t*)p)); }
__device__ __forceinline__ float rowmax(const f32x16&p0,const f32x16&p1){
  float a=max3f(p0[0],p0[1],p1[0]),b=max3f(p0[2],p0[3],p1[1]);a=max3f(a,p1[2],p1[3]);
  #pragma unroll
  for(int r=4;r<16;r+=4){a=max3f(a,p0[r],p0[r+1]);b=max3f(b,p0[r+2],p0[r+3]);a=max3f(a,p1[r],p1[r+1]);b=max3f(b,p1[r+2],p1[r+3]);}
  const float m=max2f(a,b);
  auto rr=__builtin_amdgcn_permlane32_swap(__float_as_uint(m),__float_as_uint(m),false,false);
  return max2f(__uint_as_float(rr[0]),__uint_as_float(rr[1]));
}
__device__ __forceinline__ void pv(f32x16*o,int vb,bf16x8 pa0,bf16x8 pa1,bf16x8 pa2,bf16x8 pa3){
  #pragma unroll
  for(int d0=0;d0<2;++d0){s16x4 lo[4],hi[4];
    #pragma unroll
    for(int ks=0;ks<4;++ks){
      asm volatile("ds_read_b64_tr_b16 %0,%1 offset:%c2":"=&v"(lo[ks]):"v"(vb),"i"(d0*4096+ks*1024):"memory");
      asm volatile("ds_read_b64_tr_b16 %0,%1 offset:%c2":"=&v"(hi[ks]):"v"(vb),"i"(d0*4096+ks*1024+512):"memory");}
    asm volatile("s_waitcnt lgkmcnt(0)":::"memory");SBAR();
    #define PK(k) (bf16x8){lo[k][0],lo[k][1],lo[k][2],lo[k][3],hi[k][0],hi[k][1],hi[k][2],hi[k][3]}
    o[d0]=__builtin_amdgcn_mfma_f32_32x32x16_bf16(pa0,PK(0),o[d0],0,0,0);
    o[d0]=__builtin_amdgcn_mfma_f32_32x32x16_bf16(pa1,PK(1),o[d0],0,0,0);
    o[d0]=__builtin_amdgcn_mfma_f32_32x32x16_bf16(pa2,PK(2),o[d0],0,0,0);
    o[d0]=__builtin_amdgcn_mfma_f32_32x32x16_bf16(pa3,PK(3),o[d0],0,0,0);
    #undef PK
  }
}

#ifndef ATTN_STORE16
#define ATTN_STORE16(p,v) (*(u32x4*)(p)=(v))
#endif
template<int THRL> __device__ __forceinline__ void attn_unit(const int tid,int qb,const bf16*Qh,const bf16*__restrict__ Kh,const bf16*__restrict__ Vh,bf16*Oh,char*shm){
  const int lane=tid&63,r32=lane&31,hi=lane>>5; const int wid=__builtin_amdgcn_readfirstlane(tid>>6);
  const int q0=qb*QB;
  const bf16*Qw=Qh+(long)(q0+wid*QBLK)*PQ;
  const unsigned lds0=(unsigned)(uintptr_t)shm;
  float*wsf=(float*)(shm+LDS_WS)+wid*64;
  const bf16*ksrc=Kh+(long)lane*PQ+wid*8;
  const bf16*vsrc=Vh+(long)(16*(wid&3)+(lane>>2))*PQ+(wid>>2)*32+(lane&3)*8;
  const unsigned kdst=lds0+LDS_K+wid*1024, vdst=lds0+LDS_V+wid*1024;
  #define DMA_K(t,slot) glds16(ksrc+(long)(t)*KVBLK*PQ,(unsigned)__builtin_amdgcn_readfirstlane(kdst+(slot)))
  #define DMA_V(t,slot) glds16(vsrc+(long)(t)*KVBLK*PQ,(unsigned)__builtin_amdgcn_readfirstlane(vdst+(slot)))
  const int vb0=(int)(lds0+LDS_V)+((lane>>4)&1)*32+(lane&3)*8+(4*hi+((lane&15)>>2))*64;
  const char*Kbase=shm+LDS_K; bf16x8 kf[8];
  const lds_cptr shm3=(lds_cptr)shm; const lds_cptr kp0=shm3+LDS_K+hi*1024+r32*16; const lds_cptr vp0=shm3+LDS_V+((lane>>4)&1)*32+(lane&3)*8+(4*hi+((lane&15)>>2))*64;
  const int NT=(q0+QB)/KVBLK;
  DMA_K(0,0);DMA_V(0,0);DMA_K(1,SLOTB);
  bf16x8 qr[4];
  #pragma unroll
  for(int d0=0;d0<4;++d0)qr[d0]=*reinterpret_cast<const bf16x8*>(&Qw[(long)r32*PQ+d0*16+hi*8]);
  float mhat=0.f,l_reg=0.f;f32x16 o[2];o[0]=f32x16{};o[1]=f32x16{};const f32x16 negm=f32x16{};
  const int qrel=wid*QBLK+r32;
  #define CMASK(P0,P1,t) do{int jb_=(t)-(NT-4); if(jb_>=0)cmask(P0,P1,jb_,qrel,hi);}while(0)
  bool resc=false;
  #define START(P0,P1) do{ const float rm=rowmax(P0,P1); resc=false; \
    { const float dl=rm; mhat=fadd_s(mhat,dl); \
      _Pragma("unroll") for(int r=0;r<16;++r){P0[r]=fsub_s(P0[r],dl);P1[r]=fsub_s(P1[r],dl);} \
      } \
    _Pragma("unroll") for(int r=0;r<16;++r)P0[r]=__builtin_amdgcn_exp2f(P0[r]); }while(0)
  #define RESC() do{ if(resc){ asm volatile("s_waitcnt lgkmcnt(0)":::"memory"); \
      _Pragma("unroll") for(int d_=0;d_<2;++d_) _Pragma("unroll") for(int r=0;r<16;++r)o[d_][r]*=wsf[crow(r,hi)]; } }while(0)
  f32x16 pA0,pA1,pB0,pB1;
  int sl_prev=0,sl_cur=0,sl_next=SLOTB;
  #define ROT() do{sl_prev=sl_cur;sl_cur=sl_next;sl_next=(sl_next==(NSLOT-1)*SLOTB)?0:sl_next+SLOTB;}while(0)
  DMA_K(2,2*SLOTB);
  WAIT_BAR(3);
  qkt(pA0,pA1,Kbase,qr,negm,r32,hi);asm volatile("s_nop 15\n\ts_nop 7":"+v"(pA0),"+v"(pA1));CMASK(pA0,pA1,0);
  START(pA0,pA1);
  _Pragma("unroll") for(int r=0;r<16;++r)pA1[r]=__builtin_amdgcn_exp2f(pA1[r]);
  WAIT_BAR(0);
  DMA_K(3,0);DMA_V(1,SLOTB);
  ROT();
  kload8(kf,kp0+sl_cur);
  WAIT_BAR(2);
  s16x4 vlo[8],vhi[8]; u32x4 pw0,pw1,pw2,pw3;
  #define PKW(P,B) cvtpk_s(P[B],P[B+1])
  #define PAF(k) __builtin_bit_cast(bf16x8,pw##k)
  #define VFR(i) (bf16x8){vlo[i][0],vlo[i][1],vlo[i][2],vlo[i][3],vhi[i][0],vhi[i][1],vhi[i][2],vhi[i][3]}
  #define PIN(x) asm volatile("":"+v"(x))
  #define MX3(a,b,c) __builtin_fmaxf(__builtin_fmaxf((a),(b)),(c))
  #define GAPA(MF,A0,A1,A2,A3,W0,W1,PW) do{ MF; sacc+=A0; sacc+=A1; sacc+=A2; sacc+=A3; PIN(sacc); W0; W1; PIN(PW); SBAR(); }while(0)
  #define EX(v) __builtin_amdgcn_exp2f(v)
  #define GAPB(MF,X,B) do{ MF; X[B]=EX(X[B]-mhat); X[B+1]=EX(X[B+1]-mhat); X[B+2]=EX(X[B+2]-mhat); X[B+3]=EX(X[B+3]-mhat); PIN(X); SBAR(); }while(0)
  #define VRD(i) do{ vlo[i]=vtr(vp_+(((i)>>2)*4096+((i)&3)*1024)); vhi[i]=vtr(vp_+(((i)>>2)*4096+((i)&3)*1024+512)); }while(0)
  #define KRD(G,j) do{ if(G){ kload2(kf,kp0+sl_next,j); SBAR(); } }while(0)
  #define STEP(C0,C1,P0,P1,t,GK,GV,GL) do{ SBAR(); \
    const lds_cptr vp_=vp0+sl_prev; \
    VRD(0); SBAR(); float sacc=(P0[0]+P0[1]); \
    GAPA(C0=__builtin_amdgcn_mfma_f32_32x32x16_bf16(kf[0],qr[0],negm,0,0,0), P0[2],P0[3],P0[4],P0[5],     pw0[0]=PKW(P0,0), pw0[1]=PKW(P0,2), pw0); \
    VRD(4); SBAR(); GAPA(C1=__builtin_amdgcn_mfma_f32_32x32x16_bf16(kf[1],qr[0],negm,0,0,0), P0[6],P0[7],P0[8],P0[9],     pw0[2]=PKW(P0,4), pw0[3]=PKW(P0,6), pw0); \
    VRD(1); SBAR(); GAPA(C0=__builtin_amdgcn_mfma_f32_32x32x16_bf16(kf[2],qr[1],C0,0,0,0),   P0[10],P0[11],P0[12],P0[13], pw1[0]=PKW(P0,8), pw1[1]=PKW(P0,10), pw1); \
    VRD(5); SBAR(); GAPA(C1=__builtin_amdgcn_mfma_f32_32x32x16_bf16(kf[3],qr[1],C1,0,0,0),   P0[14],P0[15],P1[0],P1[1],   pw1[2]=PKW(P0,12),pw1[3]=PKW(P0,14), pw1); \
    VRD(2); SBAR(); GAPA(C0=__builtin_amdgcn_mfma_f32_32x32x16_bf16(kf[4],qr[2],C0,0,0,0),   P1[2],P1[3],P1[4],P1[5],     pw2[0]=PKW(P1,0), pw2[1]=PKW(P1,2), pw2); \
    VRD(6); SBAR(); GAPA(C1=__builtin_amdgcn_mfma_f32_32x32x16_bf16(kf[5],qr[2],C1,0,0,0),   P1[6],P1[7],P1[8],P1[9],     pw2[2]=PKW(P1,4), pw2[3]=PKW(P1,6), pw2); \
    VRD(3); SBAR(); GAPA(C0=__builtin_amdgcn_mfma_f32_32x32x16_bf16(kf[6],qr[3],C0,0,0,0),   P1[10],P1[11],P1[12],P1[13], pw3[0]=PKW(P1,8), pw3[1]=PKW(P1,10), pw3); \
    VRD(7); SBAR(); GAPA(C1=__builtin_amdgcn_mfma_f32_32x32x16_bf16(kf[7],qr[3],C1,0,0,0),   P1[14],P1[15],0.f,0.f,       pw3[2]=PKW(P1,12),pw3[3]=PKW(P1,14), pw3); \
    l_reg+=sacc; \
    if(GK){DMA_K((t)+3,sl_cur);} if(GV){DMA_V((t)+1,sl_next);} \
    CMASK(C0,C1,t); \
    { float a=MX3(C0[0],C0[1],C1[0]),b=MX3(C0[2],C0[3],C1[1]); a=MX3(a,C1[2],C1[3]); \
      _Pragma("unroll") for(int r=4;r<16;r+=4){a=MX3(a,C0[r],C0[r+1]);b=MX3(b,C0[r+2],C0[r+3]);a=MX3(a,C1[r],C1[r+1]);b=MX3(b,C1[r+2],C1[r+3]);} \
      float rm=__builtin_fmaxf(a,b); { auto rr=__builtin_amdgcn_permlane32_swap(__float_as_uint(rm),__float_as_uint(rm),false,false); rm=__builtin_fmaxf(__uint_as_float(rr[0]),__uint_as_float(rr[1])); } \
      resc=false; \
      rm-=mhat; \
      if(__builtin_expect(__any(rm>(float)THRL),0)){ const float dl=__builtin_fmaxf(rm,0.f); mhat+=dl; \
        const float f=__builtin_amdgcn_exp2f(-dl); l_reg*=f; if(hi==0)wsf[r32]=f; resc=true; } } \
    SBAR(); \
    GAPB(o[0]=__builtin_amdgcn_mfma_f32_32x32x16_bf16(PAF(0),VFR(0),o[0],0,0,0), C0,0); \
    GAPB(o[1]=__builtin_amdgcn_mfma_f32_32x32x16_bf16(PAF(0),VFR(4),o[1],0,0,0), C0,4); \
    KRD(GL,0); GAPB(o[0]=__builtin_amdgcn_mfma_f32_32x32x16_bf16(PAF(1),VFR(1),o[0],0,0,0), C0,8); \
    KRD(GL,1); GAPB(o[1]=__builtin_amdgcn_mfma_f32_32x32x16_bf16(PAF(1),VFR(5),o[1],0,0,0), C0,12); \
    KRD(GL,2); GAPB(o[0]=__builtin_amdgcn_mfma_f32_32x32x16_bf16(PAF(2),VFR(2),o[0],0,0,0), C1,0); \
    KRD(GL,3); GAPB(o[1]=__builtin_amdgcn_mfma_f32_32x32x16_bf16(PAF(2),VFR(6),o[1],0,0,0), C1,4); \
    GAPB(o[0]=__builtin_amdgcn_mfma_f32_32x32x16_bf16(PAF(3),VFR(3),o[0],0,0,0), C1,8); \
    GAPB(o[1]=__builtin_amdgcn_mfma_f32_32x32x16_bf16(PAF(3),VFR(7),o[1],0,0,0), C1,12); \
    }while(0)
  int t=1;
  #undef CMASK
  #define CMASK(P0,P1,t) do{}while(0)
  for(;t+5<NT;t+=2){
    STEP(pB0,pB1,pA0,pA1,t,true,true,true);     WAIT_BAR(2); RESC(); ROT();
    STEP(pA0,pA1,pB0,pB1,t+1,true,true,true);   WAIT_BAR(2); RESC(); ROT();
  }
  #undef CMASK
  #define CMASK(P0,P1,t) do{int jb_=(t)-(NT-4); if(jb_>=0)cmask(P0,P1,jb_,qrel,hi);}while(0)
  #define ENDW(tt) do{ if((tt)+3<NT){WAIT_BAR(2);} else if((tt)+2<NT){WAIT_BAR(1);} else {WAIT_BAR(0);} }while(0)
  for(;t+1<NT;t+=2){
    STEP(pB0,pB1,pA0,pA1,t,(t+3<NT),(t+1<NT),(t+1<NT));       ENDW(t);   RESC(); ROT();
    STEP(pA0,pA1,pB0,pB1,t+1,(t+4<NT),(t+2<NT),(t+2<NT));     ENDW(t+1); RESC(); ROT();
  }
  STEP(pB0,pB1,pA0,pA1,NT-1,false,false,false); RESC();
  { float sacc=pB0[0]+pB0[1]; _Pragma("unroll") for(int r=2;r<16;++r)sacc+=pB0[r]; _Pragma("unroll") for(int r=0;r<16;++r)sacc+=pB1[r]; l_reg+=sacc;
    pw0=(u32x4){PKW(pB0,0),PKW(pB0,2),PKW(pB0,4),PKW(pB0,6)};pw1=(u32x4){PKW(pB0,8),PKW(pB0,10),PKW(pB0,12),PKW(pB0,14)};pw2=(u32x4){PKW(pB1,0),PKW(pB1,2),PKW(pB1,4),PKW(pB1,6)};pw3=(u32x4){PKW(pB1,8),PKW(pB1,10),PKW(pB1,12),PKW(pB1,14)};
    SBAR(); pv(o,vb0+sl_cur,PAF(0),PAF(1),PAF(2),PAF(3)); }
  #undef PKW
  #undef PAF
  #undef VFR
  #undef PIN
  #undef MX3
  #undef GAPA
  #undef GAPB
  #undef EX
  #undef VRD
  #undef KRD
  #undef STEP
  #undef ENDW
  {auto rr=__builtin_amdgcn_permlane32_swap(__float_as_uint(l_reg),__float_as_uint(l_reg),false,false);l_reg=__uint_as_float(rr[0])+__uint_as_float(rr[1]);}
  if(hi==0)wsf[32+r32]=l_reg;asm volatile("s_waitcnt lgkmcnt(0)":::"memory");
  float rli[16];
  #pragma unroll
  for(int r=0;r<16;++r)rli[r]=__builtin_amdgcn_rcpf(wsf[32+crow(r,hi)]);
  bf16*Ow=Oh+(long)(q0+wid*QBLK)*PO;
  { bf16*stg=(bf16*)(shm+LDS_OST)+wid*2048;
    #pragma unroll
    for(int r=0;r<16;++r){const int orow=crow(r,hi);
      #pragma unroll
      for(int d0=0;d0<2;++d0)stg[orow*64+d0*32+r32]=__float2bfloat16(o[d0][r]*rli[r]);}
    asm volatile("s_waitcnt lgkmcnt(0)":::"memory");
    #pragma unroll
    for(int i=0;i<4;++i){const int row=i*8+(lane>>3),ch=lane&7; const u32x4 v=*(const u32x4*)(stg+row*64+ch*8); ATTN_STORE16(Ow+(long)row*PO+ch*8,v);} }
  asm volatile("s_waitcnt lgkmcnt(0)\n\ts_barrier":::"memory");
  #undef DMA_K
  #undef DMA_V
  #undef CMASK
  #undef START
  #undef RESC
  #undef ROT
}
constexpr int ATTN_LDS_BYTES=LDS_BYTES;
#undef SBAR
#undef WAIT_BAR
}
namespace attn_body {
#define SBAR() __builtin_amdgcn_sched_barrier(0)
#define WAIT_BAR(N) asm volatile("s_waitcnt vmcnt(" #N ") lgkmcnt(0)\n\ts_barrier":::"memory")
constexpr int SLOTV=16384;
constexpr int L2_K=0, L2_V=NSLOT*SLOTB, L2_WS=L2_V+NSLOT*SLOTV, L2_OST=L2_WS+NW*64*4, LDS2_BYTES=L2_OST+NW*4096;
template<int THRL> __device__ __forceinline__ void attn_unit2(const int tid,int qb,const bf16*Qh,const bf16*__restrict__ Kh,const bf16*__restrict__ Vh,bf16*Oh,char*shm){
  const int lane=tid&63,r32=lane&31,hi=lane>>5; const int wid=__builtin_amdgcn_readfirstlane(tid>>6);
  const int q0=qb*QB;
  const bf16*Qw=Qh+(long)(q0+wid*QBLK)*PQ;
  const unsigned lds0=(unsigned)(uintptr_t)shm;
  float*wsf=(float*)(shm+L2_WS)+wid*64;
  const bf16*ksrc=Kh+(long)lane*PQ+wid*8;
  const bf16*vsrc=Vh+(long)(16*(wid&3)+(lane>>2))*PQ+(wid>>2)*32+(lane&3)*8;
  const unsigned kdst=lds0+L2_K+wid*1024, vdst=lds0+L2_V+wid*1024;
  #define DMA_K(t,slot) glds16(ksrc+(long)(t)*KVBLK*PQ,(unsigned)__builtin_amdgcn_readfirstlane(kdst+(slot)))
  #define DMA_V(t,slot) do{ glds16(vsrc+(long)(t)*KVBLK*PQ,(unsigned)__builtin_amdgcn_readfirstlane(vdst+2*(slot))); glds16(vsrc+64+(long)(t)*KVBLK*PQ,(unsigned)__builtin_amdgcn_readfirstlane(vdst+8192+2*(slot))); }while(0)
  const int vb0=(int)(lds0+L2_V)+((lane>>4)&1)*32+(lane&3)*8+(4*hi+((lane&15)>>2))*64;
  const char*Kbase=shm+L2_K; bf16x8 kf[8];
  const lds_cptr shm3=(lds_cptr)shm; const lds_cptr kp0=shm3+L2_K+hi*1024+r32*16; const lds_cptr vp0=shm3+L2_V+((lane>>4)&1)*32+(lane&3)*8+(4*hi+((lane&15)>>2))*64;
  const int NT=(q0+QB)/KVBLK;
  DMA_K(0,0);DMA_V(0,0);DMA_K(1,SLOTB);
  bf16x8 qr[4];
  #pragma unroll
  for(int d0=0;d0<4;++d0)qr[d0]=*reinterpret_cast<const bf16x8*>(&Qw[(long)r32*PQ+d0*16+hi*8]);
  float mhat=0.f,l_reg=0.f;f32x16 o[4];o[0]=f32x16{};o[1]=f32x16{};o[2]=f32x16{};o[3]=f32x16{};const f32x16 zc=f32x16{};
  const int qrel=wid*QBLK+r32;
  #define CMASK(P0,P1,t) do{int jb_=(t)-(NT-4); if(jb_>=0)cmask(P0,P1,jb_,qrel,hi);}while(0)
  bool resc=false;
  #define RESC() do{ if(resc){ asm volatile("s_waitcnt lgkmcnt(0)":::"memory"); \
      _Pragma("unroll") for(int d_=0;d_<4;++d_) _Pragma("unroll") for(int r=0;r<16;++r)o[d_][r]*=wsf[crow(r,hi)]; } }while(0)
  f32x16 C0,C1;
  int sl_prev=0,sl_cur=0,sl_next=SLOTB;
  #define ROT() do{sl_prev=sl_cur;sl_cur=sl_next;sl_next=(sl_next==(NSLOT-1)*SLOTB)?0:sl_next+SLOTB;}while(0)
  DMA_K(2,2*SLOTB);
  WAIT_BAR(3);
  s16x4 vlo[8],vhi[8]; u32x4 pw0,pw1,pw2,pw3;
  #define PKW(P,B) cvtpk_s(P[B],P[B+1])
  #define PAF(k) __builtin_bit_cast(bf16x8,pw##k)
  #define VFR(i) (bf16x8){vlo[i][0],vlo[i][1],vlo[i][2],vlo[i][3],vhi[i][0],vhi[i][1],vhi[i][2],vhi[i][3]}
  #define PIN(x) asm volatile("":"+v"(x))
  #define MX3(a,b,c) __builtin_fmaxf(__builtin_fmaxf((a),(b)),(c))
  #define EX(v) __builtin_amdgcn_exp2f(v)
  qkt(C0,C1,Kbase,qr,zc,r32,hi);asm volatile("s_nop 15\n\ts_nop 7":"+v"(C0),"+v"(C1));CMASK(C0,C1,0);
  { const float rm=rowmax(C0,C1); mhat=rm;
    _Pragma("unroll") for(int r=0;r<16;++r){C0[r]=EX(C0[r]-rm);C1[r]=EX(C1[r]-rm);}
    float sacc=C0[0]+C0[1]; _Pragma("unroll") for(int r=2;r<16;++r)sacc+=C0[r]; _Pragma("unroll") for(int r=0;r<16;++r)sacc+=C1[r]; l_reg=sacc;
    pw0=(u32x4){PKW(C0,0),PKW(C0,2),PKW(C0,4),PKW(C0,6)};pw1=(u32x4){PKW(C0,8),PKW(C0,10),PKW(C0,12),PKW(C0,14)};pw2=(u32x4){PKW(C1,0),PKW(C1,2),PKW(C1,4),PKW(C1,6)};pw3=(u32x4){PKW(C1,8),PKW(C1,10),PKW(C1,12),PKW(C1,14)}; }
  WAIT_BAR(0);
  DMA_K(3,0);DMA_V(1,SLOTB);
  ROT();
  kload8(kf,kp0+sl_cur);
  WAIT_BAR(3);
  #define GAPA(MF) do{ MF; SBAR(); }while(0)
  #define GAPB1(MF,X,B,I) do{ MF; X[B]=EX(X[B]-mhat); X[B+1]=EX(X[B+1]-mhat); X[B+2]=EX(X[B+2]-mhat); X[B+3]=EX(X[B+3]-mhat); PIN(X); VRD2(I); SBAR(); }while(0)
  #define VRD(i)  do{ vlo[i]=vtr(vp_+(((i)>>2)*4096+((i)&3)*1024)); vhi[i]=vtr(vp_+(((i)>>2)*4096+((i)&3)*1024+512)); }while(0)
  #define VRD2(i) do{ vlo[i]=vtr(vp_+(8192+((i)>>2)*4096+((i)&3)*1024)); vhi[i]=vtr(vp_+(8192+((i)>>2)*4096+((i)&3)*1024+512)); }while(0)
  #define KRD(G,j) do{ if(G){ kload2(kf,kp0+sl_next,j); } }while(0)
  #define ADD4(a,b,c,d) do{ sacc+=a; sacc+=b; sacc+=c; sacc+=d; PIN(sacc); }while(0)
  #define STEP2(t,GK,GV,GL) do{ SBAR(); \
    const lds_cptr vp_=vp0+2*sl_prev; \
    VRD(0); SBAR(); GAPA(C0=__builtin_amdgcn_mfma_f32_32x32x16_bf16(kf[0],qr[0],zc,0,0,0)); \
    VRD(4); SBAR(); GAPA(C1=__builtin_amdgcn_mfma_f32_32x32x16_bf16(kf[1],qr[0],zc,0,0,0)); \
    VRD(1); SBAR(); GAPA(C0=__builtin_amdgcn_mfma_f32_32x32x16_bf16(kf[2],qr[1],C0,0,0,0)); \
    VRD(5); SBAR(); GAPA(C1=__builtin_amdgcn_mfma_f32_32x32x16_bf16(kf[3],qr[1],C1,0,0,0)); \
    VRD(2); SBAR(); GAPA(C0=__builtin_amdgcn_mfma_f32_32x32x16_bf16(kf[4],qr[2],C0,0,0,0)); \
    VRD(6); SBAR(); GAPA(C1=__builtin_amdgcn_mfma_f32_32x32x16_bf16(kf[5],qr[2],C1,0,0,0)); \
    VRD(3); SBAR(); GAPA(C0=__builtin_amdgcn_mfma_f32_32x32x16_bf16(kf[6],qr[3],C0,0,0,0)); \
    VRD(7); SBAR(); GAPA(C1=__builtin_amdgcn_mfma_f32_32x32x16_bf16(kf[7],qr[3],C1,0,0,0)); \
    if(GK){DMA_K((t)+3,sl_cur);} if(GV){DMA_V((t)+1,sl_next);} \
    CMASK(C0,C1,t); \
    { float a=MX3(C0[0],C0[1],C1[0]),b=MX3(C0[2],C0[3],C1[1]); a=MX3(a,C1[2],C1[3]); \
      _Pragma("unroll") for(int r=4;r<16;r+=4){a=MX3(a,C0[r],C0[r+1]);b=MX3(b,C0[r+2],C0[r+3]);a=MX3(a,C1[r],C1[r+1]);b=MX3(b,C1[r+2],C1[r+3]);} \
      float rm=__builtin_fmaxf(a,b); { auto rr=__builtin_amdgcn_permlane32_swap(__float_as_uint(rm),__float_as_uint(rm),false,false); rm=__builtin_fmaxf(__uint_as_float(rr[0]),__uint_as_float(rr[1])); } \
      resc=false; rm-=mhat; \
      if(__builtin_expect(__any(rm>(float)THRL),0)){ const float dl=__builtin_fmaxf(rm,0.f); mhat+=dl; \
        const float f=__builtin_amdgcn_exp2f(-dl); l_reg*=f; if(hi==0)wsf[r32]=f; resc=true; } } \
    SBAR(); \
    GAPB1(o[0]=__builtin_amdgcn_mfma_f32_32x32x16_bf16(PAF(0),VFR(0),o[0],0,0,0), C0,0, 0); \
    GAPB1(o[1]=__builtin_amdgcn_mfma_f32_32x32x16_bf16(PAF(0),VFR(4),o[1],0,0,0), C0,4, 4); \
    GAPB1(o[0]=__builtin_amdgcn_mfma_f32_32x32x16_bf16(PAF(1),VFR(1),o[0],0,0,0), C0,8, 1); \
    GAPB1(o[1]=__builtin_amdgcn_mfma_f32_32x32x16_bf16(PAF(1),VFR(5),o[1],0,0,0), C0,12,5); \
    GAPB1(o[0]=__builtin_amdgcn_mfma_f32_32x32x16_bf16(PAF(2),VFR(2),o[0],0,0,0), C1,0, 2); \
    GAPB1(o[1]=__builtin_amdgcn_mfma_f32_32x32x16_bf16(PAF(2),VFR(6),o[1],0,0,0), C1,4, 6); \
    GAPB1(o[0]=__builtin_amdgcn_mfma_f32_32x32x16_bf16(PAF(3),VFR(3),o[0],0,0,0), C1,8, 3); \
    GAPB1(o[1]=__builtin_amdgcn_mfma_f32_32x32x16_bf16(PAF(3),VFR(7),o[1],0,0,0), C1,12,7); \
    float sacc=(C0[0]+C0[1]); \
    o[2]=__builtin_amdgcn_mfma_f32_32x32x16_bf16(PAF(0),VFR(0),o[2],0,0,0); ADD4(C0[2],C0[3],C0[4],C0[5]); KRD(GL,0); SBAR(); \
    o[3]=__builtin_amdgcn_mfma_f32_32x32x16_bf16(PAF(0),VFR(4),o[3],0,0,0); ADD4(C0[6],C0[7],C0[8],C0[9]); KRD(GL,1); SBAR(); \
    o[2]=__builtin_amdgcn_mfma_f32_32x32x16_bf16(PAF(1),VFR(1),o[2],0,0,0); ADD4(C0[10],C0[11],C0[12],C0[13]); pw0[0]=PKW(C0,0); pw0[1]=PKW(C0,2); PIN(pw0); KRD(GL,2); SBAR(); \
    o[3]=__builtin_amdgcn_mfma_f32_32x32x16_bf16(PAF(1),VFR(5),o[3],0,0,0); ADD4(C0[14],C0[15],C1[0],C1[1]); pw0[2]=PKW(C0,4); pw0[3]=PKW(C0,6); PIN(pw0); KRD(GL,3); SBAR(); \
    o[2]=__builtin_amdgcn_mfma_f32_32x32x16_bf16(PAF(2),VFR(2),o[2],0,0,0); ADD4(C1[2],C1[3],C1[4],C1[5]); pw1[0]=PKW(C0,8); pw1[1]=PKW(C0,10); PIN(pw1); SBAR(); \
    o[3]=__builtin_amdgcn_mfma_f32_32x32x16_bf16(PAF(2),VFR(6),o[3],0,0,0); ADD4(C1[6],C1[7],C1[8],C1[9]); pw1[2]=PKW(C0,12); pw1[3]=PKW(C0,14); PIN(pw1); SBAR(); \
    o[2]=__builtin_amdgcn_mfma_f32_32x32x16_bf16(PAF(3),VFR(3),o[2],0,0,0); ADD4(C1[10],C1[11],C1[12],C1[13]); pw2[0]=PKW(C1,0); pw2[1]=PKW(C1,2); PIN(pw2); SBAR(); \
    o[3]=__builtin_amdgcn_mfma_f32_32x32x16_bf16(PAF(3),VFR(7),o[3],0,0,0); sacc+=C1[14]; sacc+=C1[15]; PIN(sacc); pw2[2]=PKW(C1,4); pw2[3]=PKW(C1,6); PIN(pw2); SBAR(); \
    pw3[0]=PKW(C1,8); pw3[1]=PKW(C1,10); pw3[2]=PKW(C1,12); pw3[3]=PKW(C1,14); PIN(pw3); l_reg+=sacc; \
    }while(0)
  #define ENDW(tt) do{ if((tt)+3<NT){WAIT_BAR(3);} else if((tt)+2<NT){WAIT_BAR(2);} else {WAIT_BAR(0);} }while(0)
  int t=1;
  #undef CMASK
  #define CMASK(P0,P1,t) do{}while(0)
  for(;t+4<NT;++t){ STEP2(t,true,true,true); WAIT_BAR(3); RESC(); ROT(); }
  #undef CMASK
  #define CMASK(P0,P1,t) do{int jb_=(t)-(NT-4); if(jb_>=0)cmask(P0,P1,jb_,qrel,hi);}while(0)
  for(;t+1<NT;++t){ STEP2(t,(t+3<NT),(t+1<NT),(t+1<NT)); ENDW(t); RESC(); ROT(); }
  STEP2(NT-1,false,false,false); RESC();
  { SBAR(); const int vb=vb0+2*sl_cur;
    #pragma unroll
    for(int d0=0;d0<4;++d0){s16x4 lo[4],hi4[4];
      #pragma unroll
      for(int ks=0;ks<4;++ks){
        asm volatile("ds_read_b64_tr_b16 %0,%1 offset:%c2":"=&v"(lo[ks]):"v"(vb),"i"(d0*4096+ks*1024):"memory");
        asm volatile("ds_read_b64_tr_b16 %0,%1 offset:%c2":"=&v"(hi4[ks]):"v"(vb),"i"(d0*4096+ks*1024+512):"memory");}
      asm volatile("s_waitcnt lgkmcnt(0)":::"memory");SBAR();
      #define PK(k) (bf16x8){lo[k][0],lo[k][1],lo[k][2],lo[k][3],hi4[k][0],hi4[k][1],hi4[k][2],hi4[k][3]}
      o[d0]=__builtin_amdgcn_mfma_f32_32x32x16_bf16(PAF(0),PK(0),o[d0],0,0,0);
      o[d0]=__builtin_amdgcn_mfma_f32_32x32x16_bf16(PAF(1),PK(1),o[d0],0,0,0);
      o[d0]=__builtin_amdgcn_mfma_f32_32x32x16_bf16(PAF(2),PK(2),o[d0],0,0,0);
      o[d0]=__builtin_amdgcn_mfma_f32_32x32x16_bf16(PAF(3),PK(3),o[d0],0,0,0);
      #undef PK
    } }
  {auto rr=__builtin_amdgcn_permlane32_swap(__float_as_uint(l_reg),__float_as_uint(l_reg),false,false);l_reg=__uint_as_float(rr[0])+__uint_as_float(rr[1]);}
  if(hi==0)wsf[32+r32]=l_reg;asm volatile("s_waitcnt lgkmcnt(0)":::"memory");
  float rli[16];
  #pragma unroll
  for(int r=0;r<16;++r)rli[r]=__builtin_amdgcn_rcpf(wsf[32+crow(r,hi)]);
  bf16*Ow=Oh+(long)(q0+wid*QBLK)*PO;
  { bf16*stg=(bf16*)(shm+L2_OST)+wid*2048;
    #pragma unroll
    for(int hf=0;hf<2;++hf){
      #pragma unroll
      for(int r=0;r<16;++r){const int orow=crow(r,hi);
        #pragma unroll
        for(int d0=0;d0<2;++d0)stg[orow*64+d0*32+r32]=__float2bfloat16(o[2*hf+d0][r]*rli[r]);}
      asm volatile("s_waitcnt lgkmcnt(0)":::"memory");
      #pragma unroll
      for(int i=0;i<4;++i){const int row=i*8+(lane>>3),ch=lane&7; const u32x4 v=*(const u32x4*)(stg+row*64+ch*8); ATTN_STORE16(Ow+(long)row*PO+hf*64+ch*8,v);}
      asm volatile("s_waitcnt lgkmcnt(0)":::"memory");
    } }
  asm volatile("s_waitcnt lgkmcnt(0)\n\ts_barrier":::"memory");
  #undef DMA_K
  #undef DMA_V
  #undef CMASK
  #undef RESC
  #undef ROT
  #undef PKW
  #undef PAF
  #undef VFR
  #undef PIN
  #undef MX3
  #undef EX
  #undef GAPA
  #undef GAPB1
  #undef VRD
  #undef VRD2
  #undef KRD
  #undef ADD4
  #undef STEP2
  #undef ENDW
}
#undef SBAR
#undef WAIT_BAR
}
#define GAS __attribute__((address_space(1)))
#define LAS __attribute__((address_space(3)))
typedef unsigned short bf16;
typedef unsigned v4u __attribute__((ext_vector_type(4)));
typedef float f32x4 __attribute__((ext_vector_type(4)));
typedef short bf16x8 __attribute__((ext_vector_type(8)));
typedef GAS unsigned gu32;
typedef GAS unsigned long long gu64;
#define RLX_AGENT __ATOMIC_RELAXED, __HIP_MEMORY_SCOPE_AGENT
#define LDS_WAIT() asm volatile("s_waitcnt lgkmcnt(0)" ::: "memory")
#define VM_WAIT() asm volatile("s_waitcnt vmcnt(0)" ::: "memory")
__device__ __forceinline__ unsigned long long rt() { return __builtin_amdgcn_s_memrealtime(); }
__device__ __forceinline__ unsigned f2bf(float f) { unsigned u = __builtin_bit_cast(unsigned, f); return (u + 0x7fffu + ((u >> 16) & 1u)) >> 16; }
__device__ __forceinline__ unsigned pk2(float lo, float hi) { return f2bf(lo) | (f2bf(hi) << 16); }

#define XB_TMO      128
#define XB_XCNT(j)  (256  + 64 * (j))
#define XB_XSUB(j)  (1280 + 64 * (j))
#define XB_XGEN(j)  (2304 + 64 * (j))
#define XB_TOP      3328
#define XB_TOPGEN   3392
#define XCD_BAR_WORDS 3456
#define XB_SPIN_CAP (1u << 18)

__device__ __forceinline__ unsigned xb_ld(unsigned* p)              { return __hip_atomic_load(p, __ATOMIC_RELAXED, __HIP_MEMORY_SCOPE_AGENT); }
__device__ __forceinline__ unsigned xb_add(unsigned* p, unsigned v) { return __hip_atomic_fetch_add(p, v, __ATOMIC_RELAXED, __HIP_MEMORY_SCOPE_AGENT); }
__device__ __forceinline__ unsigned xb_xcc_id() { return (unsigned)__builtin_amdgcn_s_getreg((3 << 11) | 20) & 0xFu; }
#define XB_SPIN(cond, bar) do { unsigned _sp = 0; while (cond) { __builtin_amdgcn_s_sleep(1); \
    if ((++_sp & 255u) == 0u) { if (xb_ld(&(bar)[XB_TMO])) break; if (_sp > XB_SPIN_CAP) { atomicAdd(&(bar)[XB_TMO], 1u); break; } } } } while (0)

struct XcdBarrier {
    unsigned* bar; unsigned x;
    volatile LAS unsigned* st;
};

__device__ __forceinline__ XcdBarrier xcd_barrier_post(unsigned* bar, volatile LAS unsigned* st, const int tid) {
    XcdBarrier b; b.bar = bar; b.x = xb_xcc_id(); b.st = st;
    if (tid == 0) (void)xb_add(&bar[XB_XCNT(b.x)], 1u);
    return b;
}
__device__ __forceinline__ void xcd_barrier_complete(unsigned* bar, unsigned x, unsigned& nloc, unsigned& nx) {
    const unsigned G = gridDim.x * gridDim.y * gridDim.z;
    unsigned sum, cnt, mine, sp = 0u;
    for (;;) {
        sum = 0u; cnt = 0u; mine = 0u;
#pragma unroll
        for (unsigned j = 0; j < 16; ++j) { const unsigned c = xb_ld(&bar[XB_XCNT(j)]); sum += c; cnt += (c > 0u) ? 1u : 0u; mine = (j == x) ? c : mine; }
        if (sum == G) break;
        __builtin_amdgcn_s_sleep(1);
        if ((++sp & 255u) == 0u) { if (xb_ld(&bar[XB_TMO])) break; if (sp > XB_SPIN_CAP) { atomicAdd(&bar[XB_TMO], 1u); break; } }
    }
    nloc = mine > 0u ? mine : 1u; nx = cnt > 0u ? cnt : 1u;
}

__device__ __forceinline__ void xcd_barrier(const XcdBarrier& b, const int tid) {
    asm volatile("s_waitcnt vmcnt(0)" ::: "memory");
    __syncthreads();
    if (tid == 0) {
        unsigned* bar = b.bar;
        __builtin_amdgcn_s_waitcnt(0);
        unsigned nloc = b.st[0], nx = b.st[1];
        if (nloc == 0u) { xcd_barrier_complete(bar, b.x, nloc, nx); b.st[0] = nloc; b.st[1] = nx; }
        const unsigned old = xb_add(&bar[XB_XSUB(b.x)], 1u);
        const unsigned gen = old / nloc;
        if (old + 1u == (gen + 1u) * nloc) {
            __builtin_amdgcn_fence(__ATOMIC_RELEASE, "agent");
            asm volatile("s_waitcnt vmcnt(0)" ::: "memory");
            const unsigned og = xb_add(&bar[XB_TOP], 1u);
            const unsigned tg = og / nx;
            if (og + 1u == (tg + 1u) * nx) xb_add(&bar[XB_TOPGEN], 1u);
            else XB_SPIN(xb_ld(&bar[XB_TOPGEN]) == tg, bar);
            __builtin_amdgcn_fence(__ATOMIC_ACQUIRE, "agent");
            xb_add(&bar[XB_XGEN(b.x)], 1u);
            asm volatile("s_waitcnt vmcnt(0)" ::: "memory");
        } else {
            XB_SPIN(xb_ld(&bar[XB_XGEN(b.x)]) == gen, bar);
            __builtin_amdgcn_fence(__ATOMIC_ACQUIRE, "agent");
            asm volatile("s_waitcnt vmcnt(0)" ::: "memory");
        }
    }
    __syncthreads();
}
constexpr int NWAVES = 8;
#ifndef MK_N_LAUNCHES
#define MK_N_LAUNCHES 1
#endif
constexpr int NPH_LAYER = 11, NPH = 2 + 2 * NPH_LAYER;
constexpr int N_LAUNCHES = MK_N_LAUNCHES;
static_assert(N_LAUNCHES == 1 || N_LAUNCHES == NPH, "MK_N_LAUNCHES is 1 or NPH");

constexpr int SEQ = 16384, DMODEL = 1024, DIN = 2816, FFD = 2816, NEXP = 8, EDIM = 3584, DEPTH = 2;
constexpr int M = SEQ;
constexpr float LN_EPS = 1e-5f;
constexpr float ALPHA = 1.4142135623730951f;
constexpr int MAXSLOT = 135 * 256;

constexpr size_t MiB = 1u << 20;
constexpr size_t WS_CTL = 0, CTL_ZERO_BYTES = 1 * MiB;
constexpr size_t WS_SMALL = 1 * MiB;
constexpr size_t SM_MOD = 0, SM_LBS = 49152, SM_LAM = 51200, SM_TOK = 65536, SM_PERM = 327680;
constexpr size_t WS_ROPE = 2 * MiB;
constexpr size_t WS_EXP13 = 6 * MiB, WS_EXP2 = 118 * MiB;
constexpr size_t WS_HPERM = 174 * MiB;
constexpr size_t WS_YSLOT = 174 * MiB;
constexpr size_t WS_HID = 242 * MiB;
constexpr size_t WS_PROJ = 242 * MiB, WS_DHID = 242 * MiB;
constexpr size_t WS_ATTNO = 330 * MiB, WS_HBUF = 330 * MiB;
constexpr size_t WS_MIX = 362 * MiB, WS_HGS = 394 * MiB, WS_HGD = 410 * MiB;
constexpr size_t WS_WIN = 411 * MiB, WS_WOUT = 422 * MiB, WS_FFN13 = 426 * MiB, WS_FFN2 = 437 * MiB;
constexpr size_t WS_END = 479 * MiB;
static_assert(WS_YSLOT + (size_t)MAXSLOT * 1024 * 2 <= WS_HID && WS_HID + (size_t)MAXSLOT * 3584 * 2 <= WS_END && WS_FFN2 + (size_t)1024 * 2816 * 2 <= WS_END, "d_ws map");
constexpr int CW_TMO = 0, CW_CODE = 1;
constexpr int CW_CNT = 64;
constexpr int CW_BAR = 4096;

constexpr int RING_OFF = 0, RING_BYTES = 131072;
constexpr int LDSCTL_OFF = RING_BYTES, MISC_OFF = LDSCTL_OFF + 320;
constexpr int XTRA_OFF = LDSCTL_OFF + 1024;
constexpr int LDS_BYTES = 147456;

__device__ __forceinline__ float bf2f(unsigned short b) { return __uint_as_float((unsigned)b << 16); }
template <int O> __device__ __forceinline__ float swzx(float v) { return __int_as_float(__builtin_amdgcn_ds_swizzle(__float_as_int(v), (O << 10) | 0x1f)); }
__device__ __forceinline__ float wave_sum(float v) {
    v += swzx<1>(v); v += swzx<2>(v); v += swzx<4>(v); v += swzx<8>(v); v += swzx<16>(v);
    auto rr = __builtin_amdgcn_permlane32_swap(__float_as_uint(v), __float_as_uint(v), false, false);
    return __uint_as_float(rr[0]) + __uint_as_float(rr[1]);
}
__device__ __forceinline__ float sigmoid_f(float z) { return __builtin_amdgcn_rcpf(1.0f + __builtin_amdgcn_exp2f(-1.4426950408889634f * z)); }
__device__ __forceinline__ float silu_ff(float a) { return a * sigmoid_f(a); }

struct Args { const float* in[23]; float* out; unsigned char* ws; int ph_lo, ph_hi, li, pad; };
enum { I_X = 0, I_C, I_WADA, I_BADA, I_WIN, I_LAMQK, I_ATTNG, I_HGLB, I_HGG, I_POOLW, I_POOLS, I_WOUT, I_LN1G, I_LN1B, I_LN2G, I_LN2B, I_FW1, I_FW3, I_FW2, I_RW, I_EW1, I_EW3, I_EW2 };

struct Frame {
    LAS unsigned char* lds; volatile LAS unsigned* MISC; gu32* ctl; unsigned char* ws;
    int tid, lane, wave, vcu, G, bid;
};

__device__ const float kInvFreq[32] = {1.f, 0.749894202f, 0.562341332f, 0.421696514f, 0.316227764f, 0.237137392f, 0.177827939f, 0.133352146f, 0.100000001f, 0.0749894157f, 0.0562341288f, 0.0421696492f,
    0.0316227786f, 0.0237137359f, 0.0177827943f, 0.0133352149f, 0.00999999978f, 0.00749894232f, 0.00562341325f, 0.00421696482f, 0.00316227786f, 0.00237137382f, 0.00177827943f, 0.00133352145f,
    0.00100000005f, 0.000749894185f, 0.000562341302f, 0.000421696546f, 0.000316227786f, 0.000237137385f, 0.00017782794f, 0.00013335215f};

template <int KIND> __device__ __forceinline__ int rowmap(int n) {
    if (KIND == 0) { if (n >= 1024) return n; const int d = n & 63; return (n & ~63) + ((d < 32) ? 2 * d : 2 * (d - 32) + 1); }
    if (KIND == 2) return ((n >> 7) << 8) + (n & 127);
    if (KIND == 3) return ((n >> 7) << 8) + 128 + (n & 127);
    return n;
}
template <int KIND> __device__ __forceinline__ void transpose_item(const float* W, int K, int N, bf16* WT, LAS float* scr, int item, int lane) {
    const int nblk = N / 32, kb = item / nblk, nb = item % nblk, k0 = 64 * kb, n0 = 32 * nb;
#pragma unroll 8
    for (int i = 0; i < 32; ++i) { const int kk = 2 * i + (lane >> 5); scr[kk * 33 + (lane & 31)] = W[(size_t)(k0 + kk) * N + n0 + (lane & 31)]; }
    LDS_WAIT(); asm volatile("" ::: "memory");
    const int c = lane & 7;
#pragma unroll
    for (int j = 0; j < 4; ++j) { const int n = (lane >> 3) + 8 * j; const LAS float* s = scr + (8 * c) * 33 + n;
        v4u o; o.x = pk2(s[0 * 33], s[1 * 33]); o.y = pk2(s[2 * 33], s[3 * 33]); o.z = pk2(s[4 * 33], s[5 * 33]); o.w = pk2(s[6 * 33], s[7 * 33]);
        *(GAS v4u*)(WT + (size_t)rowmap<KIND>(n0 + n) * K + k0 + 8 * c) = o; }
    LDS_WAIT(); asm volatile("" ::: "memory");
}
__device__ __forceinline__ void sincos_acc(float ang, float& s, float& c) {
    const double a = (double)ang; const double n = __builtin_rint(a * 0.63661977236758134308);
    double r = __builtin_fma(-n, 1.57079632679489655800, a); r = __builtin_fma(-n, 6.12323399573676603587e-17, r);
    const double r2 = r * r;
    double sp = -1.0 / 1307674368000.0; sp = sp * r2 + 1.0 / 6227020800.0; sp = sp * r2 - 1.0 / 39916800.0; sp = sp * r2 + 1.0 / 362880.0; sp = sp * r2 - 1.0 / 5040.0; sp = sp * r2 + 1.0 / 120.0; sp = sp * r2 - 1.0 / 6.0;
    const double sr = r + r * r2 * sp;
    double cp = 1.0 / 20922789888000.0; cp = cp * r2 - 1.0 / 87178291200.0; cp = cp * r2 + 1.0 / 479001600.0; cp = cp * r2 - 1.0 / 3628800.0; cp = cp * r2 + 1.0 / 40320.0; cp = cp * r2 - 1.0 / 720.0; cp = cp * r2 + 1.0 / 24.0; cp = cp * r2 - 0.5;
    const double cr = 1.0 + r2 * cp;
    const int q = ((int)n) & 3;
    const double ss = (q == 0) ? sr : (q == 1) ? cr : (q == 2) ? -sr : -cr;
    const double cc = (q == 0) ? cr : (q == 1) ? -sr : (q == 2) ? -cr : sr;
    s = (float)ss; c = (float)cc;
}
__device__ __forceinline__ void p0a_prologue(Frame& F, const Args& A) {
    const int gw = F.vcu * NWAVES + F.wave, NGW = F.G * NWAVES;
    {
        LAS float* red = (LAS float*)(F.lds + XTRA_OFF);
        for (int cb = F.bid; cb < 256; cb += F.G) {
            const int fc = cb * 48 + F.lane; const int l = fc / 6144, j = fc % 6144; float acc = 0.f;
            if (F.lane < 48) {
                const float* w = A.in[I_WADA] + (size_t)l * 1024 * 6144 + j; const float* c = A.in[I_C];
#pragma unroll 8
                for (int k = F.wave * 128; k < F.wave * 128 + 128; ++k) acc += silu_ff(c[k]) * w[(size_t)k * 6144];
            }
            red[F.wave * 64 + F.lane] = acc;
            __syncthreads();
            if (F.wave == 0 && F.lane < 48) { float s = 0.f;
#pragma unroll
                for (int w8 = 0; w8 < 8; ++w8) s += red[w8 * 64 + F.lane];
                ((float*)(F.ws + WS_SMALL + SM_MOD))[fc] = s + A.in[I_BADA][fc]; }
            __syncthreads();
        }
    }
    {
        float* cosT = (float*)(F.ws + WS_ROPE); float* sinT = cosT + (size_t)SEQ * 32;
        for (int idx = F.bid * (NWAVES * 64) + F.tid; idx < SEQ * 32; idx += F.G * NWAVES * 64) {
            const int pos = idx >> 5, i = idx & 31; const float ang = (float)pos * kInvFreq[i]; float s, c; sincos_acc(ang, s, c);
            cosT[idx] = c; sinT[idx] = s; }
    }
    if (F.bid == 0) {
        float* lbs = (float*)(F.ws + WS_SMALL + SM_LBS); float* lam = (float*)(F.ws + WS_SMALL + SM_LAM);
        if (F.tid < 256) { const float a0 = A.in[I_HGLB][F.tid], a1 = A.in[I_HGLB][256 + F.tid]; const float mx = fmaxf(a0, a1); const float e0 = __expf(a0 - mx), e1 = __expf(a1 - mx);
            lbs[F.tid] = 0.f; lbs[256 + F.tid] = e1 / (e0 + e1); }
        if (F.tid >= 256 && F.tid < 258) { const int l = F.tid - 256; const float* q = A.in[I_LAMQK] + l * 256; float s1 = 0.f, s2 = 0.f;
            for (int j = 0; j < 64; ++j) { s1 += q[j] * q[64 + j]; s2 += q[128 + j] * q[192 + j]; }
            const float li = 0.8f - 0.6f * expf(-0.3f * (float)l); lam[l] = expf(s1) - expf(s2) + li; lam[2 + l] = li; }
    }
    LAS float* scr = (LAS float*)(F.lds + RING_OFF + F.wave * 16384);
    constexpr int I_WI = 16 * 88, I_WO = 16 * 32, I_F13 = 16 * 88, I_F2 = 44 * 32, I_E13 = 16 * 112, I_E2 = 56 * 32;
    constexpr int NITEMS = 2 * I_WI + 2 * I_WO + 2 * I_F13 + I_F2 + 16 * I_E13 + 8 * I_E2;
    for (int it = gw; it < NITEMS; it += NGW) {
        int r = it;
        if (r < 2 * I_WI) { const int l = r / I_WI; transpose_item<0>(A.in[I_WIN] + (size_t)l * 1024 * DIN, 1024, DIN, (bf16*)(F.ws + WS_WIN) + (size_t)l * DIN * 1024, scr, r % I_WI, F.lane); continue; } r -= 2 * I_WI;
        if (r < 2 * I_WO) { const int l = r / I_WO; transpose_item<1>(A.in[I_WOUT] + (size_t)l * 1024 * 1024, 1024, 1024, (bf16*)(F.ws + WS_WOUT) + (size_t)l * 1024 * 1024, scr, r % I_WO, F.lane); continue; } r -= 2 * I_WO;
        if (r < I_F13) { transpose_item<2>(A.in[I_FW1], 1024, FFD, (bf16*)(F.ws + WS_FFN13), scr, r, F.lane); continue; } r -= I_F13;
        if (r < I_F13) { transpose_item<3>(A.in[I_FW3], 1024, FFD, (bf16*)(F.ws + WS_FFN13), scr, r, F.lane); continue; } r -= I_F13;
        if (r < I_F2) { transpose_item<1>(A.in[I_FW2], FFD, 1024, (bf16*)(F.ws + WS_FFN2), scr, r, F.lane); continue; } r -= I_F2;
        if (r < 8 * I_E13) { const int e = r / I_E13; transpose_item<2>(A.in[I_EW1] + (size_t)e * 1024 * EDIM, 1024, EDIM, (bf16*)(F.ws + WS_EXP13) + (size_t)e * 2 * EDIM * 1024, scr, r % I_E13, F.lane); continue; } r -= 8 * I_E13;
        if (r < 8 * I_E13) { const int e = r / I_E13; transpose_item<3>(A.in[I_EW3] + (size_t)e * 1024 * EDIM, 1024, EDIM, (bf16*)(F.ws + WS_EXP13) + (size_t)e * 2 * EDIM * 1024, scr, r % I_E13, F.lane); continue; } r -= 8 * I_E13;
        { const int e = r / I_E2; transpose_item<1>(A.in[I_EW2] + (size_t)e * EDIM * 1024, EDIM, 1024, (bf16*)(F.ws + WS_EXP2) + (size_t)e * 1024 * EDIM, scr, r % I_E2, F.lane); }
    }
}

__device__ __forceinline__ void load4(f32x4 (&v)[4], const float* p, int lane) { const GAS f32x4* q = (const GAS f32x4*)p + lane;
#pragma unroll
    for (int j = 0; j < 4; ++j) v[j] = q[64 * j]; }
__device__ __forceinline__ void store_bf16_row(bf16* orow, const f32x4 (&v)[4], int lane) {
    GAS unsigned long long* o8 = (GAS unsigned long long*)orow + lane;
#pragma unroll
    for (int j = 0; j < 4; ++j) o8[64 * j] = (unsigned long long)pk2(v[j].x, v[j].y) | ((unsigned long long)pk2(v[j].z, v[j].w) << 32);
}
__device__ __forceinline__ void store_f32_row(float* orow, const f32x4 (&v)[4], int lane) { GAS f32x4* o = (GAS f32x4*)orow + lane;
#pragma unroll
    for (int j = 0; j < 4; ++j) o[64 * j] = v[j]; }
__device__ __forceinline__ void ln_row(f32x4 (&v)[4], const f32x4 (&g)[4], const f32x4 (&b)[4]) {
    float s = 0.f;
#pragma unroll
    for (int j = 0; j < 4; ++j) s += (v[j].x + v[j].y) + (v[j].z + v[j].w);
    const float mean = wave_sum(s) * (1.f / DMODEL); float s2 = 0.f;
#pragma unroll
    for (int j = 0; j < 4; ++j) { v[j] = v[j] - mean; s2 += (v[j].x * v[j].x + v[j].y * v[j].y) + (v[j].z * v[j].z + v[j].w * v[j].w); }
    const float rstd = 1.f / sqrtf(wave_sum(s2) * (1.f / DMODEL) + LN_EPS);
#pragma unroll
    for (int j = 0; j < 4; ++j) v[j] = v[j] * rstd * g[j] + b[j];
}
__device__ __forceinline__ void p_modulate(Frame& F, const float* x, const float* mod  , bf16* H) {
    const int gw = F.vcu * NWAVES + F.wave, NGW = F.G * NWAVES;
    f32x4 sh[4], sc[4]; load4(sh, mod, F.lane); load4(sc, mod + 1024, F.lane);
    for (int m = gw; m < M; m += NGW) { f32x4 v[4]; load4(v, x + (size_t)m * DMODEL, F.lane);
#pragma unroll
        for (int j = 0; j < 4; ++j) v[j] = v[j] * (sc[j] + 1.0f) + sh[j];
        store_bf16_row(H + (size_t)m * DMODEL, v, F.lane); }
}
template <bool ROUTE> __device__ __forceinline__ void p_ln(Frame& F, float* xio, const float* lg, const float* lb, const float* mod, bf16* H, const float* rw) {
    const int gw = F.vcu * NWAVES + F.wave, NGW = F.G * NWAVES;
    f32x4 g[4], b[4], sh[4], sc[4]; load4(g, lg, F.lane); load4(b, lb, F.lane);
    if (mod) { load4(sh, mod, F.lane); load4(sc, mod + 1024, F.lane); }
    LAS float* rwT = (LAS float*)(F.lds + RING_OFF);
    LAS int* lcnt = (LAS int*)(F.lds + RING_OFF + 32768);
    LAS int* rinfo = (LAS int*)(F.lds + RING_OFF + 32768 + 256) + F.wave * 64;
    if (ROUTE) {
        for (int i = F.tid; i < 8192; i += NWAVES * 64) { const int k = i >> 3, e = i & 7; rwT[e * 1024 + k] = rw[i]; }
        if (F.tid < 16) lcnt[F.tid] = 0;
        __syncthreads();
    }
    int nr = 0;
    for (int m = gw; m < M; m += NGW) { f32x4 v[4]; load4(v, xio + (size_t)m * DMODEL, F.lane);
        ln_row(v, g, b);
        store_f32_row(xio + (size_t)m * DMODEL, v, F.lane);
        if (mod) {
#pragma unroll
            for (int j = 0; j < 4; ++j) v[j] = v[j] * (sc[j] + 1.0f) + sh[j];
            store_bf16_row(H + (size_t)m * DMODEL, v, F.lane);
        }
        if (ROUTE) {
            float lgt[8];
#pragma unroll
            for (int e = 0; e < 8; ++e) { float s = 0.f;
#pragma unroll
                for (int j = 0; j < 4; ++j) { const f32x4 w = *(const LAS f32x4*)(rwT + e * 1024 + 256 * j + 4 * F.lane); s += (v[j].x * w.x + v[j].y * w.y) + (v[j].z * w.z + v[j].w * w.w); }
                lgt[e] = wave_sum(s); }
            int e0 = 0; float v0 = lgt[0];
#pragma unroll
            for (int e = 1; e < 8; ++e) if (lgt[e] > v0) { v0 = lgt[e]; e0 = e; }
            int e1 = -1; float v1 = -INFINITY;
#pragma unroll
            for (int e = 0; e < 8; ++e) if (e != e0 && (e1 < 0 || lgt[e] > v1)) { v1 = lgt[e]; e1 = e; }
            const float g0 = 1.0f / (1.0f + __expf(v1 - v0));
            if (F.lane == 0) { const int p0 = atomicAdd((int*)&lcnt[e0], 1), p1 = atomicAdd((int*)&lcnt[e1], 1);
                rinfo[nr * 8 + 0] = m; rinfo[nr * 8 + 1] = e0; rinfo[nr * 8 + 2] = e1; rinfo[nr * 8 + 3] = p0; rinfo[nr * 8 + 4] = p1; rinfo[nr * 8 + 5] = __float_as_int(g0); }
            ++nr;
        }
    }
    if (ROUTE) {
        __syncthreads();
        if (F.tid < 8) lcnt[8 + F.tid] = (int)__hip_atomic_fetch_add((unsigned*)(F.ctl + CW_CNT + 64 * F.tid), (unsigned)lcnt[F.tid], __ATOMIC_RELAXED, __HIP_MEMORY_SCOPE_AGENT);
        __syncthreads();
        int* perm = (int*)(F.ws + WS_SMALL + SM_PERM); int* tok = (int*)(F.ws + WS_SMALL + SM_TOK);
        if (F.lane == 0) for (int i = 0; i < nr; ++i) { const int m = rinfo[i * 8 + 0], e0 = rinfo[i * 8 + 1], e1 = rinfo[i * 8 + 2];
            const int p0 = lcnt[8 + e0] + rinfo[i * 8 + 3], p1 = lcnt[8 + e1] + rinfo[i * 8 + 4];
            perm[e0 * SEQ + p0] = m; perm[e1 * SEQ + p1] = m;
            tok[m * 4 + 0] = e0 | (e1 << 8); tok[m * 4 + 1] = p0; tok[m * 4 + 2] = p1; tok[m * 4 + 3] = rinfo[i * 8 + 5]; }
    }
}
__device__ __forceinline__ void p_ln_moe(Frame& F, float* xio, const float* lg, const float* lb, const float* g2v) {
    const int gw = F.vcu * NWAVES + F.wave, NGW = F.G * NWAVES;
    f32x4 g[4], b[4], gg[4]; load4(g, lg, F.lane); load4(b, lb, F.lane); load4(gg, g2v, F.lane);
    int tb[8]; { int acc = 0;
#pragma unroll
        for (int e = 0; e < 8; ++e) { tb[e] = acc; acc += ((int)__hip_atomic_load(F.ctl + CW_CNT + 64 * e, RLX_AGENT) + 255) >> 8; } }
    const int* tok = (const int*)(F.ws + WS_SMALL + SM_TOK); const bf16* Y = (const bf16*)(F.ws + WS_YSLOT);
    for (int m = gw; m < M; m += NGW) {
        const int ee = tok[m * 4 + 0], p0 = tok[m * 4 + 1], p1 = tok[m * 4 + 2]; const float g0 = __int_as_float(tok[m * 4 + 3]), g1 = 1.0f - g0;
        const int e0 = ee & 255, e1 = ee >> 8; int t0 = 0, t1 = 0;
#pragma unroll
        for (int e = 0; e < 8; ++e) { t0 = (e0 == e) ? tb[e] : t0; t1 = (e1 == e) ? tb[e] : t1; }
        const size_t s0 = (size_t)(t0 * 256 + p0), s1 = (size_t)(t1 * 256 + p1);
        f32x4 v[4]; load4(v, xio + (size_t)m * DMODEL, F.lane);
        const GAS unsigned long long* y0 = (const GAS unsigned long long*)(Y + s0 * DMODEL) + F.lane; const GAS unsigned long long* y1 = (const GAS unsigned long long*)(Y + s1 * DMODEL) + F.lane;
#pragma unroll
        for (int j = 0; j < 4; ++j) { const unsigned long long a = y0[64 * j], c = y1[64 * j];
            f32x4 f; f.x = g0 * bf2f((unsigned short)a) + g1 * bf2f((unsigned short)c); f.y = g0 * bf2f((unsigned short)(a >> 16)) + g1 * bf2f((unsigned short)(c >> 16));
            f.z = g0 * bf2f((unsigned short)(a >> 32)) + g1 * bf2f((unsigned short)(c >> 32)); f.w = g0 * bf2f((unsigned short)(a >> 48)) + g1 * bf2f((unsigned short)(c >> 48));
            v[j] = v[j] * ALPHA + (gg[j] + 1.0f) * f; }
        ln_row(v, g, b);
        store_f32_row(xio + (size_t)m * DMODEL, v, F.lane);
    }
}

__device__ __forceinline__ void hg_pass1(Frame& F, int l) {
    const bf16* P = (const bf16*)(F.ws + WS_PROJ); const float* lbs = (const float*)(F.ws + WS_SMALL + SM_LBS) + l * 256;
    float* HGS = (float*)(F.ws + WS_HGS); float* HGD = (float*)(F.ws + WS_HGD);
    LAS float* fk = (LAS float*)(F.lds + RING_OFF + F.wave * 16384);
    LAS float* vl = fk + 1024;
    const int kh = F.wave & 1;
    for (int tk = F.bid * 4 + (F.wave >> 1); tk < 1024; tk += F.G * 4) {
        const int c = tk >> 2, h = tk & 3;
        float S[32];
#pragma unroll
        for (int k = 0; k < 32; ++k) S[k] = 0.f;
        float dp = 1.f;
        for (int sb = 0; sb < 4; ++sb) {
            const int row0 = c * 64 + sb * 16;
#pragma unroll
            for (int j = 0; j < 8; ++j) { const int p = j * 64 + F.lane, tt = p >> 5, kk = p & 31, k = h * 64 + kh * 32 + kk;
                const float z = bf2f(P[(size_t)(row0 + tt) * DIN + 1792 + k]); const float lbv = lbs[k];
                const float f = lbv + (1.0f - lbv) * sigmoid_f(z), key = (1.0f - lbv) * sigmoid_f(-z);
                fk[(tt * 32 + kk) * 2] = f; fk[(tt * 32 + kk) * 2 + 1] = key; }
#pragma unroll
            for (int tt = 0; tt < 16; ++tt) vl[tt * 64 + F.lane] = silu_ff(bf2f(P[(size_t)(row0 + tt) * DIN + 2048 + h * 64 + F.lane]));
            for (int tt = 0; tt < 16; ++tt) {
                const float v = vl[tt * 64 + F.lane];
#pragma unroll
                for (int kk = 0; kk < 32; kk += 2) { const f32x4 q = *(const LAS f32x4*)(fk + (tt * 32 + kk) * 2);
                    S[kk] = q.x * S[kk] + q.y * v; S[kk + 1] = q.z * S[kk + 1] + q.w * v; }
            }
            if (F.lane < 32) {
#pragma unroll
                for (int tt = 0; tt < 16; ++tt) dp *= fk[(tt * 32 + F.lane) * 2]; }
        }
        float* Lp = HGS + ((size_t)(c * 4 + h) * 64 + kh * 32) * 64 + F.lane;
#pragma unroll
        for (int k = 0; k < 32; ++k) Lp[k * 64] = S[k];
        if (F.lane < 32) HGD[c * 256 + h * 64 + kh * 32 + F.lane] = dp;
    }
}
__device__ __forceinline__ void hg_pass2(Frame& F) {
    float* HGS = (float*)(F.ws + WS_HGS); const float* HGD = (const float*)(F.ws + WS_HGD);
    if (F.wave == 0) for (int b = F.bid; b < 256; b += F.G) {
        float carry = 0.f;
        for (int c0 = 0; c0 < 256; c0 += 16) { float Lv[16], Dv[16];
#pragma unroll
            for (int u = 0; u < 16; ++u) { Lv[u] = HGS[(size_t)(c0 + u) * 16384 + b * 64 + F.lane]; Dv[u] = HGD[(c0 + u) * 256 + b]; }
#pragma unroll
            for (int u = 0; u < 16; ++u) { HGS[(size_t)(c0 + u) * 16384 + b * 64 + F.lane] = carry; carry = Dv[u] * carry + Lv[u]; }
        }
    }
}
__device__ __forceinline__ void hg_pass3(Frame& F, int l, const float* hgg) {
    const bf16* P = (const bf16*)(F.ws + WS_PROJ); const float* lbs = (const float*)(F.ws + WS_SMALL + SM_LBS) + l * 256;
    const float* HGS = (const float*)(F.ws + WS_HGS); bf16* MIX = (bf16*)(F.ws + WS_MIX);
    LAS float* fk = (LAS float*)(F.lds + RING_OFF + F.wave * 16384);
    LAS float* vl = fk + 2048;
    LAS float* op = fk + 3072;
    LAS float* opp = (LAS float*)(F.lds + RING_OFF + (F.wave ^ 1) * 16384) + 3072;
    const int kh = F.wave & 1; const float gn = hgg[F.lane];
    for (int tk0 = F.bid * 4; tk0 < 1024; tk0 += F.G * 4) {
        const int tk = tk0 + (F.wave >> 1); const int c = tk >> 2, h = tk & 3;
        float S[32];
        { const float* Sp = HGS + ((size_t)(c * 4 + h) * 64 + kh * 32) * 64 + F.lane;
#pragma unroll
          for (int k = 0; k < 32; ++k) S[k] = Sp[k * 64]; }
        for (int sb = 0; sb < 4; ++sb) {
            const int row0 = c * 64 + sb * 16;
#pragma unroll
            for (int j = 0; j < 8; ++j) { const int p = j * 64 + F.lane, tt = p >> 5, kk = p & 31, k = h * 64 + kh * 32 + kk;
                const float z = bf2f(P[(size_t)(row0 + tt) * DIN + 1792 + k]); const float qv = bf2f(P[(size_t)(row0 + tt) * DIN + 1536 + k]); const float lbv = lbs[k];
                const float f = lbv + (1.0f - lbv) * sigmoid_f(z), key = (1.0f - lbv) * sigmoid_f(-z);
                *(LAS f32x4*)(fk + (tt * 32 + kk) * 4) = (f32x4){f, key, qv, 0.f}; }
#pragma unroll
            for (int tt = 0; tt < 16; ++tt) vl[tt * 64 + F.lane] = silu_ff(bf2f(P[(size_t)(row0 + tt) * DIN + 2048 + h * 64 + F.lane]));
            for (int tt = 0; tt < 16; ++tt) {
                const float v = vl[tt * 64 + F.lane]; float o = 0.f;
#pragma unroll
                for (int kk = 0; kk < 32; ++kk) { const f32x4 q = *(const LAS f32x4*)(fk + (tt * 32 + kk) * 4);
                    S[kk] = q.x * S[kk] + q.y * v; o += q.z * S[kk]; }
                op[tt * 64 + F.lane] = o;
            }
            __syncthreads();
#pragma unroll
            for (int t8 = 0; t8 < 8; ++t8) { const int tt = kh * 8 + t8; const float o = op[tt * 64 + F.lane] + opp[tt * 64 + F.lane];
                const float ss = wave_sum(o * o); const float rstd = 1.0f / sqrtf(ss * (1.0f / 64.0f) + LN_EPS);
                const float gt = bf2f(P[(size_t)(row0 + tt) * DIN + 2304 + h * 64 + F.lane]);
                MIX[(size_t)(row0 + tt) * DMODEL + 512 + h * 64 + F.lane] = (bf16)f2bf(o * rstd * gn * silu_ff(gt)); }
            __syncthreads();
        }
    }
}
__device__ __forceinline__ void pool_phase(Frame& F, const float* pw, const float* ps) {
    const bf16* P = (const bf16*)(F.ws + WS_PROJ); bf16* MIX = (bf16*)(F.ws + WS_MIX);
    LAS float* U = (LAS float*)(F.lds + RING_OFF + F.wave * 16384);
    LAS float* PL = U + 2048;
    const int gw = F.vcu * NWAVES + F.wave, NGW = F.G * NWAVES;
    for (int task = gw; task < 4096; task += NGW) {
        const int tg = task >> 2, gi = task & 3, t0 = tg * 16, win = 2 << gi;
        float wcol[64];
#pragma unroll
        for (int c = 0; c < 64; ++c) wcol[c] = pw[(size_t)(gi * 64 + c) * 64 + F.lane];
        const float scl = ps[gi * 64 + F.lane];
        for (int r = 0; r < 31; ++r) { const int t = t0 - 15 + r; U[r * 64 + F.lane] = (t >= 0) ? bf2f(P[(size_t)t * DIN + 2560 + gi * 64 + F.lane]) : 0.f; }
        for (int tt = 0; tt < 16; ++tt) { float s = 0.f;
            for (int j = 0; j < win; ++j) s += U[(15 + tt - j) * 64 + F.lane];
            const int t = t0 + tt; const float cntw = (float)((t + 1 < win) ? (t + 1) : win);
            PL[tt * 64 + F.lane] = s / cntw - U[(15 + tt) * 64 + F.lane]; }
        for (int tt = 0; tt < 16; ++tt) { float acc = 0.f;
#pragma unroll
            for (int c = 0; c < 64; c += 4) { const f32x4 p4 = *(const LAS f32x4*)(PL + tt * 64 + c);
                acc += p4.x * wcol[c]; acc += p4.y * wcol[c + 1]; acc += p4.z * wcol[c + 2]; acc += p4.w * wcol[c + 3]; }
            MIX[(size_t)(t0 + tt) * DMODEL + 768 + gi * 64 + F.lane] = (bf16)f2bf(acc * scl); }
    }
}
__device__ __forceinline__ void moe_gather(Frame& F) {
    const int gw = F.vcu * NWAVES + F.wave, NGW = F.G * NWAVES;
    int cn[8], tb[9]; tb[0] = 0;
#pragma unroll
    for (int e = 0; e < 8; ++e) { cn[e] = (int)__hip_atomic_load(F.ctl + CW_CNT + 64 * e, RLX_AGENT); tb[e + 1] = tb[e] + ((cn[e] + 255) >> 8); }
    const int* perm = (const int*)(F.ws + WS_SMALL + SM_PERM); const bf16* H = (const bf16*)(F.ws + WS_HBUF); bf16* HP = (bf16*)(F.ws + WS_HPERM);
    for (int slot = gw; slot < tb[8] * 256; slot += NGW) {
        const int T = slot >> 8; int e = 0, tbe = 0, ce = cn[0];
#pragma unroll
        for (int j = 1; j < 8; ++j) if (T >= tb[j]) { e = j; tbe = tb[j]; ce = cn[j]; }
        const int pos = ((T - tbe) << 8) + (slot & 255);
        const int tokn = (pos < ce) ? perm[e * SEQ + pos] : 0;
        const GAS v4u* src = (const GAS v4u*)(H + (size_t)tokn * DMODEL) + F.lane; GAS v4u* dst = (GAS v4u*)(HP + (size_t)slot * DMODEL) + F.lane;
        const v4u a = src[0], b = src[64]; dst[0] = a; dst[64] = b;
    }
}
__device__ __forceinline__ void attn_finalize(Frame& F, int l, const float* ag) {
    const bf16* O1 = (const bf16*)(F.ws + WS_ATTNO); const bf16* O2 = O1 + (size_t)SEQ * 512; bf16* MIX = (bf16*)(F.ws + WS_MIX);
    const float* lamv = (const float*)(F.ws + WS_SMALL + SM_LAM); const float lam = lamv[l], osc = 1.0f - lamv[2 + l];
    const int gw = F.vcu * NWAVES + F.wave, NGW = F.G * NWAVES;
    float gv[8];
#pragma unroll
    for (int j = 0; j < 8; ++j) gv[j] = ag[(F.lane & 15) * 8 + j] * osc;
    for (int m = gw; m < M; m += NGW) {
        const v4u a = *(const GAS v4u*)(O1 + (size_t)m * 512 + F.lane * 8), b = *(const GAS v4u*)(O2 + (size_t)m * 512 + F.lane * 8);
        float d[8];
        d[0] = __uint_as_float(a.x << 16) - lam * __uint_as_float(b.x << 16); d[1] = __uint_as_float(a.x & 0xffff0000u) - lam * __uint_as_float(b.x & 0xffff0000u);
        d[2] = __uint_as_float(a.y << 16) - lam * __uint_as_float(b.y << 16); d[3] = __uint_as_float(a.y & 0xffff0000u) - lam * __uint_as_float(b.y & 0xffff0000u);
        d[4] = __uint_as_float(a.z << 16) - lam * __uint_as_float(b.z << 16); d[5] = __uint_as_float(a.z & 0xffff0000u) - lam * __uint_as_float(b.z & 0xffff0000u);
        d[6] = __uint_as_float(a.w << 16) - lam * __uint_as_float(b.w << 16); d[7] = __uint_as_float(a.w & 0xffff0000u) - lam * __uint_as_float(b.w & 0xffff0000u);
        float ss = 0.f;
#pragma unroll
        for (int j = 0; j < 8; ++j) ss += d[j] * d[j];
        ss += swzx<1>(ss); ss += swzx<2>(ss); ss += swzx<4>(ss); ss += swzx<8>(ss);
        const float rstd = 1.0f / sqrtf(ss * (1.0f / 128.0f) + LN_EPS);
        v4u o; o.x = pk2(d[0] * rstd * gv[0], d[1] * rstd * gv[1]); o.y = pk2(d[2] * rstd * gv[2], d[3] * rstd * gv[3]);
        o.z = pk2(d[4] * rstd * gv[4], d[5] * rstd * gv[5]); o.w = pk2(d[6] * rstd * gv[6], d[7] * rstd * gv[7]);
        *(GAS v4u*)(MIX + (size_t)m * DMODEL + F.lane * 8) = o;
    }
}

#ifndef DIS
#define DIS 0
#endif
#ifndef DUP
#define DUP 0
#endif
#ifndef ATTN_B
#define ATTN_B 1
#endif
#define RELOAD_ARGS() do { asm volatile("" : "+s"(argp), "+s"(F.ws), "+s"(F.ctl), "+s"(bar.bar), "+s"(bar.x), "+s"(F.G), "+s"(F.vcu), "+s"(F.bid)); { unsigned z_ = 0u; asm volatile("" : "+s"(z_)); F.lane = (int)__builtin_amdgcn_mbcnt_hi(~0u, __builtin_amdgcn_mbcnt_lo(~0u, z_)); } asm volatile("" : "+v"(F.lane)); F.tid = F.wave * 64 + F.lane; } while (0)
#define args (*argp)
__global__ void __launch_bounds__(NWAVES * 64, 2) mk_fwd(Args args_) {
    const Args* argp = (const Args*)__builtin_amdgcn_kernarg_segment_ptr();
    extern __shared__ __attribute__((aligned(16))) unsigned char lds[];
    Frame F;
    F.lds = (LAS unsigned char*)lds;
    F.MISC = (volatile LAS unsigned*)(F.lds + MISC_OFF);
    F.tid = threadIdx.x; F.lane = F.tid & 63; F.wave = __builtin_amdgcn_readfirstlane(F.tid >> 6);
    F.G = gridDim.x; F.bid = blockIdx.x; { const int bx = blockIdx.x; F.vcu = (F.G % 8 == 0) ? (bx % 8) * (F.G / 8) + bx / 8 : bx; }
    F.ws = args.ws; F.ctl = (gu32*)(args.ws + WS_CTL);
    for (int u = F.tid; u < (LDS_BYTES - LDSCTL_OFF) / 4; u += NWAVES * 64) ((LAS unsigned*)(F.lds + LDSCTL_OFF))[u] = 0u;
    __syncthreads();
    XcdBarrier bar; bar.bar = (unsigned*)(F.ctl + CW_BAR); bar.x = 0; bar.st = nullptr;
    if (N_LAUNCHES == 1) bar = xcd_barrier_post((unsigned*)(F.ctl + CW_BAR), F.MISC + 8, F.tid);
    const int lo = (N_LAUNCHES == 1) ? 0 : args.ph_lo, hi = (N_LAUNCHES == 1) ? NPH : args.ph_hi;
#define IN(k) (lo <= (k) && (k) < hi)
#define SEAM(k) do { if (IN(k) && IN((k) + 1)) xcd_barrier(bar, F.tid); RELOAD_ARGS(); } while (0)
#define MOD ((const float*)(F.ws + WS_SMALL + SM_MOD))
#define HB ((bf16*)(F.ws + WS_HBUF))

    if (IN(0)) {
#if !(DIS&1)
        p0a_prologue(F, args);
#if (DUP&1)
            __syncthreads();
            p0a_prologue(F, args);
#endif

#endif
    } SEAM(0);
    if (IN(1)) { p_modulate(F, args.in[I_X], MOD, HB); } SEAM(1);

    for (int l = 0; l < DEPTH; ++l) {
        const int pb = 2 + NPH_LAYER * l;
#define mod (MOD + l * 6144)
#define xin ((l == 0) ? args.in[I_X] : (const float*)args.out)
        if (IN(pb + 0)) {
            pg8::Gemm g{HB, (const bf16*)(F.ws + WS_WIN) + (size_t)l * DIN * 1024, 1024}; pg8::StaticOrder S; S.init(M, DIN, F.G, F.bid);
            pg8::EpiProj E{(bf16*)(F.ws + WS_PROJ), DIN, (const float*)(F.ws + WS_ROPE), (const float*)(F.ws + WS_ROPE) + (size_t)SEQ * 32, attn_body::C2};
#if !(DIS&2)
            pg8::gemm_phase<pg8::EpiProj, pg8::StaticOrder, true>(F.lds + RING_OFF, g, S, E, F.tid);
#if (DUP&2)
            __syncthreads();
            pg8::gemm_phase<pg8::EpiProj, pg8::StaticOrder, true>(F.lds + RING_OFF, g, S, E, F.tid);
#endif

#endif
        } SEAM(pb + 0);
        if (IN(pb + 1)) {
#if !(DIS&4)
            hg_pass1(F, l);
#if (DUP&4)
            __syncthreads();
            hg_pass1(F, l);
#endif

#endif
            __syncthreads();
#if !(DIS&8)
            pool_phase(F, args.in[I_POOLW] + (size_t)l * 4 * 64 * 64, args.in[I_POOLS] + l * 256);
#if (DUP&8)
            __syncthreads();
            pool_phase(F, args.in[I_POOLW] + (size_t)l * 4 * 64 * 64, args.in[I_POOLS] + l * 256);
#endif

#endif
        } SEAM(pb + 1);
        if (IN(pb + 2)) {
#if !(DIS&16)
            hg_pass2(F);
#endif
        } SEAM(pb + 2);
        if (IN(pb + 3)) {
            const attn_body::bf16* PJ = (const attn_body::bf16*)(F.ws + WS_PROJ); attn_body::bf16* AO = (attn_body::bf16*)(F.ws + WS_ATTNO);
#if ATTN_B
            for (int rep_ = 0; rep_ < ((DUP&32) ? 2 : 1); ++rep_)
            for (int i = 0; i < 2; ++i) { const int j = i * F.G + F.vcu; if (j >= 512) break;
                const int v = j & 255, ii = j >> 8, mpi = v >> 5, s = v & 31; const int qb = (ii == 0) ? s : 63 - s;
                const int h = mpi >> 1, mp = mpi & 1;
#if !(DIS&32)
                attn_body::attn_unit2<8>(F.tid, qb, PJ + mpi * 64, PJ + 512 + mpi * 64, PJ + 1024 + h * 128, AO + (size_t)mp * SEQ * 512 + h * 128, (char*)lds + RING_OFF);
#endif
            }
#else
            for (int rep_ = 0; rep_ < ((DUP&32) ? 2 : 1); ++rep_)
            for (int i = 0; i < 4; ++i) { const int j = i * F.G + F.vcu; if (j >= 1024) break;
                const int v = j & 255, ii = j >> 8, vh = v >> 4, s = v & 15; const int qb = (ii == 0) ? s : (ii == 1) ? 31 - s : (ii == 2) ? 32 + s : 63 - s;
                const int h = vh >> 2, mp = (vh >> 1) & 1, vf = vh & 1;
#if !(DIS&32)
                attn_body::attn_unit<8>(F.tid, qb, PJ + (h * 2 + mp) * 64, PJ + 512 + (h * 2 + mp) * 64, PJ + 1024 + h * 128 + vf * 64, AO + (size_t)mp * SEQ * 512 + h * 128 + vf * 64, (char*)lds + RING_OFF);
#endif
            }
#endif
            __syncthreads();
#if !(DIS&64)
            hg_pass3(F, l, args.in[I_HGG] + l * 64);
#if (DUP&64)
            __syncthreads();
            hg_pass3(F, l, args.in[I_HGG] + l * 64);
#endif

#endif
        } SEAM(pb + 3);
        if (IN(pb + 4)) {
#if !(DIS&128)
            attn_finalize(F, l, args.in[I_ATTNG] + l * 128);
#if (DUP&128)
            __syncthreads();
            attn_finalize(F, l, args.in[I_ATTNG] + l * 128);
#endif

#endif
        } SEAM(pb + 4);
        if (IN(pb + 5)) {
            pg8::Gemm g{(const bf16*)(F.ws + WS_MIX), (const bf16*)(F.ws + WS_WOUT) + (size_t)l * 1024 * 1024, 1024}; pg8::StaticOrder S; S.init(M, DMODEL, F.G, F.bid);
            pg8::EpiResid E{xin, args.out, DMODEL, mod + 2048, ALPHA};
#if !(DIS&256)
            pg8::gemm_phase<pg8::EpiResid, pg8::StaticOrder, false>(F.lds + RING_OFF, g, S, E, F.tid);
#endif
        } SEAM(pb + 5);
        if (IN(pb + 6)) {
#if !(DIS&512)
            if (l & 1) p_ln<true>(F, args.out, args.in[I_LN1G] + l * 1024, args.in[I_LN1B] + l * 1024, mod + 3072, HB, args.in[I_RW] + (size_t)(l >> 1) * 1024 * 8);
#endif
#if !(DIS&1024)
            if (!(l & 1)) p_ln<false>(F, args.out, args.in[I_LN1G] + l * 1024, args.in[I_LN1B] + l * 1024, mod + 3072, HB, nullptr);
#endif
        } SEAM(pb + 6);
        if (!(l & 1)) {
            if (IN(pb + 8)) {
                pg8::Gemm g{HB, (const bf16*)(F.ws + WS_FFN13), 1024}; pg8::StaticOrder S; S.init(M, 2 * FFD, F.G, F.bid);
                pg8::EpiSwiglu E{(bf16*)(F.ws + WS_DHID), FFD};
#if !(DIS&2048)
                pg8::gemm_phase<pg8::EpiSwiglu, pg8::StaticOrder, true>(F.lds + RING_OFF, g, S, E, F.tid);
#if (DUP&2048)
            __syncthreads();
            pg8::gemm_phase<pg8::EpiSwiglu, pg8::StaticOrder, true>(F.lds + RING_OFF, g, S, E, F.tid);
#endif

#endif
            } SEAM(pb + 8);
            if (IN(pb + 9)) {
                pg8::Gemm g{(const bf16*)(F.ws + WS_DHID), (const bf16*)(F.ws + WS_FFN2), FFD}; pg8::StaticOrder S; S.init(M, DMODEL, F.G, F.bid);
                pg8::EpiResid E{args.out, args.out, DMODEL, mod + 5120, ALPHA};
#if !(DIS&4096)
                pg8::gemm_phase<pg8::EpiResid, pg8::StaticOrder, false>(F.lds + RING_OFF, g, S, E, F.tid);
#endif
            } SEAM(pb + 9);
            if (IN(pb + 10)) {
                p_ln<false>(F, args.out, args.in[I_LN2G] + l * 1024, args.in[I_LN2B] + l * 1024, (l + 1 < DEPTH) ? MOD + (l + 1) * 6144 : nullptr, HB, nullptr);
            } SEAM(pb + 10);
        } else {
            const unsigned* cnt = (const unsigned*)(F.ctl + CW_CNT);
            if (IN(pb + 7)) {
#if !(DIS&65536)
                moe_gather(F);
#if (DUP&65536)
            __syncthreads();
            moe_gather(F);
#endif

#endif
            } SEAM(pb + 7);
            if (IN(pb + 8)) {
                pg8::Gemm g{(const bf16*)(F.ws + WS_HPERM), (const bf16*)(F.ws + WS_EXP13), 1024}; pg8::MoeOrder S; S.init(cnt, 2 * EDIM / 256, F.G, F.bid);
                pg8::EpiSwiglu E{(bf16*)(F.ws + WS_HID), EDIM};
#if !(DIS&8192)
                pg8::gemm_phase<pg8::EpiSwiglu, pg8::MoeOrder, true>(F.lds + RING_OFF, g, S, E, F.tid);
#if (DUP&8192)
            __syncthreads();
            pg8::gemm_phase<pg8::EpiSwiglu, pg8::MoeOrder, true>(F.lds + RING_OFF, g, S, E, F.tid);
#endif

#endif
            } SEAM(pb + 8);
            if (IN(pb + 9)) {
                pg8::Gemm g{(const bf16*)(F.ws + WS_HID), (const bf16*)(F.ws + WS_EXP2), EDIM}; pg8::MoeOrder S; S.init(cnt, DMODEL / 256, F.G, F.bid);
                pg8::EpiBf16 E{(bf16*)(F.ws + WS_YSLOT), DMODEL};
#if !(DIS&16384)
                pg8::gemm_phase<pg8::EpiBf16, pg8::MoeOrder, true>(F.lds + RING_OFF, g, S, E, F.tid);
#if (DUP&16384)
            __syncthreads();
            pg8::gemm_phase<pg8::EpiBf16, pg8::MoeOrder, true>(F.lds + RING_OFF, g, S, E, F.tid);
#endif

#endif
            } SEAM(pb + 9);
            if (IN(pb + 10)) {
#if !(DIS&32768)
                p_ln_moe(F, args.out, args.in[I_LN2G] + l * 1024, args.in[I_LN2B] + l * 1024, mod + 5120);
#endif
            } SEAM(pb + 10);
        }
    }
#undef IN
#undef SEAM
#undef args
#undef MOD
#undef HB
#undef mod
#undef xin
}

extern "C" void kernel_launch(void* const* d_in, const int* in_sizes, int n_in, void* d_out, int out_size, void* d_ws, size_t ws_size, hipStream_t stream) {
    static int grid = 0;
    if (grid == 0) {
        if (n_in != 23 || in_sizes[0] != M * DMODEL || out_size != M * DMODEL || ws_size < WS_END) { fprintf(stderr, "kernel_launch: unexpected shapes (n_in %d, out %d, ws %zu); nothing launched\n", n_in, out_size, ws_size); grid = -1; return; }
        int dev = 0, cus = 0, per_cu = 0;
        if (hipGetDevice(&dev) != hipSuccess || hipDeviceGetAttribute(&cus, hipDeviceAttributeMultiprocessorCount, dev) != hipSuccess) { grid = -1; return; }
        if (hipFuncSetAttribute((const void*)mk_fwd, hipFuncAttributeMaxDynamicSharedMemorySize, LDS_BYTES) != hipSuccess) { fprintf(stderr, "kernel_launch: hipFuncSetAttribute failed\n"); grid = -1; return; }
        if (hipOccupancyMaxActiveBlocksPerMultiprocessor(&per_cu, (const void*)mk_fwd, NWAVES * 64, LDS_BYTES) != hipSuccess || per_cu < 1) { fprintf(stderr, "kernel_launch: occupancy query says %d\n", per_cu); }
        (void)hipGetLastError();
        grid = cus;
    }
    if (grid < 0) return;
    if (hipMemsetAsync((char*)d_ws + WS_CTL, 0, CTL_ZERO_BYTES, stream) != hipSuccess) return;
    Args a{};
    for (int i = 0; i < 23; ++i) a.in[i] = (const float*)d_in[i];
    a.out = (float*)d_out; a.ws = (unsigned char*)d_ws;
    for (int li = 0; li < N_LAUNCHES; ++li) {
        a.ph_lo = (N_LAUNCHES == 1) ? 0 : li; a.ph_hi = (N_LAUNCHES == 1) ? NPH : li + 1; a.li = li; a.pad = 0;
        hipLaunchKernelGGL(mk_fwd, dim3(grid), dim3(NWAVES * 64), LDS_BYTES, stream, a);
    }
}
```

```cpp
#define MK_N_LAUNCHES 1
#include <hip/hip_runtime.h>
#include <hip/hip_bf16.h>
#include <cstdio>
#include <cstdint>
#include <cmath>
namespace pg8 {
#define PG8_LAS __attribute__((address_space(3)))
typedef unsigned short bf16_t;
typedef short bf16x8 __attribute__((ext_vector_type(8)));
typedef float f32x4 __attribute__((ext_vector_type(4)));
typedef unsigned u32x4 __attribute__((ext_vector_type(4)));
constexpr int BM = 256, BK = 64, HALF = 128, HTB = HALF * BK * 2  , STAGE_BYTES = 8 * HTB, NXCD = 8, WGM = 8;

__host__ __device__ __forceinline__ int lds_byte(int r, int c) { const int st = (r >> 4) * 2 + (c >> 5), rr = r & 15, cc = c & 31, ob = rr * 64 + cc * 2; return st * 1024 + (ob ^ (((ob >> 9) & 1) << 5)); }
__host__ __device__ __forceinline__ void stage_rc(int b, int& R, int& C) { const int st = b / 1024, sb = b % 1024, swz = sb ^ (((sb >> 9) & 1) << 5); R = (st >> 1) * 16 + swz / 64; C = (st & 1) * 32 + (swz % 64) / 2; }
__host__ __device__ __forceinline__ int perm32(int rho) { const int n = rho >> 4, i = rho & 15; return 8 * (i >> 2) + 4 * n + (i & 3); }

struct Unit { int pm, pn, pb; };
struct Gemm { const bf16_t* A; const bf16_t* Bt; int K; };

struct StaticOrder {
    int nM, nN, nwg, G, c;
    __host__ __device__ void init(int M, int N, int G_, int c_) { nM = M / BM; nN = N / BM; nwg = nM * nN; G = G_; c = c_; }
    __host__ __device__ bool next(int i, Unit& u) const {
        const long L = (long)i * G + c; if (L >= nwg) return false;
        int wgid = (int)L; { const int q = nwg / NXCD, r = nwg % NXCD, xcd = wgid % NXCD, off = wgid / NXCD; wgid = (xcd < r ? xcd * (q + 1) : r * (q + 1) + (xcd - r) * q) + off; }
        const int nig = WGM * nN, gid = wgid / nig, fm = gid * WGM, gsz = (nM - fm) < WGM ? (nM - fm) : WGM;
        u.pm = fm + ((wgid % nig) % gsz); u.pn = (wgid % nig) / gsz; u.pb = u.pn; return true;
    }
};

struct MoeOrder {
    int tb1, tb2, tb3, tb4, tb5, tb6, tb7, tb8;
    int nN, G, c;
    __device__ __forceinline__ void init(const unsigned* cnt, int nN_, int G_, int c_) {
        tb1 = ((int)cnt[0] + 255) >> 8; tb2 = tb1 + (((int)cnt[64] + 255) >> 8); tb3 = tb2 + (((int)cnt[128] + 255) >> 8); tb4 = tb3 + (((int)cnt[192] + 255) >> 8);
        tb5 = tb4 + (((int)cnt[256] + 255) >> 8); tb6 = tb5 + (((int)cnt[320] + 255) >> 8); tb7 = tb6 + (((int)cnt[384] + 255) >> 8); tb8 = tb7 + (((int)cnt[448] + 255) >> 8);
        nN = nN_; G = G_; c = c_;
    }
    __device__ __forceinline__ bool next(int i, Unit& u) const {
        const int L = i * G + c; const int T = L / nN; if (T >= tb8) return false;
        const int pn = L - T * nN;
        const int e = (T >= tb1) + (T >= tb2) + (T >= tb3) + (T >= tb4) + (T >= tb5) + (T >= tb6) + (T >= tb7);
        u.pm = T; u.pn = pn; u.pb = e * nN + pn; return true;
    }
};

__device__ __forceinline__ unsigned cvt_pk_bf16(float lo, float hi) { unsigned r; asm volatile("v_cvt_pk_bf16_f32 %0, %1, %2" : "=v"(r) : "v"(lo), "v"(hi)); return r; }

struct EpiBf16 {
    static constexpr bool PERM = true;
    bf16_t* O; int ldc;
    __device__ __forceinline__ void operator()(const f32x4 (&acc)[2][2][4][2], const Unit& u, int wr, int wc, int fr, int fq) const {
        const int row0 = u.pm * BM + wr * 64 + fr; const int col0 = u.pn * BM + wc * 32 + 8 * fq;
#pragma unroll
        for (int ai = 0; ai < 2; ++ai)
#pragma unroll
            for (int m = 0; m < 4; ++m) { bf16_t* rowp = O + (size_t)(row0 + ai * HALF + m * 16) * ldc + col0;
#pragma unroll
                for (int bj = 0; bj < 2; ++bj) { const f32x4 v0 = acc[ai][bj][m][0], v1 = acc[ai][bj][m][1];
                    u32x4 w; w.x = cvt_pk_bf16(v0[0], v0[1]); w.y = cvt_pk_bf16(v0[2], v0[3]); w.z = cvt_pk_bf16(v1[0], v1[1]); w.w = cvt_pk_bf16(v1[2], v1[3]);
                    *(u32x4*)(rowp + bj * HALF) = w; } }
    }
};

struct EpiProj {
    static constexpr bool PERM = true;
    bf16_t* O; int ldc; const float* cosT; const float* sinT; float qscale;
    __device__ __forceinline__ void operator()(const f32x4 (&acc)[2][2][4][2], const Unit& u, int wr, int wc, int fr, int fq) const {
        const int row0 = u.pm * BM + wr * 64 + fr; const int col0 = u.pn * BM + wc * 32 + 8 * fq;
        if (u.pn < 4) {
            const int i0 = 16 * (wc & 1) + 4 * fq; const float sc = (u.pn < 2) ? qscale : 1.0f;
#pragma unroll
            for (int ai = 0; ai < 2; ++ai)
#pragma unroll
                for (int m = 0; m < 4; ++m) { const int row = row0 + ai * HALF + m * 16; bf16_t* rowp = O + (size_t)row * ldc + col0;
                    f32x4 c4 = *(const f32x4*)(cosT + (size_t)row * 32 + i0), s4 = *(const f32x4*)(sinT + (size_t)row * 32 + i0);
                    c4 = c4 * sc; s4 = s4 * sc;
#pragma unroll
                    for (int bj = 0; bj < 2; ++bj) { const f32x4 v0 = acc[ai][bj][m][0], v1 = acc[ai][bj][m][1];
                        const float o0 = v0[0] * c4[0] - v0[1] * s4[0], o1 = v0[1] * c4[0] + v0[0] * s4[0];
                        const float o2 = v0[2] * c4[1] - v0[3] * s4[1], o3 = v0[3] * c4[1] + v0[2] * s4[1];
                        const float o4 = v1[0] * c4[2] - v1[1] * s4[2], o5 = v1[1] * c4[2] + v1[0] * s4[2];
                        const float o6 = v1[2] * c4[3] - v1[3] * s4[3], o7 = v1[3] * c4[3] + v1[2] * s4[3];
                        u32x4 w; w.x = cvt_pk_bf16(o0, o1); w.y = cvt_pk_bf16(o2, o3); w.z = cvt_pk_bf16(o4, o5); w.w = cvt_pk_bf16(o6, o7);
                        *(u32x4*)(rowp + bj * HALF) = w; } }
        } else {
#pragma unroll
            for (int ai = 0; ai < 2; ++ai)
#pragma unroll
                for (int m = 0; m < 4; ++m) { bf16_t* rowp = O + (size_t)(row0 + ai * HALF + m * 16) * ldc + col0;
#pragma unroll
                    for (int bj = 0; bj < 2; ++bj) { const f32x4 v0 = acc[ai][bj][m][0], v1 = acc[ai][bj][m][1];
                        u32x4 w; w.x = cvt_pk_bf16(v0[0], v0[1]); w.y = cvt_pk_bf16(v0[2], v0[3]); w.z = cvt_pk_bf16(v1[0], v1[1]); w.w = cvt_pk_bf16(v1[2], v1[3]);
                        *(u32x4*)(rowp + bj * HALF) = w; } }
        }
    }
};

__device__ __forceinline__ float silu_f(float a) { return a * __builtin_amdgcn_rcpf(1.0f + __builtin_amdgcn_exp2f(-1.4426950408889634f * a)); }
struct EpiSwiglu {
    static constexpr bool PERM = true;
    bf16_t* O; int ldc;
    __device__ __forceinline__ void operator()(const f32x4 (&acc)[2][2][4][2], const Unit& u, int wr, int wc, int fr, int fq) const {
        const int row0 = u.pm * BM + wr * 64 + fr; const int col0 = u.pn * HALF + wc * 32 + 8 * fq;
#pragma unroll
        for (int ai = 0; ai < 2; ++ai)
#pragma unroll
            for (int m = 0; m < 4; ++m) { bf16_t* rowp = O + (size_t)(row0 + ai * HALF + m * 16) * ldc + col0;
                const f32x4 a0 = acc[ai][0][m][0], a1 = acc[ai][0][m][1], b0 = acc[ai][1][m][0], b1 = acc[ai][1][m][1];
                u32x4 w;
                w.x = cvt_pk_bf16(silu_f(a0[0]) * b0[0], silu_f(a0[1]) * b0[1]); w.y = cvt_pk_bf16(silu_f(a0[2]) * b0[2], silu_f(a0[3]) * b0[3]);
                w.z = cvt_pk_bf16(silu_f(a1[0]) * b1[0], silu_f(a1[1]) * b1[1]); w.w = cvt_pk_bf16(silu_f(a1[2]) * b1[2], silu_f(a1[3]) * b1[3]);
                *(u32x4*)rowp = w; }
    }
};

struct EpiResid {
    static constexpr bool PERM = false;
    const float* xin; float* out; int ldc; const float* gate; float alpha;
    __device__ __forceinline__ void operator()(const f32x4 (&acc)[2][2][4][2], const Unit& u, int wr, int wc, int fr, int fq) const {
        const int col0 = u.pn * BM + wc * 32 + 4 * fq;
        f32x4 gv[2][2];
#pragma unroll
        for (int bj = 0; bj < 2; ++bj)
#pragma unroll
            for (int n = 0; n < 2; ++n) gv[bj][n] = *(const f32x4*)(gate + col0 + bj * HALF + n * 16) + 1.0f;
#pragma unroll
        for (int ai = 0; ai < 2; ++ai)
#pragma unroll
            for (int m = 0; m < 4; ++m) { const size_t off = (size_t)(u.pm * BM + ai * HALF + wr * 64 + m * 16 + fr) * ldc + col0;
#pragma unroll
                for (int bj = 0; bj < 2; ++bj)
#pragma unroll
                    for (int n = 0; n < 2; ++n) { const f32x4 x = *(const f32x4*)(xin + off + bj * HALF + n * 16);
                        *(f32x4*)(out + off + bj * HALF + n * 16) = x * alpha + gv[bj][n] * acc[ai][bj][m][n]; }
                if (m & 1) asm volatile("" ::: "memory"); }
    }
};

template <class Epi, class Sched, bool ALIGN_EPI>
__device__ __forceinline__ void gemm_phase(PG8_LAS unsigned char* lds, const Gemm g, const Sched& S, const Epi& E, const int tid) {
    const int wid = __builtin_amdgcn_readfirstlane(tid >> 6), lane = tid & 63, wr = wid >> 2, wc = wid & 3, fr = lane & 15, fq = lane >> 4;
    const int K = g.K, nt = K / BK;
    unsigned voffA[2], voffB[2];
#pragma unroll
    for (int i = 0; i < 2; ++i) { int R, C; stage_rc(tid * 16 + i * 8192, R, C); const int Rb = Epi::PERM ? ((R & ~31) + perm32(R & 31)) : R;
        voffA[i] = (unsigned)(R * K + C) * 2u; voffB[i] = (unsigned)(Rb * K + C) * 2u; }
    const size_t kstep = (size_t)(BK * 2);
    const size_t hstep = (size_t)HALF * K * 2;
    const size_t tstep = 2 * hstep;
    const unsigned ldsw = (unsigned)wid * 1024u;
    const int aoff = lds_byte(wr * 64 + fr, fq * 8), boff = lds_byte(wc * 32 + fr, fq * 8);
#define PG8_SA(b, h) (((b) * 2 + (h)) * HTB)
#define PG8_SB(b, h) ((4 + (b) * 2 + (h)) * HTB)
#define PG8_STAGE(bufoff, gbase, voff) do { _Pragma("unroll") for (int _i = 0; _i < 2; ++_i) \
        __builtin_amdgcn_global_load_lds((const unsigned*)((const char*)(gbase) + (voff)[_i]), (PG8_LAS unsigned*)(lds + (bufoff) + ldsw + _i * 8192), 16, 0, 0); } while (0)
#define PG8_LDA(dst, b, h) do { _Pragma("unroll") for (int m = 0; m < 4; ++m) _Pragma("unroll") for (int k = 0; k < 2; ++k) dst[m][k] = *(const PG8_LAS bf16x8*)(lds + PG8_SA(b, h) + aoff + m * 2048 + k * 1024); } while (0)
#define PG8_LDB(dst, b, h) do { _Pragma("unroll") for (int n = 0; n < 2; ++n) _Pragma("unroll") for (int k = 0; k < 2; ++k) dst[n][k] = *(const PG8_LAS bf16x8*)(lds + PG8_SB(b, h) + boff + n * 2048 + k * 1024); } while (0)
#define PG8_MMA(ai, bj, At, Bt) do { __builtin_amdgcn_s_setprio(1); _Pragma("unroll") for (int m = 0; m < 4; ++m) _Pragma("unroll") for (int n = 0; n < 2; ++n) _Pragma("unroll") for (int k = 0; k < 2; ++k) \
        acc[ai][bj][m][n] = __builtin_amdgcn_mfma_f32_16x16x32_bf16(Bt[n][k], At[m][k], acc[ai][bj][m][n], 0, 0, 0); __builtin_amdgcn_s_setprio(0); } while (0)
#define PG8_WAIT_V(n) asm volatile("s_waitcnt vmcnt(" #n ")" ::: "memory")
#define PG8_WAIT_L(n) asm volatile("s_waitcnt lgkmcnt(" #n ")" ::: "memory")
#define PG8_BAR __builtin_amdgcn_s_barrier()
#define PG8_SCHED __builtin_amdgcn_sched_barrier(0)
    Unit cur, nxt; int ui = 0;
    if (!S.next(0, cur)) return;
    f32x4 acc[2][2][4][2];
#pragma unroll
    for (int a = 0; a < 2; ++a)
#pragma unroll
        for (int b = 0; b < 2; ++b)
#pragma unroll
            for (int m = 0; m < 4; ++m)
#pragma unroll
                for (int n = 0; n < 2; ++n) acc[a][b][m][n] = (f32x4){0.f, 0.f, 0.f, 0.f};
    bf16x8 At[4][2], B0[2][2], B1[2][2];
    const char* cA = (const char*)g.A + (size_t)cur.pm * tstep; const char* cB = (const char*)g.Bt + (size_t)cur.pb * tstep;
    PG8_STAGE(PG8_SB(0, 0), cB, voffB); PG8_STAGE(PG8_SB(0, 1), cB + hstep, voffB); PG8_STAGE(PG8_SA(0, 0), cA, voffA); PG8_STAGE(PG8_SA(0, 1), cA + hstep, voffA);
    if (wr == 1) PG8_BAR;
    PG8_WAIT_V(2); PG8_BAR;
    PG8_STAGE(PG8_SB(1, 0), cB + kstep, voffB); PG8_STAGE(PG8_SA(1, 0), cA + kstep, voffA); PG8_STAGE(PG8_SB(1, 1), cB + hstep + kstep, voffB);
    PG8_WAIT_V(6); PG8_BAR;
    for (;;) {
        const bool has_next = S.next(ui + 1, nxt);
        const char* nA = has_next ? (const char*)g.A + (size_t)nxt.pm * tstep : cA; const char* nB = has_next ? (const char*)g.Bt + (size_t)nxt.pb * tstep : cB;
        for (int t = 0; t < nt; t += 2) {
            const bool last = (t == nt - 2);
            const char* a1 = cA + (size_t)(t + 1) * kstep;
            const char* a2 = last ? nA : cA + (size_t)(t + 2) * kstep; const char* b2 = last ? nB : cB + (size_t)(t + 2) * kstep;
            const char* a3 = a2 + kstep; const char* b3 = b2 + kstep;
            PG8_LDB(B0, 0, 0); PG8_LDB(B1, 0, 1); PG8_SCHED; PG8_LDA(At, 0, 0); PG8_STAGE(PG8_SA(1, 1), a1 + hstep, voffA);
            PG8_WAIT_V(8); PG8_WAIT_L(0); PG8_BAR; PG8_MMA(0, 0, At, B0); PG8_MMA(0, 1, At, B1); PG8_BAR; PG8_SCHED;
            PG8_LDA(At, 0, 1); PG8_STAGE(PG8_SB(0, 0), b2, voffB); PG8_STAGE(PG8_SB(0, 1), b2 + hstep, voffB); PG8_STAGE(PG8_SA(0, 0), a2, voffA);
            PG8_WAIT_V(8); PG8_WAIT_L(0); PG8_BAR; PG8_MMA(1, 0, At, B0); PG8_MMA(1, 1, At, B1); PG8_BAR; PG8_SCHED;
            PG8_LDB(B0, 1, 0); PG8_LDB(B1, 1, 1); PG8_SCHED; PG8_LDA(At, 1, 0); PG8_STAGE(PG8_SA(0, 1), a2 + hstep, voffA);
            PG8_WAIT_V(8); PG8_WAIT_L(0); PG8_BAR; PG8_MMA(0, 0, At, B0); PG8_MMA(0, 1, At, B1); PG8_BAR; PG8_SCHED;
            PG8_LDA(At, 1, 1); PG8_STAGE(PG8_SB(1, 0), b3, voffB); PG8_STAGE(PG8_SB(1, 1), b3 + hstep, voffB); PG8_STAGE(PG8_SA(1, 0), a3, voffA);
            PG8_WAIT_V(8); PG8_WAIT_L(0); PG8_BAR; PG8_MMA(1, 0, At, B0); PG8_MMA(1, 1, At, B1); PG8_BAR; PG8_SCHED;
        }
        if constexpr (ALIGN_EPI) { if (wr == 0) PG8_BAR; }
        E(acc, cur, wr, wc, fr, fq);
        if (!has_next) break;
#pragma unroll
        for (int a = 0; a < 2; ++a)
#pragma unroll
            for (int b = 0; b < 2; ++b)
#pragma unroll
                for (int m = 0; m < 4; ++m)
#pragma unroll
                    for (int n = 0; n < 2; ++n) acc[a][b][m][n] = (f32x4){0.f, 0.f, 0.f, 0.f};
        cur = nxt; cA = nA; cB = nB; ++ui;
        if constexpr (ALIGN_EPI) { if (wr == 1) PG8_BAR; }
    }
    PG8_WAIT_V(0);
    if constexpr (!ALIGN_EPI) { if (wr == 0) PG8_BAR; }
    PG8_BAR;
#undef PG8_SA
#undef PG8_SB
#undef PG8_STAGE
#undef PG8_LDA
#undef PG8_LDB
#undef PG8_MMA
#undef PG8_WAIT_V
#undef PG8_WAIT_L
#undef PG8_BAR
#undef PG8_SCHED
}
}
namespace attn_body {
using bf16=__hip_bfloat16;
using bf16x8=__attribute__((ext_vector_type(8)))short;
using s16x4=__attribute__((ext_vector_type(4)))short;
using f32x16=__attribute__((ext_vector_type(16)))float;
using u32x4=__attribute__((ext_vector_type(4)))unsigned;
constexpr int SEQ=16384,D=64,PQ=2816,PO=512;
constexpr int NW=8,QBLK=32,QB=QBLK*NW,KVBLK=64,NQB=SEQ/QB;
constexpr int ATTN_UNIT_ROWS=QB;
__device__ __forceinline__ int crow(int r,int hi){return (r&3)+8*(r>>2)+4*hi;}
#define SBAR() __builtin_amdgcn_sched_barrier(0)
__device__ __forceinline__ void cmask(f32x16&p0,f32x16&p1,int jb,int qrel,int hi){
  const float NEG=-INFINITY; int kb=64*jb+4*hi;
  #pragma unroll
  for(int r=0;r<16;++r){int kv=kb+(r&3)+8*(r>>2); if(kv>qrel)p0[r]=NEG; if(kv+32>qrel)p1[r]=NEG;}
}

constexpr int NSLOT=3, SLOTB=8192;
constexpr int LDS_K=0, LDS_V=NSLOT*SLOTB, LDS_WS=2*NSLOT*SLOTB, LDS_OST=LDS_WS+NW*64*4, LDS_BYTES=LDS_OST+NW*4096;
constexpr float C2=0.125f*1.4426950408889634f;
__device__ __forceinline__ void glds16(const void*gsrc,unsigned lds_dst){unsigned keep;
  asm volatile("s_mov_b32 %0, m0\n\ts_mov_b32 m0, %2\n\ts_nop 0\n\tglobal_load_lds_dwordx4 %1, off\n\ts_mov_b32 m0, %0":"=&s"(keep):"v"(gsrc),"s"(lds_dst):"memory");}
__device__ __forceinline__ float max3f(float a,float b,float c){float r;asm("v_max3_f32 %0, %1, %2, %3":"=v"(r):"v"(a),"v"(b),"v"(c));return r;}
__device__ __forceinline__ float max2f(float a,float b){float r;asm("v_max_f32_e32 %0, %1, %2":"=v"(r):"v"(a),"v"(b));return r;}
__device__ __forceinline__ float fadd_s(float a,float b){float r;asm("v_add_f32_e32 %0, %1, %2":"=v"(r):"v"(a),"v"(b));return r;}
__device__ __forceinline__ float fsub_s(float a,float b){float r;asm("v_sub_f32_e32 %0, %1, %2":"=v"(r):"v"(a),"v"(b));return r;}
typedef float f32x2_t __attribute__((ext_vector_type(2))); typedef __bf16 bf16x2_t __attribute__((ext_vector_type(2)));
__device__ __forceinline__ unsigned cvtpk_s(float lo,float hi){f32x2_t v={lo,hi};bf16x2_t b=__builtin_convertvector(v,bf16x2_t);return __builtin_bit_cast(unsigned,b);}
#define WAIT_BAR(N) asm volatile("s_waitcnt vmcnt(" #N ") lgkmcnt(0)\n\ts_barrier":::"memory")

__device__ __forceinline__ void qkt(f32x16&p0,f32x16&p1,const char*Kslot,const bf16x8*qr,const f32x16&negm,int r32,int hi){
  const char*kb=Kslot+hi*1024+r32*16;
  #pragma unroll
  for(int d0=0;d0<4;++d0){
    const bf16x8 b0=*reinterpret_cast<const bf16x8*>(kb+d0*2048);
    const bf16x8 b1=*reinterpret_cast<const bf16x8*>(kb+d0*2048+512);
    if(d0==0){p0=__builtin_amdgcn_mfma_f32_32x32x16_bf16(b0,qr[0],negm,0,0,0);p1=__builtin_amdgcn_mfma_f32_32x32x16_bf16(b1,qr[0],negm,0,0,0);}
    else{p0=__builtin_amdgcn_mfma_f32_32x32x16_bf16(b0,qr[d0],p0,0,0,0);p1=__builtin_amdgcn_mfma_f32_32x32x16_bf16(b1,qr[d0],p1,0,0,0);}}
}
typedef __attribute__((address_space(3))) const char* lds_cptr;
typedef short v4i16_t __attribute__((ext_vector_type(4)));
__device__ __forceinline__ void kload8(bf16x8*kf,lds_cptr kp){
  kf[0]=*(const __attribute__((address_space(3))) bf16x8*)(kp);      kf[1]=*(const __attribute__((address_space(3))) bf16x8*)(kp+512);
  kf[2]=*(const __attribute__((address_space(3))) bf16x8*)(kp+2048); kf[3]=*(const __attribute__((address_space(3))) bf16x8*)(kp+2560);
  kf[4]=*(const __attribute__((address_space(3))) bf16x8*)(kp+4096); kf[5]=*(const __attribute__((address_space(3))) bf16x8*)(kp+4608);
  kf[6]=*(const __attribute__((address_space(3))) bf16x8*)(kp+6144); kf[7]=*(const __attribute__((address_space(3))) bf16x8*)(kp+6656);
}
__device__ __forceinline__ void kload2(bf16x8*kf,lds_cptr kp,int j){ kf[2*j]=*(const __attribute__((address_space(3))) bf16x8*)(kp+j*2048); kf[2*j+1]=*(const __attribute__((address_space(3))) bf16x8*)(kp+j*2048+512); }
__device__ __forceinline__ s16x4 vtr(lds_cptr p){ return __builtin_bit_cast(s16x4,__builtin_amdgcn_ds_read_tr16_b64_v4i16((__attribute__((address_space(3))) v4i16_t*)p)); }
__device__ __forceinline__ float rowmax(const f32x16&p0,const f32x16&p1){
  float a=max3f(p0[0],p0[1],p1[0]),b=max3f(p0[2],p0[3],p1[1]);a=max3f(a,p1[2],p1[3]);
  #pragma unroll
  for(int r=4;r<16;r+=4){a=max3f(a,p0[r],p0[r+1]);b=max3f(b,p0[r+2],p0[r+3]);a=max3f(a,p1[r],p1[r+1]);b=max3f(b,p1[r+2],p1[r+3]);}
  const float m=max2f(a,b);
  auto rr=__builtin_amdgcn_permlane32_swap(__float_as_uint(m),__float_as_uint(m),false,false);
  return max2f(__uint_as_float(rr[0]),__uint_as_float(rr[1]));
}
__device__ __forceinline__ void pv(f32x16*o,int vb,bf16x8 pa0,bf16x8 pa1,bf16x8 pa2,bf16x8 pa3){
  #pragma unroll
  for(int d0=0;d0<2;++d0){s16x4 lo[4],hi[4];
    #pragma unroll
    for(int ks=0;ks<4;++ks){
      asm volatile("ds_read_b64_tr_b16 %0,%1 offset:%c2":"=&v"(lo[ks]):"v"(vb),"i"(d0*4096+ks*1024):"memory");
      asm volatile("ds_read_b64_tr_b16 %0,%1 offset:%c2":"=&v"(hi[ks]):"v"(vb),"i"(d0*4096+ks*1024+512):"memory");}
    asm volatile("s_waitcnt lgkmcnt(0)":::"memory");SBAR();
    #define PK(k) (bf16x8){lo[k][0],lo[k][1],lo[k][2],lo[k][3],hi[k][0],hi[k][1],hi[k][2],hi[k][3]}
    o[d0]=__builtin_amdgcn_mfma_f32_32x32x16_bf16(pa0,PK(0),o[d0],0,0,0);
    o[d0]=__builtin_amdgcn_mfma_f32_32x32x16_bf16(pa1,PK(1),o[d0],0,0,0);
    o[d0]=__builtin_amdgcn_mfma_f32_32x32x16_bf16(pa2,PK(2),o[d0],0,0,0);
    o[d0]=__builtin_amdgcn_mfma_f32_32x32x16_bf16(pa3,PK(3),o[d0],0,0,0);
    #undef PK
  }
}

#ifndef ATTN_STORE16
#define ATTN_STORE16(p,v) (*(u32x4*)(p)=(v))
#endif
template<int THRL> __device__ __forceinline__ void attn_unit(const int tid,int qb,const bf16*Qh,const bf16*__restrict__ Kh,const bf16*__restrict__ Vh,bf16*Oh,char*shm){
  const int lane=tid&63,r32=lane&31,hi=lane>>5; const int wid=__builtin_amdgcn_readfirstlane(tid>>6);
  const int q0=qb*QB;
  const bf16*Qw=Qh+(long)(q0+wid*QBLK)*PQ;
  const unsigned lds0=(unsigned)(uintptr_t)shm;
  float*wsf=(float*)(shm+LDS_WS)+wid*64;
  const bf16*ksrc=Kh+(long)lane*PQ+wid*8;
  const bf16*vsrc=Vh+(long)(16*(wid&3)+(lane>>2))*PQ+(wid>>2)*32+(lane&3)*8;
  const unsigned kdst=lds0+LDS_K+wid*1024, vdst=lds0+LDS_V+wid*1024;
  #define DMA_K(t,slot) glds16(ksrc+(long)(t)*KVBLK*PQ,(unsigned)__builtin_amdgcn_readfirstlane(kdst+(slot)))
  #define DMA_V(t,slot) glds16(vsrc+(long)(t)*KVBLK*PQ,(unsigned)__builtin_amdgcn_readfirstlane(vdst+(slot)))
  const int vb0=(int)(lds0+LDS_V)+((lane>>4)&1)*32+(lane&3)*8+(4*hi+((lane&15)>>2))*64;
  const char*Kbase=shm+LDS_K; bf16x8 kf[8];
  const lds_cptr shm3=(lds_cptr)shm; const lds_cptr kp0=shm3+LDS_K+hi*1024+r32*16; const lds_cptr vp0=shm3+LDS_V+((lane>>4)&1)*32+(lane&3)*8+(4*hi+((lane&15)>>2))*64;
  const int NT=(q0+QB)/KVBLK;
  DMA_K(0,0);DMA_V(0,0);DMA_K(1,SLOTB);
  bf16x8 qr[4];
  #pragma unroll
  for(int d0=0;d0<4;++d0)qr[d0]=*reinterpret_cast<const bf16x8*>(&Qw[(long)r32*PQ+d0*16+hi*8]);
  float mhat=0.f,l_reg=0.f;f32x16 o[2];o[0]=f32x16{};o[1]=f32x16{};const f32x16 negm=f32x16{};
  const int qrel=wid*QBLK+r32;
  #define CMASK(P0,P1,t) do{int jb_=(t)-(NT-4); if(jb_>=0)cmask(P0,P1,jb_,qrel,hi);}while(0)
  bool resc=false;
  #define START(P0,P1) do{ const float rm=rowmax(P0,P1); resc=false; \
    { const float dl=rm; mhat=fadd_s(mhat,dl); \
      _Pragma("unroll") for(int r=0;r<16;++r){P0[r]=fsub_s(P0[r],dl);P1[r]=fsub_s(P1[r],dl);} \
      } \
    _Pragma("unroll") for(int r=0;r<16;++r)P0[r]=__builtin_amdgcn_exp2f(P0[r]); }while(0)
  #define RESC() do{ if(resc){ asm volatile("s_waitcnt lgkmcnt(0)":::"memory"); \
      _Pragma("unroll") for(int d_=0;d_<2;++d_) _Pragma("unroll") for(int r=0;r<16;++r)o[d_][r]*=wsf[crow(r,hi)]; } }while(0)
  f32x16 pA0,pA1,pB0,pB1;
  int sl_prev=0,sl_cur=0,sl_next=SLOTB;
  #define ROT() do{sl_prev=sl_cur;sl_cur=sl_next;sl_next=(sl_next==(NSLOT-1)*SLOTB)?0:sl_next+SLOTB;}while(0)
  DMA_K(2,2*SLOTB);
  WAIT_BAR(3);
  qkt(pA0,pA1,Kbase,qr,negm,r32,hi);asm volatile("s_nop 15\n\ts_nop 7":"+v"(pA0),"+v"(pA1));CMASK(pA0,pA1,0);
  START(pA0,pA1);
  _Pragma("unroll") for(int r=0;r<16;++r)pA1[r]=__builtin_amdgcn_exp2f(pA1[r]);
  WAIT_BAR(0);
  DMA_K(3,0);DMA_V(1,SLOTB);
  ROT();
  kload8(kf,kp0+sl_cur);
  WAIT_BAR(2);
  s16x4 vlo[8],vhi[8]; u32x4 pw0,pw1,pw2,pw3;
  #define PKW(P,B) cvtpk_s(P[B],P[B+1])
  #define PAF(k) __builtin_bit_cast(bf16x8,pw##k)
  #define VFR(i) (bf16x8){vlo[i][0],vlo[i][1],vlo[i][2],vlo[i][3],vhi[i][0],vhi[i][1],vhi[i][2],vhi[i][3]}
  #define PIN(x) asm volatile("":"+v"(x))
  #define MX3(a,b,c) __builtin_fmaxf(__builtin_fmaxf((a),(b)),(c))
  #define GAPA(MF,A0,A1,A2,A3,W0,W1,PW) do{ MF; sacc+=A0; sacc+=A1; sacc+=A2; sacc+=A3; PIN(sacc); W0; W1; PIN(PW); SBAR(); }while(0)
  #define EX(v) __builtin_amdgcn_exp2f(v)
  #define GAPB(MF,X,B) do{ MF; X[B]=EX(X[B]-mhat); X[B+1]=EX(X[B+1]-mhat); X[B+2]=EX(X[B+2]-mhat); X[B+3]=EX(X[B+3]-mhat); PIN(X); SBAR(); }while(0)
  #define VRD(i) do{ vlo[i]=vtr(vp_+(((i)>>2)*4096+((i)&3)*1024)); vhi[i]=vtr(vp_+(((i)>>2)*4096+((i)&3)*1024+512)); }while(0)
  #define KRD(G,j) do{ if(G){ kload2(kf,kp0+sl_next,j); SBAR(); } }while(0)
  #define STEP(C0,C1,P0,P1,t,GK,GV,GL) do{ SBAR(); \
    const lds_cptr vp_=vp0+sl_prev; \
    VRD(0); SBAR(); float sacc=(P0[0]+P0[1]); \
    GAPA(C0=__builtin_amdgcn_mfma_f32_32x32x16_bf16(kf[0],qr[0],negm,0,0,0), P0[2],P0[3],P0[4],P0[5],     pw0[0]=PKW(P0,0), pw0[1]=PKW(P0,2), pw0); \
    VRD(4); SBAR(); GAPA(C1=__builtin_amdgcn_mfma_f32_32x32x16_bf16(kf[1],qr[0],negm,0,0,0), P0[6],P0[7],P0[8],P0[9],     pw0[2]=PKW(P0,4), pw0[3]=PKW(P0,6), pw0); \
    VRD(1); SBAR(); GAPA(C0=__builtin_amdgcn_mfma_f32_32x32x16_bf16(kf[2],qr[1],C0,0,0,0),   P0[10],P0[11],P0[12],P0[13], pw1[0]=PKW(P0,8), pw1[1]=PKW(P0,10), pw1); \
    VRD(5); SBAR(); GAPA(C1=__builtin_amdgcn_mfma_f32_32x32x16_bf16(kf[3],qr[1],C1,0,0,0),   P0[14],P0[15],P1[0],P1[1],   pw1[2]=PKW(P0,12),pw1[3]=PKW(P0,14), pw1); \
    VRD(2); SBAR(); GAPA(C0=__builtin_amdgcn_mfma_f32_32x32x16_bf16(kf[4],qr[2],C0,0,0,0),   P1[2],P1[3],P1[4],P1[5],     pw2[0]=PKW(P1,0), pw2[1]=PKW(P1,2), pw2); \
    VRD(6); SBAR(); GAPA(C1=__builtin_amdgcn_mfma_f32_32x32x16_bf16(kf[5],qr[2],C1,0,0,0),   P1[6],P1[7],P1[8],P1[9],     pw2[2]=PKW(P1,4), pw2[3]=PKW(P1,6), pw2); \
    VRD(3); SBAR(); GAPA(C0=__builtin_amdgcn_mfma_f32_32x32x16_bf16(kf[6],qr[3],C0,0,0,0),   P1[10],P1[11],P1[12],P1[13], pw3[0]=PKW(P1,8), pw3[1]=PKW(P1,10), pw3); \
    VRD(7); SBAR(); GAPA(C1=__builtin_amdgcn_mfma_f32_32x32x16_bf16(kf[7],qr[3],C1,0,0,0),   P1[14],P1[15],0.f,0.f,       pw3[2]=PKW(P1,12),pw3[3]=PKW(P1,14), pw3); \
    l_reg+=sacc; \
    if(GK){DMA_K((t)+3,sl_cur);} if(GV){DMA_V((t)+1,sl_next);} \
    CMASK(C0,C1,t); \
    { float a=MX3(C0[0],C0[1],C1[0]),b=MX3(C0[2],C0[3],C1[1]); a=MX3(a,C1[2],C1[3]); \
      _Pragma("unroll") for(int r=4;r<16;r+=4){a=MX3(a,C0[r],C0[r+1]);b=MX3(b,C0[r+2],C0[r+3]);a=MX3(a,C1[r],C1[r+1]);b=MX3(b,C1[r+2],C1[r+3]);} \
      float rm=__builtin_fmaxf(a,b); { auto rr=__builtin_amdgcn_permlane32_swap(__float_as_uint(rm),__float_as_uint(rm),false,false); rm=__builtin_fmaxf(__uint_as_float(rr[0]),__uint_as_float(rr[1])); } \
      resc=false; \
      rm-=mhat; \
      if(__builtin_expect(__any(rm>(float)THRL),0)){ const float dl=__builtin_fmaxf(rm,0.f); mhat+=dl; \
        const float f=__builtin_amdgcn_exp2f(-dl); l_reg*=f; if(hi==0)wsf[r32]=f; resc=true; } } \
    SBAR(); \
    GAPB(o[0]=__builtin_amdgcn_mfma_f32_32x32x16_bf16(PAF(0),VFR(0),o[0],0,0,0), C0,0); \
    GAPB(o[1]=__builtin_amdgcn_mfma_f32_32x32x16_bf16(PAF(0),VFR(4),o[1],0,0,0), C0,4); \
    KRD(GL,0); GAPB(o[0]=__builtin_amdgcn_mfma_f32_32x32x16_bf16(PAF(1),VFR(1),o[0],0,0,0), C0,8); \
    KRD(GL,1); GAPB(o[1]=__builtin_amdgcn_mfma_f32_32x32x16_bf16(PAF(1),VFR(5),o[1],0,0,0), C0,12); \
    KRD(GL,2); GAPB(o[0]=__builtin_amdgcn_mfma_f32_32x32x16_bf16(PAF(2),VFR(2),o[0],0,0,0), C1,0); \
    KRD(GL,3); GAPB(o[1]=__builtin_amdgcn_mfma_f32_32x32x16_bf16(PAF(2),VFR(6),o[1],0,0,0), C1,4); \
    GAPB(o[0]=__builtin_amdgcn_mfma_f32_32x32x16_bf16(PAF(3),VFR(3),o[0],0,0,0), C1,8); \
    GAPB(o[1]=__builtin_amdgcn_mfma_f32_32x32x16_bf16(PAF(3),VFR(7),o[1],0,0,0), C1,12); \
    }while(0)
  int t=1;
  #undef CMASK
  #define CMASK(P0,P1,t) do{}while(0)
  for(;t+5<NT;t+=2){
    STEP(pB0,pB1,pA0,pA1,t,true,true,true);     WAIT_BAR(2); RESC(); ROT();
    STEP(pA0,pA1,pB0,pB1,t+1,true,true,true);   WAIT_BAR(2); RESC(); ROT();
  }
  #undef CMASK
  #define CMASK(P0,P1,t) do{int jb_=(t)-(NT-4); if(jb_>=0)cmask(P0,P1,jb_,qrel,hi);}while(0)
  #define ENDW(tt) do{ if((tt)+3<NT){WAIT_BAR(2);} else if((tt)+2<NT){WAIT_BAR(1);} else {WAIT_BAR(0);} }while(0)
  for(;t+1<NT;t+=2){
    STEP(pB0,pB1,pA0,pA1,t,(t+3<NT),(t+1<NT),(t+1<NT));       ENDW(t);   RESC(); ROT();
    STEP(pA0,pA1,pB0,pB1,t+1,(t+4<NT),(t+2<NT),(t+2<NT));     ENDW(t+1); RESC(); ROT();
  }
  STEP(pB0,pB1,pA0,pA1,NT-1,false,false,false); RESC();
  { float sacc=pB0[0]+pB0[1]; _Pragma("unroll") for(int r=2;r<16;++r)sacc+=pB0[r]; _Pragma("unroll") for(int r=0;r<16;++r)sacc+=pB1[r]; l_reg+=sacc;
    pw0=(u32x4){PKW(pB0,0),PKW(pB0,2),PKW(pB0,4),PKW(pB0,6)};pw1=(u32x4){PKW(pB0,8),PKW(pB0,10),PKW(pB0,12),PKW(pB0,14)};pw2=(u32x4){PKW(pB1,0),PKW(pB1,2),PKW(pB1,4),PKW(pB1,6)};pw3=(u32x4){PKW(pB1,8),PKW(pB1,10),PKW(pB1,12),PKW(pB1,14)};
    SBAR(); pv(o,vb0+sl_cur,PAF(0),PAF(1),PAF(2),PAF(3)); }
  #undef PKW
  #undef PAF
  #undef VFR
  #undef PIN
  #undef MX3
  #undef GAPA
  #undef GAPB
  #undef EX
  #undef VRD
  #undef KRD
  #undef STEP
  #undef ENDW
  {auto rr=__builtin_amdgcn_permlane32_swap(__float_as_uint(l_reg),__float_as_uint(l_reg),false,false);l_reg=__uint_as_float(rr[0])+__uint_as_float(rr[1]);}
  if(hi==0)wsf[32+r32]=l_reg;asm volatile("s_waitcnt lgkmcnt(0)":::"memory");
  float rli[16];
  #pragma unroll
  for(int r=0;r<16;++r)rli[r]=__builtin_amdgcn_rcpf(wsf[32+crow(r,hi)]);
  bf16*Ow=Oh+(long)(q0+wid*QBLK)*PO;
  { bf16*stg=(bf16*)(shm+LDS_OST)+wid*2048;
    #pragma unroll
    for(int r=0;r<16;++r){const int orow=crow(r,hi);
      #pragma unroll
      for(int d0=0;d0<2;++d0)stg[orow*64+d0*32+r32]=__float2bfloat16(o[d0][r]*rli[r]);}
    asm volatile("s_waitcnt lgkmcnt(0)":::"memory");
    #pragma unroll
    for(int i=0;i<4;++i){const int row=i*8+(lane>>3),ch=lane&7; const u32x4 v=*(const u32x4*)(stg+row*64+ch*8); ATTN_STORE16(Ow+(long)row*PO+ch*8,v);} }
  asm volatile("s_waitcnt lgkmcnt(0)\n\ts_barrier":::"memory");
  #undef DMA_K
  #undef DMA_V
  #undef CMASK
  #undef START
  #undef RESC
  #undef ROT
}
constexpr int ATTN_LDS_BYTES=LDS_BYTES;
#undef SBAR
#undef WAIT_BAR
}
namespace attn_body {
#define SBAR() __builtin_amdgcn_sched_barrier(0)
#define WAIT_BAR(N) asm volatile("s_waitcnt vmcnt(" #N ") lgkmcnt(0)\n\ts_barrier":::"memory")
constexpr int SLOTV=16384;
constexpr int L2_K=0, L2_V=NSLOT*SLOTB, L2_WS=L2_V+NSLOT*SLOTV, L2_OST=L2_WS+NW*64*4, LDS2_BYTES=L2_OST+NW*4096;
template<int THRL> __device__ __forceinline__ void attn_unit2(const int tid,int qb,const bf16*Qh,const bf16*__restrict__ Kh,const bf16*__restrict__ Vh,bf16*Oh,char*shm){
  const int lane=tid&63,r32=lane&31,hi=lane>>5; const int wid=__builtin_amdgcn_readfirstlane(tid>>6);
  const int q0=qb*QB;
  const bf16*Qw=Qh+(long)(q0+wid*QBLK)*PQ;
  const unsigned lds0=(unsigned)(uintptr_t)shm;
  float*wsf=(float*)(shm+L2_WS)+wid*64;
  const bf16*ksrc=Kh+(long)lane*PQ+wid*8;
  const bf16*vsrc=Vh+(long)(16*(wid&3)+(lane>>2))*PQ+(wid>>2)*32+(lane&3)*8;
  const unsigned kdst=lds0+L2_K+wid*1024, vdst=lds0+L2_V+wid*1024;
  #define DMA_K(t,slot) glds16(ksrc+(long)(t)*KVBLK*PQ,(unsigned)__builtin_amdgcn_readfirstlane(kdst+(slot)))
  #define DMA_V(t,slot) do{ glds16(vsrc+(long)(t)*KVBLK*PQ,(unsigned)__builtin_amdgcn_readfirstlane(vdst+2*(slot))); glds16(vsrc+64+(long)(t)*KVBLK*PQ,(unsigned)__builtin_amdgcn_readfirstlane(vdst+8192+2*(slot))); }while(0)
  const int vb0=(int)(lds0+L2_V)+((lane>>4)&1)*32+(lane&3)*8+(4*hi+((lane&15)>>2))*64;
  const char*Kbase=shm+L2_K; bf16x8 kf[8];
  const lds_cptr shm3=(lds_cptr)shm; const lds_cptr kp0=shm3+L2_K+hi*1024+r32*16; const lds_cptr vp0=shm3+L2_V+((lane>>4)&1)*32+(lane&3)*8+(4*hi+((lane&15)>>2))*64;
  const int NT=(q0+QB)/KVBLK;
  DMA_K(0,0);DMA_V(0,0);DMA_K(1,SLOTB);
  bf16x8 qr[4];
  #pragma unroll
  for(int d0=0;d0<4;++d0)qr[d0]=*reinterpret_cast<const bf16x8*>(&Qw[(long)r32*PQ+d0*16+hi*8]);
  float mhat=0.f,l_reg=0.f;f32x16 o[4];o[0]=f32x16{};o[1]=f32x16{};o[2]=f32x16{};o[3]=f32x16{};const f32x16 zc=f32x16{};
  const int qrel=wid*QBLK+r32;
  #define CMASK(P0,P1,t) do{int jb_=(t)-(NT-4); if(jb_>=0)cmask(P0,P1,jb_,qrel,hi);}while(0)
  bool resc=false;
  #define RESC() do{ if(resc){ asm volatile("s_waitcnt lgkmcnt(0)":::"memory"); \
      _Pragma("unroll") for(int d_=0;d_<4;++d_) _Pragma("unroll") for(int r=0;r<16;++r)o[d_][r]*=wsf[crow(r,hi)]; } }while(0)
  f32x16 C0,C1;
  int sl_prev=0,sl_cur=0,sl_next=SLOTB;
  #define ROT() do{sl_prev=sl_cur;sl_cur=sl_next;sl_next=(sl_next==(NSLOT-1)*SLOTB)?0:sl_next+SLOTB;}while(0)
  DMA_K(2,2*SLOTB);
  WAIT_BAR(3);
  s16x4 vlo[8],vhi[8]; u32x4 pw0,pw1,pw2,pw3;
  #define PKW(P,B) cvtpk_s(P[B],P[B+1])
  #define PAF(k) __builtin_bit_cast(bf16x8,pw##k)
  #define VFR(i) (bf16x8){vlo[i][0],vlo[i][1],vlo[i][2],vlo[i][3],vhi[i][0],vhi[i][1],vhi[i][2],vhi[i][3]}
  #define PIN(x) asm volatile("":"+v"(x))
  #define MX3(a,b,c) __builtin_fmaxf(__builtin_fmaxf((a),(b)),(c))
  #define EX(v) __builtin_amdgcn_exp2f(v)
  qkt(C0,C1,Kbase,qr,zc,r32,hi);asm volatile("s_nop 15\n\ts_nop 7":"+v"(C0),"+v"(C1));CMASK(C0,C1,0);
  { const float rm=rowmax(C0,C1); mhat=rm;
    _Pragma("unroll") for(int r=0;r<16;++r){C0[r]=EX(C0[r]-rm);C1[r]=EX(C1[r]-rm);}
    float sacc=C0[0]+C0[1]; _Pragma("unroll") for(int r=2;r<16;++r)sacc+=C0[r]; _Pragma("unroll") for(int r=0;r<16;++r)sacc+=C1[r]; l_reg=sacc;
    pw0=(u32x4){PKW(C0,0),PKW(C0,2),PKW(C0,4),PKW(C0,6)};pw1=(u32x4){PKW(C0,8),PKW(C0,10),PKW(C0,12),PKW(C0,14)};pw2=(u32x4){PKW(C1,0),PKW(C1,2),PKW(C1,4),PKW(C1,6)};pw3=(u32x4){PKW(C1,8),PKW(C1,10),PKW(C1,12),PKW(C1,14)}; }
  WAIT_BAR(0);
  DMA_K(3,0);DMA_V(1,SLOTB);
  ROT();
  kload8(kf,kp0+sl_cur);
  WAIT_BAR(3);
  #define GAPA(MF) do{ MF; SBAR(); }while(0)
  #define GAPB1(MF,X,B,I) do{ MF; X[B]=EX(X[B]-mhat); X[B+1]=EX(X[B+1]-mhat); X[B+2]=EX(X[B+2]-mhat); X[B+3]=EX(X[B+3]-mhat); PIN(X); VRD2(I); SBAR(); }while(0)
  #define VRD(i)  do{ vlo[i]=vtr(vp_+(((i)>>2)*4096+((i)&3)*1024)); vhi[i]=vtr(vp_+(((i)>>2)*4096+((i)&3)*1024+512)); }while(0)
  #define VRD2(i) do{ vlo[i]=vtr(vp_+(8192+((i)>>2)*4096+((i)&3)*1024)); vhi[i]=vtr(vp_+(8192+((i)>>2)*4096+((i)&3)*1024+512)); }while(0)
  #define KRD(G,j) do{ if(G){ kload2(kf,kp0+sl_next,j); } }while(0)
  #define ADD4(a,b,c,d) do{ sacc+=a; sacc+=b; sacc+=c; sacc+=d; PIN(sacc); }while(0)
  #define STEP2(t,GK,GV,GL) do{ SBAR(); \
    const lds_cptr vp_=vp0+2*sl_prev; \
    VRD(0); SBAR(); GAPA(C0=__builtin_amdgcn_mfma_f32_32x32x16_bf16(kf[0],qr[0],zc,0,0,0)); \
    VRD(4); SBAR(); GAPA(C1=__builtin_amdgcn_mfma_f32_32x32x16_bf16(kf[1],qr[0],zc,0,0,0)); \
    VRD(1); SBAR(); GAPA(C0=__builtin_amdgcn_mfma_f32_32x32x16_bf16(kf[2],qr[1],C0,0,0,0)); \
    VRD(5); SBAR(); GAPA(C1=__builtin_amdgcn_mfma_f32_32x32x16_bf16(kf[3],qr[1],C1,0,0,0)); \
    VRD(2); SBAR(); GAPA(C0=__builtin_amdgcn_mfma_f32_32x32x16_bf16(kf[4],qr[2],C0,0,0,0)); \
    VRD(6); SBAR(); GAPA(C1=__builtin_amdgcn_mfma_f32_32x32x16_bf16(kf[5],qr[2],C1,0,0,0)); \
    VRD(3); SBAR(); GAPA(C0=__builtin_amdgcn_mfma_f32_32x32x16_bf16(kf[6],qr[3],C0,0,0,0)); \
    VRD(7); SBAR(); GAPA(C1=__builtin_amdgcn_mfma_f32_32x32x16_bf16(kf[7],qr[3],C1,0,0,0)); \
    if(GK){DMA_K((t)+3,sl_cur);} if(GV){DMA_V((t)+1,sl_next);} \
    CMASK(C0,C1,t); \
    { float a=MX3(C0[0],C0[1],C1[0]),b=MX3(C0[2],C0[3],C1[1]); a=MX3(a,C1[2],C1[3]); \
      _Pragma("unroll") for(int r=4;r<16;r+=4){a=MX3(a,C0[r],C0[r+1]);b=MX3(b,C0[r+2],C0[r+3]);a=MX3(a,C1[r],C1[r+1]);b=MX3(b,C1[r+2],C1[r+3]);} \
      float rm=__builtin_fmaxf(a,b); { auto rr=__builtin_amdgcn_permlane32_swap(__float_as_uint(rm),__float_as_uint(rm),false,false); rm=__builtin_fmaxf(__uint_as_float(rr[0]),__uint_as_float(rr[1])); } \
      resc=false; rm-=mhat; \
      if(__builtin_expect(__any(rm>(float)THRL),0)){ const float dl=__builtin_fmaxf(rm,0.f); mhat+=dl; \
        const float f=__builtin_amdgcn_exp2f(-dl); l_reg*=f; if(hi==0)wsf[r32]=f; resc=true; } } \
    SBAR(); \
    GAPB1(o[0]=__builtin_amdgcn_mfma_f32_32x32x16_bf16(PAF(0),VFR(0),o[0],0,0,0), C0,0, 0); \
    GAPB1(o[1]=__builtin_amdgcn_mfma_f32_32x32x16_bf16(PAF(0),VFR(4),o[1],0,0,0), C0,4, 4); \
    GAPB1(o[0]=__builtin_amdgcn_mfma_f32_32x32x16_bf16(PAF(1),VFR(1),o[0],0,0,0), C0,8, 1); \
    GAPB1(o[1]=__builtin_amdgcn_mfma_f32_32x32x16_bf16(PAF(1),VFR(5),o[1],0,0,0), C0,12,5); \
    GAPB1(o[0]=__builtin_amdgcn_mfma_f32_32x32x16_bf16(PAF(2),VFR(2),o[0],0,0,0), C1,0, 2); \
    GAPB1(o[1]=__builtin_amdgcn_mfma_f32_32x32x16_bf16(PAF(2),VFR(6),o[1],0,0,0), C1,4, 6); \
    GAPB1(o[0]=__builtin_amdgcn_mfma_f32_32x32x16_bf16(PAF(3),VFR(3),o[0],0,0,0), C1,8, 3); \
    GAPB1(o[1]=__builtin_amdgcn_mfma_f32_32x32x16_bf16(PAF(3),VFR(7),o[1],0,0,0), C1,12,7); \
    float sacc=(C0[0]+C0[1]); \
    o[2]=__builtin_amdgcn_mfma_f32_32x32x16_bf16(PAF(0),VFR(0),o[2],0,0,0); ADD4(C0[2],C0[3],C0[4],C0[5]); KRD(GL,0); SBAR(); \
    o[3]=__builtin_amdgcn_mfma_f32_32x32x16_bf16(PAF(0),VFR(4),o[3],0,0,0); ADD4(C0[6],C0[7],C0[8],C0[9]); KRD(GL,1); SBAR(); \
    o[2]=__builtin_amdgcn_mfma_f32_32x32x16_bf16(PAF(1),VFR(1),o[2],0,0,0); ADD4(C0[10],C0[11],C0[12],C0[13]); pw0[0]=PKW(C0,0); pw0[1]=PKW(C0,2); PIN(pw0); KRD(GL,2); SBAR(); \
    o[3]=__builtin_amdgcn_mfma_f32_32x32x16_bf16(PAF(1),VFR(5),o[3],0,0,0); ADD4(C0[14],C0[15],C1[0],C1[1]); pw0[2]=PKW(C0,4); pw0[3]=PKW(C0,6); PIN(pw0); KRD(GL,3); SBAR(); \
    o[2]=__builtin_amdgcn_mfma_f32_32x32x16_bf16(PAF(2),VFR(2),o[2],0,0,0); ADD4(C1[2],C1[3],C1[4],C1[5]); pw1[0]=PKW(C0,8); pw1[1]=PKW(C0,10); PIN(pw1); SBAR(); \
    o[3]=__builtin_amdgcn_mfma_f32_32x32x16_bf16(PAF(2),VFR(6),o[3],0,0,0); ADD4(C1[6],C1[7],C1[8],C1[9]); pw1[2]=PKW(C0,12); pw1[3]=PKW(C0,14); PIN(pw1); SBAR(); \
    o[2]=__builtin_amdgcn_mfma_f32_32x32x16_bf16(PAF(3),VFR(3),o[2],0,0,0); ADD4(C1[10],C1[11],C1[12],C1[13]); pw2[0]=PKW(C1,0); pw2[1]=PKW(C1,2); PIN(pw2); SBAR(); \
    o[3]=__builtin_amdgcn_mfma_f32_32x32x16_bf16(PAF(3),VFR(7),o[3],0,0,0); sacc+=C1[14]; sacc+=C1[15]; PIN(sacc); pw2[2]=PKW(C1,4); pw2[3]=PKW(C1,6); PIN(pw2); SBAR(); \
    pw3[0]=PKW(C1,8); pw3[1]=PKW(C1,10); pw3[2]=PKW(C1,12); pw3[3]=PKW(C1,14); PIN(pw3); l_reg+=sacc; \
    }while(0)
  #define ENDW(tt) do{ if((tt)+3<NT){WAIT_BAR(3);} else if((tt)+2<NT){WAIT_BAR(2);} else {WAIT_BAR(0);} }while(0)
  int t=1;
  #undef CMASK
  #define CMASK(P0,P1,t) do{}while(0)
  for(;t+4<NT;++t){ STEP2(t,true,true,true); WAIT_BAR(3); RESC(); ROT(); }
  #undef CMASK
  #define CMASK(P0,P1,t) do{int jb_=(t)-(NT-4); if(jb_>=0)cmask(P0,P1,jb_,qrel,hi);}while(0)
  for(;t+1<NT;++t){ STEP2(t,(t+3<NT),(t+1<NT),(t+1<NT)); ENDW(t); RESC(); ROT(); }
  STEP2(NT-1,false,false,false); RESC();
  { SBAR(); const int vb=vb0+2*sl_cur;
    #pragma unroll
    for(int d0=0;d0<4;++d0){s16x4 lo[4],hi4[4];
      #pragma unroll
      for(int ks=0;ks<4;++ks){
        asm volatile("ds_read_b64_tr_b16 %0,%1 offset:%c2":"=&v"(lo[ks]):"v"(vb),"i"(d0*4096+ks*1024):"memory");
        asm volatile("ds_read_b64_tr_b16 %0,%1 offset:%c2":"=&v"(hi4[ks]):"v"(vb),"i"(d0*4096+ks*1024+512):"memory");}
      asm volatile("s_waitcnt lgkmcnt(0)":::"memory");SBAR();
      #define PK(k) (bf16x8){lo[k][0],lo[k][1],lo[k][2],lo[k][3],hi4[k][0],hi4[k][1],hi4[k][2],hi4[k][3]}
      o[d0]=__builtin_amdgcn_mfma_f32_32x32x16_bf16(PAF(0),PK(0),o[d0],0,0,0);
      o[d0]=__builtin_amdgcn_mfma_f32_32x32x16_bf16(PAF(1),PK(1),o[d0],0,0,0);
      o[d0]=__builtin_amdgcn_mfma_f32_32x32x16_bf16(PAF(2),PK(2),o[d0],0,0,0);
      o[d0]=__builtin_amdgcn_mfma_f32_32x32x16_bf16(PAF(3),PK(3),o[d0],0,0,0);
      #undef PK
    } }
  {auto rr=__builtin_amdgcn_permlane32_swap(__float_as_uint(l_reg),__float_as_uint(l_reg),false,false);l_reg=__uint_as_float(rr[0])+__uint_as_float(rr[1]);}
  if(hi==0)wsf[32+r32]=l_reg;asm volatile("s_waitcnt lgkmcnt(0)":::"memory");
  float rli[16];
  #pragma unroll
  for(int r=0;r<16;++r)rli[r]=__builtin_amdgcn_rcpf(wsf[32+crow(r,hi)]);
  bf16*Ow=Oh+(long)(q0+wid*QBLK)*PO;
  { bf16*stg=(bf16*)(shm+L2_OST)+wid*2048;
    #pragma unroll
    for(int hf=0;hf<2;++hf){
      #pragma unroll
      for(int r=0;r<16;++r){const int orow=crow(r,hi);
        #pragma unroll
        for(int d0=0;d0<2;++d0)stg[orow*64+d0*32+r32]=__float2bfloat16(o[2*hf+d0][r]*rli[r]);}
      asm volatile("s_waitcnt lgkmcnt(0)":::"memory");
      #pragma unroll
      for(int i=0;i<4;++i){const int row=i*8+(lane>>3),ch=lane&7; const u32x4 v=*(const u32x4*)(stg+row*64+ch*8); ATTN_STORE16(Ow+(long)row*PO+hf*64+ch*8,v);}
      asm volatile("s_waitcnt lgkmcnt(0)":::"memory");
    } }
  asm volatile("s_waitcnt lgkmcnt(0)\n\ts_barrier":::"memory");
  #undef DMA_K
  #undef DMA_V
  #undef CMASK
  #undef RESC
  #undef ROT
  #undef PKW
  #undef PAF
  #undef VFR
  #undef PIN
  #undef MX3
  #undef EX
  #undef GAPA
  #undef GAPB1
  #undef VRD
  #undef VRD2
  #undef KRD
  #undef ADD4
  #undef STEP2
  #undef ENDW
}
#undef SBAR
#undef WAIT_BAR
}
#define GAS __attribute__((address_space(1)))
#define LAS __attribute__((address_space(3)))
typedef unsigned short bf16;
typedef unsigned v4u __attribute__((ext_vector_type(4)));
typedef float f32x4 __attribute__((ext_vector_type(4)));
typedef short bf16x8 __attribute__((ext_vector_type(8)));
typedef GAS unsigned gu32;
typedef GAS unsigned long long gu64;
#define RLX_AGENT __ATOMIC_RELAXED, __HIP_MEMORY_SCOPE_AGENT
#define LDS_WAIT() asm volatile("s_waitcnt lgkmcnt(0)" ::: "memory")
#define VM_WAIT() asm volatile("s_waitcnt vmcnt(0)" ::: "memory")
__device__ __forceinline__ unsigned long long rt() { return __builtin_amdgcn_s_memrealtime(); }
__device__ __forceinline__ unsigned f2bf(float f) { unsigned u = __builtin_bit_cast(unsigned, f); return (u + 0x7fffu + ((u >> 16) & 1u)) >> 16; }
__device__ __forceinline__ unsigned pk2(float lo, float hi) { return f2bf(lo) | (f2bf(hi) << 16); }

#define XB_TMO      128
#define XB_XCNT(j)  (256  + 64 * (j))
#define XB_XSUB(j)  (1280 + 64 * (j))
#define XB_XGEN(j)  (2304 + 64 * (j))
#define XB_TOP      3328
#define XB_TOPGEN   3392
#define XCD_BAR_WORDS 3456
#define XB_SPIN_CAP (1u << 18)

__device__ __forceinline__ unsigned xb_ld(unsigned* p)              { return __hip_atomic_load(p, __ATOMIC_RELAXED, __HIP_MEMORY_SCOPE_AGENT); }
__device__ __forceinline__ unsigned xb_add(unsigned* p, unsigned v) { return __hip_atomic_fetch_add(p, v, __ATOMIC_RELAXED, __HIP_MEMORY_SCOPE_AGENT); }
__device__ __forceinline__ unsigned xb_xcc_id() { return (unsigned)__builtin_amdgcn_s_getreg((3 << 11) | 20) & 0xFu; }
#define XB_SPIN(cond, bar) do { unsigned _sp = 0; while (cond) { __builtin_amdgcn_s_sleep(1); \
    if ((++_sp & 255u) == 0u) { if (xb_ld(&(bar)[XB_TMO])) break; if (_sp > XB_SPIN_CAP) { atomicAdd(&(bar)[XB_TMO], 1u); break; } } } } while (0)

struct XcdBarrier {
    unsigned* bar; unsigned x;
    volatile LAS unsigned* st;
};

__device__ __forceinline__ XcdBarrier xcd_barrier_post(unsigned* bar, volatile LAS unsigned* st, const int tid) {
    XcdBarrier b; b.bar = bar; b.x = xb_xcc_id(); b.st = st;
    if (tid == 0) (void)xb_add(&bar[XB_XCNT(b.x)], 1u);
    return b;
}
__device__ __forceinline__ void xcd_barrier_complete(unsigned* bar, unsigned x, unsigned& nloc, unsigned& nx) {
    const unsigned G = gridDim.x * gridDim.y * gridDim.z;
    unsigned sum, cnt, mine, sp = 0u;
    for (;;) {
        sum = 0u; cnt = 0u; mine = 0u;
#pragma unroll
        for (unsigned j = 0; j < 16; ++j) { const unsigned c = xb_ld(&bar[XB_XCNT(j)]); sum += c; cnt += (c > 0u) ? 1u : 0u; mine = (j == x) ? c : mine; }
        if (sum == G) break;
        __builtin_amdgcn_s_sleep(1);
        if ((++sp & 255u) == 0u) { if (xb_ld(&bar[XB_TMO])) break; if (sp > XB_SPIN_CAP) { atomicAdd(&bar[XB_TMO], 1u); break; } }
    }
    nloc = mine > 0u ? mine : 1u; nx = cnt > 0u ? cnt : 1u;
}

__device__ __forceinline__ void xcd_barrier(const XcdBarrier& b, const int tid) {
    asm volatile("s_waitcnt vmcnt(0)" ::: "memory");
    __syncthreads();
    if (tid == 0) {
        unsigned* bar = b.bar;
        __builtin_amdgcn_s_waitcnt(0);
        unsigned nloc = b.st[0], nx = b.st[1];
        if (nloc == 0u) { xcd_barrier_complete(bar, b.x, nloc, nx); b.st[0] = nloc; b.st[1] = nx; }
        const unsigned old = xb_add(&bar[XB_XSUB(b.x)], 1u);
        const unsigned gen = old / nloc;
        if (old + 1u == (gen + 1u) * nloc) {
            __builtin_amdgcn_fence(__ATOMIC_RELEASE, "agent");
            asm volatile("s_waitcnt vmcnt(0)" ::: "memory");
            const unsigned og = xb_add(&bar[XB_TOP], 1u);
            const unsigned tg = og / nx;
            if (og + 1u == (tg + 1u) * nx) xb_add(&bar[XB_TOPGEN], 1u);
            else XB_SPIN(xb_ld(&bar[XB_TOPGEN]) == tg, bar);
            __builtin_amdgcn_fence(__ATOMIC_ACQUIRE, "agent");
            xb_add(&bar[XB_XGEN(b.x)], 1u);
            asm volatile("s_waitcnt vmcnt(0)" ::: "memory");
        } else {
            XB_SPIN(xb_ld(&bar[XB_XGEN(b.x)]) == gen, bar);
            __builtin_amdgcn_fence(__ATOMIC_ACQUIRE, "agent");
            asm volatile("s_waitcnt vmcnt(0)" ::: "memory");
        }
    }
    __syncthreads();
}
constexpr int NWAVES = 8;
#ifndef MK_N_LAUNCHES
#define MK_N_LAUNCHES 1
#endif
constexpr int NPH_LAYER = 11, NPH = 2 + 2 * NPH_LAYER;
constexpr int N_LAUNCHES = MK_N_LAUNCHES;
static_assert(N_LAUNCHES == 1 || N_LAUNCHES == NPH, "MK_N_LAUNCHES is 1 or NPH");

constexpr int SEQ = 16384, DMODEL = 1024, DIN = 2816, FFD = 2816, NEXP = 8, EDIM = 3584, DEPTH = 2;
constexpr int M = SEQ;
constexpr float LN_EPS = 1e-5f;
constexpr float ALPHA = 1.4142135623730951f;
constexpr int MAXSLOT = 135 * 256;

constexpr size_t MiB = 1u << 20;
constexpr size_t WS_CTL = 0, CTL_ZERO_BYTES = 1 * MiB;
constexpr size_t WS_SMALL = 1 * MiB;
constexpr size_t SM_MOD = 0, SM_LBS = 49152, SM_LAM = 51200, SM_TOK = 65536, SM_PERM = 327680;
constexpr size_t WS_ROPE = 2 * MiB;
constexpr size_t WS_EXP13 = 6 * MiB, WS_EXP2 = 118 * MiB;
constexpr size_t WS_HPERM = 174 * MiB;
constexpr size_t WS_YSLOT = 174 * MiB;
constexpr size_t WS_HID = 242 * MiB;
constexpr size_t WS_PROJ = 242 * MiB, WS_DHID = 242 * MiB;
constexpr size_t WS_ATTNO = 330 * MiB, WS_HBUF = 330 * MiB;
constexpr size_t WS_MIX = 362 * MiB, WS_HGS = 394 * MiB, WS_HGD = 410 * MiB;
constexpr size_t WS_WIN = 411 * MiB, WS_WOUT = 422 * MiB, WS_FFN13 = 426 * MiB, WS_FFN2 = 437 * MiB;
constexpr size_t WS_END = 479 * MiB;
static_assert(WS_YSLOT + (size_t)MAXSLOT * 1024 * 2 <= WS_HID && WS_HID + (size_t)MAXSLOT * 3584 * 2 <= WS_END && WS_FFN2 + (size_t)1024 * 2816 * 2 <= WS_END, "d_ws map");
constexpr int CW_TMO = 0, CW_CODE = 1;
constexpr int CW_CNT = 64;
constexpr int CW_BAR = 4096;

constexpr int RING_OFF = 0, RING_BYTES = 131072;
constexpr int LDSCTL_OFF = RING_BYTES, MISC_OFF = LDSCTL_OFF + 320;
constexpr int XTRA_OFF = LDSCTL_OFF + 1024;
constexpr int LDS_BYTES = 147456;

__device__ __forceinline__ float bf2f(unsigned short b) { return __uint_as_float((unsigned)b << 16); }
template <int O> __device__ __forceinline__ float swzx(float v) { return __int_as_float(__builtin_amdgcn_ds_swizzle(__float_as_int(v), (O << 10) | 0x1f)); }
__device__ __forceinline__ float wave_sum(float v) {
    v += swzx<1>(v); v += swzx<2>(v); v += swzx<4>(v); v += swzx<8>(v); v += swzx<16>(v);
    auto rr = __builtin_amdgcn_permlane32_swap(__float_as_uint(v), __float_as_uint(v), false, false);
    return __uint_as_float(rr[0]) + __uint_as_float(rr[1]);
}
__device__ __forceinline__ float sigmoid_f(float z) { return __builtin_amdgcn_rcpf(1.0f + __builtin_amdgcn_exp2f(-1.4426950408889634f * z)); }
__device__ __forceinline__ float silu_ff(float a) { return a * sigmoid_f(a); }

struct Args { const float* in[23]; float* out; unsigned char* ws; int ph_lo, ph_hi, li, pad; };
enum { I_X = 0, I_C, I_WADA, I_BADA, I_WIN, I_LAMQK, I_ATTNG, I_HGLB, I_HGG, I_POOLW, I_POOLS, I_WOUT, I_LN1G, I_LN1B, I_LN2G, I_LN2B, I_FW1, I_FW3, I_FW2, I_RW, I_EW1, I_EW3, I_EW2 };

struct Frame {
    LAS unsigned char* lds; volatile LAS unsigned* MISC; gu32* ctl; unsigned char* ws;
    int tid, lane, wave, vcu, G, bid;
};

__device__ const float kInvFreq[32] = {1.f, 0.749894202f, 0.562341332f, 0.421696514f, 0.316227764f, 0.237137392f, 0.177827939f, 0.133352146f, 0.100000001f, 0.0749894157f, 0.0562341288f, 0.0421696492f,
    0.0316227786f, 0.0237137359f, 0.0177827943f, 0.0133352149f, 0.00999999978f, 0.00749894232f, 0.00562341325f, 0.00421696482f, 0.00316227786f, 0.00237137382f, 0.00177827943f, 0.00133352145f,
    0.00100000005f, 0.000749894185f, 0.000562341302f, 0.000421696546f, 0.000316227786f, 0.000237137385f, 0.00017782794f, 0.00013335215f};

template <int KIND> __device__ __forceinline__ int rowmap(int n) {
    if (KIND == 0) { if (n >= 1024) return n; const int d = n & 63; return (n & ~63) + ((d < 32) ? 2 * d : 2 * (d - 32) + 1); }
    if (KIND == 2) return ((n >> 7) << 8) + (n & 127);
    if (KIND == 3) return ((n >> 7) << 8) + 128 + (n & 127);
    return n;
}
template <int KIND> __device__ __forceinline__ void transpose_item(const float* W, int K, int N, bf16* WT, LAS float* scr, int item, int lane) {
    const int nblk = N / 32, kb = item / nblk, nb = item % nblk, k0 = 64 * kb, n0 = 32 * nb;
#pragma unroll 8
    for (int i = 0; i < 32; ++i) { const int kk = 2 * i + (lane >> 5); scr[kk * 33 + (lane & 31)] = W[(size_t)(k0 + kk) * N + n0 + (lane & 31)]; }
    LDS_WAIT(); asm volatile("" ::: "memory");
    const int c = lane & 7;
#pragma unroll
    for (int j = 0; j < 4; ++j) { const int n = (lane >> 3) + 8 * j; const LAS float* s = scr + (8 * c) * 33 + n;
        v4u o; o.x = pk2(s[0 * 33], s[1 * 33]); o.y = pk2(s[2 * 33], s[3 * 33]); o.z = pk2(s[4 * 33], s[5 * 33]); o.w = pk2(s[6 * 33], s[7 * 33]);
        *(GAS v4u*)(WT + (size_t)rowmap<KIND>(n0 + n) * K + k0 + 8 * c) = o; }
    LDS_WAIT(); asm volatile("" ::: "memory");
}
__device__ __forceinline__ void sincos_acc(float ang, float& s, float& c) {
    const double a = (double)ang; const double n = __builtin_rint(a * 0.63661977236758134308);
    double r = __builtin_fma(-n, 1.57079632679489655800, a); r = __builtin_fma(-n, 6.12323399573676603587e-17, r);
    const double r2 = r * r;
    double sp = -1.0 / 1307674368000.0; sp = sp * r2 + 1.0 / 6227020800.0; sp = sp * r2 - 1.0 / 39916800.0; sp = sp * r2 + 1.0 / 362880.0; sp = sp * r2 - 1.0 / 5040.0; sp = sp * r2 + 1.0 / 120.0; sp = sp * r2 - 1.0 / 6.0;
    const double sr = r + r * r2 * sp;
    double cp = 1.0 / 20922789888000.0; cp = cp * r2 - 1.0 / 87178291200.0; cp = cp * r2 + 1.0 / 479001600.0; cp = cp * r2 - 1.0 / 3628800.0; cp = cp * r2 + 1.0 / 40320.0; cp = cp * r2 - 1.0 / 720.0; cp = cp * r2 + 1.0 / 24.0; cp = cp * r2 - 0.5;
    const double cr = 1.0 + r2 * cp;
    const int q = ((int)n) & 3;
    const double ss = (q == 0) ? sr : (q == 1) ? cr : (q == 2) ? -sr : -cr;
    const double cc = (q == 0) ? cr : (q == 1) ? -sr : (q == 2) ? -cr : sr;
    s = (float)ss; c = (float)cc;
}
__device__ __forceinline__ void p0a_prologue(Frame& F, const Args& A) {
    const int gw = F.vcu * NWAVES + F.wave, NGW = F.G * NWAVES;
    {
        LAS float* red = (LAS float*)(F.lds + XTRA_OFF);
        for (int cb = F.bid; cb < 256; cb += F.G) {
            const int fc = cb * 48 + F.lane; const int l = fc / 6144, j = fc % 6144; float acc = 0.f;
            if (F.lane < 48) {
                const float* w = A.in[I_WADA] + (size_t)l * 1024 * 6144 + j; const float* c = A.in[I_C];
#pragma unroll 8
                for (int k = F.wave * 128; k < F.wave * 128 + 128; ++k) acc += silu_ff(c[k]) * w[(size_t)k * 6144];
            }
            red[F.wave * 64 + F.lane] = acc;
            __syncthreads();
            if (F.wave == 0 && F.lane < 48) { float s = 0.f;
#pragma unroll
                for (int w8 = 0; w8 < 8; ++w8) s += red[w8 * 64 + F.lane];
                ((float*)(F.ws + WS_SMALL + SM_MOD))[fc] = s + A.in[I_BADA][fc]; }
            __syncthreads();
        }
    }
    {
        float* cosT = (float*)(F.ws + WS_ROPE); float* sinT = cosT + (size_t)SEQ * 32;
        for (int idx = F.bid * (NWAVES * 64) + F.tid; idx < SEQ * 32; idx += F.G * NWAVES * 64) {
            const int pos = idx >> 5, i = idx & 31; const float ang = (float)pos * kInvFreq[i]; float s, c; sincos_acc(ang, s, c);
            cosT[idx] = c; sinT[idx] = s; }
    }
    if (F.bid == 0) {
        float* lbs = (float*)(F.ws + WS_SMALL + SM_LBS); float* lam = (float*)(F.ws + WS_SMALL + SM_LAM);
        if (F.tid < 256) { const float a0 = A.in[I_HGLB][F.tid], a1 = A.in[I_HGLB][256 + F.tid]; const float mx = fmaxf(a0, a1); const float e0 = __expf(a0 - mx), e1 = __expf(a1 - mx);
            lbs[F.tid] = 0.f; lbs[256 + F.tid] = e1 / (e0 + e1); }
        if (F.tid >= 256 && F.tid < 258) { const int l = F.tid - 256; const float* q = A.in[I_LAMQK] + l * 256; float s1 = 0.f, s2 = 0.f;
            for (int j = 0; j < 64; ++j) { s1 += q[j] * q[64 + j]; s2 += q[128 + j] * q[192 + j]; }
            const float li = 0.8f - 0.6f * expf(-0.3f * (float)l); lam[l] = expf(s1) - expf(s2) + li; lam[2 + l] = li; }
    }
    LAS float* scr = (LAS float*)(F.lds + RING_OFF + F.wave * 16384);
    constexpr int I_WI = 16 * 88, I_WO = 16 * 32, I_F13 = 16 * 88, I_F2 = 44 * 32, I_E13 = 16 * 112, I_E2 = 56 * 32;
    constexpr int NITEMS = 2 * I_WI + 2 * I_WO + 2 * I_F13 + I_F2 + 16 * I_E13 + 8 * I_E2;
    for (int it = gw; it < NITEMS; it += NGW) {
        int r = it;
        if (r < 2 * I_WI) { const int l = r / I_WI; transpose_item<0>(A.in[I_WIN] + (size_t)l * 1024 * DIN, 1024, DIN, (bf16*)(F.ws + WS_WIN) + (size_t)l * DIN * 1024, scr, r % I_WI, F.lane); continue; } r -= 2 * I_WI;
        if (r < 2 * I_WO) { const int l = r / I_WO; transpose_item<1>(A.in[I_WOUT] + (size_t)l * 1024 * 1024, 1024, 1024, (bf16*)(F.ws + WS_WOUT) + (size_t)l * 1024 * 1024, scr, r % I_WO, F.lane); continue; } r -= 2 * I_WO;
        if (r < I_F13) { transpose_item<2>(A.in[I_FW1], 1024, FFD, (bf16*)(F.ws + WS_FFN13), scr, r, F.lane); continue; } r -= I_F13;
        if (r < I_F13) { transpose_item<3>(A.in[I_FW3], 1024, FFD, (bf16*)(F.ws + WS_FFN13), scr, r, F.lane); continue; } r -= I_F13;
        if (r < I_F2) { transpose_item<1>(A.in[I_FW2], FFD, 1024, (bf16*)(F.ws + WS_FFN2), scr, r, F.lane); continue; } r -= I_F2;
        if (r < 8 * I_E13) { const int e = r / I_E13; transpose_item<2>(A.in[I_EW1] + (size_t)e * 1024 * EDIM, 1024, EDIM, (bf16*)(F.ws + WS_EXP13) + (size_t)e * 2 * EDIM * 1024, scr, r % I_E13, F.lane); continue; } r -= 8 * I_E13;
        if (r < 8 * I_E13) { const int e = r / I_E13; transpose_item<3>(A.in[I_EW3] + (size_t)e * 1024 * EDIM, 1024, EDIM, (bf16*)(F.ws + WS_EXP13) + (size_t)e * 2 * EDIM * 1024, scr, r % I_E13, F.lane); continue; } r -= 8 * I_E13;
        { const int e = r / I_E2; transpose_item<1>(A.in[I_EW2] + (size_t)e * EDIM * 1024, EDIM, 1024, (bf16*)(F.ws + WS_EXP2) + (size_t)e * 1024 * EDIM, scr, r % I_E2, F.lane); }
    }
}

__device__ __forceinline__ void load4(f32x4 (&v)[4], const float* p, int lane) { const GAS f32x4* q = (const GAS f32x4*)p + lane;
#pragma unroll
    for (int j = 0; j < 4; ++j) v[j] = q[64 * j]; }
__device__ __forceinline__ void store_bf16_row(bf16* orow, const f32x4 (&v)[4], int lane) {
    GAS unsigned long long* o8 = (GAS unsigned long long*)orow + lane;
#pragma unroll
    for (int j = 0; j < 4; ++j) o8[64 * j] = (unsigned long long)pk2(v[j].x, v[j].y) | ((unsigned long long)pk2(v[j].z, v[j].w) << 32);
}
__device__ __forceinline__ void store_f32_row(float* orow, const f32x4 (&v)[4], int lane) { GAS f32x4* o = (GAS f32x4*)orow + lane;
#pragma unroll
    for (int j = 0; j < 4; ++j) o[64 * j] = v[j]; }
__device__ __forceinline__ void ln_row(f32x4 (&v)[4], const f32x4 (&g)[4], const f32x4 (&b)[4]) {
    float s = 0.f;
#pragma unroll
    for (int j = 0; j < 4; ++j) s += (v[j].x + v[j].y) + (v[j].z + v[j].w);
    const float mean = wave_sum(s) * (1.f / DMODEL); float s2 = 0.f;
#pragma unroll
    for (int j = 0; j < 4; ++j) { v[j] = v[j] - mean; s2 += (v[j].x * v[j].x + v[j].y * v[j].y) + (v[j].z * v[j].z + v[j].w * v[j].w); }
    const float rstd = 1.f / sqrtf(wave_sum(s2) * (1.f / DMODEL) + LN_EPS);
#pragma unroll
    for (int j = 0; j < 4; ++j) v[j] = v[j] * rstd * g[j] + b[j];
}
__device__ __forceinline__ void p_modulate(Frame& F, const float* x, const float* mod  , bf16* H) {
    const int gw = F.vcu * NWAVES + F.wave, NGW = F.G * NWAVES;
    f32x4 sh[4], sc[4]; load4(sh, mod, F.lane); load4(sc, mod + 1024, F.lane);
    for (int m = gw; m < M; m += NGW) { f32x4 v[4]; load4(v, x + (size_t)m * DMODEL, F.lane);
#pragma unroll
        for (int j = 0; j < 4; ++j) v[j] = v[j] * (sc[j] + 1.0f) + sh[j];
        store_bf16_row(H + (size_t)m * DMODEL, v, F.lane); }
}
template <bool ROUTE> __device__ __forceinline__ void p_ln(Frame& F, float* xio, const float* lg, const float* lb, const float* mod, bf16* H, const float* rw) {
    const int gw = F.vcu * NWAVES + F.wave, NGW = F.G * NWAVES;
    f32x4 g[4], b[4], sh[4], sc[4]; load4(g, lg, F.lane); load4(b, lb, F.lane);
    if (mod) { load4(sh, mod, F.lane); load4(sc, mod + 1024, F.lane); }
    LAS float* rwT = (LAS float*)(F.lds + RING_OFF);
    LAS int* lcnt = (LAS int*)(F.lds + RING_OFF + 32768);
    LAS int* rinfo = (LAS int*)(F.lds + RING_OFF + 32768 + 256) + F.wave * 64;
    if (ROUTE) {
        for (int i = F.tid; i < 8192; i += NWAVES * 64) { const int k = i >> 3, e = i & 7; rwT[e * 1024 + k] = rw[i]; }
        if (F.tid < 16) lcnt[F.tid] = 0;
        __syncthreads();
    }
    int nr = 0;
    for (int m = gw; m < M; m += NGW) { f32x4 v[4]; load4(v, xio + (size_t)m * DMODEL, F.lane);
        ln_row(v, g, b);
        store_f32_row(xio + (size_t)m * DMODEL, v, F.lane);
        if (mod) {
#pragma unroll
            for (int j = 0; j < 4; ++j) v[j] = v[j] * (sc[j] + 1.0f) + sh[j];
            store_bf16_row(H + (size_t)m * DMODEL, v, F.lane);
        }
        if (ROUTE) {
            float lgt[8];
#pragma unroll
            for (int e = 0; e < 8; ++e) { float s = 0.f;
#pragma unroll
                for (int j = 0; j < 4; ++j) { const f32x4 w = *(const LAS f32x4*)(rwT + e * 1024 + 256 * j + 4 * F.lane); s += (v[j].x * w.x + v[j].y * w.y) + (v[j].z * w.z + v[j].w * w.w); }
                lgt[e] = wave_sum(s); }
            int e0 = 0; float v0 = lgt[0];
#pragma unroll
            for (int e = 1; e < 8; ++e) if (lgt[e] > v0) { v0 = lgt[e]; e0 = e; }
            int e1 = -1; float v1 = -INFINITY;
#pragma unroll
            for (int e = 0; e < 8; ++e) if (e != e0 && (e1 < 0 || lgt[e] > v1)) { v1 = lgt[e]; e1 = e; }
            const float g0 = 1.0f / (1.0f + __expf(v1 - v0));
            if (F.lane == 0) { const int p0 = atomicAdd((int*)&lcnt[e0], 1), p1 = atomicAdd((int*)&lcnt[e1], 1);
                rinfo[nr * 8 + 0] = m; rinfo[nr * 8 + 1] = e0; rinfo[nr * 8 + 2] = e1; rinfo[nr * 8 + 3] = p0; rinfo[nr * 8 + 4] = p1; rinfo[nr * 8 + 5] = __float_as_int(g0); }
            ++nr;
        }
    }
    if (ROUTE) {
        __syncthreads();
        if (F.tid < 8) lcnt[8 + F.tid] = (int)__hip_atomic_fetch_add((unsigned*)(F.ctl + CW_CNT + 64 * F.tid), (unsigned)lcnt[F.tid], __ATOMIC_RELAXED, __HIP_MEMORY_SCOPE_AGENT);
        __syncthreads();
        int* perm = (int*)(F.ws + WS_SMALL + SM_PERM); int* tok = (int*)(F.ws + WS_SMALL + SM_TOK);
        if (F.lane == 0) for (int i = 0; i < nr; ++i) { const int m = rinfo[i * 8 + 0], e0 = rinfo[i * 8 + 1], e1 = rinfo[i * 8 + 2];
            const int p0 = lcnt[8 + e0] + rinfo[i * 8 + 3], p1 = lcnt[8 + e1] + rinfo[i * 8 + 4];
            perm[e0 * SEQ + p0] = m; perm[e1 * SEQ + p1] = m;
            tok[m * 4 + 0] = e0 | (e1 << 8); tok[m * 4 + 1] = p0; tok[m * 4 + 2] = p1; tok[m * 4 + 3] = rinfo[i * 8 + 5]; }
    }
}
__device__ __forceinline__ void p_ln_moe(Frame& F, float* xio, const float* lg, const float* lb, const float* g2v) {
    const int gw = F.vcu * NWAVES + F.wave, NGW = F.G * NWAVES;
    f32x4 g[4], b[4], gg[4]; load4(g, lg, F.lane); load4(b, lb, F.lane); load4(gg, g2v, F.lane);
    int tb[8]; { int acc = 0;
#pragma unroll
        for (int e = 0; e < 8; ++e) { tb[e] = acc; acc += ((int)__hip_atomic_load(F.ctl + CW_CNT + 64 * e, RLX_AGENT) + 255) >> 8; } }
    const int* tok = (const int*)(F.ws + WS_SMALL + SM_TOK); const bf16* Y = (const bf16*)(F.ws + WS_YSLOT);
    for (int m = gw; m < M; m += NGW) {
        const int ee = tok[m * 4 + 0], p0 = tok[m * 4 + 1], p1 = tok[m * 4 + 2]; const float g0 = __int_as_float(tok[m * 4 + 3]), g1 = 1.0f - g0;
        const int e0 = ee & 255, e1 = ee >> 8; int t0 = 0, t1 = 0;
#pragma unroll
        for (int e = 0; e < 8; ++e) { t0 = (e0 == e) ? tb[e] : t0; t1 = (e1 == e) ? tb[e] : t1; }
        const size_t s0 = (size_t)(t0 * 256 + p0), s1 = (size_t)(t1 * 256 + p1);
        f32x4 v[4]; load4(v, xio + (size_t)m * DMODEL, F.lane);
        const GAS unsigned long long* y0 = (const GAS unsigned long long*)(Y + s0 * DMODEL) + F.lane; const GAS unsigned long long* y1 = (const GAS unsigned long long*)(Y + s1 * DMODEL) + F.lane;
#pragma unroll
        for (int j = 0; j < 4; ++j) { const unsigned long long a = y0[64 * j], c = y1[64 * j];
            f32x4 f; f.x = g0 * bf2f((unsigned short)a) + g1 * bf2f((unsigned short)c); f.y = g0 * bf2f((unsigned short)(a >> 16)) + g1 * bf2f((unsigned short)(c >> 16));
            f.z = g0 * bf2f((unsigned short)(a >> 32)) + g1 * bf2f((unsigned short)(c >> 32)); f.w = g0 * bf2f((unsigned short)(a >> 48)) + g1 * bf2f((unsigned short)(c >> 48));
            v[j] = v[j] * ALPHA + (gg[j] + 1.0f) * f; }
        ln_row(v, g, b);
        store_f32_row(xio + (size_t)m * DMODEL, v, F.lane);
    }
}

__device__ __forceinline__ void hg_pass1(Frame& F, int l) {
    const bf16* P = (const bf16*)(F.ws + WS_PROJ); const float* lbs = (const float*)(F.ws + WS_SMALL + SM_LBS) + l * 256;
    float* HGS = (float*)(F.ws + WS_HGS); float* HGD = (float*)(F.ws + WS_HGD);
    LAS float* fk = (LAS float*)(F.lds + RING_OFF + F.wave * 16384);
    LAS float* vl = fk + 1024;
    const int kh = F.wave & 1;
    for (int tk = F.bid * 4 + (F.wave >> 1); tk < 1024; tk += F.G * 4) {
        const int c = tk >> 2, h = tk & 3;
        float S[32];
#pragma unroll
        for (int k = 0; k < 32; ++k) S[k] = 0.f;
        float dp = 1.f;
        for (int sb = 0; sb < 4; ++sb) {
            const int row0 = c * 64 + sb * 16;
#pragma unroll
            for (int j = 0; j < 8; ++j) { const int p = j * 64 + F.lane, tt = p >> 5, kk = p & 31, k = h * 64 + kh * 32 + kk;
                const float z = bf2f(P[(size_t)(row0 + tt) * DIN + 1792 + k]); const float lbv = lbs[k];
                const float f = lbv + (1.0f - lbv) * sigmoid_f(z), key = (1.0f - lbv) * sigmoid_f(-z);
                fk[(tt * 32 + kk) * 2] = f; fk[(tt * 32 + kk) * 2 + 1] = key; }
#pragma unroll
            for (int tt = 0; tt < 16; ++tt) vl[tt * 64 + F.lane] = silu_ff(bf2f(P[(size_t)(row0 + tt) * DIN + 2048 + h * 64 + F.lane]));
            for (int tt = 0; tt < 16; ++tt) {
                const float v = vl[tt * 64 + F.lane];
#pragma unroll
                for (int kk = 0; kk < 32; kk += 2) { const f32x4 q = *(const LAS f32x4*)(fk + (tt * 32 + kk) * 2);
                    S[kk] = q.x * S[kk] + q.y * v; S[kk + 1] = q.z * S[kk + 1] + q.w * v; }
            }
            if (F.lane < 32) {
#pragma unroll
                for (int tt = 0; tt < 16; ++tt) dp *= fk[(tt * 32 + F.lane) * 2]; }
        }
        float* Lp = HGS + ((size_t)(c * 4 + h) * 64 + kh * 32) * 64 + F.lane;
#pragma unroll
        for (int k = 0; k < 32; ++k) Lp[k * 64] = S[k];
        if (F.lane < 32) HGD[c * 256 + h * 64 + kh * 32 + F.lane] = dp;
    }
}
__device__ __forceinline__ void hg_pass2(Frame& F) {
    float* HGS = (float*)(F.ws + WS_HGS); const float* HGD = (const float*)(F.ws + WS_HGD);
    if (F.wave == 0) for (int b = F.bid; b < 256; b += F.G) {
        float carry = 0.f;
        for (int c0 = 0; c0 < 256; c0 += 16) { float Lv[16], Dv[16];
#pragma unroll
            for (int u = 0; u < 16; ++u) { Lv[u] = HGS[(size_t)(c0 + u) * 16384 + b * 64 + F.lane]; Dv[u] = HGD[(c0 + u) * 256 + b]; }
#pragma unroll
            for (int u = 0; u < 16; ++u) { HGS[(size_t)(c0 + u) * 16384 + b * 64 + F.lane] = carry; carry = Dv[u] * carry + Lv[u]; }
        }
    }
}
__device__ __forceinline__ void hg_pass3(Frame& F, int l, const float* hgg) {
    const bf16* P = (const bf16*)(F.ws + WS_PROJ); const float* lbs = (const float*)(F.ws + WS_SMALL + SM_LBS) + l * 256;
    const float* HGS = (const float*)(F.ws + WS_HGS); bf16* MIX = (bf16*)(F.ws + WS_MIX);
    LAS float* fk = (LAS float*)(F.lds + RING_OFF + F.wave * 16384);
    LAS float* vl = fk + 2048;
    LAS float* op = fk + 3072;
    LAS float* opp = (LAS float*)(F.lds + RING_OFF + (F.wave ^ 1) * 16384) + 3072;
    const int kh = F.wave & 1; const float gn = hgg[F.lane];
    for (int tk0 = F.bid * 4; tk0 < 1024; tk0 += F.G * 4) {
        const int tk = tk0 + (F.wave >> 1); const int c = tk >> 2, h = tk & 3;
        float S[32];
        { const float* Sp = HGS + ((size_t)(c * 4 + h) * 64 + kh * 32) * 64 + F.lane;
#pragma unroll
          for (int k = 0; k < 32; ++k) S[k] = Sp[k * 64]; }
        for (int sb = 0; sb < 4; ++sb) {
            const int row0 = c * 64 + sb * 16;
#pragma unroll
            for (int j = 0; j < 8; ++j) { const int p = j * 64 + F.lane, tt = p >> 5, kk = p & 31, k = h * 64 + kh * 32 + kk;
                const float z = bf2f(P[(size_t)(row0 + tt) * DIN + 1792 + k]); const float qv = bf2f(P[(size_t)(row0 + tt) * DIN + 1536 + k]); const float lbv = lbs[k];
                const float f = lbv + (1.0f - lbv) * sigmoid_f(z), key = (1.0f - lbv) * sigmoid_f(-z);
                *(LAS f32x4*)(fk + (tt * 32 + kk) * 4) = (f32x4){f, key, qv, 0.f}; }
#pragma unroll
            for (int tt = 0; tt < 16; ++tt) vl[tt * 64 + F.lane] = silu_ff(bf2f(P[(size_t)(row0 + tt) * DIN + 2048 + h * 64 + F.lane]));
            for (int tt = 0; tt < 16; ++tt) {
                const float v = vl[tt * 64 + F.lane]; float o = 0.f;
#pragma unroll
                for (int kk = 0; kk < 32; ++kk) { const f32x4 q = *(const LAS f32x4*)(fk + (tt * 32 + kk) * 4);
                    S[kk] = q.x * S[kk] + q.y * v; o += q.z * S[kk]; }
                op[tt * 64 + F.lane] = o;
            }
            __syncthreads();
#pragma unroll
            for (int t8 = 0; t8 < 8; ++t8) { const int tt = kh * 8 + t8; const float o = op[tt * 64 + F.lane] + opp[tt * 64 + F.lane];
                const float ss = wave_sum(o * o); const float rstd = 1.0f / sqrtf(ss * (1.0f / 64.0f) + LN_EPS);
                const float gt = bf2f(P[(size_t)(row0 + tt) * DIN + 2304 + h * 64 + F.lane]);
                MIX[(size_t)(row0 + tt) * DMODEL + 512 + h * 64 + F.lane] = (bf16)f2bf(o * rstd * gn * silu_ff(gt)); }
            __syncthreads();
        }
    }
}
__device__ __forceinline__ void pool_phase(Frame& F, const float* pw, const float* ps) {
    const bf16* P = (const bf16*)(F.ws + WS_PROJ); bf16* MIX = (bf16*)(F.ws + WS_MIX);
    LAS float* U = (LAS float*)(F.lds + RING_OFF + F.wave * 16384);
    LAS float* PL = U + 2048;
    const int gw = F.vcu * NWAVES + F.wave, NGW = F.G * NWAVES;
    for (int task = gw; task < 4096; task += NGW) {
        const int tg = task >> 2, gi = task & 3, t0 = tg * 16, win = 2 << gi;
        float wcol[64];
#pragma unroll
        for (int c = 0; c < 64; ++c) wcol[c] = pw[(size_t)(gi * 64 + c) * 64 + F.lane];
        const float scl = ps[gi * 64 + F.lane];
        for (int r = 0; r < 31; ++r) { const int t = t0 - 15 + r; U[r * 64 + F.lane] = (t >= 0) ? bf2f(P[(size_t)t * DIN + 2560 + gi * 64 + F.lane]) : 0.f; }
        for (int tt = 0; tt < 16; ++tt) { float s = 0.f;
            for (int j = 0; j < win; ++j) s += U[(15 + tt - j) * 64 + F.lane];
            const int t = t0 + tt; const float cntw = (float)((t + 1 < win) ? (t + 1) : win);
            PL[tt * 64 + F.lane] = s / cntw - U[(15 + tt) * 64 + F.lane]; }
        for (int tt = 0; tt < 16; ++tt) { float acc = 0.f;
#pragma unroll
            for (int c = 0; c < 64; c += 4) { const f32x4 p4 = *(const LAS f32x4*)(PL + tt * 64 + c);
                acc += p4.x * wcol[c]; acc += p4.y * wcol[c + 1]; acc += p4.z * wcol[c + 2]; acc += p4.w * wcol[c + 3]; }
            MIX[(size_t)(t0 + tt) * DMODEL + 768 + gi * 64 + F.lane] = (bf16)f2bf(acc * scl); }
    }
}
__device__ __forceinline__ void moe_gather(Frame& F) {
    const int gw = F.vcu * NWAVES + F.wave, NGW = F.G * NWAVES;
    int cn[8], tb[9]; tb[0] = 0;
#pragma unroll
    for (int e = 0; e < 8; ++e) { cn[e] = (int)__hip_atomic_load(F.ctl + CW_CNT + 64 * e, RLX_AGENT); tb[e + 1] = tb[e] + ((cn[e] + 255) >> 8); }
    const int* perm = (const int*)(F.ws + WS_SMALL + SM_PERM); const bf16* H = (const bf16*)(F.ws + WS_HBUF); bf16* HP = (bf16*)(F.ws + WS_HPERM);
    for (int slot = gw; slot < tb[8] * 256; slot += NGW) {
        const int T = slot >> 8; int e = 0, tbe = 0, ce = cn[0];
#pragma unroll
        for (int j = 1; j < 8; ++j) if (T >= tb[j]) { e = j; tbe = tb[j]; ce = cn[j]; }
        const int pos = ((T - tbe) << 8) + (slot & 255);
        const int tokn = (pos < ce) ? perm[e * SEQ + pos] : 0;
        const GAS v4u* src = (const GAS v4u*)(H + (size_t)tokn * DMODEL) + F.lane; GAS v4u* dst = (GAS v4u*)(HP + (size_t)slot * DMODEL) + F.lane;
        const v4u a = src[0], b = src[64]; dst[0] = a; dst[64] = b;
    }
}
__device__ __forceinline__ void attn_finalize(Frame& F, int l, const float* ag) {
    const bf16* O1 = (const bf16*)(F.ws + WS_ATTNO); const bf16* O2 = O1 + (size_t)SEQ * 512; bf16* MIX = (bf16*)(F.ws + WS_MIX);
    const float* lamv = (const float*)(F.ws + WS_SMALL + SM_LAM); const float lam = lamv[l], osc = 1.0f - lamv[2 + l];
    const int gw = F.vcu * NWAVES + F.wave, NGW = F.G * NWAVES;
    float gv[8];
#pragma unroll
    for (int j = 0; j < 8; ++j) gv[j] = ag[(F.lane & 15) * 8 + j] * osc;
    for (int m = gw; m < M; m += NGW) {
        const v4u a = *(const GAS v4u*)(O1 + (size_t)m * 512 + F.lane * 8), b = *(const GAS v4u*)(O2 + (size_t)m * 512 + F.lane * 8);
        float d[8];
        d[0] = __uint_as_float(a.x << 16) - lam * __uint_as_float(b.x << 16); d[1] = __uint_as_float(a.x & 0xffff0000u) - lam * __uint_as_float(b.x & 0xffff0000u);
        d[2] = __uint_as_float(a.y << 16) - lam * __uint_as_float(b.y << 16); d[3] = __uint_as_float(a.y & 0xffff0000u) - lam * __uint_as_float(b.y & 0xffff0000u);
        d[4] = __uint_as_float(a.z << 16) - lam * __uint_as_float(b.z << 16); d[5] = __uint_as_float(a.z & 0xffff0000u) - lam * __uint_as_float(b.z & 0xffff0000u);
        d[6] = __uint_as_float(a.w << 16) - lam * __uint_as_float(b.w << 16); d[7] = __uint_as_float(a.w & 0xffff0000u) - lam * __uint_as_float(b.w & 0xffff0000u);
        float ss = 0.f;
#pragma unroll
        for (int j = 0; j < 8; ++j) ss += d[j] * d[j];
        ss += swzx<1>(ss); ss += swzx<2>(ss); ss += swzx<4>(ss); ss += swzx<8>(ss);
        const float rstd = 1.0f / sqrtf(ss * (1.0f / 128.0f) + LN_EPS);
        v4u o; o.x = pk2(d[0] * rstd * gv[0], d[1] * rstd * gv[1]); o.y = pk2(d[2] * rstd * gv[2], d[3] * rstd * gv[3]);
        o.z = pk2(d[4] * rstd * gv[4], d[5] * rstd * gv[5]); o.w = pk2(d[6] * rstd * gv[6], d[7] * rstd * gv[7]);
        *(GAS v4u*)(MIX + (size_t)m * DMODEL + F.lane * 8) = o;
    }
}

typedef float f32x16v __attribute__((ext_vector_type(16)));
typedef __bf16 bf16x2v __attribute__((ext_vector_type(2)));
typedef float f32x2v_ __attribute__((ext_vector_type(2)));
typedef short s16x4v __attribute__((ext_vector_type(4)));
__device__ __forceinline__ int crow16(int i, int hh) { return (i & 3) + 8 * (i >> 2) + 4 * hh; }
__device__ __forceinline__ unsigned pkbf(float lo, float hi) { f32x2v_ v = {lo, hi}; bf16x2v b = __builtin_convertvector(v, bf16x2v); return __builtin_bit_cast(unsigned, b); }
__device__ __forceinline__ bf16x8 pk8(const float (&x)[8]) { v4u w; w.x = pkbf(x[0], x[1]); w.y = pkbf(x[2], x[3]); w.z = pkbf(x[4], x[5]); w.w = pkbf(x[6], x[7]); return __builtin_bit_cast(bf16x8, w); }
__device__ __forceinline__ void unpk8(const v4u w, float (&x)[8]) {
    x[0] = __uint_as_float(w.x << 16); x[1] = __uint_as_float(w.x & 0xffff0000u); x[2] = __uint_as_float(w.y << 16); x[3] = __uint_as_float(w.y & 0xffff0000u);
    x[4] = __uint_as_float(w.z << 16); x[5] = __uint_as_float(w.z & 0xffff0000u); x[6] = __uint_as_float(w.w << 16); x[7] = __uint_as_float(w.w & 0xffff0000u); }
#define MFMA32(a, b, c) __builtin_amdgcn_mfma_f32_32x32x16_bf16((a), (b), (c), 0, 0, 0)
constexpr int HG_LDS = 26624, VT_PITCH = 72;
constexpr float HG_CLAMP = 80.0f;

__device__ __forceinline__ void hg_build_vt(LAS bf16* VT, const bf16* P, int row0, int h, int lane) {
    for (int t8 = 0; t8 < 8; ++t8) { float x[8];
#pragma unroll
        for (int j = 0; j < 8; ++j) x[j] = silu_ff(bf2f(P[(size_t)(row0 + t8 * 8 + j) * DIN + 2048 + h * 64 + lane]));
        *(LAS bf16x8*)(VT + lane * VT_PITCH + t8 * 8) = pk8(x); }
}
__device__ __forceinline__ void hg_pass1_mfma(Frame& F, int l) {
    const bf16* P = (const bf16*)(F.ws + WS_PROJ); const float* lbs = (const float*)(F.ws + WS_SMALL + SM_LBS) + l * 256;
    float* HGS = (float*)(F.ws + WS_HGS); float* HGD = (float*)(F.ws + WS_HGD);
    if (F.wave >= 4) return;
    LAS bf16* KH = (LAS bf16*)(F.lds + RING_OFF + F.wave * HG_LDS);
    LAS bf16* VT = KH + 64 * VT_PITCH;
    const int lane = F.lane, r = lane & 31, hh = lane >> 5;
    for (int tk = F.bid * 4 + F.wave; tk < 1024; tk += F.G * 4) {
        const int c = tk >> 2, h = tk & 3, row0 = c * 64;
        const float lbv = lbs[h * 64 + lane];
        const bf16* zp = P + (size_t)row0 * DIN + 1792 + h * 64 + lane;
        float b = 0.f;
#pragma unroll 8
        for (int t = 0; t < 64; ++t) { const float f = lbv + (1.0f - lbv) * sigmoid_f(bf2f(zp[(size_t)t * DIN])); b += __logf(fmaxf(f, 1e-30f)); }
        float bt = 0.f;
        for (int t8 = 0; t8 < 8; ++t8) { float x[8];
#pragma unroll
            for (int j = 0; j < 8; ++j) { const float z = bf2f(zp[(size_t)(t8 * 8 + j) * DIN]); const float f = lbv + (1.0f - lbv) * sigmoid_f(z); bt += __logf(fmaxf(f, 1e-30f));
                x[j] = (1.0f - lbv) * sigmoid_f(-z) * __expf(b - bt); }
            *(LAS bf16x8*)(KH + lane * VT_PITCH + t8 * 8) = pk8(x); }
        HGD[c * 256 + h * 64 + lane] = __expf(b);
        hg_build_vt(VT, P, row0, h, lane);
#pragma unroll
        for (int kb = 0; kb < 2; ++kb)
#pragma unroll
            for (int vb = 0; vb < 2; ++vb) { f32x16v acc = {};
#pragma unroll
                for (int ss = 0; ss < 4; ++ss) { const bf16x8 a = *(const LAS bf16x8*)(KH + (32 * kb + r) * VT_PITCH + 16 * ss + 8 * hh); const bf16x8 bq = *(const LAS bf16x8*)(VT + (32 * vb + r) * VT_PITCH + 16 * ss + 8 * hh);
                    acc = MFMA32(a, bq, acc); }
                float* Lp = HGS + ((size_t)(c * 4 + h) * 64 + 32 * kb) * 64 + 32 * vb + r;
#pragma unroll
                for (int i = 0; i < 16; ++i) Lp[crow16(i, hh) * 64] = acc[i]; }
    }
}
__device__ __forceinline__ void hg_pass3_mfma(Frame& F, int l, const float* hgg) {
    const bf16* P = (const bf16*)(F.ws + WS_PROJ); const float* lbs = (const float*)(F.ws + WS_SMALL + SM_LBS) + l * 256;
    const float* HGS = (const float*)(F.ws + WS_HGS); bf16* MIX = (bf16*)(F.ws + WS_MIX);
    if (F.wave >= 4) return;
    LAS float* BL = (LAS float*)(F.lds + RING_OFF + F.wave * HG_LDS);
    LAS bf16* VT = (LAS bf16*)(BL + 4096);
    LAS float* R1 = (LAS float*)(VT + 64 * VT_PITCH);
    const int lane = F.lane, r = lane & 31, hh = lane >> 5;
    for (int tk = F.bid * 4 + F.wave; tk < 1024; tk += F.G * 4) {
        const int c = tk >> 2, h = tk & 3, row0 = c * 64;
        { const float lbv = lbs[h * 64 + lane]; float b = 0.f;
#pragma unroll 8
          for (int t = 0; t < 64; ++t) { const float z = bf2f(P[(size_t)(row0 + t) * DIN + 1792 + h * 64 + lane]); const float f = lbv + (1.0f - lbv) * sigmoid_f(z); b += __logf(fmaxf(f, 1e-30f));
              BL[t * 64 + lane] = b; if (t == 31) R1[lane] = b; } }
        hg_build_vt(VT, P, row0, h, lane);
        bf16x8 Qt[2][4], Qh1[4];
#pragma unroll
        for (int tb = 0; tb < 2; ++tb)
#pragma unroll
            for (int ks = 0; ks < 4; ++ks) { const int t = 32 * tb + r, k0 = 16 * ks + 8 * hh; float q[8], e[8];
                unpk8(*(const GAS v4u*)(P + (size_t)(row0 + t) * DIN + 1536 + h * 64 + k0), q);
                const f32x4 b0 = *(const LAS f32x4*)(BL + t * 64 + k0), b1 = *(const LAS f32x4*)(BL + t * 64 + k0 + 4);
                e[0] = b0.x; e[1] = b0.y; e[2] = b0.z; e[3] = b0.w; e[4] = b1.x; e[5] = b1.y; e[6] = b1.z; e[7] = b1.w;
                if (tb == 1) { const f32x4 r0 = *(const LAS f32x4*)(R1 + k0), r1 = *(const LAS f32x4*)(R1 + k0 + 4); const float rr[8] = {r0.x, r0.y, r0.z, r0.w, r1.x, r1.y, r1.z, r1.w}; float qh[8];
#pragma unroll
                    for (int j = 0; j < 8; ++j) { q[j] *= __expf(e[j] - rr[j]); qh[j] = q[j] * __expf(rr[j]); }
                    Qh1[ks] = pk8(qh);
                } else {
#pragma unroll
                    for (int j = 0; j < 8; ++j) q[j] *= __expf(e[j]);
                }
                Qt[tb][ks] = pk8(q); }
        f32x16v X00 = {}, X01 = {}, X11 = {};
#pragma unroll
        for (int ks = 0; ks < 4; ++ks) { const int k0 = 16 * ks + 8 * hh;
            const f32x4 l0 = *(const GAS f32x4*)(lbs + h * 64 + k0), l1 = *(const GAS f32x4*)(lbs + h * 64 + k0 + 4); const float lb8[8] = {l0.x, l0.y, l0.z, l0.w, l1.x, l1.y, l1.z, l1.w};
            const f32x4 r0 = *(const LAS f32x4*)(R1 + k0), r1 = *(const LAS f32x4*)(R1 + k0 + 4); const float rr[8] = {r0.x, r0.y, r0.z, r0.w, r1.x, r1.y, r1.z, r1.w};
            float key[8], bs[8], x0[8], x1[8];
            unpk8(*(const GAS v4u*)(P + (size_t)(row0 + r) * DIN + 1792 + h * 64 + k0), key);
            { const f32x4 b0 = *(const LAS f32x4*)(BL + r * 64 + k0), b1 = *(const LAS f32x4*)(BL + r * 64 + k0 + 4); bs[0] = b0.x; bs[1] = b0.y; bs[2] = b0.z; bs[3] = b0.w; bs[4] = b1.x; bs[5] = b1.y; bs[6] = b1.z; bs[7] = b1.w; }
#pragma unroll
            for (int j = 0; j < 8; ++j) { const float ky = (1.0f - lb8[j]) * sigmoid_f(-key[j]); x0[j] = ky * __expf(fminf(-bs[j], HG_CLAMP)); x1[j] = ky * __expf(rr[j] - bs[j]); }
            X00 = MFMA32(pk8(x0), Qt[0][ks], X00);
            X01 = MFMA32(pk8(x1), Qt[1][ks], X01);
            unpk8(*(const GAS v4u*)(P + (size_t)(row0 + 32 + r) * DIN + 1792 + h * 64 + k0), key);
            { const f32x4 b0 = *(const LAS f32x4*)(BL + (32 + r) * 64 + k0), b1 = *(const LAS f32x4*)(BL + (32 + r) * 64 + k0 + 4); bs[0] = b0.x; bs[1] = b0.y; bs[2] = b0.z; bs[3] = b0.w; bs[4] = b1.x; bs[5] = b1.y; bs[6] = b1.z; bs[7] = b1.w; }
#pragma unroll
            for (int j = 0; j < 8; ++j) { const float ky = (1.0f - lb8[j]) * sigmoid_f(-key[j]); x1[j] = ky * __expf(fminf(rr[j] - bs[j], HG_CLAMP)); }
            X11 = MFMA32(pk8(x1), Qt[1][ks], X11);
        }
#pragma unroll
        for (int i = 0; i < 16; ++i) { const bool keep = crow16(i, hh) <= r; X00[i] = keep ? X00[i] : 0.f; X11[i] = keep ? X11[i] : 0.f; }
        f32x16v O[2][2] = {};
#pragma unroll
        for (int sp = 0; sp < 2; ++sp) {
            float p[8]; bf16x8 P00, P01, P11;
#pragma unroll
            for (int j = 0; j < 8; ++j) p[j] = X00[8 * sp + j]; P00 = pk8(p);
#pragma unroll
            for (int j = 0; j < 8; ++j) p[j] = X01[8 * sp + j]; P01 = pk8(p);
#pragma unroll
            for (int j = 0; j < 8; ++j) p[j] = X11[8 * sp + j]; P11 = pk8(p);
#pragma unroll
            for (int vb = 0; vb < 2; ++vb) {
                const LAS bf16* vrow = VT + (32 * vb + r) * VT_PITCH + 16 * sp + 4 * hh;
                const s16x4v a0 = *(const LAS s16x4v*)(vrow), a1 = *(const LAS s16x4v*)(vrow + 8);
                const s16x4v c0 = *(const LAS s16x4v*)(vrow + 32), c1 = *(const LAS s16x4v*)(vrow + 40);
                const bf16x8 V0 = (bf16x8){a0[0], a0[1], a0[2], a0[3], a1[0], a1[1], a1[2], a1[3]}, V1 = (bf16x8){c0[0], c0[1], c0[2], c0[3], c1[0], c1[1], c1[2], c1[3]};
                O[0][vb] = MFMA32(P00, V0, O[0][vb]);
                O[1][vb] = MFMA32(P01, V0, O[1][vb]);
                O[1][vb] = MFMA32(P11, V1, O[1][vb]);
            }
        }
#pragma unroll
        for (int ks = 0; ks < 4; ++ks)
#pragma unroll
            for (int vb = 0; vb < 2; ++vb) { float sv[8]; const float* Sp = HGS + ((size_t)(c * 4 + h) * 64 + 16 * ks + 8 * hh) * 64 + 32 * vb + r;
#pragma unroll
                for (int j = 0; j < 8; ++j) sv[j] = Sp[j * 64];
                const bf16x8 sf = pk8(sv);
                O[0][vb] = MFMA32(Qt[0][ks], sf, O[0][vb]);
                O[1][vb] = MFMA32(Qh1[ks], sf, O[1][vb]); }
        const float gn0 = hgg[r], gn1 = hgg[32 + r];
#pragma unroll
        for (int tb = 0; tb < 2; ++tb)
#pragma unroll
            for (int i = 0; i < 16; ++i) { const int t = 32 * tb + crow16(i, hh); const float o0 = O[tb][0][i], o1 = O[tb][1][i];
                float ss = o0 * o0 + o1 * o1; ss += swzx<1>(ss); ss += swzx<2>(ss); ss += swzx<4>(ss); ss += swzx<8>(ss); ss += swzx<16>(ss);
                const float rstd = 1.0f / sqrtf(ss * (1.0f / 64.0f) + LN_EPS);
                const bf16* gp = P + (size_t)(row0 + t) * DIN + 2304 + h * 64 + r; bf16* op = MIX + (size_t)(row0 + t) * DMODEL + 512 + h * 64 + r;
                op[0] = (bf16)f2bf(o0 * rstd * gn0 * silu_ff(bf2f(gp[0]))); op[32] = (bf16)f2bf(o1 * rstd * gn1 * silu_ff(bf2f(gp[32]))); }
    }
}
__device__ __forceinline__ void pool_mfma(Frame& F, const float* pw, const float* ps) {
    const bf16* P = (const bf16*)(F.ws + WS_PROJ); bf16* MIX = (bf16*)(F.ws + WS_MIX);
    LAS float* ZL = (LAS float*)(F.lds + RING_OFF + F.wave * 12288);
    const int lane = F.lane, r = lane & 31, hh = lane >> 5, gi = F.wave >> 1, db = F.wave & 1, win = 2 << gi;
    bf16x8 wf[4];
#pragma unroll
    for (int ks = 0; ks < 4; ++ks) { float x[8];
#pragma unroll
        for (int j = 0; j < 8; ++j) x[j] = pw[(size_t)(gi * 64 + 16 * ks + 8 * hh + j) * 64 + 32 * db + r];
        wf[ks] = pk8(x); }
    const float scl = ps[gi * 64 + 32 * db + r];
    for (int tile = F.bid; tile < SEQ / 64; tile += F.G) {
        const int t0 = tile * 64 - 32;
#pragma unroll
        for (int rt = 0; rt < 3; ++rt) { f32x16v acc = {}; const int t = t0 + 32 * rt + r;
#pragma unroll
            for (int ks = 0; ks < 4; ++ks) { v4u a = {0u, 0u, 0u, 0u}; if (t >= 0) a = *(const GAS v4u*)(P + (size_t)t * DIN + 2560 + gi * 64 + 16 * ks + 8 * hh);
                acc = MFMA32(__builtin_bit_cast(bf16x8, a), wf[ks], acc); }
#pragma unroll
            for (int i = 0; i < 16; ++i) ZL[(32 * rt + crow16(i, hh)) * 32 + r] = acc[i]; }
        const int tl0 = 32 + 32 * hh; float s = 0.f;
        for (int j = 1; j < win; ++j) s += ZL[(tl0 - j) * 32 + r];
        for (int tt = 0; tt < 32; ++tt) { const int tl = tl0 + tt; const float zc = ZL[tl * 32 + r]; s += zc;
            const int tg = t0 + tl; const float cntw = (float)((tg + 1 < win) ? (tg + 1) : win);
            MIX[(size_t)tg * DMODEL + 768 + gi * 64 + 32 * db + r] = (bf16)f2bf((s / cntw - zc) * scl);
            s -= ZL[(tl - win + 1) * 32 + r]; }
    }
}
#ifndef DIS
#define DIS 0
#endif
#ifndef DUP
#define DUP 0
#endif
#ifndef ATTN_B
#define ATTN_B 1
#endif
#ifndef HG_MFMA
#define HG_MFMA 1
#endif
#ifndef POOL_MFMA
#define POOL_MFMA 1
#endif
#if HG_MFMA
#define HG1 hg_pass1_mfma
#define HG3 hg_pass3_mfma
#else
#define HG1 hg_pass1
#define HG3 hg_pass3
#endif
#if POOL_MFMA
#define POOLF pool_mfma
#else
#define POOLF pool_phase
#endif
#define RELOAD_ARGS() do { asm volatile("" : "+s"(argp), "+s"(F.ws), "+s"(F.ctl), "+s"(bar.bar), "+s"(bar.x), "+s"(F.G), "+s"(F.vcu), "+s"(F.bid)); { unsigned z_ = 0u; asm volatile("" : "+s"(z_)); F.lane = (int)__builtin_amdgcn_mbcnt_hi(~0u, __builtin_amdgcn_mbcnt_lo(~0u, z_)); } asm volatile("" : "+v"(F.lane)); F.tid = F.wave * 64 + F.lane; } while (0)
#define args (*argp)
__global__ void __launch_bounds__(NWAVES * 64, 2) mk_fwd(Args args_) {
    const Args* argp = (const Args*)__builtin_amdgcn_kernarg_segment_ptr();
    extern __shared__ __attribute__((aligned(16))) unsigned char lds[];
    Frame F;
    F.lds = (LAS unsigned char*)lds;
    F.MISC = (volatile LAS unsigned*)(F.lds + MISC_OFF);
    F.tid = threadIdx.x; F.lane = F.tid & 63; F.wave = __builtin_amdgcn_readfirstlane(F.tid >> 6);
    F.G = gridDim.x; F.bid = blockIdx.x; { const int bx = blockIdx.x; F.vcu = (F.G % 8 == 0) ? (bx % 8) * (F.G / 8) + bx / 8 : bx; }
    F.ws = args.ws; F.ctl = (gu32*)(args.ws + WS_CTL);
    for (int u = F.tid; u < (LDS_BYTES - LDSCTL_OFF) / 4; u += NWAVES * 64) ((LAS unsigned*)(F.lds + LDSCTL_OFF))[u] = 0u;
    __syncthreads();
    XcdBarrier bar; bar.bar = (unsigned*)(F.ctl + CW_BAR); bar.x = 0; bar.st = nullptr;
    if (N_LAUNCHES == 1) bar = xcd_barrier_post((unsigned*)(F.ctl + CW_BAR), F.MISC + 8, F.tid);
    const int lo = (N_LAUNCHES == 1) ? 0 : args.ph_lo, hi = (N_LAUNCHES == 1) ? NPH : args.ph_hi;
#define IN(k) (lo <= (k) && (k) < hi)
#define SEAM(k) do { if (IN(k) && IN((k) + 1)) xcd_barrier(bar, F.tid); RELOAD_ARGS(); } while (0)
#define MOD ((const float*)(F.ws + WS_SMALL + SM_MOD))
#define HB ((bf16*)(F.ws + WS_HBUF))

    if (IN(0)) {
#if !(DIS&1)
        p0a_prologue(F, args);
#if (DUP&1)
            __syncthreads();
            p0a_prologue(F, args);
#endif

#endif
    } SEAM(0);
    if (IN(1)) { p_modulate(F, args.in[I_X], MOD, HB); } SEAM(1);

    for (int l = 0; l < DEPTH; ++l) {
        const int pb = 2 + NPH_LAYER * l;
#define mod (MOD + l * 6144)
#define xin ((l == 0) ? args.in[I_X] : (const float*)args.out)
        if (IN(pb + 0)) {
            pg8::Gemm g{HB, (const bf16*)(F.ws + WS_WIN) + (size_t)l * DIN * 1024, 1024}; pg8::StaticOrder S; S.init(M, DIN, F.G, F.bid);
            pg8::EpiProj E{(bf16*)(F.ws + WS_PROJ), DIN, (const float*)(F.ws + WS_ROPE), (const float*)(F.ws + WS_ROPE) + (size_t)SEQ * 32, attn_body::C2};
#if !(DIS&2)
            pg8::gemm_phase<pg8::EpiProj, pg8::StaticOrder, true>(F.lds + RING_OFF, g, S, E, F.tid);
#if (DUP&2)
            __syncthreads();
            pg8::gemm_phase<pg8::EpiProj, pg8::StaticOrder, true>(F.lds + RING_OFF, g, S, E, F.tid);
#endif

#endif
        } SEAM(pb + 0);
        if (IN(pb + 1)) {
#if !(DIS&4)
            HG1(F, l);
#if (DUP&4)
            __syncthreads();
            HG1(F, l);
#endif

#endif
            __syncthreads(); RELOAD_ARGS();
#if !(DIS&8)
            POOLF(F, args.in[I_POOLW] + (size_t)l * 4 * 64 * 64, args.in[I_POOLS] + l * 256);
#if (DUP&8)
            __syncthreads();
            POOLF(F, args.in[I_POOLW] + (size_t)l * 4 * 64 * 64, args.in[I_POOLS] + l * 256);
#endif

#endif
        } SEAM(pb + 1);
        if (IN(pb + 2)) {
#if !(DIS&16)
            hg_pass2(F);
#endif
        } SEAM(pb + 2);
        if (IN(pb + 3)) {
            const attn_body::bf16* PJ = (const attn_body::bf16*)(F.ws + WS_PROJ); attn_body::bf16* AO = (attn_body::bf16*)(F.ws + WS_ATTNO);
#if ATTN_B
            for (int rep_ = 0; rep_ < ((DUP&32) ? 2 : 1); ++rep_)
            for (int i = 0; i < 2; ++i) { const int j = i * F.G + F.vcu; if (j >= 512) break;
                const int v = j & 255, ii = j >> 8, mpi = v >> 5, s = v & 31; const int qb = (ii == 0) ? s : 63 - s;
                const int h = mpi >> 1, mp = mpi & 1;
#if !(DIS&32)
                attn_body::attn_unit2<8>(F.tid, qb, PJ + mpi * 64, PJ + 512 + mpi * 64, PJ + 1024 + h * 128, AO + (size_t)mp * SEQ * 512 + h * 128, (char*)lds + RING_OFF);
#endif
            }
#else
            for (int rep_ = 0; rep_ < ((DUP&32) ? 2 : 1); ++rep_)
            for (int i = 0; i < 4; ++i) { const int j = i * F.G + F.vcu; if (j >= 1024) break;
                const int v = j & 255, ii = j >> 8, vh = v >> 4, s = v & 15; const int qb = (ii == 0) ? s : (ii == 1) ? 31 - s : (ii == 2) ? 32 + s : 63 - s;
                const int h = vh >> 2, mp = (vh >> 1) & 1, vf = vh & 1;
#if !(DIS&32)
                attn_body::attn_unit<8>(F.tid, qb, PJ + (h * 2 + mp) * 64, PJ + 512 + (h * 2 + mp) * 64, PJ + 1024 + h * 128 + vf * 64, AO + (size_t)mp * SEQ * 512 + h * 128 + vf * 64, (char*)lds + RING_OFF);
#endif
            }
#endif
            __syncthreads(); RELOAD_ARGS();
#if !(DIS&64)
            HG3(F, l, args.in[I_HGG] + l * 64);
#if (DUP&64)
            __syncthreads();
            HG3(F, l, args.in[I_HGG] + l * 64);
#endif

#endif
        } SEAM(pb + 3);
        if (IN(pb + 4)) {
#if !(DIS&128)
            attn_finalize(F, l, args.in[I_ATTNG] + l * 128);
#if (DUP&128)
            __syncthreads();
            attn_finalize(F, l, args.in[I_ATTNG] + l * 128);
#endif

#endif
        } SEAM(pb + 4);
        if (IN(pb + 5)) {
            pg8::Gemm g{(const bf16*)(F.ws + WS_MIX), (const bf16*)(F.ws + WS_WOUT) + (size_t)l * 1024 * 1024, 1024}; pg8::StaticOrder S; S.init(M, DMODEL, F.G, F.bid);
            pg8::EpiResid E{xin, args.out, DMODEL, mod + 2048, ALPHA};
#if !(DIS&256)
            pg8::gemm_phase<pg8::EpiResid, pg8::StaticOrder, false>(F.lds + RING_OFF, g, S, E, F.tid);
#endif
        } SEAM(pb + 5);
        if (IN(pb + 6)) {
#if !(DIS&512)
            if (l & 1) p_ln<true>(F, args.out, args.in[I_LN1G] + l * 1024, args.in[I_LN1B] + l * 1024, mod + 3072, HB, args.in[I_RW] + (size_t)(l >> 1) * 1024 * 8);
#endif
#if !(DIS&1024)
            if (!(l & 1)) p_ln<false>(F, args.out, args.in[I_LN1G] + l * 1024, args.in[I_LN1B] + l * 1024, mod + 3072, HB, nullptr);
#endif
        } SEAM(pb + 6);
        if (!(l & 1)) {
            if (IN(pb + 8)) {
                pg8::Gemm g{HB, (const bf16*)(F.ws + WS_FFN13), 1024}; pg8::StaticOrder S; S.init(M, 2 * FFD, F.G, F.bid);
                pg8::EpiSwiglu E{(bf16*)(F.ws + WS_DHID), FFD};
#if !(DIS&2048)
                pg8::gemm_phase<pg8::EpiSwiglu, pg8::StaticOrder, true>(F.lds + RING_OFF, g, S, E, F.tid);
#if (DUP&2048)
            __syncthreads();
            pg8::gemm_phase<pg8::EpiSwiglu, pg8::StaticOrder, true>(F.lds + RING_OFF, g, S, E, F.tid);
#endif

#endif
            } SEAM(pb + 8);
            if (IN(pb + 9)) {
                pg8::Gemm g{(const bf16*)(F.ws + WS_DHID), (const bf16*)(F.ws + WS_FFN2), FFD}; pg8::StaticOrder S; S.init(M, DMODEL, F.G, F.bid);
                pg8::EpiResid E{args.out, args.out, DMODEL, mod + 5120, ALPHA};
#if !(DIS&4096)
                pg8::gemm_phase<pg8::EpiResid, pg8::StaticOrder, false>(F.lds + RING_OFF, g, S, E, F.tid);
#endif
            } SEAM(pb + 9);
            if (IN(pb + 10)) {
                p_ln<false>(F, args.out, args.in[I_LN2G] + l * 1024, args.in[I_LN2B] + l * 1024, (l + 1 < DEPTH) ? MOD + (l + 1) * 6144 : nullptr, HB, nullptr);
            } SEAM(pb + 10);
        } else {
            const unsigned* cnt = (const unsigned*)(F.ctl + CW_CNT);
            if (IN(pb + 7)) {
#if !(DIS&65536)
                moe_gather(F);
#if (DUP&65536)
            __syncthreads();
            moe_gather(F);
#endif

#endif
            } SEAM(pb + 7);
            if (IN(pb + 8)) {
                pg8::Gemm g{(const bf16*)(F.ws + WS_HPERM), (const bf16*)(F.ws + WS_EXP13), 1024}; pg8::MoeOrder S; S.init(cnt, 2 * EDIM / 256, F.G, F.bid);
                pg8::EpiSwiglu E{(bf16*)(F.ws + WS_HID), EDIM};
#if !(DIS&8192)
                pg8::gemm_phase<pg8::EpiSwiglu, pg8::MoeOrder, true>(F.lds + RING_OFF, g, S, E, F.tid);
#if (DUP&8192)
            __syncthreads();
            pg8::gemm_phase<pg8::EpiSwiglu, pg8::MoeOrder, true>(F.lds + RING_OFF, g, S, E, F.tid);
#endif

#endif
            } SEAM(pb + 8);
            if (IN(pb + 9)) {
                pg8::Gemm g{(const bf16*)(F.ws + WS_HID), (const bf16*)(F.ws + WS_EXP2), EDIM}; pg8::MoeOrder S; S.init(cnt, DMODEL / 256, F.G, F.bid);
                pg8::EpiBf16 E{(bf16*)(F.ws + WS_YSLOT), DMODEL};
#if !(DIS&16384)
                pg8::gemm_phase<pg8::EpiBf16, pg8::MoeOrder, true>(F.lds + RING_OFF, g, S, E, F.tid);
#if (DUP&16384)
            __syncthreads();
            pg8::gemm_phase<pg8::EpiBf16, pg8::MoeOrder, true>(F.lds + RING_OFF, g, S, E, F.tid);
#endif

#endif
            } SEAM(pb + 9);
            if (IN(pb + 10)) {
#if !(DIS&32768)
                p_ln_moe(F, args.out, args.in[I_LN2G] + l * 1024, args.in[I_LN2B] + l * 1024, mod + 5120);
#endif
            } SEAM(pb + 10);
        }
    }
#undef IN
#undef SEAM
#undef args
#undef MOD
#undef HB
#undef mod
#undef xin
}

extern "C" void kernel_launch(void* const* d_in, const int* in_sizes, int n_in, void* d_out, int out_size, void* d_ws, size_t ws_size, hipStream_t stream) {
    static int grid = 0;
    if (grid == 0) {
        if (n_in != 23 || in_sizes[0] != M * DMODEL || out_size != M * DMODEL || ws_size < WS_END) { fprintf(stderr, "kernel_launch: unexpected shapes (n_in %d, out %d, ws %zu); nothing launched\n", n_in, out_size, ws_size); grid = -1; return; }
        int dev = 0, cus = 0, per_cu = 0;
        if (hipGetDevice(&dev) != hipSuccess || hipDeviceGetAttribute(&cus, hipDeviceAttributeMultiprocessorCount, dev) != hipSuccess) { grid = -1; return; }
        if (hipFuncSetAttribute((const void*)mk_fwd, hipFuncAttributeMaxDynamicSharedMemorySize, LDS_BYTES) != hipSuccess) { fprintf(stderr, "kernel_launch: hipFuncSetAttribute failed\n"); grid = -1; return; }
        if (hipOccupancyMaxActiveBlocksPerMultiprocessor(&per_cu, (const void*)mk_fwd, NWAVES * 64, LDS_BYTES) != hipSuccess || per_cu < 1) { fprintf(stderr, "kernel_launch: occupancy query says %d\n", per_cu); }
        (void)hipGetLastError();
        grid = cus;
    }
    if (grid < 0) return;
    if (hipMemsetAsync((char*)d_ws + WS_CTL, 0, CTL_ZERO_BYTES, stream) != hipSuccess) return;
    Args a{};
    for (int i = 0; i < 23; ++i) a.in[i] = (const float*)d_in[i];
    a.out = (float*)d_out; a.ws = (unsigned char*)d_ws;
    for (int li = 0; li < N_LAUNCHES; ++li) {
        a.ph_lo = (N_LAUNCHES == 1) ? 0 : li; a.ph_hi = (N_LAUNCHES == 1) ? NPH : li + 1; a.li = li; a.pad = 0;
        hipLaunchKernelGGL(mk_fwd, dim3(grid), dim3(NWAVES * 64), LDS_BYTES, stream, a);
    }
}
```

```cpp
#define MK_N_LAUNCHES 1
#include <hip/hip_runtime.h>
#include <hip/hip_bf16.h>
#include <cstdio>
#include <cstdint>
#include <cmath>
namespace pg8 {
#define PG8_LAS __attribute__((address_space(3)))
typedef unsigned short bf16_t;
typedef short bf16x8 __attribute__((ext_vector_type(8)));
typedef float f32x4 __attribute__((ext_vector_type(4)));
typedef unsigned u32x4 __attribute__((ext_vector_type(4)));
constexpr int BM = 256, BK = 64, HALF = 128, HTB = HALF * BK * 2  , STAGE_BYTES = 8 * HTB, NXCD = 8, WGM = 8;

__host__ __device__ __forceinline__ int lds_byte(int r, int c) { const int st = (r >> 4) * 2 + (c >> 5), rr = r & 15, cc = c & 31, ob = rr * 64 + cc * 2; return st * 1024 + (ob ^ (((ob >> 9) & 1) << 5)); }
__host__ __device__ __forceinline__ void stage_rc(int b, int& R, int& C) { const int st = b / 1024, sb = b % 1024, swz = sb ^ (((sb >> 9) & 1) << 5); R = (st >> 1) * 16 + swz / 64; C = (st & 1) * 32 + (swz % 64) / 2; }
__host__ __device__ __forceinline__ int perm32(int rho) { const int n = rho >> 4, i = rho & 15; return 8 * (i >> 2) + 4 * n + (i & 3); }

struct Unit { int pm, pn, pb; };
struct Gemm { const bf16_t* A; const bf16_t* Bt; int K; };

struct StaticOrder {
    int nM, nN, nwg, G, c;
    __host__ __device__ void init(int M, int N, int G_, int c_) { nM = M / BM; nN = N / BM; nwg = nM * nN; G = G_; c = c_; }
    __host__ __device__ bool next(int i, Unit& u) const {
        const long L = (long)i * G + c; if (L >= nwg) return false;
        int wgid = (int)L; { const int q = nwg / NXCD, r = nwg % NXCD, xcd = wgid % NXCD, off = wgid / NXCD; wgid = (xcd < r ? xcd * (q + 1) : r * (q + 1) + (xcd - r) * q) + off; }
        const int nig = WGM * nN, gid = wgid / nig, fm = gid * WGM, gsz = (nM - fm) < WGM ? (nM - fm) : WGM;
        u.pm = fm + ((wgid % nig) % gsz); u.pn = (wgid % nig) / gsz; u.pb = u.pn; return true;
    }
};

struct MoeOrder {
    int tb1, tb2, tb3, tb4, tb5, tb6, tb7, tb8;
    int nN, G, c;
    __device__ __forceinline__ void init(const unsigned* cnt, int nN_, int G_, int c_) {
        tb1 = ((int)cnt[0] + 255) >> 8; tb2 = tb1 + (((int)cnt[64] + 255) >> 8); tb3 = tb2 + (((int)cnt[128] + 255) >> 8); tb4 = tb3 + (((int)cnt[192] + 255) >> 8);
        tb5 = tb4 + (((int)cnt[256] + 255) >> 8); tb6 = tb5 + (((int)cnt[320] + 255) >> 8); tb7 = tb6 + (((int)cnt[384] + 255) >> 8); tb8 = tb7 + (((int)cnt[448] + 255) >> 8);
        nN = nN_; G = G_; c = c_;
    }
    __device__ __forceinline__ bool next(int i, Unit& u) const {
        const int L = i * G + c; const int T = L / nN; if (T >= tb8) return false;
        const int pn = L - T * nN;
        const int e = (T >= tb1) + (T >= tb2) + (T >= tb3) + (T >= tb4) + (T >= tb5) + (T >= tb6) + (T >= tb7);
        u.pm = T; u.pn = pn; u.pb = e * nN + pn; return true;
    }
};

__device__ __forceinline__ unsigned cvt_pk_bf16(float lo, float hi) { unsigned r; asm volatile("v_cvt_pk_bf16_f32 %0, %1, %2" : "=v"(r) : "v"(lo), "v"(hi)); return r; }

struct EpiBf16 {
    static constexpr bool PERM = true;
    bf16_t* O; int ldc;
    __device__ __forceinline__ void operator()(const f32x4 (&acc)[2][2][4][2], const Unit& u, int wr, int wc, int fr, int fq) const {
        const int row0 = u.pm * BM + wr * 64 + fr; const int col0 = u.pn * BM + wc * 32 + 8 * fq;
#pragma unroll
        for (int ai = 0; ai < 2; ++ai)
#pragma unroll
            for (int m = 0; m < 4; ++m) { bf16_t* rowp = O + (size_t)(row0 + ai * HALF + m * 16) * ldc + col0;
#pragma unroll
                for (int bj = 0; bj < 2; ++bj) { const f32x4 v0 = acc[ai][bj][m][0], v1 = acc[ai][bj][m][1];
                    u32x4 w; w.x = cvt_pk_bf16(v0[0], v0[1]); w.y = cvt_pk_bf16(v0[2], v0[3]); w.z = cvt_pk_bf16(v1[0], v1[1]); w.w = cvt_pk_bf16(v1[2], v1[3]);
                    *(u32x4*)(rowp + bj * HALF) = w; } }
    }
};

struct EpiProj {
    static constexpr bool PERM = true;
    bf16_t* O; int ldc; const float* cosT; const float* sinT; float qscale;
    __device__ __forceinline__ void operator()(const f32x4 (&acc)[2][2][4][2], const Unit& u, int wr, int wc, int fr, int fq) const {
        const int row0 = u.pm * BM + wr * 64 + fr; const int col0 = u.pn * BM + wc * 32 + 8 * fq;
        if (u.pn < 4) {
            const int i0 = 16 * (wc & 1) + 4 * fq; const float sc = (u.pn < 2) ? qscale : 1.0f;
#pragma unroll
            for (int ai = 0; ai < 2; ++ai)
#pragma unroll
                for (int m = 0; m < 4; ++m) { const int row = row0 + ai * HALF + m * 16; bf16_t* rowp = O + (size_t)row * ldc + col0;
                    f32x4 c4 = *(const f32x4*)(cosT + (size_t)row * 32 + i0), s4 = *(const f32x4*)(sinT + (size_t)row * 32 + i0);
                    c4 = c4 * sc; s4 = s4 * sc;
#pragma unroll
                    for (int bj = 0; bj < 2; ++bj) { const f32x4 v0 = acc[ai][bj][m][0], v1 = acc[ai][bj][m][1];
                        const float o0 = v0[0] * c4[0] - v0[1] * s4[0], o1 = v0[1] * c4[0] + v0[0] * s4[0];
                        const float o2 = v0[2] * c4[1] - v0[3] * s4[1], o3 = v0[3] * c4[1] + v0[2] * s4[1];
                        const float o4 = v1[0] * c4[2] - v1[1] * s4[2], o5 = v1[1] * c4[2] + v1[0] * s4[2];
                        const float o6 = v1[2] * c4[3] - v1[3] * s4[3], o7 = v1[3] * c4[3] + v1[2] * s4[3];
                        u32x4 w; w.x = cvt_pk_bf16(o0, o1); w.y = cvt_pk_bf16(o2, o3); w.z = cvt_pk_bf16(o4, o5); w.w = cvt_pk_bf16(o6, o7);
                        *(u32x4*)(rowp + bj * HALF) = w; } }
        } else {
#pragma unroll
            for (int ai = 0; ai < 2; ++ai)
#pragma unroll
                for (int m = 0; m < 4; ++m) { bf16_t* rowp = O + (size_t)(row0 + ai * HALF + m * 16) * ldc + col0;
#pragma unroll
                    for (int bj = 0; bj < 2; ++bj) { const f32x4 v0 = acc[ai][bj][m][0], v1 = acc[ai][bj][m][1];
                        u32x4 w; w.x = cvt_pk_bf16(v0[0], v0[1]); w.y = cvt_pk_bf16(v0[2], v0[3]); w.z = cvt_pk_bf16(v1[0], v1[1]); w.w = cvt_pk_bf16(v1[2], v1[3]);
                        *(u32x4*)(rowp + bj * HALF) = w; } }
        }
    }
};

__device__ __forceinline__ float silu_f(float a) { return a * __builtin_amdgcn_rcpf(1.0f + __builtin_amdgcn_exp2f(-1.4426950408889634f * a)); }
struct EpiSwiglu {
    static constexpr bool PERM = true;
    bf16_t* O; int ldc;
    __device__ __forceinline__ void operator()(const f32x4 (&acc)[2][2][4][2], const Unit& u, int wr, int wc, int fr, int fq) const {
        const int row0 = u.pm * BM + wr * 64 + fr; const int col0 = u.pn * HALF + wc * 32 + 8 * fq;
#pragma unroll
        for (int ai = 0; ai < 2; ++ai)
#pragma unroll
            for (int m = 0; m < 4; ++m) { bf16_t* rowp = O + (size_t)(row0 + ai * HALF + m * 16) * ldc + col0;
                const f32x4 a0 = acc[ai][0][m][0], a1 = acc[ai][0][m][1], b0 = acc[ai][1][m][0], b1 = acc[ai][1][m][1];
                u32x4 w;
                w.x = cvt_pk_bf16(silu_f(a0[0]) * b0[0], silu_f(a0[1]) * b0[1]); w.y = cvt_pk_bf16(silu_f(a0[2]) * b0[2], silu_f(a0[3]) * b0[3]);
                w.z = cvt_pk_bf16(silu_f(a1[0]) * b1[0], silu_f(a1[1]) * b1[1]); w.w = cvt_pk_bf16(silu_f(a1[2]) * b1[2], silu_f(a1[3]) * b1[3]);
                *(u32x4*)rowp = w; }
    }
};

struct EpiResid {
    static constexpr bool PERM = false;
    const float* xin; float* out; int ldc; const float* gate; float alpha;
    __device__ __forceinline__ void operator()(const f32x4 (&acc)[2][2][4][2], const Unit& u, int wr, int wc, int fr, int fq) const {
        const int col0 = u.pn * BM + wc * 32 + 4 * fq;
        f32x4 gv[2][2];
#pragma unroll
        for (int bj = 0; bj < 2; ++bj)
#pragma unroll
            for (int n = 0; n < 2; ++n) gv[bj][n] = *(const f32x4*)(gate + col0 + bj * HALF + n * 16) + 1.0f;
#pragma unroll
        for (int ai = 0; ai < 2; ++ai)
#pragma unroll
            for (int m = 0; m < 4; ++m) { const size_t off = (size_t)(u.pm * BM + ai * HALF + wr * 64 + m * 16 + fr) * ldc + col0;
#pragma unroll
                for (int bj = 0; bj < 2; ++bj)
#pragma unroll
                    for (int n = 0; n < 2; ++n) { const f32x4 x = *(const f32x4*)(xin + off + bj * HALF + n * 16);
                        *(f32x4*)(out + off + bj * HALF + n * 16) = x * alpha + gv[bj][n] * acc[ai][bj][m][n]; }
                if (m & 1) asm volatile("" ::: "memory"); }
    }
};

template <class Epi, class Sched, bool ALIGN_EPI>
__device__ __forceinline__ void gemm_phase(PG8_LAS unsigned char* lds, const Gemm g, const Sched& S, const Epi& E, const int tid) {
    const int wid = __builtin_amdgcn_readfirstlane(tid >> 6), lane = tid & 63, wr = wid >> 2, wc = wid & 3, fr = lane & 15, fq = lane >> 4;
    const int K = g.K, nt = K / BK;
    unsigned voffA[2], voffB[2];
#pragma unroll
    for (int i = 0; i < 2; ++i) { int R, C; stage_rc(tid * 16 + i * 8192, R, C); const int Rb = Epi::PERM ? ((R & ~31) + perm32(R & 31)) : R;
        voffA[i] = (unsigned)(R * K + C) * 2u; voffB[i] = (unsigned)(Rb * K + C) * 2u; }
    const size_t kstep = (size_t)(BK * 2);
    const size_t hstep = (size_t)HALF * K * 2;
    const size_t tstep = 2 * hstep;
    const unsigned ldsw = (unsigned)wid * 1024u;
    const int aoff = lds_byte(wr * 64 + fr, fq * 8), boff = lds_byte(wc * 32 + fr, fq * 8);
#define PG8_SA(b, h) (((b) * 2 + (h)) * HTB)
#define PG8_SB(b, h) ((4 + (b) * 2 + (h)) * HTB)
#define PG8_STAGE(bufoff, gbase, voff) do { _Pragma("unroll") for (int _i = 0; _i < 2; ++_i) \
        __builtin_amdgcn_global_load_lds((const unsigned*)((const char*)(gbase) + (voff)[_i]), (PG8_LAS unsigned*)(lds + (bufoff) + ldsw + _i * 8192), 16, 0, 0); } while (0)
#define PG8_LDA(dst, b, h) do { _Pragma("unroll") for (int m = 0; m < 4; ++m) _Pragma("unroll") for (int k = 0; k < 2; ++k) dst[m][k] = *(const PG8_LAS bf16x8*)(lds + PG8_SA(b, h) + aoff + m * 2048 + k * 1024); } while (0)
#define PG8_LDB(dst, b, h) do { _Pragma("unroll") for (int n = 0; n < 2; ++n) _Pragma("unroll") for (int k = 0; k < 2; ++k) dst[n][k] = *(const PG8_LAS bf16x8*)(lds + PG8_SB(b, h) + boff + n * 2048 + k * 1024); } while (0)
#define PG8_MMA(ai, bj, At, Bt) do { __builtin_amdgcn_s_setprio(1); _Pragma("unroll") for (int m = 0; m < 4; ++m) _Pragma("unroll") for (int n = 0; n < 2; ++n) _Pragma("unroll") for (int k = 0; k < 2; ++k) \
        acc[ai][bj][m][n] = __builtin_amdgcn_mfma_f32_16x16x32_bf16(Bt[n][k], At[m][k], acc[ai][bj][m][n], 0, 0, 0); __builtin_amdgcn_s_setprio(0); } while (0)
#define PG8_WAIT_V(n) asm volatile("s_waitcnt vmcnt(" #n ")" ::: "memory")
#define PG8_WAIT_L(n) asm volatile("s_waitcnt lgkmcnt(" #n ")" ::: "memory")
#define PG8_BAR __builtin_amdgcn_s_barrier()
#define PG8_SCHED __builtin_amdgcn_sched_barrier(0)
    Unit cur, nxt; int ui = 0;
    if (!S.next(0, cur)) return;
    f32x4 acc[2][2][4][2];
#pragma unroll
    for (int a = 0; a < 2; ++a)
#pragma unroll
        for (int b = 0; b < 2; ++b)
#pragma unroll
            for (int m = 0; m < 4; ++m)
#pragma unroll
                for (int n = 0; n < 2; ++n) acc[a][b][m][n] = (f32x4){0.f, 0.f, 0.f, 0.f};
    bf16x8 At[4][2], B0[2][2], B1[2][2];
    const char* cA = (const char*)g.A + (size_t)cur.pm * tstep; const char* cB = (const char*)g.Bt + (size_t)cur.pb * tstep;
    PG8_STAGE(PG8_SB(0, 0), cB, voffB); PG8_STAGE(PG8_SB(0, 1), cB + hstep, voffB); PG8_STAGE(PG8_SA(0, 0), cA, voffA); PG8_STAGE(PG8_SA(0, 1), cA + hstep, voffA);
    if (wr == 1) PG8_BAR;
    PG8_WAIT_V(2); PG8_BAR;
    PG8_STAGE(PG8_SB(1, 0), cB + kstep, voffB); PG8_STAGE(PG8_SA(1, 0), cA + kstep, voffA); PG8_STAGE(PG8_SB(1, 1), cB + hstep + kstep, voffB);
    PG8_WAIT_V(6); PG8_BAR;
    for (;;) {
        const bool has_next = S.next(ui + 1, nxt);
        const char* nA = has_next ? (const char*)g.A + (size_t)nxt.pm * tstep : cA; const char* nB = has_next ? (const char*)g.Bt + (size_t)nxt.pb * tstep : cB;
        for (int t = 0; t < nt; t += 2) {
            const bool last = (t == nt - 2);
            const char* a1 = cA + (size_t)(t + 1) * kstep;
            const char* a2 = last ? nA : cA + (size_t)(t + 2) * kstep; const char* b2 = last ? nB : cB + (size_t)(t + 2) * kstep;
            const char* a3 = a2 + kstep; const char* b3 = b2 + kstep;
            PG8_LDB(B0, 0, 0); PG8_LDB(B1, 0, 1); PG8_SCHED; PG8_LDA(At, 0, 0); PG8_STAGE(PG8_SA(1, 1), a1 + hstep, voffA);
            PG8_WAIT_V(8); PG8_WAIT_L(0); PG8_BAR; PG8_MMA(0, 0, At, B0); PG8_MMA(0, 1, At, B1); PG8_BAR; PG8_SCHED;
            PG8_LDA(At, 0, 1); PG8_STAGE(PG8_SB(0, 0), b2, voffB); PG8_STAGE(PG8_SB(0, 1), b2 + hstep, voffB); PG8_STAGE(PG8_SA(0, 0), a2, voffA);
            PG8_WAIT_V(8); PG8_WAIT_L(0); PG8_BAR; PG8_MMA(1, 0, At, B0); PG8_MMA(1, 1, At, B1); PG8_BAR; PG8_SCHED;
            PG8_LDB(B0, 1, 0); PG8_LDB(B1, 1, 1); PG8_SCHED; PG8_LDA(At, 1, 0); PG8_STAGE(PG8_SA(0, 1), a2 + hstep, voffA);
            PG8_WAIT_V(8); PG8_WAIT_L(0); PG8_BAR; PG8_MMA(0, 0, At, B0); PG8_MMA(0, 1, At, B1); PG8_BAR; PG8_SCHED;
            PG8_LDA(At, 1, 1); PG8_STAGE(PG8_SB(1, 0), b3, voffB); PG8_STAGE(PG8_SB(1, 1), b3 + hstep, voffB); PG8_STAGE(PG8_SA(1, 0), a3, voffA);
            PG8_WAIT_V(8); PG8_WAIT_L(0); PG8_BAR; PG8_MMA(1, 0, At, B0); PG8_MMA(1, 1, At, B1); PG8_BAR; PG8_SCHED;
        }
        if constexpr (ALIGN_EPI) { if (wr == 0) PG8_BAR; }
        E(acc, cur, wr, wc, fr, fq);
        if (!has_next) break;
#pragma unroll
        for (int a = 0; a < 2; ++a)
#pragma unroll
            for (int b = 0; b < 2; ++b)
#pragma unroll
                for (int m = 0; m < 4; ++m)
#pragma unroll
                    for (int n = 0; n < 2; ++n) acc[a][b][m][n] = (f32x4){0.f, 0.f, 0.f, 0.f};
        cur = nxt; cA = nA; cB = nB; ++ui;
        if constexpr (ALIGN_EPI) { if (wr == 1) PG8_BAR; }
    }
    PG8_WAIT_V(0);
    if constexpr (!ALIGN_EPI) { if (wr == 0) PG8_BAR; }
    PG8_BAR;
#undef PG8_SA
#undef PG8_SB
#undef PG8_STAGE
#undef PG8_LDA
#undef PG8_LDB
#undef PG8_MMA
#undef PG8_WAIT_V
#undef PG8_WAIT_L
#undef PG8_BAR
#undef PG8_SCHED
}
}
namespace attn_body {
using bf16=__hip_bfloat16;
using bf16x8=__attribute__((ext_vector_type(8)))short;
using s16x4=__attribute__((ext_vector_type(4)))short;
using f32x16=__attribute__((ext_vector_type(16)))float;
using u32x4=__attribute__((ext_vector_type(4)))unsigned;
constexpr int SEQ=16384,D=64,PQ=2816,PO=512;
constexpr int NW=8,QBLK=32,QB=QBLK*NW,KVBLK=64,NQB=SEQ/QB;
constexpr int ATTN_UNIT_ROWS=QB;
__device__ __forceinline__ int crow(int r,int hi){return (r&3)+8*(r>>2)+4*hi;}
#define SBAR() __builtin_amdgcn_sched_barrier(0)
__device__ __forceinline__ void cmask(f32x16&p0,f32x16&p1,int jb,int qrel,int hi){
  const float NEG=-INFINITY; int kb=64*jb+4*hi;
  #pragma unroll
  for(int r=0;r<16;++r){int kv=kb+(r&3)+8*(r>>2); if(kv>qrel)p0[r]=NEG; if(kv+32>qrel)p1[r]=NEG;}
}

constexpr int NSLOT=3, SLOTB=8192;
constexpr int LDS_K=0, LDS_V=NSLOT*SLOTB, LDS_WS=2*NSLOT*SLOTB, LDS_OST=LDS_WS+NW*64*4, LDS_BYTES=LDS_OST+NW*4096;
constexpr float C2=0.125f*1.4426950408889634f;
__device__ __forceinline__ void glds16(const void*gsrc,unsigned lds_dst){unsigned keep;
  asm volatile("s_mov_b32 %0, m0\n\ts_mov_b32 m0, %2\n\ts_nop 0\n\tglobal_load_lds_dwordx4 %1, off\n\ts_mov_b32 m0, %0":"=&s"(keep):"v"(gsrc),"s"(lds_dst):"memory");}
__device__ __forceinline__ float max3f(float a,float b,float c){float r;asm("v_max3_f32 %0, %1, %2, %3":"=v"(r):"v"(a),"v"(b),"v"(c));return r;}
__device__ __forceinline__ float max2f(float a,float b){float r;asm("v_max_f32_e32 %0, %1, %2":"=v"(r):"v"(a),"v"(b));return r;}
__device__ __forceinline__ float fadd_s(float a,float b){float r;asm("v_add_f32_e32 %0, %1, %2":"=v"(r):"v"(a),"v"(b));return r;}
__device__ __forceinline__ float fsub_s(float a,float b){float r;asm("v_sub_f32_e32 %0, %1, %2":"=v"(r):"v"(a),"v"(b));return r;}
typedef float f32x2_t __attribute__((ext_vector_type(2))); typedef __bf16 bf16x2_t __attribute__((ext_vector_type(2)));
__device__ __forceinline__ unsigned cvtpk_s(float lo,float hi){f32x2_t v={lo,hi};bf16x2_t b=__builtin_convertvector(v,bf16x2_t);return __builtin_bit_cast(unsigned,b);}
#define WAIT_BAR(N) asm volatile("s_waitcnt vmcnt(" #N ") lgkmcnt(0)\n\ts_barrier":::"memory")

__device__ __forceinline__ void qkt(f32x16&p0,f32x16&p1,const char*Kslot,const bf16x8*qr,const f32x16&negm,int r32,int hi){
  const char*kb=Kslot+hi*1024+r32*16;
  #pragma unroll
  for(int d0=0;d0<4;++d0){
    const bf16x8 b0=*reinterpret_cast<const bf16x8*>(kb+d0*2048);
    const bf16x8 b1=*reinterpret_cast<const bf16x8*>(kb+d0*2048+512);
    if(d0==0){p0=__builtin_amdgcn_mfma_f32_32x32x16_bf16(b0,qr[0],negm,0,0,0);p1=__builtin_amdgcn_mfma_f32_32x32x16_bf16(b1,qr[0],negm,0,0,0);}
    else{p0=__builtin_amdgcn_mfma_f32_32x32x16_bf16(b0,qr[d0],p0,0,0,0);p1=__builtin_amdgcn_mfma_f32_32x32x16_bf16(b1,qr[d0],p1,0,0,0);}}
}
typedef __attribute__((address_space(3))) const char* lds_cptr;
typedef short v4i16_t __attribute__((ext_vector_type(4)));
__device__ __forceinline__ void kload8(bf16x8*kf,lds_cptr kp){
  kf[0]=*(const __attribute__((address_space(3))) bf16x8*)(kp);      kf[1]=*(const __attribute__((address_space(3))) bf16x8*)(kp+512);
  kf[2]=*(const __attribute__((address_space(3))) bf16x8*)(kp+2048); kf[3]=*(const __attribute__((address_space(3))) bf16x8*)(kp+2560);
  kf[4]=*(const __attribute__((address_space(3))) bf16x8*)(kp+4096); kf[5]=*(const __attribute__((address_space(3))) bf16x8*)(kp+4608);
  kf[6]=*(const __attribute__((address_space(3))) bf16x8*)(kp+6144); kf[7]=*(const __attribute__((address_space(3))) bf16x8*)(kp+6656);
}
__device__ __forceinline__ void kload2(bf16x8*kf,lds_cptr kp,int j){ kf[2*j]=*(const __attribute__((address_space(3))) bf16x8*)(kp+j*2048); kf[2*j+1]=*(const __attribute__((address_space(3))) bf16x8*)(kp+j*2048+512); }
__device__ __forceinline__ s16x4 vtr(lds_cptr p){ return __builtin_bit_cast(s16x4,__builtin_amdgcn_ds_read_tr16_b64_v4i16((__attribute__((address_space(3))) v4i16_t*)p)); }
__device__ __forceinline__ float rowmax(const f32x16&p0,const f32x16&p1){
  float a=max3f(p0[0],p0[1],p1[0]),b=max3f(p0[2],p0[3],p1[1]);a=max3f(a,p1[2],p1[3]);
  #pragma unroll
  for(int r=4;r<16;r+=4){a=max3f(a,p0[r],p0[r+1]);b=max3f(b,p0[r+2],p0[r+3]);a=max3f(a,p1[r],p1[r+1]);b=max3f(b,p1[r+2],p1[r+3]);}
  const float m=max2f(a,b);
  auto rr=__builtin_amdgcn_permlane32_swap(__float_as_uint(m),__float_as_uint(m),false,false);
  return max2f(__uint_as_float(rr[0]),__uint_as_float(rr[1]));
}
__device__ __forceinline__ void pv(f32x16*o,int vb,bf16x8 pa0,bf16x8 pa1,bf16x8 pa2,bf16x8 pa3){
  #pragma unroll
  for(int d0=0;d0<2;++d0){s16x4 lo[4],hi[4];
    #pragma unroll
    for(int ks=0;ks<4;++ks){
      asm volatile("ds_read_b64_tr_b16 %0,%1 offset:%c2":"=&v"(lo[ks]):"v"(vb),"i"(d0*4096+ks*1024):"memory");
      asm volatile("ds_read_b64_tr_b16 %0,%1 offset:%c2":"=&v"(hi[ks]):"v"(vb),"i"(d0*4096+ks*1024+512):"memory");}
    asm volatile("s_waitcnt lgkmcnt(0)":::"memory");SBAR();
    #define PK(k) (bf16x8){lo[k][0],lo[k][1],lo[k][2],lo[k][3],hi[k][0],hi[k][1],hi[k][2],hi[k][3]}
    o[d0]=__builtin_amdgcn_mfma_f32_32x32x16_bf16(pa0,PK(0),o[d0],0,0,0);
    o[d0]=__builtin_amdgcn_mfma_f32_32x32x16_bf16(pa1,PK(1),o[d0],0,0,0);
    o[d0]=__builtin_amdgcn_mfma_f32_32x32x16_bf16(pa2,PK(2),o[d0],0,0,0);
    o[d0]=__builtin_amdgcn_mfma_f32_32x32x16_bf16(pa3,PK(3),o[d0],0,0,0);
    #undef PK
  }
}

#ifndef ATTN_STORE16
#define ATTN_STORE16(p,v) (*(u32x4*)(p)=(v))
#endif
template<int THRL> __device__ __forceinline__ void attn_unit(const int tid,int qb,const bf16*Qh,const bf16*__restrict__ Kh,const bf16*__restrict__ Vh,bf16*Oh,char*shm){
  const int lane=tid&63,r32=lane&31,hi=lane>>5; const int wid=__builtin_amdgcn_readfirstlane(tid>>6);
  const int q0=qb*QB;
  const bf16*Qw=Qh+(long)(q0+wid*QBLK)*PQ;
  const unsigned lds0=(unsigned)(uintptr_t)shm;
  float*wsf=(float*)(shm+LDS_WS)+wid*64;
  const bf16*ksrc=Kh+(long)lane*PQ+wid*8;
  const bf16*vsrc=Vh+(long)(16*(wid&3)+(lane>>2))*PQ+(wid>>2)*32+(lane&3)*8;
  const unsigned kdst=lds0+LDS_K+wid*1024, vdst=lds0+LDS_V+wid*1024;
  #define DMA_K(t,slot) glds16(ksrc+(long)(t)*KVBLK*PQ,(unsigned)__builtin_amdgcn_readfirstlane(kdst+(slot)))
  #define DMA_V(t,slot) glds16(vsrc+(long)(t)*KVBLK*PQ,(unsigned)__builtin_amdgcn_readfirstlane(vdst+(slot)))
  const int vb0=(int)(lds0+LDS_V)+((lane>>4)&1)*32+(lane&3)*8+(4*hi+((lane&15)>>2))*64;
  const char*Kbase=shm+LDS_K; bf16x8 kf[8];
  const lds_cptr shm3=(lds_cptr)shm; const lds_cptr kp0=shm3+LDS_K+hi*1024+r32*16; const lds_cptr vp0=shm3+LDS_V+((lane>>4)&1)*32+(lane&3)*8+(4*hi+((lane&15)>>2))*64;
  const int NT=(q0+QB)/KVBLK;
  DMA_K(0,0);DMA_V(0,0);DMA_K(1,SLOTB);
  bf16x8 qr[4];
  #pragma unroll
  for(int d0=0;d0<4;++d0)qr[d0]=*reinterpret_cast<const bf16x8*>(&Qw[(long)r32*PQ+d0*16+hi*8]);
  float mhat=0.f,l_reg=0.f;f32x16 o[2];o[0]=f32x16{};o[1]=f32x16{};const f32x16 negm=f32x16{};
  const int qrel=wid*QBLK+r32;
  #define CMASK(P0,P1,t) do{int jb_=(t)-(NT-4); if(jb_>=0)cmask(P0,P1,jb_,qrel,hi);}while(0)
  bool resc=false;
  #define START(P0,P1) do{ const float rm=rowmax(P0,P1); resc=false; \
    { const float dl=rm; mhat=fadd_s(mhat,dl); \
      _Pragma("unroll") for(int r=0;r<16;++r){P0[r]=fsub_s(P0[r],dl);P1[r]=fsub_s(P1[r],dl);} \
      } \
    _Pragma("unroll") for(int r=0;r<16;++r)P0[r]=__builtin_amdgcn_exp2f(P0[r]); }while(0)
  #define RESC() do{ if(resc){ asm volatile("s_waitcnt lgkmcnt(0)":::"memory"); \
      _Pragma("unroll") for(int d_=0;d_<2;++d_) _Pragma("unroll") for(int r=0;r<16;++r)o[d_][r]*=wsf[crow(r,hi)]; } }while(0)
  f32x16 pA0,pA1,pB0,pB1;
  int sl_prev=0,sl_cur=0,sl_next=SLOTB;
  #define ROT() do{sl_prev=sl_cur;sl_cur=sl_next;sl_next=(sl_next==(NSLOT-1)*SLOTB)?0:sl_next+SLOTB;}while(0)
  DMA_K(2,2*SLOTB);
  WAIT_BAR(3);
  qkt(pA0,pA1,Kbase,qr,negm,r32,hi);asm volatile("s_nop 15\n\ts_nop 7":"+v"(pA0),"+v"(pA1));CMASK(pA0,pA1,0);
  START(pA0,pA1);
  _Pragma("unroll") for(int r=0;r<16;++r)pA1[r]=__builtin_amdgcn_exp2f(pA1[r]);
  WAIT_BAR(0);
  DMA_K(3,0);DMA_V(1,SLOTB);
  ROT();
  kload8(kf,kp0+sl_cur);
  WAIT_BAR(2);
  s16x4 vlo[8],vhi[8]; u32x4 pw0,pw1,pw2,pw3;
  #define PKW(P,B) cvtpk_s(P[B],P[B+1])
  #define PAF(k) __builtin_bit_cast(bf16x8,pw##k)
  #define VFR(i) (bf16x8){vlo[i][0],vlo[i][1],vlo[i][2],vlo[i][3],vhi[i][0],vhi[i][1],vhi[i][2],vhi[i][3]}
  #define PIN(x) asm volatile("":"+v"(x))
  #define MX3(a,b,c) __builtin_fmaxf(__builtin_fmaxf((a),(b)),(c))
  #define GAPA(MF,A0,A1,A2,A3,W0,W1,PW) do{ MF; sacc+=A0; sacc+=A1; sacc+=A2; sacc+=A3; PIN(sacc); W0; W1; PIN(PW); SBAR(); }while(0)
  #define EX(v) __builtin_amdgcn_exp2f(v)
  #define GAPB(MF,X,B) do{ MF; X[B]=EX(X[B]-mhat); X[B+1]=EX(X[B+1]-mhat); X[B+2]=EX(X[B+2]-mhat); X[B+3]=EX(X[B+3]-mhat); PIN(X); SBAR(); }while(0)
  #define VRD(i) do{ vlo[i]=vtr(vp_+(((i)>>2)*4096+((i)&3)*1024)); vhi[i]=vtr(vp_+(((i)>>2)*4096+((i)&3)*1024+512)); }while(0)
  #define KRD(G,j) do{ if(G){ kload2(kf,kp0+sl_next,j); SBAR(); } }while(0)
  #define STEP(C0,C1,P0,P1,t,GK,GV,GL) do{ SBAR(); \
    const lds_cptr vp_=vp0+sl_prev; \
    VRD(0); SBAR(); float sacc=(P0[0]+P0[1]); \
    GAPA(C0=__builtin_amdgcn_mfma_f32_32x32x16_bf16(kf[0],qr[0],negm,0,0,0), P0[2],P0[3],P0[4],P0[5],     pw0[0]=PKW(P0,0), pw0[1]=PKW(P0,2), pw0); \
    VRD(4); SBAR(); GAPA(C1=__builtin_amdgcn_mfma_f32_32x32x16_bf16(kf[1],qr[0],negm,0,0,0), P0[6],P0[7],P0[8],P0[9],     pw0[2]=PKW(P0,4), pw0[3]=PKW(P0,6), pw0); \
    VRD(1); SBAR(); GAPA(C0=__builtin_amdgcn_mfma_f32_32x32x16_bf16(kf[2],qr[1],C0,0,0,0),   P0[10],P0[11],P0[12],P0[13], pw1[0]=PKW(P0,8), pw1[1]=PKW(P0,10), pw1); \
    VRD(5); SBAR(); GAPA(C1=__builtin_amdgcn_mfma_f32_32x32x16_bf16(kf[3],qr[1],C1,0,0,0),   P0[14],P0[15],P1[0],P1[1],   pw1[2]=PKW(P0,12),pw1[3]=PKW(P0,14), pw1); \
    VRD(2); SBAR(); GAPA(C0=__builtin_amdgcn_mfma_f32_32x32x16_bf16(kf[4],qr[2],C0,0,0,0),   P1[2],P1[3],P1[4],P1[5],     pw2[0]=PKW(P1,0), pw2[1]=PKW(P1,2), pw2); \
    VRD(6); SBAR(); GAPA(C1=__builtin_amdgcn_mfma_f32_32x32x16_bf16(kf[5],qr[2],C1,0,0,0),   P1[6],P1[7],P1[8],P1[9],     pw2[2]=PKW(P1,4), pw2[3]=PKW(P1,6), pw2); \
    VRD(3); SBAR(); GAPA(C0=__builtin_amdgcn_mfma_f32_32x32x16_bf16(kf[6],qr[3],C0,0,0,0),   P1[10],P1[11],P1[12],P1[13], pw3[0]=PKW(P1,8), pw3[1]=PKW(P1,10), pw3); \
    VRD(7); SBAR(); GAPA(C1=__builtin_amdgcn_mfma_f32_32x32x16_bf16(kf[7],qr[3],C1,0,0,0),   P1[14],P1[15],0.f,0.f,       pw3[2]=PKW(P1,12),pw3[3]=PKW(P1,14), pw3); \
    l_reg+=sacc; \
    if(GK){DMA_K((t)+3,sl_cur);} if(GV){DMA_V((t)+1,sl_next);} \
    CMASK(C0,C1,t); \
    { float a=MX3(C0[0],C0[1],C1[0]),b=MX3(C0[2],C0[3],C1[1]); a=MX3(a,C1[2],C1[3]); \
      _Pragma("unroll") for(int r=4;r<16;r+=4){a=MX3(a,C0[r],C0[r+1]);b=MX3(b,C0[r+2],C0[r+3]);a=MX3(a,C1[r],C1[r+1]);b=MX3(b,C1[r+2],C1[r+3]);} \
      float rm=__builtin_fmaxf(a,b); { auto rr=__builtin_amdgcn_permlane32_swap(__float_as_uint(rm),__float_as_uint(rm),false,false); rm=__builtin_fmaxf(__uint_as_float(rr[0]),__uint_as_float(rr[1])); } \
      resc=false; \
      rm-=mhat; \
      if(__builtin_expect(__any(rm>(float)THRL),0)){ const float dl=__builtin_fmaxf(rm,0.f); mhat+=dl; \
        const float f=__builtin_amdgcn_exp2f(-dl); l_reg*=f; if(hi==0)wsf[r32]=f; resc=true; } } \
    SBAR(); \
    GAPB(o[0]=__builtin_amdgcn_mfma_f32_32x32x16_bf16(PAF(0),VFR(0),o[0],0,0,0), C0,0); \
    GAPB(o[1]=__builtin_amdgcn_mfma_f32_32x32x16_bf16(PAF(0),VFR(4),o[1],0,0,0), C0,4); \
    KRD(GL,0); GAPB(o[0]=__builtin_amdgcn_mfma_f32_32x32x16_bf16(PAF(1),VFR(1),o[0],0,0,0), C0,8); \
    KRD(GL,1); GAPB(o[1]=__builtin_amdgcn_mfma_f32_32x32x16_bf16(PAF(1),VFR(5),o[1],0,0,0), C0,12); \
    KRD(GL,2); GAPB(o[0]=__builtin_amdgcn_mfma_f32_32x32x16_bf16(PAF(2),VFR(2),o[0],0,0,0), C1,0); \
    KRD(GL,3); GAPB(o[1]=__builtin_amdgcn_mfma_f32_32x32x16_bf16(PAF(2),VFR(6),o[1],0,0,0), C1,4); \
    GAPB(o[0]=__builtin_amdgcn_mfma_f32_32x32x16_bf16(PAF(3),VFR(3),o[0],0,0,0), C1,8); \
    GAPB(o[1]=__builtin_amdgcn_mfma_f32_32x32x16_bf16(PAF(3),VFR(7),o[1],0,0,0), C1,12); \
    }while(0)
  int t=1;
  #undef CMASK
  #define CMASK(P0,P1,t) do{}while(0)
  for(;t+5<NT;t+=2){
    STEP(pB0,pB1,pA0,pA1,t,true,true,true);     WAIT_BAR(2); RESC(); ROT();
    STEP(pA0,pA1,pB0,pB1,t+1,true,true,true);   WAIT_BAR(2); RESC(); ROT();
  }
  #undef CMASK
  #define CMASK(P0,P1,t) do{int jb_=(t)-(NT-4); if(jb_>=0)cmask(P0,P1,jb_,qrel,hi);}while(0)
  #define ENDW(tt) do{ if((tt)+3<NT){WAIT_BAR(2);} else if((tt)+2<NT){WAIT_BAR(1);} else {WAIT_BAR(0);} }while(0)
  for(;t+1<NT;t+=2){
    STEP(pB0,pB1,pA0,pA1,t,(t+3<NT),(t+1<NT),(t+1<NT));       ENDW(t);   RESC(); ROT();
    STEP(pA0,pA1,pB0,pB1,t+1,(t+4<NT),(t+2<NT),(t+2<NT));     ENDW(t+1); RESC(); ROT();
  }
  STEP(pB0,pB1,pA0,pA1,NT-1,false,false,false); RESC();
  { float sacc=pB0[0]+pB0[1]; _Pragma("unroll") for(int r=2;r<16;++r)sacc+=pB0[r]; _Pragma("unroll") for(int r=0;r<16;++r)sacc+=pB1[r]; l_reg+=sacc;
    pw0=(u32x4){PKW(pB0,0),PKW(pB0,2),PKW(pB0,4),PKW(pB0,6)};pw1=(u32x4){PKW(pB0,8),PKW(pB0,10),PKW(pB0,12),PKW(pB0,14)};pw2=(u32x4){PKW(pB1,0),PKW(pB1,2),PKW(pB1,4),PKW(pB1,6)};pw3=(u32x4){PKW(pB1,8),PKW(pB1,10),PKW(pB1,12),PKW(pB1,14)};
    SBAR(); pv(o,vb0+sl_cur,PAF(0),PAF(1),PAF(2),PAF(3)); }
  #undef PKW
  #undef PAF
  #undef VFR
  #undef PIN
  #undef MX3
  #undef GAPA
  #undef GAPB
  #undef EX
  #undef VRD
  #undef KRD
  #undef STEP
  #undef ENDW
  {auto rr=__builtin_amdgcn_permlane32_swap(__float_as_uint(l_reg),__float_as_uint(l_reg),false,false);l_reg=__uint_as_float(rr[0])+__uint_as_float(rr[1]);}
  if(hi==0)wsf[32+r32]=l_reg;asm volatile("s_waitcnt lgkmcnt(0)":::"memory");
  float rli[16];
  #pragma unroll
  for(int r=0;r<16;++r)rli[r]=__builtin_amdgcn_rcpf(wsf[32+crow(r,hi)]);
  bf16*Ow=Oh+(long)(q0+wid*QBLK)*PO;
  { bf16*stg=(bf16*)(shm+LDS_OST)+wid*2048;
    #pragma unroll
    for(int r=0;r<16;++r){const int orow=crow(r,hi);
      #pragma unroll
      for(int d0=0;d0<2;++d0)stg[orow*64+d0*32+r32]=__float2bfloat16(o[d0][r]*rli[r]);}
    asm volatile("s_waitcnt lgkmcnt(0)":::"memory");
    #pragma unroll
    for(int i=0;i<4;++i){const int row=i*8+(lane>>3),ch=lane&7; const u32x4 v=*(const u32x4*)(stg+row*64+ch*8); ATTN_STORE16(Ow+(long)row*PO+ch*8,v);} }
  asm volatile("s_waitcnt lgkmcnt(0)\n\ts_barrier":::"memory");
  #undef DMA_K
  #undef DMA_V
  #undef CMASK
  #undef START
  #undef RESC
  #undef ROT
}
constexpr int ATTN_LDS_BYTES=LDS_BYTES;
#undef SBAR
#undef WAIT_BAR
}
namespace attn_body {
#define SBAR() __builtin_amdgcn_sched_barrier(0)
#define WAIT_BAR(N) asm volatile("s_waitcnt vmcnt(" #N ") lgkmcnt(0)\n\ts_barrier":::"memory")
constexpr int SLOTV=16384;
constexpr int L2_K=0, L2_V=NSLOT*SLOTB, L2_WS=L2_V+NSLOT*SLOTV, L2_OST=L2_WS+NW*64*4, LDS2_BYTES=L2_OST+NW*4096;
template<int THRL> __device__ __forceinline__ void attn_unit2(const int tid,int qb,const bf16*Qh,const bf16*__restrict__ Kh,const bf16*__restrict__ Vh,bf16*Oh,char*shm){
  const int lane=tid&63,r32=lane&31,hi=lane>>5; const int wid=__builtin_amdgcn_readfirstlane(tid>>6);
  const int q0=qb*QB;
  const bf16*Qw=Qh+(long)(q0+wid*QBLK)*PQ;
  const unsigned lds0=(unsigned)(uintptr_t)shm;
  float*wsf=(float*)(shm+L2_WS)+wid*64;
  const bf16*ksrc=Kh+(long)lane*PQ+wid*8;
  const bf16*vsrc=Vh+(long)(16*(wid&3)+(lane>>2))*PQ+(wid>>2)*32+(lane&3)*8;
  const unsigned kdst=lds0+L2_K+wid*1024, vdst=lds0+L2_V+wid*1024;
  #define DMA_K(t,slot) glds16(ksrc+(long)(t)*KVBLK*PQ,(unsigned)__builtin_amdgcn_readfirstlane(kdst+(slot)))
  #define DMA_V(t,slot) do{ glds16(vsrc+(long)(t)*KVBLK*PQ,(unsigned)__builtin_amdgcn_readfirstlane(vdst+2*(slot))); glds16(vsrc+64+(long)(t)*KVBLK*PQ,(unsigned)__builtin_amdgcn_readfirstlane(vdst+8192+2*(slot))); }while(0)
  const int vb0=(int)(lds0+L2_V)+((lane>>4)&1)*32+(lane&3)*8+(4*hi+((lane&15)>>2))*64;
  const char*Kbase=shm+L2_K; bf16x8 kf[8];
  const lds_cptr shm3=(lds_cptr)shm; const lds_cptr kp0=shm3+L2_K+hi*1024+r32*16; const lds_cptr vp0=shm3+L2_V+((lane>>4)&1)*32+(lane&3)*8+(4*hi+((lane&15)>>2))*64;
  const int NT=(q0+QB)/KVBLK;
  DMA_K(0,0);DMA_V(0,0);DMA_K(1,SLOTB);
  bf16x8 qr[4];
  #pragma unroll
  for(int d0=0;d0<4;++d0)qr[d0]=*reinterpret_cast<const bf16x8*>(&Qw[(long)r32*PQ+d0*16+hi*8]);
  float mhat=0.f,l_reg=0.f;f32x16 o[4];o[0]=f32x16{};o[1]=f32x16{};o[2]=f32x16{};o[3]=f32x16{};const f32x16 zc=f32x16{};
  const int qrel=wid*QBLK+r32;
  #define CMASK(P0,P1,t) do{int jb_=(t)-(NT-4); if(jb_>=0)cmask(P0,P1,jb_,qrel,hi);}while(0)
  bool resc=false;
  #define RESC() do{ if(resc){ asm volatile("s_waitcnt lgkmcnt(0)":::"memory"); \
      _Pragma("unroll") for(int d_=0;d_<4;++d_) _Pragma("unroll") for(int r=0;r<16;++r)o[d_][r]*=wsf[crow(r,hi)]; } }while(0)
  f32x16 C0,C1;
  int sl_prev=0,sl_cur=0,sl_next=SLOTB;
  #define ROT() do{sl_prev=sl_cur;sl_cur=sl_next;sl_next=(sl_next==(NSLOT-1)*SLOTB)?0:sl_next+SLOTB;}while(0)
  DMA_K(2,2*SLOTB);
  WAIT_BAR(3);
  s16x4 vlo[8],vhi[8]; u32x4 pw0,pw1,pw2,pw3;
  #define PKW(P,B) cvtpk_s(P[B],P[B+1])
  #define PAF(k) __builtin_bit_cast(bf16x8,pw##k)
  #define VFR(i) (bf16x8){vlo[i][0],vlo[i][1],vlo[i][2],vlo[i][3],vhi[i][0],vhi[i][1],vhi[i][2],vhi[i][3]}
  #define PIN(x) asm volatile("":"+v"(x))
  #define MX3(a,b,c) __builtin_fmaxf(__builtin_fmaxf((a),(b)),(c))
  #define EX(v) __builtin_amdgcn_exp2f(v)
  qkt(C0,C1,Kbase,qr,zc,r32,hi);asm volatile("s_nop 15\n\ts_nop 7":"+v"(C0),"+v"(C1));CMASK(C0,C1,0);
  { const float rm=rowmax(C0,C1); mhat=rm;
    _Pragma("unroll") for(int r=0;r<16;++r){C0[r]=EX(C0[r]-rm);C1[r]=EX(C1[r]-rm);}
    float sacc=C0[0]+C0[1]; _Pragma("unroll") for(int r=2;r<16;++r)sacc+=C0[r]; _Pragma("unroll") for(int r=0;r<16;++r)sacc+=C1[r]; l_reg=sacc;
    pw0=(u32x4){PKW(C0,0),PKW(C0,2),PKW(C0,4),PKW(C0,6)};pw1=(u32x4){PKW(C0,8),PKW(C0,10),PKW(C0,12),PKW(C0,14)};pw2=(u32x4){PKW(C1,0),PKW(C1,2),PKW(C1,4),PKW(C1,6)};pw3=(u32x4){PKW(C1,8),PKW(C1,10),PKW(C1,12),PKW(C1,14)}; }
  WAIT_BAR(0);
  DMA_K(3,0);DMA_V(1,SLOTB);
  ROT();
  kload8(kf,kp0+sl_cur);
  WAIT_BAR(3);
  #define GAPA(MF) do{ MF; SBAR(); }while(0)
  #define GAPB1(MF,X,B,I) do{ MF; X[B]=EX(X[B]-mhat); X[B+1]=EX(X[B+1]-mhat); X[B+2]=EX(X[B+2]-mhat); X[B+3]=EX(X[B+3]-mhat); PIN(X); VRD2(I); SBAR(); }while(0)
  #define VRD(i)  do{ vlo[i]=vtr(vp_+(((i)>>2)*4096+((i)&3)*1024)); vhi[i]=vtr(vp_+(((i)>>2)*4096+((i)&3)*1024+512)); }while(0)
  #define VRD2(i) do{ vlo[i]=vtr(vp_+(8192+((i)>>2)*4096+((i)&3)*1024)); vhi[i]=vtr(vp_+(8192+((i)>>2)*4096+((i)&3)*1024+512)); }while(0)
  #define KRD(G,j) do{ if(G){ kload2(kf,kp0+sl_next,j); } }while(0)
  #define ADD4(a,b,c,d) do{ sacc+=a; sacc+=b; sacc+=c; sacc+=d; PIN(sacc); }while(0)
  #define STEP2(t,GK,GV,GL) do{ SBAR(); \
    const lds_cptr vp_=vp0+2*sl_prev; \
    VRD(0); SBAR(); GAPA(C0=__builtin_amdgcn_mfma_f32_32x32x16_bf16(kf[0],qr[0],zc,0,0,0)); \
    VRD(4); SBAR(); GAPA(C1=__builtin_amdgcn_mfma_f32_32x32x16_bf16(kf[1],qr[0],zc,0,0,0)); \
    VRD(1); SBAR(); GAPA(C0=__builtin_amdgcn_mfma_f32_32x32x16_bf16(kf[2],qr[1],C0,0,0,0)); \
    VRD(5); SBAR(); GAPA(C1=__builtin_amdgcn_mfma_f32_32x32x16_bf16(kf[3],qr[1],C1,0,0,0)); \
    VRD(2); SBAR(); GAPA(C0=__builtin_amdgcn_mfma_f32_32x32x16_bf16(kf[4],qr[2],C0,0,0,0)); \
    VRD(6); SBAR(); GAPA(C1=__builtin_amdgcn_mfma_f32_32x32x16_bf16(kf[5],qr[2],C1,0,0,0)); \
    VRD(3); SBAR(); GAPA(C0=__builtin_amdgcn_mfma_f32_32x32x16_bf16(kf[6],qr[3],C0,0,0,0)); \
    VRD(7); SBAR(); GAPA(C1=__builtin_amdgcn_mfma_f32_32x32x16_bf16(kf[7],qr[3],C1,0,0,0)); \
    if(GK){DMA_K((t)+3,sl_cur);} if(GV){DMA_V((t)+1,sl_next);} \
    CMASK(C0,C1,t); \
    { float a=MX3(C0[0],C0[1],C1[0]),b=MX3(C0[2],C0[3],C1[1]); a=MX3(a,C1[2],C1[3]); \
      _Pragma("unroll") for(int r=4;r<16;r+=4){a=MX3(a,C0[r],C0[r+1]);b=MX3(b,C0[r+2],C0[r+3]);a=MX3(a,C1[r],C1[r+1]);b=MX3(b,C1[r+2],C1[r+3]);} \
      float rm=__builtin_fmaxf(a,b); { auto rr=__builtin_amdgcn_permlane32_swap(__float_as_uint(rm),__float_as_uint(rm),false,false); rm=__builtin_fmaxf(__uint_as_float(rr[0]),__uint_as_float(rr[1])); } \
      resc=false; rm-=mhat; \
      if(__builtin_expect(__any(rm>(float)THRL),0)){ const float dl=__builtin_fmaxf(rm,0.f); mhat+=dl; \
        const float f=__builtin_amdgcn_exp2f(-dl); l_reg*=f; if(hi==0)wsf[r32]=f; resc=true; } } \
    SBAR(); \
    GAPB1(o[0]=__builtin_amdgcn_mfma_f32_32x32x16_bf16(PAF(0),VFR(0),o[0],0,0,0), C0,0, 0); \
    GAPB1(o[1]=__builtin_amdgcn_mfma_f32_32x32x16_bf16(PAF(0),VFR(4),o[1],0,0,0), C0,4, 4); \
    GAPB1(o[0]=__builtin_amdgcn_mfma_f32_32x32x16_bf16(PAF(1),VFR(1),o[0],0,0,0), C0,8, 1); \
    GAPB1(o[1]=__builtin_amdgcn_mfma_f32_32x32x16_bf16(PAF(1),VFR(5),o[1],0,0,0), C0,12,5); \
    GAPB1(o[0]=__builtin_amdgcn_mfma_f32_32x32x16_bf16(PAF(2),VFR(2),o[0],0,0,0), C1,0, 2); \
    GAPB1(o[1]=__builtin_amdgcn_mfma_f32_32x32x16_bf16(PAF(2),VFR(6),o[1],0,0,0), C1,4, 6); \
    GAPB1(o[0]=__builtin_amdgcn_mfma_f32_32x32x16_bf16(PAF(3),VFR(3),o[0],0,0,0), C1,8, 3); \
    GAPB1(o[1]=__builtin_amdgcn_mfma_f32_32x32x16_bf16(PAF(3),VFR(7),o[1],0,0,0), C1,12,7); \
    float sacc=(C0[0]+C0[1]); \
    o[2]=__builtin_amdgcn_mfma_f32_32x32x16_bf16(PAF(0),VFR(0),o[2],0,0,0); ADD4(C0[2],C0[3],C0[4],C0[5]); KRD(GL,0); SBAR(); \
    o[3]=__builtin_amdgcn_mfma_f32_32x32x16_bf16(PAF(0),VFR(4),o[3],0,0,0); ADD4(C0[6],C0[7],C0[8],C0[9]); KRD(GL,1); SBAR(); \
    o[2]=__builtin_amdgcn_mfma_f32_32x32x16_bf16(PAF(1),VFR(1),o[2],0,0,0); ADD4(C0[10],C0[11],C0[12],C0[13]); pw0[0]=PKW(C0,0); pw0[1]=PKW(C0,2); PIN(pw0); KRD(GL,2); SBAR(); \
    o[3]=__builtin_amdgcn_mfma_f32_32x32x16_bf16(PAF(1),VFR(5),o[3],0,0,0); ADD4(C0[14],C0[15],C1[0],C1[1]); pw0[2]=PKW(C0,4); pw0[3]=PKW(C0,6); PIN(pw0); KRD(GL,3); SBAR(); \
    o[2]=__builtin_amdgcn_mfma_f32_32x32x16_bf16(PAF(2),VFR(2),o[2],0,0,0); ADD4(C1[2],C1[3],C1[4],C1[5]); pw1[0]=PKW(C0,8); pw1[1]=PKW(C0,10); PIN(pw1); SBAR(); \
    o[3]=__builtin_amdgcn_mfma_f32_32x32x16_bf16(PAF(2),VFR(6),o[3],0,0,0); ADD4(C1[6],C1[7],C1[8],C1[9]); pw1[2]=PKW(C0,12); pw1[3]=PKW(C0,14); PIN(pw1); SBAR(); \
    o[2]=__builtin_amdgcn_mfma_f32_32x32x16_bf16(PAF(3),VFR(3),o[2],0,0,0); ADD4(C1[10],C1[11],C1[12],C1[13]); pw2[0]=PKW(C1,0); pw2[1]=PKW(C1,2); PIN(pw2); SBAR(); \
    o[3]=__builtin_amdgcn_mfma_f32_32x32x16_bf16(PAF(3),VFR(7),o[3],0,0,0); sacc+=C1[14]; sacc+=C1[15]; PIN(sacc); pw2[2]=PKW(C1,4); pw2[3]=PKW(C1,6); PIN(pw2); SBAR(); \
    pw3[0]=PKW(C1,8); pw3[1]=PKW(C1,10); pw3[2]=PKW(C1,12); pw3[3]=PKW(C1,14); PIN(pw3); l_reg+=sacc; \
    }while(0)
  #define ENDW(tt) do{ if((tt)+3<NT){WAIT_BAR(3);} else if((tt)+2<NT){WAIT_BAR(2);} else {WAIT_BAR(0);} }while(0)
  int t=1;
  #undef CMASK
  #define CMASK(P0,P1,t) do{}while(0)
  for(;t+4<NT;++t){ STEP2(t,true,true,true); WAIT_BAR(3); RESC(); ROT(); }
  #undef CMASK
  #define CMASK(P0,P1,t) do{int jb_=(t)-(NT-4); if(jb_>=0)cmask(P0,P1,jb_,qrel,hi);}while(0)
  for(;t+1<NT;++t){ STEP2(t,(t+3<NT),(t+1<NT),(t+1<NT)); ENDW(t); RESC(); ROT(); }
  STEP2(NT-1,false,false,false); RESC();
  { SBAR(); const int vb=vb0+2*sl_cur;
    #pragma unroll
    for(int d0=0;d0<4;++d0){s16x4 lo[4],hi4[4];
      #pragma unroll
      for(int ks=0;ks<4;++ks){
        asm volatile("ds_read_b64_tr_b16 %0,%1 offset:%c2":"=&v"(lo[ks]):"v"(vb),"i"(d0*4096+ks*1024):"memory");
        asm volatile("ds_read_b64_tr_b16 %0,%1 offset:%c2":"=&v"(hi4[ks]):"v"(vb),"i"(d0*4096+ks*1024+512):"memory");}
      asm volatile("s_waitcnt lgkmcnt(0)":::"memory");SBAR();
      #define PK(k) (bf16x8){lo[k][0],lo[k][1],lo[k][2],lo[k][3],hi4[k][0],hi4[k][1],hi4[k][2],hi4[k][3]}
      o[d0]=__builtin_amdgcn_mfma_f32_32x32x16_bf16(PAF(0),PK(0),o[d0],0,0,0);
      o[d0]=__builtin_amdgcn_mfma_f32_32x32x16_bf16(PAF(1),PK(1),o[d0],0,0,0);
      o[d0]=__builtin_amdgcn_mfma_f32_32x32x16_bf16(PAF(2),PK(2),o[d0],0,0,0);
      o[d0]=__builtin_amdgcn_mfma_f32_32x32x16_bf16(PAF(3),PK(3),o[d0],0,0,0);
      #undef PK
    } }
  {auto rr=__builtin_amdgcn_permlane32_swap(__float_as_uint(l_reg),__float_as_uint(l_reg),false,false);l_reg=__uint_as_float(rr[0])+__uint_as_float(rr[1]);}
  if(hi==0)wsf[32+r32]=l_reg;asm volatile("s_waitcnt lgkmcnt(0)":::"memory");
  float rli[16];
  #pragma unroll
  for(int r=0;r<16;++r)rli[r]=__builtin_amdgcn_rcpf(wsf[32+crow(r,hi)]);
  bf16*Ow=Oh+(long)(q0+wid*QBLK)*PO;
  { bf16*stg=(bf16*)(shm+L2_OST)+wid*2048;
    #pragma unroll
    for(int hf=0;hf<2;++hf){
      #pragma unroll
      for(int r=0;r<16;++r){const int orow=crow(r,hi);
        #pragma unroll
        for(int d0=0;d0<2;++d0)stg[orow*64+d0*32+r32]=__float2bfloat16(o[2*hf+d0][r]*rli[r]);}
      asm volatile("s_waitcnt lgkmcnt(0)":::"memory");
      #pragma unroll
      for(int i=0;i<4;++i){const int row=i*8+(lane>>3),ch=lane&7; const u32x4 v=*(const u32x4*)(stg+row*64+ch*8); ATTN_STORE16(Ow+(long)row*PO+hf*64+ch*8,v);}
      asm volatile("s_waitcnt lgkmcnt(0)":::"memory");
    } }
  asm volatile("s_waitcnt lgkmcnt(0)\n\ts_barrier":::"memory");
  #undef DMA_K
  #undef DMA_V
  #undef CMASK
  #undef RESC
  #undef ROT
  #undef PKW
  #undef PAF
  #undef VFR
  #undef PIN
  #undef MX3
  #undef EX
  #undef GAPA
  #undef GAPB1
  #undef VRD
  #undef VRD2
  #undef KRD
  #undef ADD4
  #undef STEP2
  #undef ENDW
}
#undef SBAR
#undef WAIT_BAR
}
#define GAS __attribute__((address_space(1)))
#define LAS __attribute__((address_space(3)))
typedef unsigned short bf16;
typedef unsigned v4u __attribute__((ext_vector_type(4)));
typedef float f32x4 __attribute__((ext_vector_type(4)));
typedef short bf16x8 __attribute__((ext_vector_type(8)));
typedef GAS unsigned gu32;
typedef GAS unsigned long long gu64;
#define RLX_AGENT __ATOMIC_RELAXED, __HIP_MEMORY_SCOPE_AGENT
#define LDS_WAIT() asm volatile("s_waitcnt lgkmcnt(0)" ::: "memory")
#define VM_WAIT() asm volatile("s_waitcnt vmcnt(0)" ::: "memory")
__device__ __forceinline__ unsigned long long rt() { return __builtin_amdgcn_s_memrealtime(); }
__device__ __forceinline__ unsigned f2bf(float f) { unsigned u = __builtin_bit_cast(unsigned, f); return (u + 0x7fffu + ((u >> 16) & 1u)) >> 16; }
__device__ __forceinline__ unsigned pk2(float lo, float hi) { return f2bf(lo) | (f2bf(hi) << 16); }

#define XB_TMO      128
#define XB_XCNT(j)  (256  + 64 * (j))
#define XB_XSUB(j)  (1280 + 64 * (j))
#define XB_XGEN(j)  (2304 + 64 * (j))
#define XB_TOP      3328
#define XB_TOPGEN   3392
#define XCD_BAR_WORDS 3456
#define XB_SPIN_CAP (1u << 18)

__device__ __forceinline__ unsigned xb_ld(unsigned* p)              { return __hip_atomic_load(p, __ATOMIC_RELAXED, __HIP_MEMORY_SCOPE_AGENT); }
__device__ __forceinline__ unsigned xb_add(unsigned* p, unsigned v) { return __hip_atomic_fetch_add(p, v, __ATOMIC_RELAXED, __HIP_MEMORY_SCOPE_AGENT); }
__device__ __forceinline__ unsigned xb_xcc_id() { return (unsigned)__builtin_amdgcn_s_getreg((3 << 11) | 20) & 0xFu; }
#define XB_SPIN(cond, bar) do { unsigned _sp = 0; while (cond) { __builtin_amdgcn_s_sleep(1); \
    if ((++_sp & 255u) == 0u) { if (xb_ld(&(bar)[XB_TMO])) break; if (_sp > XB_SPIN_CAP) { atomicAdd(&(bar)[XB_TMO], 1u); break; } } } } while (0)

struct XcdBarrier {
    unsigned* bar; unsigned x;
    volatile LAS unsigned* st;
};

__device__ __forceinline__ XcdBarrier xcd_barrier_post(unsigned* bar, volatile LAS unsigned* st, const int tid) {
    XcdBarrier b; b.bar = bar; b.x = xb_xcc_id(); b.st = st;
    if (tid == 0) (void)xb_add(&bar[XB_XCNT(b.x)], 1u);
    return b;
}
__device__ __forceinline__ void xcd_barrier_complete(unsigned* bar, unsigned x, unsigned& nloc, unsigned& nx) {
    const unsigned G = gridDim.x * gridDim.y * gridDim.z;
    unsigned sum, cnt, mine, sp = 0u;
    for (;;) {
        sum = 0u; cnt = 0u; mine = 0u;
#pragma unroll
        for (unsigned j = 0; j < 16; ++j) { const unsigned c = xb_ld(&bar[XB_XCNT(j)]); sum += c; cnt += (c > 0u) ? 1u : 0u; mine = (j == x) ? c : mine; }
        if (sum == G) break;
        __builtin_amdgcn_s_sleep(1);
        if ((++sp & 255u) == 0u) { if (xb_ld(&bar[XB_TMO])) break; if (sp > XB_SPIN_CAP) { atomicAdd(&bar[XB_TMO], 1u); break; } }
    }
    nloc = mine > 0u ? mine : 1u; nx = cnt > 0u ? cnt : 1u;
}

__device__ __forceinline__ void xcd_barrier(const XcdBarrier& b, const int tid) {
    asm volatile("s_waitcnt vmcnt(0)" ::: "memory");
    __syncthreads();
    if (tid == 0) {
        unsigned* bar = b.bar;
        __builtin_amdgcn_s_waitcnt(0);
        unsigned nloc = b.st[0], nx = b.st[1];
        if (nloc == 0u) { xcd_barrier_complete(bar, b.x, nloc, nx); b.st[0] = nloc; b.st[1] = nx; }
        const unsigned old = xb_add(&bar[XB_XSUB(b.x)], 1u);
        const unsigned gen = old / nloc;
        if (old + 1u == (gen + 1u) * nloc) {
            __builtin_amdgcn_fence(__ATOMIC_RELEASE, "agent");
            asm volatile("s_waitcnt vmcnt(0)" ::: "memory");
            const unsigned og = xb_add(&bar[XB_TOP], 1u);
            const unsigned tg = og / nx;
            if (og + 1u == (tg + 1u) * nx) xb_add(&bar[XB_TOPGEN], 1u);
            else XB_SPIN(xb_ld(&bar[XB_TOPGEN]) == tg, bar);
            __builtin_amdgcn_fence(__ATOMIC_ACQUIRE, "agent");
            xb_add(&bar[XB_XGEN(b.x)], 1u);
            asm volatile("s_waitcnt vmcnt(0)" ::: "memory");
        } else {
            XB_SPIN(xb_ld(&bar[XB_XGEN(b.x)]) == gen, bar);
            __builtin_amdgcn_fence(__ATOMIC_ACQUIRE, "agent");
            asm volatile("s_waitcnt vmcnt(0)" ::: "memory");
        }
    }
    __syncthreads();
}
constexpr int NWAVES = 8;
#ifndef MK_N_LAUNCHES
#define MK_N_LAUNCHES 1
#endif
constexpr int NPH_LAYER = 11, NPH = 2 + 2 * NPH_LAYER;
constexpr int N_LAUNCHES = MK_N_LAUNCHES;
static_assert(N_LAUNCHES == 1 || N_LAUNCHES == NPH, "MK_N_LAUNCHES is 1 or NPH");

constexpr int SEQ = 16384, DMODEL = 1024, DIN = 2816, FFD = 2816, NEXP = 8, EDIM = 3584, DEPTH = 2;
constexpr int M = SEQ;
constexpr float LN_EPS = 1e-5f;
constexpr float ALPHA = 1.4142135623730951f;
constexpr int MAXSLOT = 135 * 256;

constexpr size_t MiB = 1u << 20;
constexpr size_t WS_CTL = 0, CTL_ZERO_BYTES = 1 * MiB;
constexpr size_t WS_SMALL = 1 * MiB;
constexpr size_t SM_MOD = 0, SM_LBS = 49152, SM_LAM = 51200, SM_TOK = 65536, SM_PERM = 327680;
constexpr size_t WS_ROPE = 2 * MiB;
constexpr size_t WS_EXP13 = 6 * MiB, WS_EXP2 = 118 * MiB;
constexpr size_t WS_HPERM = 174 * MiB;
constexpr size_t WS_YSLOT = 174 * MiB;
constexpr size_t WS_HID = 242 * MiB;
constexpr size_t WS_PROJ = 242 * MiB, WS_DHID = 242 * MiB;
constexpr size_t WS_ATTNO = 330 * MiB, WS_HBUF = 330 * MiB;
constexpr size_t WS_MIX = 362 * MiB, WS_HGS = 394 * MiB, WS_HGD = 410 * MiB;
constexpr size_t WS_WIN = 411 * MiB, WS_WOUT = 422 * MiB, WS_FFN13 = 426 * MiB, WS_FFN2 = 437 * MiB;
constexpr size_t WS_END = 479 * MiB;
static_assert(WS_YSLOT + (size_t)MAXSLOT * 1024 * 2 <= WS_HID && WS_HID + (size_t)MAXSLOT * 3584 * 2 <= WS_END && WS_FFN2 + (size_t)1024 * 2816 * 2 <= WS_END, "d_ws map");
constexpr int CW_TMO = 0, CW_CODE = 1;
constexpr int CW_CNT = 64;
constexpr int CW_BAR = 4096;

constexpr int RING_OFF = 0, RING_BYTES = 131072;
constexpr int LDSCTL_OFF = RING_BYTES, MISC_OFF = LDSCTL_OFF + 320;
constexpr int XTRA_OFF = LDSCTL_OFF + 1024;
constexpr int LDS_BYTES = 147456;

__device__ __forceinline__ float bf2f(unsigned short b) { return __uint_as_float((unsigned)b << 16); }
template <int O> __device__ __forceinline__ float swzx(float v) { return __int_as_float(__builtin_amdgcn_ds_swizzle(__float_as_int(v), (O << 10) | 0x1f)); }
__device__ __forceinline__ float wave_sum(float v) {
    v += swzx<1>(v); v += swzx<2>(v); v += swzx<4>(v); v += swzx<8>(v); v += swzx<16>(v);
    auto rr = __builtin_amdgcn_permlane32_swap(__float_as_uint(v), __float_as_uint(v), false, false);
    return __uint_as_float(rr[0]) + __uint_as_float(rr[1]);
}
__device__ __forceinline__ float sigmoid_f(float z) { return __builtin_amdgcn_rcpf(1.0f + __builtin_amdgcn_exp2f(-1.4426950408889634f * z)); }
__device__ __forceinline__ float silu_ff(float a) { return a * sigmoid_f(a); }

struct Args { const float* in[23]; float* out; unsigned char* ws; int ph_lo, ph_hi, li, pad; };
enum { I_X = 0, I_C, I_WADA, I_BADA, I_WIN, I_LAMQK, I_ATTNG, I_HGLB, I_HGG, I_POOLW, I_POOLS, I_WOUT, I_LN1G, I_LN1B, I_LN2G, I_LN2B, I_FW1, I_FW3, I_FW2, I_RW, I_EW1, I_EW3, I_EW2 };

struct Frame {
    LAS unsigned char* lds; volatile LAS unsigned* MISC; gu32* ctl; unsigned char* ws;
    int tid, lane, wave, vcu, G, bid;
};

__device__ const float kInvFreq[32] = {1.f, 0.749894202f, 0.562341332f, 0.421696514f, 0.316227764f, 0.237137392f, 0.177827939f, 0.133352146f, 0.100000001f, 0.0749894157f, 0.0562341288f, 0.0421696492f,
    0.0316227786f, 0.0237137359f, 0.0177827943f, 0.0133352149f, 0.00999999978f, 0.00749894232f, 0.00562341325f, 0.00421696482f, 0.00316227786f, 0.00237137382f, 0.00177827943f, 0.00133352145f,
    0.00100000005f, 0.000749894185f, 0.000562341302f, 0.000421696546f, 0.000316227786f, 0.000237137385f, 0.00017782794f, 0.00013335215f};

template <int KIND> __device__ __forceinline__ int rowmap(int n) {
    if (KIND == 0) { if (n >= 1024) return n; const int d = n & 63; return (n & ~63) + ((d < 32) ? 2 * d : 2 * (d - 32) + 1); }
    if (KIND == 2) return ((n >> 7) << 8) + (n & 127);
    if (KIND == 3) return ((n >> 7) << 8) + 128 + (n & 127);
    return n;
}
template <int KIND> __device__ __forceinline__ void transpose_item(const float* W_, int K, int N, bf16* WT, LAS float* scr, int item, int lane) {
    const GAS float* W = (const GAS float*)W_;
    const int nblk = N / 32, kb = item / nblk, nb = item % nblk, k0 = 64 * kb, n0 = 32 * nb;
#pragma unroll 8
    for (int i = 0; i < 32; ++i) { const int kk = 2 * i + (lane >> 5); scr[kk * 33 + (lane & 31)] = W[(size_t)(k0 + kk) * N + n0 + (lane & 31)]; }
    LDS_WAIT(); asm volatile("" ::: "memory");
    const int c = lane & 7;
#pragma unroll
    for (int j = 0; j < 4; ++j) { const int n = (lane >> 3) + 8 * j; const LAS float* s = scr + (8 * c) * 33 + n;
        v4u o; o.x = pk2(s[0 * 33], s[1 * 33]); o.y = pk2(s[2 * 33], s[3 * 33]); o.z = pk2(s[4 * 33], s[5 * 33]); o.w = pk2(s[6 * 33], s[7 * 33]);
        *(GAS v4u*)(WT + (size_t)rowmap<KIND>(n0 + n) * K + k0 + 8 * c) = o; }
    LDS_WAIT(); asm volatile("" ::: "memory");
}
__device__ __forceinline__ void sincos_acc(float ang, float& s, float& c) {
    const double a = (double)ang; const double n = __builtin_rint(a * 0.63661977236758134308);
    double r = __builtin_fma(-n, 1.57079632679489655800, a); r = __builtin_fma(-n, 6.12323399573676603587e-17, r);
    const double r2 = r * r;
    double sp = -1.0 / 1307674368000.0; sp = sp * r2 + 1.0 / 6227020800.0; sp = sp * r2 - 1.0 / 39916800.0; sp = sp * r2 + 1.0 / 362880.0; sp = sp * r2 - 1.0 / 5040.0; sp = sp * r2 + 1.0 / 120.0; sp = sp * r2 - 1.0 / 6.0;
    const double sr = r + r * r2 * sp;
    double cp = 1.0 / 20922789888000.0; cp = cp * r2 - 1.0 / 87178291200.0; cp = cp * r2 + 1.0 / 479001600.0; cp = cp * r2 - 1.0 / 3628800.0; cp = cp * r2 + 1.0 / 40320.0; cp = cp * r2 - 1.0 / 720.0; cp = cp * r2 + 1.0 / 24.0; cp = cp * r2 - 0.5;
    const double cr = 1.0 + r2 * cp;
    const int q = ((int)n) & 3;
    const double ss = (q == 0) ? sr : (q == 1) ? cr : (q == 2) ? -sr : -cr;
    const double cc = (q == 0) ? cr : (q == 1) ? -sr : (q == 2) ? -cr : sr;
    s = (float)ss; c = (float)cc;
}
__device__ __forceinline__ void p0a_prologue(Frame& F, const Args& A) {
    const int gw = F.vcu * NWAVES + F.wave, NGW = F.G * NWAVES;
    {
        LAS float* red = (LAS float*)(F.lds + XTRA_OFF);
        for (int cb = F.bid; cb < 256; cb += F.G) {
            const int fc = cb * 48 + F.lane; const int l = fc / 6144, j = fc % 6144; float acc = 0.f;
            if (F.lane < 48) {
                const float* w = A.in[I_WADA] + (size_t)l * 1024 * 6144 + j; const float* c = A.in[I_C];
#pragma unroll 8
                for (int k = F.wave * 128; k < F.wave * 128 + 128; ++k) acc += silu_ff(c[k]) * w[(size_t)k * 6144];
            }
            red[F.wave * 64 + F.lane] = acc;
            __syncthreads();
            if (F.wave == 0 && F.lane < 48) { float s = 0.f;
#pragma unroll
                for (int w8 = 0; w8 < 8; ++w8) s += red[w8 * 64 + F.lane];
                ((float*)(F.ws + WS_SMALL + SM_MOD))[fc] = s + A.in[I_BADA][fc]; }
            __syncthreads();
        }
    }
    {
        float* cosT = (float*)(F.ws + WS_ROPE); float* sinT = cosT + (size_t)SEQ * 32;
        for (int idx = F.bid * (NWAVES * 64) + F.tid; idx < SEQ * 32; idx += F.G * NWAVES * 64) {
            const int pos = idx >> 5, i = idx & 31; const float ang = (float)pos * kInvFreq[i]; float s, c; sincos_acc(ang, s, c);
            cosT[idx] = c; sinT[idx] = s; }
    }
    if (F.bid == 0) {
        float* lbs = (float*)(F.ws + WS_SMALL + SM_LBS); float* lam = (float*)(F.ws + WS_SMALL + SM_LAM);
        if (F.tid < 256) { const float a0 = A.in[I_HGLB][F.tid], a1 = A.in[I_HGLB][256 + F.tid]; const float mx = fmaxf(a0, a1); const float e0 = __expf(a0 - mx), e1 = __expf(a1 - mx);
            lbs[F.tid] = 0.f; lbs[256 + F.tid] = e1 / (e0 + e1); }
        if (F.tid >= 256 && F.tid < 258) { const int l = F.tid - 256; const float* q = A.in[I_LAMQK] + l * 256; float s1 = 0.f, s2 = 0.f;
            for (int j = 0; j < 64; ++j) { s1 += q[j] * q[64 + j]; s2 += q[128 + j] * q[192 + j]; }
            const float li = 0.8f - 0.6f * expf(-0.3f * (float)l); lam[l] = expf(s1) - expf(s2) + li; lam[2 + l] = li; }
    }
    LAS float* scr = (LAS float*)(F.lds + RING_OFF + F.wave * 16384);
    constexpr int I_WI = 16 * 88, I_WO = 16 * 32, I_F13 = 16 * 88, I_F2 = 44 * 32, I_E13 = 16 * 112, I_E2 = 56 * 32;
    constexpr int NITEMS = 2 * I_WI + 2 * I_WO + 2 * I_F13 + I_F2 + 16 * I_E13 + 8 * I_E2;
    for (int it = gw; it < NITEMS; it += NGW) {
        int r = it;
        if (r < 2 * I_WI) { const int l = r / I_WI; transpose_item<0>(A.in[I_WIN] + (size_t)l * 1024 * DIN, 1024, DIN, (bf16*)(F.ws + WS_WIN) + (size_t)l * DIN * 1024, scr, r % I_WI, F.lane); continue; } r -= 2 * I_WI;
        if (r < 2 * I_WO) { const int l = r / I_WO; transpose_item<1>(A.in[I_WOUT] + (size_t)l * 1024 * 1024, 1024, 1024, (bf16*)(F.ws + WS_WOUT) + (size_t)l * 1024 * 1024, scr, r % I_WO, F.lane); continue; } r -= 2 * I_WO;
        if (r < I_F13) { transpose_item<2>(A.in[I_FW1], 1024, FFD, (bf16*)(F.ws + WS_FFN13), scr, r, F.lane); continue; } r -= I_F13;
        if (r < I_F13) { transpose_item<3>(A.in[I_FW3], 1024, FFD, (bf16*)(F.ws + WS_FFN13), scr, r, F.lane); continue; } r -= I_F13;
        if (r < I_F2) { transpose_item<1>(A.in[I_FW2], FFD, 1024, (bf16*)(F.ws + WS_FFN2), scr, r, F.lane); continue; } r -= I_F2;
        if (r < 8 * I_E13) { const int e = r / I_E13; transpose_item<2>(A.in[I_EW1] + (size_t)e * 1024 * EDIM, 1024, EDIM, (bf16*)(F.ws + WS_EXP13) + (size_t)e * 2 * EDIM * 1024, scr, r % I_E13, F.lane); continue; } r -= 8 * I_E13;
        if (r < 8 * I_E13) { const int e = r / I_E13; transpose_item<3>(A.in[I_EW3] + (size_t)e * 1024 * EDIM, 1024, EDIM, (bf16*)(F.ws + WS_EXP13) + (size_t)e * 2 * EDIM * 1024, scr, r % I_E13, F.lane); continue; } r -= 8 * I_E13;
        { const int e = r / I_E2; transpose_item<1>(A.in[I_EW2] + (size_t)e * EDIM * 1024, EDIM, 1024, (bf16*)(F.ws + WS_EXP2) + (size_t)e * 1024 * EDIM, scr, r % I_E2, F.lane); }
    }
}

__device__ __forceinline__ void load4(f32x4 (&v)[4], const float* p, int lane) { const GAS f32x4* q = (const GAS f32x4*)p + lane;
#pragma unroll
    for (int j = 0; j < 4; ++j) v[j] = q[64 * j]; }
__device__ __forceinline__ void store_bf16_row(bf16* orow, const f32x4 (&v)[4], int lane) {
    GAS unsigned long long* o8 = (GAS unsigned long long*)orow + lane;
#pragma unroll
    for (int j = 0; j < 4; ++j) o8[64 * j] = (unsigned long long)pk2(v[j].x, v[j].y) | ((unsigned long long)pk2(v[j].z, v[j].w) << 32);
}
__device__ __forceinline__ void store_f32_row(float* orow, const f32x4 (&v)[4], int lane) { GAS f32x4* o = (GAS f32x4*)orow + lane;
#pragma unroll
    for (int j = 0; j < 4; ++j) o[64 * j] = v[j]; }
__device__ __forceinline__ void ln_row(f32x4 (&v)[4], const f32x4 (&g)[4], const f32x4 (&b)[4]) {
    float s = 0.f;
#pragma unroll
    for (int j = 0; j < 4; ++j) s += (v[j].x + v[j].y) + (v[j].z + v[j].w);
    const float mean = wave_sum(s) * (1.f / DMODEL); float s2 = 0.f;
#pragma unroll
    for (int j = 0; j < 4; ++j) { v[j] = v[j] - mean; s2 += (v[j].x * v[j].x + v[j].y * v[j].y) + (v[j].z * v[j].z + v[j].w * v[j].w); }
    const float rstd = 1.f / sqrtf(wave_sum(s2) * (1.f / DMODEL) + LN_EPS);
#pragma unroll
    for (int j = 0; j < 4; ++j) v[j] = v[j] * rstd * g[j] + b[j];
}
__device__ __forceinline__ void p_modulate(Frame& F, const float* x, const float* mod  , bf16* H) {
    const int gw = F.vcu * NWAVES + F.wave, NGW = F.G * NWAVES;
    f32x4 sh[4], sc[4]; load4(sh, mod, F.lane); load4(sc, mod + 1024, F.lane);
    for (int m = gw; m < M; m += NGW) { f32x4 v[4]; load4(v, x + (size_t)m * DMODEL, F.lane);
#pragma unroll
        for (int j = 0; j < 4; ++j) v[j] = v[j] * (sc[j] + 1.0f) + sh[j];
        store_bf16_row(H + (size_t)m * DMODEL, v, F.lane); }
}
template <bool ROUTE> __device__ __forceinline__ void p_ln(Frame& F, float* xio, const float* lg, const float* lb, const float* mod, bf16* H, const float* rw) {
    const int gw = F.vcu * NWAVES + F.wave, NGW = F.G * NWAVES;
    f32x4 g[4], b[4], sh[4], sc[4]; load4(g, lg, F.lane); load4(b, lb, F.lane);
    if (mod) { load4(sh, mod, F.lane); load4(sc, mod + 1024, F.lane); }
    LAS float* rwT = (LAS float*)(F.lds + RING_OFF);
    LAS int* lcnt = (LAS int*)(F.lds + RING_OFF + 32768);
    LAS int* rinfo = (LAS int*)(F.lds + RING_OFF + 32768 + 256) + F.wave * 64;
    if (ROUTE) {
        for (int i = F.tid; i < 8192; i += NWAVES * 64) { const int k = i >> 3, e = i & 7; rwT[e * 1024 + k] = rw[i]; }
        if (F.tid < 16) lcnt[F.tid] = 0;
        __syncthreads();
    }
    int nr = 0;
    for (int m = gw; m < M; m += NGW) { f32x4 v[4]; load4(v, xio + (size_t)m * DMODEL, F.lane);
        ln_row(v, g, b);
        store_f32_row(xio + (size_t)m * DMODEL, v, F.lane);
        if (mod) {
#pragma unroll
            for (int j = 0; j < 4; ++j) v[j] = v[j] * (sc[j] + 1.0f) + sh[j];
            store_bf16_row(H + (size_t)m * DMODEL, v, F.lane);
        }
        if (ROUTE) {
            float lgt[8];
#pragma unroll
            for (int e = 0; e < 8; ++e) { float s = 0.f;
#pragma unroll
                for (int j = 0; j < 4; ++j) { const f32x4 w = *(const LAS f32x4*)(rwT + e * 1024 + 256 * j + 4 * F.lane); s += (v[j].x * w.x + v[j].y * w.y) + (v[j].z * w.z + v[j].w * w.w); }
                lgt[e] = wave_sum(s); }
            int e0 = 0; float v0 = lgt[0];
#pragma unroll
            for (int e = 1; e < 8; ++e) if (lgt[e] > v0) { v0 = lgt[e]; e0 = e; }
            int e1 = -1; float v1 = -INFINITY;
#pragma unroll
            for (int e = 0; e < 8; ++e) if (e != e0 && (e1 < 0 || lgt[e] > v1)) { v1 = lgt[e]; e1 = e; }
            const float g0 = 1.0f / (1.0f + __expf(v1 - v0));
            if (F.lane == 0) { const int p0 = atomicAdd((int*)&lcnt[e0], 1), p1 = atomicAdd((int*)&lcnt[e1], 1);
                rinfo[nr * 8 + 0] = m; rinfo[nr * 8 + 1] = e0; rinfo[nr * 8 + 2] = e1; rinfo[nr * 8 + 3] = p0; rinfo[nr * 8 + 4] = p1; rinfo[nr * 8 + 5] = __float_as_int(g0); }
            ++nr;
        }
    }
    if (ROUTE) {
        __syncthreads();
        if (F.tid < 8) lcnt[8 + F.tid] = (int)__hip_atomic_fetch_add((unsigned*)(F.ctl + CW_CNT + 64 * F.tid), (unsigned)lcnt[F.tid], __ATOMIC_RELAXED, __HIP_MEMORY_SCOPE_AGENT);
        __syncthreads();
        int* perm = (int*)(F.ws + WS_SMALL + SM_PERM); int* tok = (int*)(F.ws + WS_SMALL + SM_TOK);
        if (F.lane == 0) for (int i = 0; i < nr; ++i) { const int m = rinfo[i * 8 + 0], e0 = rinfo[i * 8 + 1], e1 = rinfo[i * 8 + 2];
            const int p0 = lcnt[8 + e0] + rinfo[i * 8 + 3], p1 = lcnt[8 + e1] + rinfo[i * 8 + 4];
            perm[e0 * SEQ + p0] = m; perm[e1 * SEQ + p1] = m;
            tok[m * 4 + 0] = e0 | (e1 << 8); tok[m * 4 + 1] = p0; tok[m * 4 + 2] = p1; tok[m * 4 + 3] = rinfo[i * 8 + 5]; }
    }
}
__device__ __forceinline__ void p_ln_moe(Frame& F, float* xio, const float* lg, const float* lb, const float* g2v) {
    const int gw = F.vcu * NWAVES + F.wave, NGW = F.G * NWAVES;
    f32x4 g[4], b[4], gg[4]; load4(g, lg, F.lane); load4(b, lb, F.lane); load4(gg, g2v, F.lane);
    int tb[8]; { int acc = 0;
#pragma unroll
        for (int e = 0; e < 8; ++e) { tb[e] = acc; acc += ((int)__hip_atomic_load(F.ctl + CW_CNT + 64 * e, RLX_AGENT) + 255) >> 8; } }
    const int* tok = (const int*)(F.ws + WS_SMALL + SM_TOK); const bf16* Y = (const bf16*)(F.ws + WS_YSLOT);
    for (int m = gw; m < M; m += NGW) {
        const int ee = tok[m * 4 + 0], p0 = tok[m * 4 + 1], p1 = tok[m * 4 + 2]; const float g0 = __int_as_float(tok[m * 4 + 3]), g1 = 1.0f - g0;
        const int e0 = ee & 255, e1 = ee >> 8; int t0 = 0, t1 = 0;
#pragma unroll
        for (int e = 0; e < 8; ++e) { t0 = (e0 == e) ? tb[e] : t0; t1 = (e1 == e) ? tb[e] : t1; }
        const size_t s0 = (size_t)(t0 * 256 + p0), s1 = (size_t)(t1 * 256 + p1);
        f32x4 v[4]; load4(v, xio + (size_t)m * DMODEL, F.lane);
        const GAS unsigned long long* y0 = (const GAS unsigned long long*)(Y + s0 * DMODEL) + F.lane; const GAS unsigned long long* y1 = (const GAS unsigned long long*)(Y + s1 * DMODEL) + F.lane;
#pragma unroll
        for (int j = 0; j < 4; ++j) { const unsigned long long a = y0[64 * j], c = y1[64 * j];
            f32x4 f; f.x = g0 * bf2f((unsigned short)a) + g1 * bf2f((unsigned short)c); f.y = g0 * bf2f((unsigned short)(a >> 16)) + g1 * bf2f((unsigned short)(c >> 16));
            f.z = g0 * bf2f((unsigned short)(a >> 32)) + g1 * bf2f((unsigned short)(c >> 32)); f.w = g0 * bf2f((unsigned short)(a >> 48)) + g1 * bf2f((unsigned short)(c >> 48));
            v[j] = v[j] * ALPHA + (gg[j] + 1.0f) * f; }
        ln_row(v, g, b);
        store_f32_row(xio + (size_t)m * DMODEL, v, F.lane);
    }
}

__device__ __forceinline__ void hg_pass1(Frame& F, int l) {
    const bf16* P = (const bf16*)(F.ws + WS_PROJ); const float* lbs = (const float*)(F.ws + WS_SMALL + SM_LBS) + l * 256;
    float* HGS = (float*)(F.ws + WS_HGS); float* HGD = (float*)(F.ws + WS_HGD);
    LAS float* fk = (LAS float*)(F.lds + RING_OFF + F.wave * 16384);
    LAS float* vl = fk + 1024;
    const int kh = F.wave & 1;
    for (int tk = F.bid * 4 + (F.wave >> 1); tk < 1024; tk += F.G * 4) {
        const int c = tk >> 2, h = tk & 3;
        float S[32];
#pragma unroll
        for (int k = 0; k < 32; ++k) S[k] = 0.f;
        float dp = 1.f;
        for (int sb = 0; sb < 4; ++sb) {
            const int row0 = c * 64 + sb * 16;
#pragma unroll
            for (int j = 0; j < 8; ++j) { const int p = j * 64 + F.lane, tt = p >> 5, kk = p & 31, k = h * 64 + kh * 32 + kk;
                const float z = bf2f(P[(size_t)(row0 + tt) * DIN + 1792 + k]); const float lbv = lbs[k];
                const float f = lbv + (1.0f - lbv) * sigmoid_f(z), key = (1.0f - lbv) * sigmoid_f(-z);
                fk[(tt * 32 + kk) * 2] = f; fk[(tt * 32 + kk) * 2 + 1] = key; }
#pragma unroll
            for (int tt = 0; tt < 16; ++tt) vl[tt * 64 + F.lane] = silu_ff(bf2f(P[(size_t)(row0 + tt) * DIN + 2048 + h * 64 + F.lane]));
            for (int tt = 0; tt < 16; ++tt) {
                const float v = vl[tt * 64 + F.lane];
#pragma unroll
                for (int kk = 0; kk < 32; kk += 2) { const f32x4 q = *(const LAS f32x4*)(fk + (tt * 32 + kk) * 2);
                    S[kk] = q.x * S[kk] + q.y * v; S[kk + 1] = q.z * S[kk + 1] + q.w * v; }
            }
            if (F.lane < 32) {
#pragma unroll
                for (int tt = 0; tt < 16; ++tt) dp *= fk[(tt * 32 + F.lane) * 2]; }
        }
        float* Lp = HGS + ((size_t)(c * 4 + h) * 64 + kh * 32) * 64 + F.lane;
#pragma unroll
        for (int k = 0; k < 32; ++k) Lp[k * 64] = S[k];
        if (F.lane < 32) HGD[c * 256 + h * 64 + kh * 32 + F.lane] = dp;
    }
}
__device__ __forceinline__ void hg_pass2(Frame& F) {
    float* HGS = (float*)(F.ws + WS_HGS); const float* HGD = (const float*)(F.ws + WS_HGD);
    if (F.wave == 0) for (int b = F.bid; b < 256; b += F.G) {
        float carry = 0.f;
        for (int c0 = 0; c0 < 256; c0 += 16) { float Lv[16], Dv[16];
#pragma unroll
            for (int u = 0; u < 16; ++u) { Lv[u] = HGS[(size_t)(c0 + u) * 16384 + b * 64 + F.lane]; Dv[u] = HGD[(c0 + u) * 256 + b]; }
#pragma unroll
            for (int u = 0; u < 16; ++u) { HGS[(size_t)(c0 + u) * 16384 + b * 64 + F.lane] = carry; carry = Dv[u] * carry + Lv[u]; }
        }
    }
}
__device__ __forceinline__ void hg_pass3(Frame& F, int l, const float* hgg) {
    const bf16* P = (const bf16*)(F.ws + WS_PROJ); const float* lbs = (const float*)(F.ws + WS_SMALL + SM_LBS) + l * 256;
    const float* HGS = (const float*)(F.ws + WS_HGS); bf16* MIX = (bf16*)(F.ws + WS_MIX);
    LAS float* fk = (LAS float*)(F.lds + RING_OFF + F.wave * 16384);
    LAS float* vl = fk + 2048;
    LAS float* op = fk + 3072;
    LAS float* opp = (LAS float*)(F.lds + RING_OFF + (F.wave ^ 1) * 16384) + 3072;
    const int kh = F.wave & 1; const float gn = hgg[F.lane];
    for (int tk0 = F.bid * 4; tk0 < 1024; tk0 += F.G * 4) {
        const int tk = tk0 + (F.wave >> 1); const int c = tk >> 2, h = tk & 3;
        float S[32];
        { const float* Sp = HGS + ((size_t)(c * 4 + h) * 64 + kh * 32) * 64 + F.lane;
#pragma unroll
          for (int k = 0; k < 32; ++k) S[k] = Sp[k * 64]; }
        for (int sb = 0; sb < 4; ++sb) {
            const int row0 = c * 64 + sb * 16;
#pragma unroll
            for (int j = 0; j < 8; ++j) { const int p = j * 64 + F.lane, tt = p >> 5, kk = p & 31, k = h * 64 + kh * 32 + kk;
                const float z = bf2f(P[(size_t)(row0 + tt) * DIN + 1792 + k]); const float qv = bf2f(P[(size_t)(row0 + tt) * DIN + 1536 + k]); const float lbv = lbs[k];
                const float f = lbv + (1.0f - lbv) * sigmoid_f(z), key = (1.0f - lbv) * sigmoid_f(-z);
                *(LAS f32x4*)(fk + (tt * 32 + kk) * 4) = (f32x4){f, key, qv, 0.f}; }
#pragma unroll
            for (int tt = 0; tt < 16; ++tt) vl[tt * 64 + F.lane] = silu_ff(bf2f(P[(size_t)(row0 + tt) * DIN + 2048 + h * 64 + F.lane]));
            for (int tt = 0; tt < 16; ++tt) {
                const float v = vl[tt * 64 + F.lane]; float o = 0.f;
#pragma unroll
                for (int kk = 0; kk < 32; ++kk) { const f32x4 q = *(const LAS f32x4*)(fk + (tt * 32 + kk) * 4);
                    S[kk] = q.x * S[kk] + q.y * v; o += q.z * S[kk]; }
                op[tt * 64 + F.lane] = o;
            }
            __syncthreads();
#pragma unroll
            for (int t8 = 0; t8 < 8; ++t8) { const int tt = kh * 8 + t8; const float o = op[tt * 64 + F.lane] + opp[tt * 64 + F.lane];
                const float ss = wave_sum(o * o); const float rstd = 1.0f / sqrtf(ss * (1.0f / 64.0f) + LN_EPS);
                const float gt = bf2f(P[(size_t)(row0 + tt) * DIN + 2304 + h * 64 + F.lane]);
                MIX[(size_t)(row0 + tt) * DMODEL + 512 + h * 64 + F.lane] = (bf16)f2bf(o * rstd * gn * silu_ff(gt)); }
            __syncthreads();
        }
    }
}
__device__ __forceinline__ void pool_phase(Frame& F, const float* pw, const float* ps) {
    const bf16* P = (const bf16*)(F.ws + WS_PROJ); bf16* MIX = (bf16*)(F.ws + WS_MIX);
    LAS float* U = (LAS float*)(F.lds + RING_OFF + F.wave * 16384);
    LAS float* PL = U + 2048;
    const int gw = F.vcu * NWAVES + F.wave, NGW = F.G * NWAVES;
    for (int task = gw; task < 4096; task += NGW) {
        const int tg = task >> 2, gi = task & 3, t0 = tg * 16, win = 2 << gi;
        float wcol[64];
#pragma unroll
        for (int c = 0; c < 64; ++c) wcol[c] = pw[(size_t)(gi * 64 + c) * 64 + F.lane];
        const float scl = ps[gi * 64 + F.lane];
        for (int r = 0; r < 31; ++r) { const int t = t0 - 15 + r; U[r * 64 + F.lane] = (t >= 0) ? bf2f(P[(size_t)t * DIN + 2560 + gi * 64 + F.lane]) : 0.f; }
        for (int tt = 0; tt < 16; ++tt) { float s = 0.f;
            for (int j = 0; j < win; ++j) s += U[(15 + tt - j) * 64 + F.lane];
            const int t = t0 + tt; const float cntw = (float)((t + 1 < win) ? (t + 1) : win);
            PL[tt * 64 + F.lane] = s / cntw - U[(15 + tt) * 64 + F.lane]; }
        for (int tt = 0; tt < 16; ++tt) { float acc = 0.f;
#pragma unroll
            for (int c = 0; c < 64; c += 4) { const f32x4 p4 = *(const LAS f32x4*)(PL + tt * 64 + c);
                acc += p4.x * wcol[c]; acc += p4.y * wcol[c + 1]; acc += p4.z * wcol[c + 2]; acc += p4.w * wcol[c + 3]; }
            MIX[(size_t)(t0 + tt) * DMODEL + 768 + gi * 64 + F.lane] = (bf16)f2bf(acc * scl); }
    }
}
__device__ __forceinline__ void moe_gather(Frame& F) {
    const int gw = F.vcu * NWAVES + F.wave, NGW = F.G * NWAVES;
    int cn[8], tb[9]; tb[0] = 0;
#pragma unroll
    for (int e = 0; e < 8; ++e) { cn[e] = (int)__hip_atomic_load(F.ctl + CW_CNT + 64 * e, RLX_AGENT); tb[e + 1] = tb[e] + ((cn[e] + 255) >> 8); }
    const int* perm = (const int*)(F.ws + WS_SMALL + SM_PERM); const bf16* H = (const bf16*)(F.ws + WS_HBUF); bf16* HP = (bf16*)(F.ws + WS_HPERM);
    for (int slot = gw; slot < tb[8] * 256; slot += NGW) {
        const int T = slot >> 8; int e = 0, tbe = 0, ce = cn[0];
#pragma unroll
        for (int j = 1; j < 8; ++j) if (T >= tb[j]) { e = j; tbe = tb[j]; ce = cn[j]; }
        const int pos = ((T - tbe) << 8) + (slot & 255);
        const int tokn = (pos < ce) ? perm[e * SEQ + pos] : 0;
        const GAS v4u* src = (const GAS v4u*)(H + (size_t)tokn * DMODEL) + F.lane; GAS v4u* dst = (GAS v4u*)(HP + (size_t)slot * DMODEL) + F.lane;
        const v4u a = src[0], b = src[64]; dst[0] = a; dst[64] = b;
    }
}
__device__ __forceinline__ void attn_finalize(Frame& F, int l, const float* ag) {
    const bf16* O1 = (const bf16*)(F.ws + WS_ATTNO); const bf16* O2 = O1 + (size_t)SEQ * 512; bf16* MIX = (bf16*)(F.ws + WS_MIX);
    const float* lamv = (const float*)(F.ws + WS_SMALL + SM_LAM); const float lam = lamv[l], osc = 1.0f - lamv[2 + l];
    const int gw = F.vcu * NWAVES + F.wave, NGW = F.G * NWAVES;
    float gv[8];
#pragma unroll
    for (int j = 0; j < 8; ++j) gv[j] = ag[(F.lane & 15) * 8 + j] * osc;
    for (int m = gw; m < M; m += NGW) {
        const v4u a = *(const GAS v4u*)(O1 + (size_t)m * 512 + F.lane * 8), b = *(const GAS v4u*)(O2 + (size_t)m * 512 + F.lane * 8);
        float d[8];
        d[0] = __uint_as_float(a.x << 16) - lam * __uint_as_float(b.x << 16); d[1] = __uint_as_float(a.x & 0xffff0000u) - lam * __uint_as_float(b.x & 0xffff0000u);
        d[2] = __uint_as_float(a.y << 16) - lam * __uint_as_float(b.y << 16); d[3] = __uint_as_float(a.y & 0xffff0000u) - lam * __uint_as_float(b.y & 0xffff0000u);
        d[4] = __uint_as_float(a.z << 16) - lam * __uint_as_float(b.z << 16); d[5] = __uint_as_float(a.z & 0xffff0000u) - lam * __uint_as_float(b.z & 0xffff0000u);
        d[6] = __uint_as_float(a.w << 16) - lam * __uint_as_float(b.w << 16); d[7] = __uint_as_float(a.w & 0xffff0000u) - lam * __uint_as_float(b.w & 0xffff0000u);
        float ss = 0.f;
#pragma unroll
        for (int j = 0; j < 8; ++j) ss += d[j] * d[j];
        ss += swzx<1>(ss); ss += swzx<2>(ss); ss += swzx<4>(ss); ss += swzx<8>(ss);
        const float rstd = 1.0f / sqrtf(ss * (1.0f / 128.0f) + LN_EPS);
        v4u o; o.x = pk2(d[0] * rstd * gv[0], d[1] * rstd * gv[1]); o.y = pk2(d[2] * rstd * gv[2], d[3] * rstd * gv[3]);
        o.z = pk2(d[4] * rstd * gv[4], d[5] * rstd * gv[5]); o.w = pk2(d[6] * rstd * gv[6], d[7] * rstd * gv[7]);
        *(GAS v4u*)(MIX + (size_t)m * DMODEL + F.lane * 8) = o;
    }
}

typedef float f32x16v __attribute__((ext_vector_type(16)));
typedef __bf16 bf16x2v __attribute__((ext_vector_type(2)));
typedef float f32x2v_ __attribute__((ext_vector_type(2)));
typedef short s16x4v __attribute__((ext_vector_type(4)));
__device__ __forceinline__ int crow16(int i, int hh) { return (i & 3) + 8 * (i >> 2) + 4 * hh; }
__device__ __forceinline__ unsigned pkbf(float lo, float hi) { f32x2v_ v = {lo, hi}; bf16x2v b = __builtin_convertvector(v, bf16x2v); return __builtin_bit_cast(unsigned, b); }
__device__ __forceinline__ bf16x8 pk8(const float (&x)[8]) { v4u w; w.x = pkbf(x[0], x[1]); w.y = pkbf(x[2], x[3]); w.z = pkbf(x[4], x[5]); w.w = pkbf(x[6], x[7]); return __builtin_bit_cast(bf16x8, w); }
__device__ __forceinline__ void unpk8(const v4u w, float (&x)[8]) {
    x[0] = __uint_as_float(w.x << 16); x[1] = __uint_as_float(w.x & 0xffff0000u); x[2] = __uint_as_float(w.y << 16); x[3] = __uint_as_float(w.y & 0xffff0000u);
    x[4] = __uint_as_float(w.z << 16); x[5] = __uint_as_float(w.z & 0xffff0000u); x[6] = __uint_as_float(w.w << 16); x[7] = __uint_as_float(w.w & 0xffff0000u); }
#define MFMA32(a, b, c) __builtin_amdgcn_mfma_f32_32x32x16_bf16((a), (b), (c), 0, 0, 0)
constexpr int HG_LDS = 26624, VT_PITCH = 72;
constexpr float HG_CLAMP = 80.0f;

__device__ __forceinline__ void hg_build_vt(LAS bf16* VT, const GAS bf16* P, int row0, int h, int lane) {
    const GAS bf16* vp = P + (size_t)row0 * DIN + 2048 + h * 64 + lane;
    for (int t0 = 0; t0 < 64; t0 += 16) { bf16 vr[16];
#pragma unroll
        for (int j = 0; j < 16; ++j) vr[j] = vp[(size_t)(t0 + j) * DIN];
#pragma unroll
        for (int t8 = 0; t8 < 2; ++t8) { float x[8];
#pragma unroll
            for (int j = 0; j < 8; ++j) x[j] = silu_ff(bf2f(vr[t8 * 8 + j]));
            *(LAS bf16x8*)(VT + lane * VT_PITCH + t0 + t8 * 8) = pk8(x); } }
}
__device__ __forceinline__ void hg_pass1_mfma(Frame& F, int l) {
    const GAS bf16* P = (const GAS bf16*)(F.ws + WS_PROJ); const GAS float* lbs = (const GAS float*)(F.ws + WS_SMALL + SM_LBS) + l * 256;
    GAS float* HGS = (GAS float*)(F.ws + WS_HGS); GAS float* HGD = (GAS float*)(F.ws + WS_HGD);
    if (F.wave >= 4) return;
    LAS bf16* KH = (LAS bf16*)(F.lds + RING_OFF + F.wave * HG_LDS);
    LAS bf16* VT = KH + 64 * VT_PITCH;
    const int lane = F.lane, r = lane & 31, hh = lane >> 5;
    for (int tk = F.bid * 4 + F.wave; tk < 1024; tk += F.G * 4) {
        const int c = tk >> 2, h = tk & 3, row0 = c * 64;
        const float lbv = lbs[h * 64 + lane];
        const GAS bf16* zp = P + (size_t)row0 * DIN + 1792 + h * 64 + lane;
        float b = 0.f;
        for (int t0 = 0; t0 < 64; t0 += 16) { bf16 zr[16];
#pragma unroll
            for (int j = 0; j < 16; ++j) zr[j] = zp[(size_t)(t0 + j) * DIN];
#pragma unroll
            for (int j = 0; j < 16; ++j) { const float f = lbv + (1.0f - lbv) * sigmoid_f(bf2f(zr[j])); b += (0.6931471805599453f * __builtin_amdgcn_logf(fmaxf(f, 1e-30f))); } }
        float bt = 0.f;
        for (int t0 = 0; t0 < 64; t0 += 16) { bf16 zr[16];
#pragma unroll
            for (int j = 0; j < 16; ++j) zr[j] = zp[(size_t)(t0 + j) * DIN];
#pragma unroll
            for (int t8 = 0; t8 < 2; ++t8) { float x[8];
#pragma unroll
                for (int j = 0; j < 8; ++j) { const float z = bf2f(zr[t8 * 8 + j]); const float f = lbv + (1.0f - lbv) * sigmoid_f(z); bt += (0.6931471805599453f * __builtin_amdgcn_logf(fmaxf(f, 1e-30f)));
                    x[j] = (1.0f - lbv) * sigmoid_f(-z) * __expf(b - bt); }
                *(LAS bf16x8*)(KH + lane * VT_PITCH + t0 + t8 * 8) = pk8(x); } }
        HGD[c * 256 + h * 64 + lane] = __expf(b);
        hg_build_vt(VT, P, row0, h, lane);
#pragma unroll
        for (int kb = 0; kb < 2; ++kb)
#pragma unroll
            for (int vb = 0; vb < 2; ++vb) { f32x16v acc = {};
#pragma unroll
                for (int ss = 0; ss < 4; ++ss) { const bf16x8 a = *(const LAS bf16x8*)(KH + (32 * kb + r) * VT_PITCH + 16 * ss + 8 * hh); const bf16x8 bq = *(const LAS bf16x8*)(VT + (32 * vb + r) * VT_PITCH + 16 * ss + 8 * hh);
                    acc = MFMA32(a, bq, acc); }
                GAS float* Lp = HGS + ((size_t)(c * 4 + h) * 64 + 32 * kb) * 64 + 32 * vb + r;
#pragma unroll
                for (int i = 0; i < 16; ++i) Lp[crow16(i, hh) * 64] = acc[i]; }
    }
}
__device__ __forceinline__ void hg_pass3_mfma(Frame& F, int l, const float* hgg) {
    const GAS bf16* P = (const GAS bf16*)(F.ws + WS_PROJ); const GAS float* lbs = (const GAS float*)(F.ws + WS_SMALL + SM_LBS) + l * 256;
    const GAS float* HGS = (const GAS float*)(F.ws + WS_HGS); GAS bf16* MIX = (GAS bf16*)(F.ws + WS_MIX); const GAS float* hgg_g = (const GAS float*)hgg;
    if (F.wave >= 4) return;
    LAS float* BL = (LAS float*)(F.lds + RING_OFF + F.wave * HG_LDS);
    LAS bf16* VT = (LAS bf16*)(BL + 4096);
    LAS float* R1 = (LAS float*)(VT + 64 * VT_PITCH);
    const int lane = F.lane, r = lane & 31, hh = lane >> 5;
    for (int tk = F.bid * 4 + F.wave; tk < 1024; tk += F.G * 4) {
        const int c = tk >> 2, h = tk & 3, row0 = c * 64;
        { const float lbv = lbs[h * 64 + lane]; float b = 0.f; const GAS bf16* zp = P + (size_t)row0 * DIN + 1792 + h * 64 + lane;
          for (int t0 = 0; t0 < 64; t0 += 16) { bf16 zr[16];
#pragma unroll
              for (int j = 0; j < 16; ++j) zr[j] = zp[(size_t)(t0 + j) * DIN];
#pragma unroll
              for (int j = 0; j < 16; ++j) { const float f = lbv + (1.0f - lbv) * sigmoid_f(bf2f(zr[j])); b += (0.6931471805599453f * __builtin_amdgcn_logf(fmaxf(f, 1e-30f))); BL[(t0 + j) * 64 + lane] = b; }
              if (t0 == 16) R1[lane] = b; } }
        hg_build_vt(VT, P, row0, h, lane);
        bf16x8 Qt[2][4], Qh1[4];
#pragma unroll
        for (int tb = 0; tb < 2; ++tb)
#pragma unroll
            for (int ks = 0; ks < 4; ++ks) { const int t = 32 * tb + r, k0 = 16 * ks + 8 * hh; float q[8], e[8];
                unpk8(*(const GAS v4u*)(P + (size_t)(row0 + t) * DIN + 1536 + h * 64 + k0), q);
                const f32x4 b0 = *(const LAS f32x4*)(BL + t * 64 + k0), b1 = *(const LAS f32x4*)(BL + t * 64 + k0 + 4);
                e[0] = b0.x; e[1] = b0.y; e[2] = b0.z; e[3] = b0.w; e[4] = b1.x; e[5] = b1.y; e[6] = b1.z; e[7] = b1.w;
                if (tb == 1) { const f32x4 r0 = *(const LAS f32x4*)(R1 + k0), r1 = *(const LAS f32x4*)(R1 + k0 + 4); const float rr[8] = {r0.x, r0.y, r0.z, r0.w, r1.x, r1.y, r1.z, r1.w}; float qh[8];
#pragma unroll
                    for (int j = 0; j < 8; ++j) { q[j] *= __expf(e[j] - rr[j]); qh[j] = q[j] * __expf(rr[j]); }
                    Qh1[ks] = pk8(qh);
                } else {
#pragma unroll
                    for (int j = 0; j < 8; ++j) q[j] *= __expf(e[j]);
                }
                Qt[tb][ks] = pk8(q); }
        f32x16v X00 = {}, X01 = {}, X11 = {};
#pragma unroll
        for (int ks = 0; ks < 4; ++ks) { const int k0 = 16 * ks + 8 * hh;
            const f32x4 l0 = *(const GAS f32x4*)(lbs + h * 64 + k0), l1 = *(const GAS f32x4*)(lbs + h * 64 + k0 + 4); const float lb8[8] = {l0.x, l0.y, l0.z, l0.w, l1.x, l1.y, l1.z, l1.w};
            const f32x4 r0 = *(const LAS f32x4*)(R1 + k0), r1 = *(const LAS f32x4*)(R1 + k0 + 4); const float rr[8] = {r0.x, r0.y, r0.z, r0.w, r1.x, r1.y, r1.z, r1.w};
            float key[8], bs[8], x0[8], x1[8];
            unpk8(*(const GAS v4u*)(P + (size_t)(row0 + r) * DIN + 1792 + h * 64 + k0), key);
            { const f32x4 b0 = *(const LAS f32x4*)(BL + r * 64 + k0), b1 = *(const LAS f32x4*)(BL + r * 64 + k0 + 4); bs[0] = b0.x; bs[1] = b0.y; bs[2] = b0.z; bs[3] = b0.w; bs[4] = b1.x; bs[5] = b1.y; bs[6] = b1.z; bs[7] = b1.w; }
#pragma unroll
            for (int j = 0; j < 8; ++j) { const float ky = (1.0f - lb8[j]) * sigmoid_f(-key[j]); x0[j] = ky * __expf(fminf(-bs[j], HG_CLAMP)); x1[j] = ky * __expf(rr[j] - bs[j]); }
            X00 = MFMA32(pk8(x0), Qt[0][ks], X00);
            X01 = MFMA32(pk8(x1), Qt[1][ks], X01);
            unpk8(*(const GAS v4u*)(P + (size_t)(row0 + 32 + r) * DIN + 1792 + h * 64 + k0), key);
            { const f32x4 b0 = *(const LAS f32x4*)(BL + (32 + r) * 64 + k0), b1 = *(const LAS f32x4*)(BL + (32 + r) * 64 + k0 + 4); bs[0] = b0.x; bs[1] = b0.y; bs[2] = b0.z; bs[3] = b0.w; bs[4] = b1.x; bs[5] = b1.y; bs[6] = b1.z; bs[7] = b1.w; }
#pragma unroll
            for (int j = 0; j < 8; ++j) { const float ky = (1.0f - lb8[j]) * sigmoid_f(-key[j]); x1[j] = ky * __expf(fminf(rr[j] - bs[j], HG_CLAMP)); }
            X11 = MFMA32(pk8(x1), Qt[1][ks], X11);
        }
#pragma unroll
        for (int i = 0; i < 16; ++i) { const bool keep = crow16(i, hh) <= r; X00[i] = keep ? X00[i] : 0.f; X11[i] = keep ? X11[i] : 0.f; }
        f32x16v O[2][2] = {};
#pragma unroll
        for (int sp = 0; sp < 2; ++sp) {
            float p[8]; bf16x8 P00, P01, P11;
#pragma unroll
            for (int j = 0; j < 8; ++j) p[j] = X00[8 * sp + j]; P00 = pk8(p);
#pragma unroll
            for (int j = 0; j < 8; ++j) p[j] = X01[8 * sp + j]; P01 = pk8(p);
#pragma unroll
            for (int j = 0; j < 8; ++j) p[j] = X11[8 * sp + j]; P11 = pk8(p);
#pragma unroll
            for (int vb = 0; vb < 2; ++vb) {
                const LAS bf16* vrow = VT + (32 * vb + r) * VT_PITCH + 16 * sp + 4 * hh;
                const s16x4v a0 = *(const LAS s16x4v*)(vrow), a1 = *(const LAS s16x4v*)(vrow + 8);
                const s16x4v c0 = *(const LAS s16x4v*)(vrow + 32), c1 = *(const LAS s16x4v*)(vrow + 40);
                const bf16x8 V0 = (bf16x8){a0[0], a0[1], a0[2], a0[3], a1[0], a1[1], a1[2], a1[3]}, V1 = (bf16x8){c0[0], c0[1], c0[2], c0[3], c1[0], c1[1], c1[2], c1[3]};
                O[0][vb] = MFMA32(P00, V0, O[0][vb]);
                O[1][vb] = MFMA32(P01, V0, O[1][vb]);
                O[1][vb] = MFMA32(P11, V1, O[1][vb]);
            }
        }
#pragma unroll
        for (int ks = 0; ks < 4; ++ks)
#pragma unroll
            for (int vb = 0; vb < 2; ++vb) { float sv[8]; const GAS float* Sp = HGS + ((size_t)(c * 4 + h) * 64 + 16 * ks + 8 * hh) * 64 + 32 * vb + r;
#pragma unroll
                for (int j = 0; j < 8; ++j) sv[j] = Sp[j * 64];
                const bf16x8 sf = pk8(sv);
                O[0][vb] = MFMA32(Qt[0][ks], sf, O[0][vb]);
                O[1][vb] = MFMA32(Qh1[ks], sf, O[1][vb]); }
        const float gn0 = hgg_g[r], gn1 = hgg_g[32 + r];
#pragma unroll
        for (int tb = 0; tb < 2; ++tb) {
            bf16 gr[16][2]; float rs[16];
#pragma unroll
            for (int i = 0; i < 16; ++i) { const GAS bf16* gp = P + (size_t)(row0 + 32 * tb + crow16(i, hh)) * DIN + 2304 + h * 64 + r; gr[i][0] = gp[0]; gr[i][1] = gp[32]; }
#pragma unroll
            for (int i = 0; i < 16; ++i) { const float o0 = O[tb][0][i], o1 = O[tb][1][i]; rs[i] = o0 * o0 + o1 * o1; }
#pragma unroll
            for (int i = 0; i < 16; ++i) rs[i] += swzx<1>(rs[i]);
#pragma unroll
            for (int i = 0; i < 16; ++i) rs[i] += swzx<2>(rs[i]);
#pragma unroll
            for (int i = 0; i < 16; ++i) rs[i] += swzx<4>(rs[i]);
#pragma unroll
            for (int i = 0; i < 16; ++i) rs[i] += swzx<8>(rs[i]);
#pragma unroll
            for (int i = 0; i < 16; ++i) rs[i] += swzx<16>(rs[i]);
#pragma unroll
            for (int i = 0; i < 16; ++i) { const int t = 32 * tb + crow16(i, hh); const float rstd = __builtin_amdgcn_rsqf(rs[i] * (1.0f / 64.0f) + LN_EPS);
                GAS bf16* op = MIX + (size_t)(row0 + t) * DMODEL + 512 + h * 64 + r;
                op[0] = (bf16)f2bf(O[tb][0][i] * rstd * gn0 * silu_ff(bf2f(gr[i][0]))); op[32] = (bf16)f2bf(O[tb][1][i] * rstd * gn1 * silu_ff(bf2f(gr[i][1]))); }
        }
    }
}
__device__ __forceinline__ void pool_mfma(Frame& F, const float* pw, const float* ps) {
    const GAS bf16* P = (const GAS bf16*)(F.ws + WS_PROJ); GAS bf16* MIX = (GAS bf16*)(F.ws + WS_MIX); const GAS float* pwg = (const GAS float*)pw; const GAS float* psg = (const GAS float*)ps;
    LAS float* ZL = (LAS float*)(F.lds + RING_OFF + F.wave * 12288);
    const int lane = F.lane, r = lane & 31, hh = lane >> 5, gi = F.wave >> 1, db = F.wave & 1, win = 2 << gi;
    bf16x8 wf[4];
#pragma unroll
    for (int ks = 0; ks < 4; ++ks) { float x[8];
#pragma unroll
        for (int j = 0; j < 8; ++j) x[j] = pwg[(size_t)(gi * 64 + 16 * ks + 8 * hh + j) * 64 + 32 * db + r];
        wf[ks] = pk8(x); }
    const float scl = psg[gi * 64 + 32 * db + r];
    for (int tile = F.bid; tile < SEQ / 64; tile += F.G) {
        const int t0 = tile * 64 - 32;
#pragma unroll
        for (int rt = 0; rt < 3; ++rt) { f32x16v acc = {}; const int t = t0 + 32 * rt + r;
#pragma unroll
            for (int ks = 0; ks < 4; ++ks) { v4u a = {0u, 0u, 0u, 0u}; if (t >= 0) a = *(const GAS v4u*)(P + (size_t)t * DIN + 2560 + gi * 64 + 16 * ks + 8 * hh);
                acc = MFMA32(__builtin_bit_cast(bf16x8, a), wf[ks], acc); }
#pragma unroll
            for (int i = 0; i < 16; ++i) ZL[(32 * rt + crow16(i, hh)) * 32 + r] = acc[i]; }
        const int tl0 = 32 + 32 * hh; float s = 0.f;
        for (int j = 1; j < win; ++j) s += ZL[(tl0 - j) * 32 + r];
        for (int tt = 0; tt < 32; ++tt) { const int tl = tl0 + tt; const float zc = ZL[tl * 32 + r]; s += zc;
            const int tg = t0 + tl; const float cntw = (float)((tg + 1 < win) ? (tg + 1) : win);
            MIX[(size_t)tg * DMODEL + 768 + gi * 64 + 32 * db + r] = (bf16)f2bf((s / cntw - zc) * scl);
            s -= ZL[(tl - win + 1) * 32 + r]; }
    }
}
#ifndef DIS
#define DIS 0
#endif
#ifndef DUP
#define DUP 0
#endif
#ifndef ATTN_B
#define ATTN_B 1
#endif
#ifndef HG_MFMA
#define HG_MFMA 1
#endif
#ifndef POOL_MFMA
#define POOL_MFMA 1
#endif
#if HG_MFMA
#define HG1 hg_pass1_mfma
#define HG3 hg_pass3_mfma
#else
#define HG1 hg_pass1
#define HG3 hg_pass3
#endif
#if POOL_MFMA
#define POOLF pool_mfma
#else
#define POOLF pool_phase
#endif
#define RELOAD_ARGS() do { asm volatile("" : "+s"(argp), "+s"(F.ws), "+s"(F.ctl), "+s"(bar.bar), "+s"(bar.x), "+s"(F.G), "+s"(F.vcu), "+s"(F.bid)); { unsigned z_ = 0u; asm volatile("" : "+s"(z_)); F.lane = (int)__builtin_amdgcn_mbcnt_hi(~0u, __builtin_amdgcn_mbcnt_lo(~0u, z_)); } asm volatile("" : "+v"(F.lane)); F.tid = F.wave * 64 + F.lane; } while (0)
#define args (*argp)
__global__ void __launch_bounds__(NWAVES * 64, 2) mk_fwd(Args args_) {
    const Args* argp = (const Args*)__builtin_amdgcn_kernarg_segment_ptr();
    extern __shared__ __attribute__((aligned(16))) unsigned char lds[];
    Frame F;
    F.lds = (LAS unsigned char*)lds;
    F.MISC = (volatile LAS unsigned*)(F.lds + MISC_OFF);
    F.tid = threadIdx.x; F.lane = F.tid & 63; F.wave = __builtin_amdgcn_readfirstlane(F.tid >> 6);
    F.G = gridDim.x; F.bid = blockIdx.x; { const int bx = blockIdx.x; F.vcu = (F.G % 8 == 0) ? (bx % 8) * (F.G / 8) + bx / 8 : bx; }
    F.ws = args.ws; F.ctl = (gu32*)(args.ws + WS_CTL);
    for (int u = F.tid; u < (LDS_BYTES - LDSCTL_OFF) / 4; u += NWAVES * 64) ((LAS unsigned*)(F.lds + LDSCTL_OFF))[u] = 0u;
    __syncthreads();
    XcdBarrier bar; bar.bar = (unsigned*)(F.ctl + CW_BAR); bar.x = 0; bar.st = nullptr;
    if (N_LAUNCHES == 1) bar = xcd_barrier_post((unsigned*)(F.ctl + CW_BAR), F.MISC + 8, F.tid);
    const int lo = (N_LAUNCHES == 1) ? 0 : args.ph_lo, hi = (N_LAUNCHES == 1) ? NPH : args.ph_hi;
#define IN(k) (lo <= (k) && (k) < hi)
#define SEAM(k) do { if (IN(k) && IN((k) + 1)) xcd_barrier(bar, F.tid); RELOAD_ARGS(); } while (0)
#define MOD ((const float*)(F.ws + WS_SMALL + SM_MOD))
#define HB ((bf16*)(F.ws + WS_HBUF))

    if (IN(0)) {
#if !(DIS&1)
        p0a_prologue(F, args);
#if (DUP&1)
            __syncthreads();
            p0a_prologue(F, args);
#endif

#endif
    } SEAM(0);
    if (IN(1)) { p_modulate(F, args.in[I_X], MOD, HB); } SEAM(1);

    for (int l = 0; l < DEPTH; ++l) {
        const int pb = 2 + NPH_LAYER * l;
#define mod (MOD + l * 6144)
#define xin ((l == 0) ? args.in[I_X] : (const float*)args.out)
        if (IN(pb + 0)) {
            pg8::Gemm g{HB, (const bf16*)(F.ws + WS_WIN) + (size_t)l * DIN * 1024, 1024}; pg8::StaticOrder S; S.init(M, DIN, F.G, F.bid);
            pg8::EpiProj E{(bf16*)(F.ws + WS_PROJ), DIN, (const float*)(F.ws + WS_ROPE), (const float*)(F.ws + WS_ROPE) + (size_t)SEQ * 32, attn_body::C2};
#if !(DIS&2)
            pg8::gemm_phase<pg8::EpiProj, pg8::StaticOrder, true>(F.lds + RING_OFF, g, S, E, F.tid);
#if (DUP&2)
            __syncthreads();
            pg8::gemm_phase<pg8::EpiProj, pg8::StaticOrder, true>(F.lds + RING_OFF, g, S, E, F.tid);
#endif

#endif
        } SEAM(pb + 0);
        if (IN(pb + 1)) {
#if !(DIS&4)
            HG1(F, l);
#if (DUP&4)
            __syncthreads();
            HG1(F, l);
#endif

#endif
            __syncthreads(); RELOAD_ARGS();
#if !(DIS&8)
            POOLF(F, args.in[I_POOLW] + (size_t)l * 4 * 64 * 64, args.in[I_POOLS] + l * 256);
#if (DUP&8)
            __syncthreads();
            POOLF(F, args.in[I_POOLW] + (size_t)l * 4 * 64 * 64, args.in[I_POOLS] + l * 256);
#endif

#endif
        } SEAM(pb + 1);
        if (IN(pb + 2)) {
#if !(DIS&16)
            hg_pass2(F);
#endif
        } SEAM(pb + 2);
        if (IN(pb + 3)) {
            const attn_body::bf16* PJ = (const attn_body::bf16*)(F.ws + WS_PROJ); attn_body::bf16* AO = (attn_body::bf16*)(F.ws + WS_ATTNO);
#if ATTN_B
            for (int rep_ = 0; rep_ < ((DUP&32) ? 2 : 1); ++rep_)
            for (int i = 0; i < 2; ++i) { const int j = i * F.G + F.vcu; if (j >= 512) break;
                const int v = j & 255, ii = j >> 8, mpi = v >> 5, s = v & 31; const int qb = (ii == 0) ? s : 63 - s;
                const int h = mpi >> 1, mp = mpi & 1;
#if !(DIS&32)
                attn_body::attn_unit2<8>(F.tid, qb, PJ + mpi * 64, PJ + 512 + mpi * 64, PJ + 1024 + h * 128, AO + (size_t)mp * SEQ * 512 + h * 128, (char*)lds + RING_OFF);
#endif
            }
#else
            for (int rep_ = 0; rep_ < ((DUP&32) ? 2 : 1); ++rep_)
            for (int i = 0; i < 4; ++i) { const int j = i * F.G + F.vcu; if (j >= 1024) break;
                const int v = j & 255, ii = j >> 8, vh = v >> 4, s = v & 15; const int qb = (ii == 0) ? s : (ii == 1) ? 31 - s : (ii == 2) ? 32 + s : 63 - s;
                const int h = vh >> 2, mp = (vh >> 1) & 1, vf = vh & 1;
#if !(DIS&32)
                attn_body::attn_unit<8>(F.tid, qb, PJ + (h * 2 + mp) * 64, PJ + 512 + (h * 2 + mp) * 64, PJ + 1024 + h * 128 + vf * 64, AO + (size_t)mp * SEQ * 512 + h * 128 + vf * 64, (char*)lds + RING_OFF);
#endif
            }
#endif
            __syncthreads(); RELOAD_ARGS();
#if !(DIS&64)
            HG3(F, l, args.in[I_HGG] + l * 64);
#if (DUP&64)
            __syncthreads();
            HG3(F, l, args.in[I_HGG] + l * 64);
#endif

#endif
        } SEAM(pb + 3);
        if (IN(pb + 4)) {
#if !(DIS&128)
            attn_finalize(F, l, args.in[I_ATTNG] + l * 128);
#if (DUP&128)
            __syncthreads();
            attn_finalize(F, l, args.in[I_ATTNG] + l * 128);
#endif

#endif
        } SEAM(pb + 4);
        if (IN(pb + 5)) {
            pg8::Gemm g{(const bf16*)(F.ws + WS_MIX), (const bf16*)(F.ws + WS_WOUT) + (size_t)l * 1024 * 1024, 1024}; pg8::StaticOrder S; S.init(M, DMODEL, F.G, F.bid);
            pg8::EpiResid E{xin, args.out, DMODEL, mod + 2048, ALPHA};
#if !(DIS&256)
            pg8::gemm_phase<pg8::EpiResid, pg8::StaticOrder, false>(F.lds + RING_OFF, g, S, E, F.tid);
#endif
        } SEAM(pb + 5);
        if (IN(pb + 6)) {
#if !(DIS&512)
            if (l & 1) p_ln<true>(F, args.out, args.in[I_LN1G] + l * 1024, args.in[I_LN1B] + l * 1024, mod + 3072, HB, args.in[I_RW] + (size_t)(l >> 1) * 1024 * 8);
#endif
#if !(DIS&1024)
            if (!(l & 1)) p_ln<false>(F, args.out, args.in[I_LN1G] + l * 1024, args.in[I_LN1B] + l * 1024, mod + 3072, HB, nullptr);
#endif
        } SEAM(pb + 6);
        if (!(l & 1)) {
            if (IN(pb + 8)) {
                pg8::Gemm g{HB, (const bf16*)(F.ws + WS_FFN13), 1024}; pg8::StaticOrder S; S.init(M, 2 * FFD, F.G, F.bid);
                pg8::EpiSwiglu E{(bf16*)(F.ws + WS_DHID), FFD};
#if !(DIS&2048)
                pg8::gemm_phase<pg8::EpiSwiglu, pg8::StaticOrder, true>(F.lds + RING_OFF, g, S, E, F.tid);
#if (DUP&2048)
            __syncthreads();
            pg8::gemm_phase<pg8::EpiSwiglu, pg8::StaticOrder, true>(F.lds + RING_OFF, g, S, E, F.tid);
#endif

#endif
            } SEAM(pb + 8);
            if (IN(pb + 9)) {
                pg8::Gemm g{(const bf16*)(F.ws + WS_DHID), (const bf16*)(F.ws + WS_FFN2), FFD}; pg8::StaticOrder S; S.init(M, DMODEL, F.G, F.bid);
                pg8::EpiResid E{args.out, args.out, DMODEL, mod + 5120, ALPHA};
#if !(DIS&4096)
                pg8::gemm_phase<pg8::EpiResid, pg8::StaticOrder, false>(F.lds + RING_OFF, g, S, E, F.tid);
#endif
            } SEAM(pb + 9);
            if (IN(pb + 10)) {
                p_ln<false>(F, args.out, args.in[I_LN2G] + l * 1024, args.in[I_LN2B] + l * 1024, (l + 1 < DEPTH) ? MOD + (l + 1) * 6144 : nullptr, HB, nullptr);
            } SEAM(pb + 10);
        } else {
            const unsigned* cnt = (const unsigned*)(F.ctl + CW_CNT);
            if (IN(pb + 7)) {
#if !(DIS&65536)
                moe_gather(F);
#if (DUP&65536)
            __syncthreads();
            moe_gather(F);
#endif

#endif
            } SEAM(pb + 7);
            if (IN(pb + 8)) {
                pg8::Gemm g{(const bf16*)(F.ws + WS_HPERM), (const bf16*)(F.ws + WS_EXP13), 1024}; pg8::MoeOrder S; S.init(cnt, 2 * EDIM / 256, F.G, F.bid);
                pg8::EpiSwiglu E{(bf16*)(F.ws + WS_HID), EDIM};
#if !(DIS&8192)
                pg8::gemm_phase<pg8::EpiSwiglu, pg8::MoeOrder, true>(F.lds + RING_OFF, g, S, E, F.tid);
#if (DUP&8192)
            __syncthreads();
            pg8::gemm_phase<pg8::EpiSwiglu, pg8::MoeOrder, true>(F.lds + RING_OFF, g, S, E, F.tid);
#endif

#endif
            } SEAM(pb + 8);
            if (IN(pb + 9)) {
                pg8::Gemm g{(const bf16*)(F.ws + WS_HID), (const bf16*)(F.ws + WS_EXP2), EDIM}; pg8::MoeOrder S; S.init(cnt, DMODEL / 256, F.G, F.bid);
                pg8::EpiBf16 E{(bf16*)(F.ws + WS_YSLOT), DMODEL};
#if !(DIS&16384)
                pg8::gemm_phase<pg8::EpiBf16, pg8::MoeOrder, true>(F.lds + RING_OFF, g, S, E, F.tid);
#if (DUP&16384)
            __syncthreads();
            pg8::gemm_phase<pg8::EpiBf16, pg8::MoeOrder, true>(F.lds + RING_OFF, g, S, E, F.tid);
#endif

#endif
            } SEAM(pb + 9);
            if (IN(pb + 10)) {
#if !(DIS&32768)
                p_ln_moe(F, args.out, args.in[I_LN2G] + l * 1024, args.in[I_LN2B] + l * 1024, mod + 5120);
#endif
            } SEAM(pb + 10);
        }
    }
#undef IN
#undef SEAM
#undef args
#undef MOD
#undef HB
#undef mod
#undef xin
}

extern "C" void kernel_launch(void* const* d_in, const int* in_sizes, int n_in, void* d_out, int out_size, void* d_ws, size_t ws_size, hipStream_t stream) {
    static int grid = 0;
    if (grid == 0) {
        if (n_in != 23 || in_sizes[0] != M * DMODEL || out_size != M * DMODEL || ws_size < WS_END) { fprintf(stderr, "kernel_launch: unexpected shapes (n_in %d, out %d, ws %zu); nothing launched\n", n_in, out_size, ws_size); grid = -1; return; }
        int dev = 0, cus = 0, per_cu = 0;
        if (hipGetDevice(&dev) != hipSuccess || hipDeviceGetAttribute(&cus, hipDeviceAttributeMultiprocessorCount, dev) != hipSuccess) { grid = -1; return; }
        if (hipFuncSetAttribute((const void*)mk_fwd, hipFuncAttributeMaxDynamicSharedMemorySize, LDS_BYTES) != hipSuccess) { fprintf(stderr, "kernel_launch: hipFuncSetAttribute failed\n"); grid = -1; return; }
        if (hipOccupancyMaxActiveBlocksPerMultiprocessor(&per_cu, (const void*)mk_fwd, NWAVES * 64, LDS_BYTES) != hipSuccess || per_cu < 1) { fprintf(stderr, "kernel_launch: occupancy query says %d\n", per_cu); }
        (void)hipGetLastError();
        grid = cus;
    }
    if (grid < 0) return;
    if (hipMemsetAsync((char*)d_ws + WS_CTL, 0, CTL_ZERO_BYTES, stream) != hipSuccess) return;
    Args a{};
    for (int i = 0; i < 23; ++i) a.in[i] = (const float*)d_in[i];
    a.out = (float*)d_out; a.ws = (unsigned char*)d_ws;
    for (int li = 0; li < N_LAUNCHES; ++li) {
        a.ph_lo = (N_LAUNCHES == 1) ? 0 : li; a.ph_hi = (N_LAUNCHES == 1) ? NPH : li + 1; a.li = li; a.pad = 0;
        hipLaunchKernelGGL(mk_fwd, dim3(grid), dim3(NWAVES * 64), LDS_BYTES, stream, a);
    }
}
```

```cpp
#define MK_N_LAUNCHES 1
#include <hip/hip_runtime.h>
#include <hip/hip_bf16.h>
#include <cstdio>
#include <cstdint>
#include <cmath>
namespace pg8 {
#define PG8_LAS __attribute__((address_space(3)))
typedef unsigned short bf16_t;
typedef short bf16x8 __attribute__((ext_vector_type(8)));
typedef float f32x4 __attribute__((ext_vector_type(4)));
typedef unsigned u32x4 __attribute__((ext_vector_type(4)));
constexpr int BM = 256, BK = 64, HALF = 128, HTB = HALF * BK * 2  , STAGE_BYTES = 8 * HTB, NXCD = 8, WGM = 8;

__host__ __device__ __forceinline__ int lds_byte(int r, int c) { const int st = (r >> 4) * 2 + (c >> 5), rr = r & 15, cc = c & 31, ob = rr * 64 + cc * 2; return st * 1024 + (ob ^ (((ob >> 9) & 1) << 5)); }
__host__ __device__ __forceinline__ void stage_rc(int b, int& R, int& C) { const int st = b / 1024, sb = b % 1024, swz = sb ^ (((sb >> 9) & 1) << 5); R = (st >> 1) * 16 + swz / 64; C = (st & 1) * 32 + (swz % 64) / 2; }
__host__ __device__ __forceinline__ int perm32(int rho) { const int n = rho >> 4, i = rho & 15; return 8 * (i >> 2) + 4 * n + (i & 3); }

struct Unit { int pm, pn, pb; };
struct Gemm { const bf16_t* A; const bf16_t* Bt; int K; };

struct StaticOrder {
    int nM, nN, nwg, G, c;
    __host__ __device__ void init(int M, int N, int G_, int c_) { nM = M / BM; nN = N / BM; nwg = nM * nN; G = G_; c = c_; }
    __host__ __device__ bool next(int i, Unit& u) const {
        const long L = (long)i * G + c; if (L >= nwg) return false;
        int wgid = (int)L; { const int q = nwg / NXCD, r = nwg % NXCD, xcd = wgid % NXCD, off = wgid / NXCD; wgid = (xcd < r ? xcd * (q + 1) : r * (q + 1) + (xcd - r) * q) + off; }
        const int nig = WGM * nN, gid = wgid / nig, fm = gid * WGM, gsz = (nM - fm) < WGM ? (nM - fm) : WGM;
        u.pm = fm + ((wgid % nig) % gsz); u.pn = (wgid % nig) / gsz; u.pb = u.pn; return true;
    }
};

struct MoeOrder {
    int tb1, tb2, tb3, tb4, tb5, tb6, tb7, tb8;
    int nN, G, c;
    __device__ __forceinline__ void init(const unsigned* cnt, int nN_, int G_, int c_) {
        tb1 = ((int)cnt[0] + 255) >> 8; tb2 = tb1 + (((int)cnt[64] + 255) >> 8); tb3 = tb2 + (((int)cnt[128] + 255) >> 8); tb4 = tb3 + (((int)cnt[192] + 255) >> 8);
        tb5 = tb4 + (((int)cnt[256] + 255) >> 8); tb6 = tb5 + (((int)cnt[320] + 255) >> 8); tb7 = tb6 + (((int)cnt[384] + 255) >> 8); tb8 = tb7 + (((int)cnt[448] + 255) >> 8);
        nN = nN_; G = G_; c = c_;
    }
    __device__ __forceinline__ bool next(int i, Unit& u) const {
        const int L = i * G + c; const int T = L / nN; if (T >= tb8) return false;
        const int pn = L - T * nN;
        const int e = (T >= tb1) + (T >= tb2) + (T >= tb3) + (T >= tb4) + (T >= tb5) + (T >= tb6) + (T >= tb7);
        u.pm = T; u.pn = pn; u.pb = e * nN + pn; return true;
    }
};

__device__ __forceinline__ unsigned cvt_pk_bf16(float lo, float hi) { unsigned r; asm volatile("v_cvt_pk_bf16_f32 %0, %1, %2" : "=v"(r) : "v"(lo), "v"(hi)); return r; }

typedef int v4i_ __attribute__((ext_vector_type(4)));
typedef int v8i_ __attribute__((ext_vector_type(8)));
typedef unsigned u32x2 __attribute__((ext_vector_type(2)));
__device__ __forceinline__ v8i_ cat8(bf16x8 lo, bf16x8 hi) { const v4i_ a = __builtin_bit_cast(v4i_, lo), b = __builtin_bit_cast(v4i_, hi); return __builtin_shufflevector(a, b, 0, 1, 2, 3, 4, 5, 6, 7); }
__device__ __forceinline__ void mfma_f8(f32x4& acc, const v8i_& a, const v8i_& b) { asm volatile("s_nop 1\n\tv_mfma_f32_16x16x128_f8f6f4 %0, %1, %2, %0" : "+v"(acc) : "v"(a), "v"(b)); }
__device__ __forceinline__ float clamp8(float x) { return __builtin_fminf(__builtin_fmaxf(x, -448.0f), 448.0f); }
__device__ __forceinline__ unsigned pk4_fp8(float a, float b, float c, float d) { int w = 0; w = __builtin_amdgcn_cvt_pk_fp8_f32(clamp8(a), clamp8(b), w, false); w = __builtin_amdgcn_cvt_pk_fp8_f32(clamp8(c), clamp8(d), w, true); return (unsigned)w; }

struct EpiBf16 {
    static constexpr bool PERM = true;
    bf16_t* O; int ldc; float sc;
    __device__ __forceinline__ void operator()(const f32x4 (&acc)[2][2][4][2], const Unit& u, int wr, int wc, int fr, int fq) const {
        const int row0 = u.pm * BM + wr * 64 + fr; const int col0 = u.pn * BM + wc * 32 + 8 * fq;
#pragma unroll
        for (int ai = 0; ai < 2; ++ai)
#pragma unroll
            for (int m = 0; m < 4; ++m) { bf16_t* rowp = O + (size_t)(row0 + ai * HALF + m * 16) * ldc + col0;
#pragma unroll
                for (int bj = 0; bj < 2; ++bj) { const f32x4 v0 = acc[ai][bj][m][0] * sc, v1 = acc[ai][bj][m][1] * sc;
                    u32x4 w; w.x = cvt_pk_bf16(v0[0], v0[1]); w.y = cvt_pk_bf16(v0[2], v0[3]); w.z = cvt_pk_bf16(v1[0], v1[1]); w.w = cvt_pk_bf16(v1[2], v1[3]);
                    *(u32x4*)(rowp + bj * HALF) = w; } }
    }
};

struct EpiProj {
    static constexpr bool PERM = true;
    bf16_t* O; int ldc; const float* cosT; const float* sinT; float qscale;
    __device__ __forceinline__ void operator()(const f32x4 (&acc)[2][2][4][2], const Unit& u, int wr, int wc, int fr, int fq) const {
        const int row0 = u.pm * BM + wr * 64 + fr; const int col0 = u.pn * BM + wc * 32 + 8 * fq;
        if (u.pn < 4) {
            const int i0 = 16 * (wc & 1) + 4 * fq; const float sc = (u.pn < 2) ? qscale : 1.0f;
#pragma unroll
            for (int ai = 0; ai < 2; ++ai)
#pragma unroll
                for (int m = 0; m < 4; ++m) { const int row = row0 + ai * HALF + m * 16; bf16_t* rowp = O + (size_t)row * ldc + col0;
                    f32x4 c4 = *(const f32x4*)(cosT + (size_t)row * 32 + i0), s4 = *(const f32x4*)(sinT + (size_t)row * 32 + i0);
                    c4 = c4 * sc; s4 = s4 * sc;
#pragma unroll
                    for (int bj = 0; bj < 2; ++bj) { const f32x4 v0 = acc[ai][bj][m][0], v1 = acc[ai][bj][m][1];
                        const float o0 = v0[0] * c4[0] - v0[1] * s4[0], o1 = v0[1] * c4[0] + v0[0] * s4[0];
                        const float o2 = v0[2] * c4[1] - v0[3] * s4[1], o3 = v0[3] * c4[1] + v0[2] * s4[1];
                        const float o4 = v1[0] * c4[2] - v1[1] * s4[2], o5 = v1[1] * c4[2] + v1[0] * s4[2];
                        const float o6 = v1[2] * c4[3] - v1[3] * s4[3], o7 = v1[3] * c4[3] + v1[2] * s4[3];
                        u32x4 w; w.x = cvt_pk_bf16(o0, o1); w.y = cvt_pk_bf16(o2, o3); w.z = cvt_pk_bf16(o4, o5); w.w = cvt_pk_bf16(o6, o7);
                        *(u32x4*)(rowp + bj * HALF) = w; } }
        } else {
#pragma unroll
            for (int ai = 0; ai < 2; ++ai)
#pragma unroll
                for (int m = 0; m < 4; ++m) { bf16_t* rowp = O + (size_t)(row0 + ai * HALF + m * 16) * ldc + col0;
#pragma unroll
                    for (int bj = 0; bj < 2; ++bj) { const f32x4 v0 = acc[ai][bj][m][0], v1 = acc[ai][bj][m][1];
                        u32x4 w; w.x = cvt_pk_bf16(v0[0], v0[1]); w.y = cvt_pk_bf16(v0[2], v0[3]); w.z = cvt_pk_bf16(v1[0], v1[1]); w.w = cvt_pk_bf16(v1[2], v1[3]);
                        *(u32x4*)(rowp + bj * HALF) = w; } }
        }
    }
};

__device__ __forceinline__ float silu_f(float a) { return a * __builtin_amdgcn_rcpf(1.0f + __builtin_amdgcn_exp2f(-1.4426950408889634f * a)); }
struct EpiSwiglu {
    static constexpr bool PERM = true;
    bf16_t* O; int ldc;
    __device__ __forceinline__ void operator()(const f32x4 (&acc)[2][2][4][2], const Unit& u, int wr, int wc, int fr, int fq) const {
        const int row0 = u.pm * BM + wr * 64 + fr; const int col0 = u.pn * HALF + wc * 32 + 8 * fq;
#pragma unroll
        for (int ai = 0; ai < 2; ++ai)
#pragma unroll
            for (int m = 0; m < 4; ++m) { bf16_t* rowp = O + (size_t)(row0 + ai * HALF + m * 16) * ldc + col0;
                const f32x4 a0 = acc[ai][0][m][0], a1 = acc[ai][0][m][1], b0 = acc[ai][1][m][0], b1 = acc[ai][1][m][1];
                u32x4 w;
                w.x = cvt_pk_bf16(silu_f(a0[0]) * b0[0], silu_f(a0[1]) * b0[1]); w.y = cvt_pk_bf16(silu_f(a0[2]) * b0[2], silu_f(a0[3]) * b0[3]);
                w.z = cvt_pk_bf16(silu_f(a1[0]) * b1[0], silu_f(a1[1]) * b1[1]); w.w = cvt_pk_bf16(silu_f(a1[2]) * b1[2], silu_f(a1[3]) * b1[3]);
                *(u32x4*)rowp = w; }
    }
};

struct EpiSwiglu8 {
    static constexpr bool PERM = true;
    unsigned char* O; int ldc; float inscale, outscale;
    __device__ __forceinline__ void operator()(const f32x4 (&acc)[2][2][4][2], const Unit& u, int wr, int wc, int fr, int fq) const {
        const int row0 = u.pm * BM + wr * 64 + fr; const int col0 = u.pn * HALF + wc * 32 + 8 * fq; const float s2 = inscale * outscale;
#pragma unroll
        for (int ai = 0; ai < 2; ++ai)
#pragma unroll
            for (int m = 0; m < 4; ++m) { unsigned char* rowp = O + (size_t)(row0 + ai * HALF + m * 16) * ldc + col0;
                const f32x4 a0 = acc[ai][0][m][0], a1 = acc[ai][0][m][1], b0 = acc[ai][1][m][0], b1 = acc[ai][1][m][1];
                u32x2 w;
                w.x = pk4_fp8(silu_f(a0[0] * inscale) * (b0[0] * s2), silu_f(a0[1] * inscale) * (b0[1] * s2), silu_f(a0[2] * inscale) * (b0[2] * s2), silu_f(a0[3] * inscale) * (b0[3] * s2));
                w.y = pk4_fp8(silu_f(a1[0] * inscale) * (b1[0] * s2), silu_f(a1[1] * inscale) * (b1[1] * s2), silu_f(a1[2] * inscale) * (b1[2] * s2), silu_f(a1[3] * inscale) * (b1[3] * s2));
                *(u32x2*)rowp = w; __builtin_amdgcn_sched_barrier(0); }
    }
};

struct EpiResid {
    static constexpr bool PERM = false;
    const float* xin; float* out; int ldc; const float* gate; float alpha; float accscale;
    __device__ __forceinline__ void operator()(const f32x4 (&acc)[2][2][4][2], const Unit& u, int wr, int wc, int fr, int fq) const {
        const int col0 = u.pn * BM + wc * 32 + 4 * fq;
        f32x4 gv[2][2];
#pragma unroll
        for (int bj = 0; bj < 2; ++bj)
#pragma unroll
            for (int n = 0; n < 2; ++n) gv[bj][n] = (*(const f32x4*)(gate + col0 + bj * HALF + n * 16) + 1.0f) * accscale;
#pragma unroll
        for (int ai = 0; ai < 2; ++ai)
#pragma unroll
            for (int m = 0; m < 4; ++m) { const size_t off = (size_t)(u.pm * BM + ai * HALF + wr * 64 + m * 16 + fr) * ldc + col0;
#pragma unroll
                for (int bj = 0; bj < 2; ++bj)
#pragma unroll
                    for (int n = 0; n < 2; ++n) { const f32x4 x = *(const f32x4*)(xin + off + bj * HALF + n * 16);
                        *(f32x4*)(out + off + bj * HALF + n * 16) = x * alpha + gv[bj][n] * acc[ai][bj][m][n]; }
                if (m & 1) asm volatile("" ::: "memory"); }
    }
};

template <class Epi, class Sched, bool ALIGN_EPI, bool FP8 = false>
__device__ __forceinline__ void gemm_phase(PG8_LAS unsigned char* lds, const Gemm g, const Sched& S, const Epi& E, const int tid) {
    const int wid = __builtin_amdgcn_readfirstlane(tid >> 6), lane = tid & 63, wr = wid >> 2, wc = wid & 3, fr = lane & 15, fq = lane >> 4;
    const int K = g.K, nt = K / BK;
    unsigned voffA[2], voffB[2];
#pragma unroll
    for (int i = 0; i < 2; ++i) { int R, C; stage_rc(tid * 16 + i * 8192, R, C); const int Rb = Epi::PERM ? ((R & ~31) + perm32(R & 31)) : R;
        voffA[i] = (unsigned)(R * K + C) * 2u; voffB[i] = (unsigned)(Rb * K + C) * 2u; }
    const size_t kstep = (size_t)(BK * 2);
    const size_t hstep = (size_t)HALF * K * 2;
    const size_t tstep = 2 * hstep;
    const unsigned ldsw = (unsigned)wid * 1024u;
    const int fcol = FP8 ? (32 * (fq >> 1) + 16 * (fq & 1)) : fq * 8;
    const int aoff = lds_byte(wr * 64 + fr, fcol), boff = lds_byte(wc * 32 + fr, fcol);
#define PG8_SA(b, h) (((b) * 2 + (h)) * HTB)
#define PG8_SB(b, h) ((4 + (b) * 2 + (h)) * HTB)
#define PG8_STAGE(bufoff, gbase, voff) do { _Pragma("unroll") for (int _i = 0; _i < 2; ++_i) \
        __builtin_amdgcn_global_load_lds((const unsigned*)((const char*)(gbase) + (voff)[_i]), (PG8_LAS unsigned*)(lds + (bufoff) + ldsw + _i * 8192), 16, 0, 0); } while (0)
#define PG8_LDA(dst, b, h) do { if constexpr (FP8) { _Pragma("unroll") for (int m = 0; m < 4; ++m) { const v4i_ lo_ = *(const PG8_LAS v4i_*)(lds + PG8_SA(b, h) + aoff + m * 2048), hi_ = *(const PG8_LAS v4i_*)(lds + PG8_SA(b, h) + aoff + m * 2048 + 16); dst##8[m] = __builtin_shufflevector(lo_, hi_, 0, 1, 2, 3, 4, 5, 6, 7); } } \
    else { _Pragma("unroll") for (int m = 0; m < 4; ++m) _Pragma("unroll") for (int k = 0; k < 2; ++k) dst[m][k] = *(const PG8_LAS bf16x8*)(lds + PG8_SA(b, h) + aoff + m * 2048 + k * 1024); } } while (0)
#define PG8_LDB(dst, b, h) do { if constexpr (FP8) { _Pragma("unroll") for (int n = 0; n < 2; ++n) { const v4i_ lo_ = *(const PG8_LAS v4i_*)(lds + PG8_SB(b, h) + boff + n * 2048), hi_ = *(const PG8_LAS v4i_*)(lds + PG8_SB(b, h) + boff + n * 2048 + 16); dst##8[n] = __builtin_shufflevector(lo_, hi_, 0, 1, 2, 3, 4, 5, 6, 7); } } \
    else { _Pragma("unroll") for (int n = 0; n < 2; ++n) _Pragma("unroll") for (int k = 0; k < 2; ++k) dst[n][k] = *(const PG8_LAS bf16x8*)(lds + PG8_SB(b, h) + boff + n * 2048 + k * 1024); } } while (0)
#define PG8_MMA(ai, bj, At, Bt) do { __builtin_amdgcn_s_setprio(1); if constexpr (FP8) { _Pragma("unroll") for (int m = 0; m < 4; ++m) _Pragma("unroll") for (int n = 0; n < 2; ++n) \
        mfma_f8(acc[ai][bj][m][n], Bt##8[n], At##8[m]); } \
    else { _Pragma("unroll") for (int m = 0; m < 4; ++m) _Pragma("unroll") for (int n = 0; n < 2; ++n) _Pragma("unroll") for (int k = 0; k < 2; ++k) \
        acc[ai][bj][m][n] = __builtin_amdgcn_mfma_f32_16x16x32_bf16(Bt[n][k], At[m][k], acc[ai][bj][m][n], 0, 0, 0); } __builtin_amdgcn_s_setprio(0); } while (0)
#define PG8_WAIT_V(n) asm volatile("s_waitcnt vmcnt(" #n ")" ::: "memory")
#define PG8_WAIT_L(n) asm volatile("s_waitcnt lgkmcnt(" #n ")" ::: "memory")
#define PG8_BAR __builtin_amdgcn_s_barrier()
#define PG8_SCHED __builtin_amdgcn_sched_barrier(0)
    Unit cur, nxt; int ui = 0;
    if (!S.next(0, cur)) return;
    f32x4 acc[2][2][4][2];
#pragma unroll
    for (int a = 0; a < 2; ++a)
#pragma unroll
        for (int b = 0; b < 2; ++b)
#pragma unroll
            for (int m = 0; m < 4; ++m)
#pragma unroll
                for (int n = 0; n < 2; ++n) acc[a][b][m][n] = (f32x4){0.f, 0.f, 0.f, 0.f};
    bf16x8 At[4][2], B0[2][2], B1[2][2];
    v8i_ At8[4], B08[2], B18[2];
    const char* cA = (const char*)g.A + (size_t)cur.pm * tstep; const char* cB = (const char*)g.Bt + (size_t)cur.pb * tstep;
    PG8_STAGE(PG8_SB(0, 0), cB, voffB); PG8_STAGE(PG8_SB(0, 1), cB + hstep, voffB); PG8_STAGE(PG8_SA(0, 0), cA, voffA); PG8_STAGE(PG8_SA(0, 1), cA + hstep, voffA);
    if (wr == 1) PG8_BAR;
    PG8_WAIT_V(2); PG8_BAR;
    PG8_STAGE(PG8_SB(1, 0), cB + kstep, voffB); PG8_STAGE(PG8_SA(1, 0), cA + kstep, voffA); PG8_STAGE(PG8_SB(1, 1), cB + hstep + kstep, voffB);
    PG8_WAIT_V(6); PG8_BAR;
    for (;;) {
        const bool has_next = S.next(ui + 1, nxt);
        const char* nA = has_next ? (const char*)g.A + (size_t)nxt.pm * tstep : cA; const char* nB = has_next ? (const char*)g.Bt + (size_t)nxt.pb * tstep : cB;
        for (int t = 0; t < nt; t += 2) {
            const bool last = (t == nt - 2);
            const char* a1 = cA + (size_t)(t + 1) * kstep;
            const char* a2 = last ? nA : cA + (size_t)(t + 2) * kstep; const char* b2 = last ? nB : cB + (size_t)(t + 2) * kstep;
            const char* a3 = a2 + kstep; const char* b3 = b2 + kstep;
            PG8_LDB(B0, 0, 0); PG8_LDB(B1, 0, 1); PG8_SCHED; PG8_LDA(At, 0, 0); PG8_STAGE(PG8_SA(1, 1), a1 + hstep, voffA);
            PG8_WAIT_V(8); PG8_WAIT_L(0); PG8_BAR; PG8_MMA(0, 0, At, B0); PG8_MMA(0, 1, At, B1); PG8_BAR; PG8_SCHED;
            PG8_LDA(At, 0, 1); PG8_STAGE(PG8_SB(0, 0), b2, voffB); PG8_STAGE(PG8_SB(0, 1), b2 + hstep, voffB); PG8_STAGE(PG8_SA(0, 0), a2, voffA);
            PG8_WAIT_V(8); PG8_WAIT_L(0); PG8_BAR; PG8_MMA(1, 0, At, B0); PG8_MMA(1, 1, At, B1); PG8_BAR; PG8_SCHED;
            PG8_LDB(B0, 1, 0); PG8_LDB(B1, 1, 1); PG8_SCHED; PG8_LDA(At, 1, 0); PG8_STAGE(PG8_SA(0, 1), a2 + hstep, voffA);
            PG8_WAIT_V(8); PG8_WAIT_L(0); PG8_BAR; PG8_MMA(0, 0, At, B0); PG8_MMA(0, 1, At, B1); PG8_BAR; PG8_SCHED;
            PG8_LDA(At, 1, 1); PG8_STAGE(PG8_SB(1, 0), b3, voffB); PG8_STAGE(PG8_SB(1, 1), b3 + hstep, voffB); PG8_STAGE(PG8_SA(1, 0), a3, voffA);
            PG8_WAIT_V(8); PG8_WAIT_L(0); PG8_BAR; PG8_MMA(1, 0, At, B0); PG8_MMA(1, 1, At, B1); PG8_BAR; PG8_SCHED;
        }
        if constexpr (ALIGN_EPI) { if (wr == 0) PG8_BAR; }
        if constexpr (FP8) asm volatile("s_nop 15\n\ts_nop 15" ::: "memory");
        E(acc, cur, wr, wc, fr, fq);
        if (!has_next) break;
#pragma unroll
        for (int a = 0; a < 2; ++a)
#pragma unroll
            for (int b = 0; b < 2; ++b)
#pragma unroll
                for (int m = 0; m < 4; ++m)
#pragma unroll
                    for (int n = 0; n < 2; ++n) acc[a][b][m][n] = (f32x4){0.f, 0.f, 0.f, 0.f};
        cur = nxt; cA = nA; cB = nB; ++ui;
        if constexpr (ALIGN_EPI) { if (wr == 1) PG8_BAR; }
    }
    PG8_WAIT_V(0);
    if constexpr (!ALIGN_EPI) { if (wr == 0) PG8_BAR; }
    PG8_BAR;
#undef PG8_SA
#undef PG8_SB
#undef PG8_STAGE
#undef PG8_LDA
#undef PG8_LDB
#undef PG8_MMA
#undef PG8_WAIT_V
#undef PG8_WAIT_L
#undef PG8_BAR
#undef PG8_SCHED
}
}
namespace attn_body {
using bf16=__hip_bfloat16;
using bf16x8=__attribute__((ext_vector_type(8)))short;
using s16x4=__attribute__((ext_vector_type(4)))short;
using f32x16=__attribute__((ext_vector_type(16)))float;
using u32x4=__attribute__((ext_vector_type(4)))unsigned;
constexpr int SEQ=16384,D=64,PQ=2816,PO=512;
constexpr int NW=8,QBLK=32,QB=QBLK*NW,KVBLK=64,NQB=SEQ/QB;
constexpr int ATTN_UNIT_ROWS=QB;
__device__ __forceinline__ int crow(int r,int hi){return (r&3)+8*(r>>2)+4*hi;}
#define SBAR() __builtin_amdgcn_sched_barrier(0)
__device__ __forceinline__ void cmask(f32x16&p0,f32x16&p1,int jb,int qrel,int hi){
  const float NEG=-INFINITY; int kb=64*jb+4*hi;
  #pragma unroll
  for(int r=0;r<16;++r){int kv=kb+(r&3)+8*(r>>2); if(kv>qrel)p0[r]=NEG; if(kv+32>qrel)p1[r]=NEG;}
}

constexpr int NSLOT=3, SLOTB=8192;
constexpr int LDS_K=0, LDS_V=NSLOT*SLOTB, LDS_WS=2*NSLOT*SLOTB, LDS_OST=LDS_WS+NW*64*4, LDS_BYTES=LDS_OST+NW*4096;
constexpr float C2=0.125f*1.4426950408889634f;
__device__ __forceinline__ void glds16(const void*gsrc,unsigned lds_dst){unsigned keep;
  asm volatile("s_mov_b32 %0, m0\n\ts_mov_b32 m0, %2\n\ts_nop 0\n\tglobal_load_lds_dwordx4 %1, off\n\ts_mov_b32 m0, %0":"=&s"(keep):"v"(gsrc),"s"(lds_dst):"memory");}
__device__ __forceinline__ float max3f(float a,float b,float c){float r;asm("v_max3_f32 %0, %1, %2, %3":"=v"(r):"v"(a),"v"(b),"v"(c));return r;}
__device__ __forceinline__ float max2f(float a,float b){float r;asm("v_max_f32_e32 %0, %1, %2":"=v"(r):"v"(a),"v"(b));return r;}
__device__ __forceinline__ float fadd_s(float a,float b){float r;asm("v_add_f32_e32 %0, %1, %2":"=v"(r):"v"(a),"v"(b));return r;}
__device__ __forceinline__ float fsub_s(float a,float b){float r;asm("v_sub_f32_e32 %0, %1, %2":"=v"(r):"v"(a),"v"(b));return r;}
typedef float f32x2_t __attribute__((ext_vector_type(2))); typedef __bf16 bf16x2_t __attribute__((ext_vector_type(2)));
__device__ __forceinline__ unsigned cvtpk_s(float lo,float hi){f32x2_t v={lo,hi};bf16x2_t b=__builtin_convertvector(v,bf16x2_t);return __builtin_bit_cast(unsigned,b);}
#define WAIT_BAR(N) asm volatile("s_waitcnt vmcnt(" #N ") lgkmcnt(0)\n\ts_barrier":::"memory")

__device__ __forceinline__ void qkt(f32x16&p0,f32x16&p1,const char*Kslot,const bf16x8*qr,const f32x16&negm,int r32,int hi){
  const char*kb=Kslot+hi*1024+r32*16;
  #pragma unroll
  for(int d0=0;d0<4;++d0){
    const bf16x8 b0=*reinterpret_cast<const bf16x8*>(kb+d0*2048);
    const bf16x8 b1=*reinterpret_cast<const bf16x8*>(kb+d0*2048+512);
    if(d0==0){p0=__builtin_amdgcn_mfma_f32_32x32x16_bf16(b0,qr[0],negm,0,0,0);p1=__builtin_amdgcn_mfma_f32_32x32x16_bf16(b1,qr[0],negm,0,0,0);}
    else{p0=__builtin_amdgcn_mfma_f32_32x32x16_bf16(b0,qr[d0],p0,0,0,0);p1=__builtin_amdgcn_mfma_f32_32x32x16_bf16(b1,qr[d0],p1,0,0,0);}}
}
typedef __attribute__((address_space(3))) const char* lds_cptr;
typedef short v4i16_t __attribute__((ext_vector_type(4)));
__device__ __forceinline__ void kload8(bf16x8*kf,lds_cptr kp){
  kf[0]=*(const __attribute__((address_space(3))) bf16x8*)(kp);      kf[1]=*(const __attribute__((address_space(3))) bf16x8*)(kp+512);
  kf[2]=*(const __attribute__((address_space(3))) bf16x8*)(kp+2048); kf[3]=*(const __attribute__((address_space(3))) bf16x8*)(kp+2560);
  kf[4]=*(const __attribute__((address_space(3))) bf16x8*)(kp+4096); kf[5]=*(const __attribute__((address_space(3))) bf16x8*)(kp+4608);
  kf[6]=*(const __attribute__((address_space(3))) bf16x8*)(kp+6144); kf[7]=*(const __attribute__((address_space(3))) bf16x8*)(kp+6656);
}
__device__ __forceinline__ void kload2(bf16x8*kf,lds_cptr kp,int j){ kf[2*j]=*(const __attribute__((address_space(3))) bf16x8*)(kp+j*2048); kf[2*j+1]=*(const __attribute__((address_space(3))) bf16x8*)(kp+j*2048+512); }
__device__ __forceinline__ s16x4 vtr(lds_cptr p){ return __builtin_bit_cast(s16x4,__builtin_amdgcn_ds_read_tr16_b64_v4i16((__attribute__((address_space(3))) v4i16_t*)p)); }
__device__ __forceinline__ float rowmax(const f32x16&p0,const f32x16&p1){
  float a=max3f(p0[0],p0[1],p1[0]),b=max3f(p0[2],p0[3],p1[1]);a=max3f(a,p1[2],p1[3]);
  #pragma unroll
  for(int r=4;r<16;r+=4){a=max3f(a,p0[r],p0[r+1]);b=max3f(b,p0[r+2],p0[r+3]);a=max3f(a,p1[r],p1[r+1]);b=max3f(b,p1[r+2],p1[r+3]);}
  const float m=max2f(a,b);
  auto rr=__builtin_amdgcn_permlane32_swap(__float_as_uint(m),__float_as_uint(m),false,false);
  return max2f(__uint_as_float(rr[0]),__uint_as_float(rr[1]));
}
__device__ __forceinline__ void pv(f32x16*o,int vb,bf16x8 pa0,bf16x8 pa1,bf16x8 pa2,bf16x8 pa3){
  #pragma unroll
  for(int d0=0;d0<2;++d0){s16x4 lo[4],hi[4];
    #pragma unroll
    for(int ks=0;ks<4;++ks){
      asm volatile("ds_read_b64_tr_b16 %0,%1 offset:%c2":"=&v"(lo[ks]):"v"(vb),"i"(d0*4096+ks*1024):"memory");
      asm volatile("ds_read_b64_tr_b16 %0,%1 offset:%c2":"=&v"(hi[ks]):"v"(vb),"i"(d0*4096+ks*1024+512):"memory");}
    asm volatile("s_waitcnt lgkmcnt(0)":::"memory");SBAR();
    #define PK(k) (bf16x8){lo[k][0],lo[k][1],lo[k][2],lo[k][3],hi[k][0],hi[k][1],hi[k][2],hi[k][3]}
    o[d0]=__builtin_amdgcn_mfma_f32_32x32x16_bf16(pa0,PK(0),o[d0],0,0,0);
    o[d0]=__builtin_amdgcn_mfma_f32_32x32x16_bf16(pa1,PK(1),o[d0],0,0,0);
    o[d0]=__builtin_amdgcn_mfma_f32_32x32x16_bf16(pa2,PK(2),o[d0],0,0,0);
    o[d0]=__builtin_amdgcn_mfma_f32_32x32x16_bf16(pa3,PK(3),o[d0],0,0,0);
    #undef PK
  }
}

#ifndef ATTN_STORE16
#define ATTN_STORE16(p,v) (*(u32x4*)(p)=(v))
#endif
template<int THRL> __device__ __forceinline__ void attn_unit(const int tid,int qb,const bf16*Qh,const bf16*__restrict__ Kh,const bf16*__restrict__ Vh,bf16*Oh,char*shm){
  const int lane=tid&63,r32=lane&31,hi=lane>>5; const int wid=__builtin_amdgcn_readfirstlane(tid>>6);
  const int q0=qb*QB;
  const bf16*Qw=Qh+(long)(q0+wid*QBLK)*PQ;
  const unsigned lds0=(unsigned)(uintptr_t)shm;
  float*wsf=(float*)(shm+LDS_WS)+wid*64;
  const bf16*ksrc=Kh+(long)lane*PQ+wid*8;
  const bf16*vsrc=Vh+(long)(16*(wid&3)+(lane>>2))*PQ+(wid>>2)*32+(lane&3)*8;
  const unsigned kdst=lds0+LDS_K+wid*1024, vdst=lds0+LDS_V+wid*1024;
  #define DMA_K(t,slot) glds16(ksrc+(long)(t)*KVBLK*PQ,(unsigned)__builtin_amdgcn_readfirstlane(kdst+(slot)))
  #define DMA_V(t,slot) glds16(vsrc+(long)(t)*KVBLK*PQ,(unsigned)__builtin_amdgcn_readfirstlane(vdst+(slot)))
  const int vb0=(int)(lds0+LDS_V)+((lane>>4)&1)*32+(lane&3)*8+(4*hi+((lane&15)>>2))*64;
  const char*Kbase=shm+LDS_K; bf16x8 kf[8];
  const lds_cptr shm3=(lds_cptr)shm; const lds_cptr kp0=shm3+LDS_K+hi*1024+r32*16; const lds_cptr vp0=shm3+LDS_V+((lane>>4)&1)*32+(lane&3)*8+(4*hi+((lane&15)>>2))*64;
  const int NT=(q0+QB)/KVBLK;
  DMA_K(0,0);DMA_V(0,0);DMA_K(1,SLOTB);
  bf16x8 qr[4];
  #pragma unroll
  for(int d0=0;d0<4;++d0)qr[d0]=*reinterpret_cast<const bf16x8*>(&Qw[(long)r32*PQ+d0*16+hi*8]);
  float mhat=0.f,l_reg=0.f;f32x16 o[2];o[0]=f32x16{};o[1]=f32x16{};const f32x16 negm=f32x16{};
  const int qrel=wid*QBLK+r32;
  #define CMASK(P0,P1,t) do{int jb_=(t)-(NT-4); if(jb_>=0)cmask(P0,P1,jb_,qrel,hi);}while(0)
  bool resc=false;
  #define START(P0,P1) do{ const float rm=rowmax(P0,P1); resc=false; \
    { const float dl=rm; mhat=fadd_s(mhat,dl); \
      _Pragma("unroll") for(int r=0;r<16;++r){P0[r]=fsub_s(P0[r],dl);P1[r]=fsub_s(P1[r],dl);} \
      } \
    _Pragma("unroll") for(int r=0;r<16;++r)P0[r]=__builtin_amdgcn_exp2f(P0[r]); }while(0)
  #define RESC() do{ if(resc){ asm volatile("s_waitcnt lgkmcnt(0)":::"memory"); \
      _Pragma("unroll") for(int d_=0;d_<2;++d_) _Pragma("unroll") for(int r=0;r<16;++r)o[d_][r]*=wsf[crow(r,hi)]; } }while(0)
  f32x16 pA0,pA1,pB0,pB1;
  int sl_prev=0,sl_cur=0,sl_next=SLOTB;
  #define ROT() do{sl_prev=sl_cur;sl_cur=sl_next;sl_next=(sl_next==(NSLOT-1)*SLOTB)?0:sl_next+SLOTB;}while(0)
  DMA_K(2,2*SLOTB);
  WAIT_BAR(3);
  qkt(pA0,pA1,Kbase,qr,negm,r32,hi);asm volatile("s_nop 15\n\ts_nop 7":"+v"(pA0),"+v"(pA1));CMASK(pA0,pA1,0);
  START(pA0,pA1);
  _Pragma("unroll") for(int r=0;r<16;++r)pA1[r]=__builtin_amdgcn_exp2f(pA1[r]);
  WAIT_BAR(0);
  DMA_K(3,0);DMA_V(1,SLOTB);
  ROT();
  kload8(kf,kp0+sl_cur);
  WAIT_BAR(2);
  s16x4 vlo[8],vhi[8]; u32x4 pw0,pw1,pw2,pw3;
  #define PKW(P,B) cvtpk_s(P[B],P[B+1])
  #define PAF(k) __builtin_bit_cast(bf16x8,pw##k)
  #define VFR(i) (bf16x8){vlo[i][0],vlo[i][1],vlo[i][2],vlo[i][3],vhi[i][0],vhi[i][1],vhi[i][2],vhi[i][3]}
  #define PIN(x) asm volatile("":"+v"(x))
  #define MX3(a,b,c) __builtin_fmaxf(__builtin_fmaxf((a),(b)),(c))
  #define GAPA(MF,A0,A1,A2,A3,W0,W1,PW) do{ MF; sacc+=A0; sacc+=A1; sacc+=A2; sacc+=A3; PIN(sacc); W0; W1; PIN(PW); SBAR(); }while(0)
  #define EX(v) __builtin_amdgcn_exp2f(v)
  #define GAPB(MF,X,B) do{ MF; X[B]=EX(X[B]-mhat); X[B+1]=EX(X[B+1]-mhat); X[B+2]=EX(X[B+2]-mhat); X[B+3]=EX(X[B+3]-mhat); PIN(X); SBAR(); }while(0)
  #define VRD(i) do{ vlo[i]=vtr(vp_+(((i)>>2)*4096+((i)&3)*1024)); vhi[i]=vtr(vp_+(((i)>>2)*4096+((i)&3)*1024+512)); }while(0)
  #define KRD(G,j) do{ if(G){ kload2(kf,kp0+sl_next,j); SBAR(); } }while(0)
  #define STEP(C0,C1,P0,P1,t,GK,GV,GL) do{ SBAR(); \
    const lds_cptr vp_=vp0+sl_prev; \
    VRD(0); SBAR(); float sacc=(P0[0]+P0[1]); \
    GAPA(C0=__builtin_amdgcn_mfma_f32_32x32x16_bf16(kf[0],qr[0],negm,0,0,0), P0[2],P0[3],P0[4],P0[5],     pw0[0]=PKW(P0,0), pw0[1]=PKW(P0,2), pw0); \
    VRD(4); SBAR(); GAPA(C1=__builtin_amdgcn_mfma_f32_32x32x16_bf16(kf[1],qr[0],negm,0,0,0), P0[6],P0[7],P0[8],P0[9],     pw0[2]=PKW(P0,4), pw0[3]=PKW(P0,6), pw0); \
    VRD(1); SBAR(); GAPA(C0=__builtin_amdgcn_mfma_f32_32x32x16_bf16(kf[2],qr[1],C0,0,0,0),   P0[10],P0[11],P0[12],P0[13], pw1[0]=PKW(P0,8), pw1[1]=PKW(P0,10), pw1); \
    VRD(5); SBAR(); GAPA(C1=__builtin_amdgcn_mfma_f32_32x32x16_bf16(kf[3],qr[1],C1,0,0,0),   P0[14],P0[15],P1[0],P1[1],   pw1[2]=PKW(P0,12),pw1[3]=PKW(P0,14), pw1); \
    VRD(2); SBAR(); GAPA(C0=__builtin_amdgcn_mfma_f32_32x32x16_bf16(kf[4],qr[2],C0,0,0,0),   P1[2],P1[3],P1[4],P1[5],     pw2[0]=PKW(P1,0), pw2[1]=PKW(P1,2), pw2); \
    VRD(6); SBAR(); GAPA(C1=__builtin_amdgcn_mfma_f32_32x32x16_bf16(kf[5],qr[2],C1,0,0,0),   P1[6],P1[7],P1[8],P1[9],     pw2[2]=PKW(P1,4), pw2[3]=PKW(P1,6), pw2); \
    VRD(3); SBAR(); GAPA(C0=__builtin_amdgcn_mfma_f32_32x32x16_bf16(kf[6],qr[3],C0,0,0,0),   P1[10],P1[11],P1[12],P1[13], pw3[0]=PKW(P1,8), pw3[1]=PKW(P1,10), pw3); \
    VRD(7); SBAR(); GAPA(C1=__builtin_amdgcn_mfma_f32_32x32x16_bf16(kf[7],qr[3],C1,0,0,0),   P1[14],P1[15],0.f,0.f,       pw3[2]=PKW(P1,12),pw3[3]=PKW(P1,14), pw3); \
    l_reg+=sacc; \
    if(GK){DMA_K((t)+3,sl_cur);} if(GV){DMA_V((t)+1,sl_next);} \
    CMASK(C0,C1,t); \
    { float a=MX3(C0[0],C0[1],C1[0]),b=MX3(C0[2],C0[3],C1[1]); a=MX3(a,C1[2],C1[3]); \
      _Pragma("unroll") for(int r=4;r<16;r+=4){a=MX3(a,C0[r],C0[r+1]);b=MX3(b,C0[r+2],C0[r+3]);a=MX3(a,C1[r],C1[r+1]);b=MX3(b,C1[r+2],C1[r+3]);} \
      float rm=__builtin_fmaxf(a,b); { auto rr=__builtin_amdgcn_permlane32_swap(__float_as_uint(rm),__float_as_uint(rm),false,false); rm=__builtin_fmaxf(__uint_as_float(rr[0]),__uint_as_float(rr[1])); } \
      resc=false; \
      rm-=mhat; \
      if(__builtin_expect(__any(rm>(float)THRL),0)){ const float dl=__builtin_fmaxf(rm,0.f); mhat+=dl; \
        const float f=__builtin_amdgcn_exp2f(-dl); l_reg*=f; if(hi==0)wsf[r32]=f; resc=true; } } \
    SBAR(); \
    GAPB(o[0]=__builtin_amdgcn_mfma_f32_32x32x16_bf16(PAF(0),VFR(0),o[0],0,0,0), C0,0); \
    GAPB(o[1]=__builtin_amdgcn_mfma_f32_32x32x16_bf16(PAF(0),VFR(4),o[1],0,0,0), C0,4); \
    KRD(GL,0); GAPB(o[0]=__builtin_amdgcn_mfma_f32_32x32x16_bf16(PAF(1),VFR(1),o[0],0,0,0), C0,8); \
    KRD(GL,1); GAPB(o[1]=__builtin_amdgcn_mfma_f32_32x32x16_bf16(PAF(1),VFR(5),o[1],0,0,0), C0,12); \
    KRD(GL,2); GAPB(o[0]=__builtin_amdgcn_mfma_f32_32x32x16_bf16(PAF(2),VFR(2),o[0],0,0,0), C1,0); \
    KRD(GL,3); GAPB(o[1]=__builtin_amdgcn_mfma_f32_32x32x16_bf16(PAF(2),VFR(6),o[1],0,0,0), C1,4); \
    GAPB(o[0]=__builtin_amdgcn_mfma_f32_32x32x16_bf16(PAF(3),VFR(3),o[0],0,0,0), C1,8); \
    GAPB(o[1]=__builtin_amdgcn_mfma_f32_32x32x16_bf16(PAF(3),VFR(7),o[1],0,0,0), C1,12); \
    }while(0)
  int t=1;
  #undef CMASK
  #define CMASK(P0,P1,t) do{}while(0)
  for(;t+5<NT;t+=2){
    STEP(pB0,pB1,pA0,pA1,t,true,true,true);     WAIT_BAR(2); RESC(); ROT();
    STEP(pA0,pA1,pB0,pB1,t+1,true,true,true);   WAIT_BAR(2); RESC(); ROT();
  }
  #undef CMASK
  #define CMASK(P0,P1,t) do{int jb_=(t)-(NT-4); if(jb_>=0)cmask(P0,P1,jb_,qrel,hi);}while(0)
  #define ENDW(tt) do{ if((tt)+3<NT){WAIT_BAR(2);} else if((tt)+2<NT){WAIT_BAR(1);} else {WAIT_BAR(0);} }while(0)
  for(;t+1<NT;t+=2){
    STEP(pB0,pB1,pA0,pA1,t,(t+3<NT),(t+1<NT),(t+1<NT));       ENDW(t);   RESC(); ROT();
    STEP(pA0,pA1,pB0,pB1,t+1,(t+4<NT),(t+2<NT),(t+2<NT));     ENDW(t+1); RESC(); ROT();
  }
  STEP(pB0,pB1,pA0,pA1,NT-1,false,false,false); RESC();
  { float sacc=pB0[0]+pB0[1]; _Pragma("unroll") for(int r=2;r<16;++r)sacc+=pB0[r]; _Pragma("unroll") for(int r=0;r<16;++r)sacc+=pB1[r]; l_reg+=sacc;
    pw0=(u32x4){PKW(pB0,0),PKW(pB0,2),PKW(pB0,4),PKW(pB0,6)};pw1=(u32x4){PKW(pB0,8),PKW(pB0,10),PKW(pB0,12),PKW(pB0,14)};pw2=(u32x4){PKW(pB1,0),PKW(pB1,2),PKW(pB1,4),PKW(pB1,6)};pw3=(u32x4){PKW(pB1,8),PKW(pB1,10),PKW(pB1,12),PKW(pB1,14)};
    SBAR(); pv(o,vb0+sl_cur,PAF(0),PAF(1),PAF(2),PAF(3)); }
  #undef PKW
  #undef PAF
  #undef VFR
  #undef PIN
  #undef MX3
  #undef GAPA
  #undef GAPB
  #undef EX
  #undef VRD
  #undef KRD
  #undef STEP
  #undef ENDW
  {auto rr=__builtin_amdgcn_permlane32_swap(__float_as_uint(l_reg),__float_as_uint(l_reg),false,false);l_reg=__uint_as_float(rr[0])+__uint_as_float(rr[1]);}
  if(hi==0)wsf[32+r32]=l_reg;asm volatile("s_waitcnt lgkmcnt(0)":::"memory");
  float rli[16];
  #pragma unroll
  for(int r=0;r<16;++r)rli[r]=__builtin_amdgcn_rcpf(wsf[32+crow(r,hi)]);
  bf16*Ow=Oh+(long)(q0+wid*QBLK)*PO;
  { bf16*stg=(bf16*)(shm+LDS_OST)+wid*2048;
    #pragma unroll
    for(int r=0;r<16;++r){const int orow=crow(r,hi);
      #pragma unroll
      for(int d0=0;d0<2;++d0)stg[orow*64+d0*32+r32]=__float2bfloat16(o[d0][r]*rli[r]);}
    asm volatile("s_waitcnt lgkmcnt(0)":::"memory");
    #pragma unroll
    for(int i=0;i<4;++i){const int row=i*8+(lane>>3),ch=lane&7; const u32x4 v=*(const u32x4*)(stg+row*64+ch*8); ATTN_STORE16(Ow+(long)row*PO+ch*8,v);} }
  asm volatile("s_waitcnt lgkmcnt(0)\n\ts_barrier":::"memory");
  #undef DMA_K
  #undef DMA_V
  #undef CMASK
  #undef START
  #undef RESC
  #undef ROT
}
constexpr int ATTN_LDS_BYTES=LDS_BYTES;
#undef SBAR
#undef WAIT_BAR
}
namespace attn_body {
#define SBAR() __builtin_amdgcn_sched_barrier(0)
#define WAIT_BAR(N) asm volatile("s_waitcnt vmcnt(" #N ") lgkmcnt(0)\n\ts_barrier":::"memory")
constexpr int SLOTV=16384;
constexpr int L2_K=0, L2_V=NSLOT*SLOTB, L2_WS=L2_V+NSLOT*SLOTV, L2_OST=L2_WS+NW*64*4, LDS2_BYTES=L2_OST+NW*4096;
template<int THRL> __device__ __forceinline__ void attn_unit2(const int tid,int qb,const bf16*Qh,const bf16*__restrict__ Kh,const bf16*__restrict__ Vh,bf16*Oh,char*shm){
  const int lane=tid&63,r32=lane&31,hi=lane>>5; const int wid=__builtin_amdgcn_readfirstlane(tid>>6);
  const int q0=qb*QB;
  const bf16*Qw=Qh+(long)(q0+wid*QBLK)*PQ;
  const unsigned lds0=(unsigned)(uintptr_t)shm;
  float*wsf=(float*)(shm+L2_WS)+wid*64;
  const bf16*ksrc=Kh+(long)lane*PQ+wid*8;
  const bf16*vsrc=Vh+(long)(16*(wid&3)+(lane>>2))*PQ+(wid>>2)*32+(lane&3)*8;
  const unsigned kdst=lds0+L2_K+wid*1024, vdst=lds0+L2_V+wid*1024;
  #define DMA_K(t,slot) glds16(ksrc+(long)(t)*KVBLK*PQ,(unsigned)__builtin_amdgcn_readfirstlane(kdst+(slot)))
  #define DMA_V(t,slot) do{ glds16(vsrc+(long)(t)*KVBLK*PQ,(unsigned)__builtin_amdgcn_readfirstlane(vdst+2*(slot))); glds16(vsrc+64+(long)(t)*KVBLK*PQ,(unsigned)__builtin_amdgcn_readfirstlane(vdst+8192+2*(slot))); }while(0)
  const int vb0=(int)(lds0+L2_V)+((lane>>4)&1)*32+(lane&3)*8+(4*hi+((lane&15)>>2))*64;
  const char*Kbase=shm+L2_K; bf16x8 kf[8];
  const lds_cptr shm3=(lds_cptr)shm; const lds_cptr kp0=shm3+L2_K+hi*1024+r32*16; const lds_cptr vp0=shm3+L2_V+((lane>>4)&1)*32+(lane&3)*8+(4*hi+((lane&15)>>2))*64;
  const int NT=(q0+QB)/KVBLK;
  DMA_K(0,0);DMA_V(0,0);DMA_K(1,SLOTB);
  bf16x8 qr[4];
  #pragma unroll
  for(int d0=0;d0<4;++d0)qr[d0]=*reinterpret_cast<const bf16x8*>(&Qw[(long)r32*PQ+d0*16+hi*8]);
  float mhat=0.f,l_reg=0.f;f32x16 o[4];o[0]=f32x16{};o[1]=f32x16{};o[2]=f32x16{};o[3]=f32x16{};const f32x16 zc=f32x16{};
  const int qrel=wid*QBLK+r32;
  #define CMASK(P0,P1,t) do{int jb_=(t)-(NT-4); if(jb_>=0)cmask(P0,P1,jb_,qrel,hi);}while(0)
  bool resc=false;
  #define RESC() do{ if(resc){ asm volatile("s_waitcnt lgkmcnt(0)":::"memory"); \
      _Pragma("unroll") for(int d_=0;d_<4;++d_) _Pragma("unroll") for(int r=0;r<16;++r)o[d_][r]*=wsf[crow(r,hi)]; } }while(0)
  f32x16 C0,C1;
  int sl_prev=0,sl_cur=0,sl_next=SLOTB;
  #define ROT() do{sl_prev=sl_cur;sl_cur=sl_next;sl_next=(sl_next==(NSLOT-1)*SLOTB)?0:sl_next+SLOTB;}while(0)
  DMA_K(2,2*SLOTB);
  WAIT_BAR(3);
  s16x4 vlo[8],vhi[8]; u32x4 pw0,pw1,pw2,pw3; float sacc=0.f;
  #define PKW(P,B) cvtpk_s(P[B],P[B+1])
  #define PAF(k) __builtin_bit_cast(bf16x8,pw##k)
  #define VFR(i) (bf16x8){vlo[i][0],vlo[i][1],vlo[i][2],vlo[i][3],vhi[i][0],vhi[i][1],vhi[i][2],vhi[i][3]}
  #define PIN(x) asm volatile("":"+v"(x))
  #define MX3(a,b,c) __builtin_fmaxf(__builtin_fmaxf((a),(b)),(c))
  #define EX(v) __builtin_amdgcn_exp2f(v)
  qkt(C0,C1,Kbase,qr,zc,r32,hi);asm volatile("s_nop 15\n\ts_nop 7":"+v"(C0),"+v"(C1));CMASK(C0,C1,0);
  { const float rm=rowmax(C0,C1); mhat=rm;
    _Pragma("unroll") for(int r=0;r<16;++r){C0[r]=EX(C0[r]-rm);C1[r]=EX(C1[r]-rm);}
    sacc=C0[0]+C0[1]; _Pragma("unroll") for(int r=2;r<16;++r)sacc+=C0[r];
    pw0=(u32x4){PKW(C0,0),PKW(C0,2),PKW(C0,4),PKW(C0,6)};pw1=(u32x4){PKW(C0,8),PKW(C0,10),PKW(C0,12),PKW(C0,14)}; }
  WAIT_BAR(0);
  DMA_K(3,0);DMA_V(1,SLOTB);
  ROT();
  kload8(kf,kp0+sl_cur);
  WAIT_BAR(3);
  #define GAPA(MF) do{ MF; SBAR(); }while(0)
  #define GAPAF(MF,A0,A1,A2,A3,W0,W1,PW) do{ MF; sacc+=A0; sacc+=A1; sacc+=A2; sacc+=A3; PIN(sacc); W0; W1; PIN(PW); SBAR(); }while(0)
  #define EX2(X,B) do{ X[B]=EX(X[B]-mhat); X[B+1]=EX(X[B+1]-mhat); PIN(X); }while(0)
  #define VRD(i)  do{ vlo[i]=vtr(vp_+(((i)>>2)*4096+((i)&3)*1024)); vhi[i]=vtr(vp_+(((i)>>2)*4096+((i)&3)*1024+512)); }while(0)
  #define VRD2(i) do{ vlo[i]=vtr(vp_+(8192+((i)>>2)*4096+((i)&3)*1024)); vhi[i]=vtr(vp_+(8192+((i)>>2)*4096+((i)&3)*1024+512)); }while(0)
  #define KRD(G,j) do{ if(G){ kload2(kf,kp0+sl_next,j); } }while(0)
  #define ADD2(a,b) do{ sacc+=a; sacc+=b; PIN(sacc); }while(0)
  #define STEP2(t,GK,GV,GL) do{ SBAR(); \
    const lds_cptr vp_=vp0+2*sl_prev; \
    VRD(0); SBAR(); GAPAF(C0=__builtin_amdgcn_mfma_f32_32x32x16_bf16(kf[0],qr[0],zc,0,0,0), C1[0],C1[1],C1[2],C1[3],     pw2[0]=PKW(C1,0), pw2[1]=PKW(C1,2), pw2); \
    VRD(4); SBAR(); GAPAF(C0=__builtin_amdgcn_mfma_f32_32x32x16_bf16(kf[2],qr[1],C0,0,0,0), C1[4],C1[5],C1[6],C1[7],     pw2[2]=PKW(C1,4), pw2[3]=PKW(C1,6), pw2); \
    VRD(1); SBAR(); GAPAF(C0=__builtin_amdgcn_mfma_f32_32x32x16_bf16(kf[4],qr[2],C0,0,0,0), C1[8],C1[9],C1[10],C1[11],   pw3[0]=PKW(C1,8), pw3[1]=PKW(C1,10), pw3); \
    VRD(5); SBAR(); GAPAF(C0=__builtin_amdgcn_mfma_f32_32x32x16_bf16(kf[6],qr[3],C0,0,0,0), C1[12],C1[13],C1[14],C1[15], pw3[2]=PKW(C1,12),pw3[3]=PKW(C1,14), pw3); \
    l_reg+=sacc; \
    VRD(2); SBAR(); GAPA(C1=__builtin_amdgcn_mfma_f32_32x32x16_bf16(kf[1],qr[0],zc,0,0,0)); \
    VRD(6); SBAR(); GAPA(C1=__builtin_amdgcn_mfma_f32_32x32x16_bf16(kf[3],qr[1],C1,0,0,0)); \
    VRD(3); SBAR(); GAPA(C1=__builtin_amdgcn_mfma_f32_32x32x16_bf16(kf[5],qr[2],C1,0,0,0)); \
    VRD(7); SBAR(); GAPA(C1=__builtin_amdgcn_mfma_f32_32x32x16_bf16(kf[7],qr[3],C1,0,0,0)); \
    if(GK){DMA_K((t)+3,sl_cur);} if(GV){DMA_V((t)+1,sl_next);} \
    CMASK(C0,C1,t); \
    { float a=MX3(C0[0],C0[1],C1[0]),b=MX3(C0[2],C0[3],C1[1]); a=MX3(a,C1[2],C1[3]); \
      _Pragma("unroll") for(int r=4;r<16;r+=4){a=MX3(a,C0[r],C0[r+1]);b=MX3(b,C0[r+2],C0[r+3]);a=MX3(a,C1[r],C1[r+1]);b=MX3(b,C1[r+2],C1[r+3]);} \
      float rm=__builtin_fmaxf(a,b); { auto rr=__builtin_amdgcn_permlane32_swap(__float_as_uint(rm),__float_as_uint(rm),false,false); rm=__builtin_fmaxf(__uint_as_float(rr[0]),__uint_as_float(rr[1])); } \
      resc=false; rm-=mhat; \
      if(__builtin_expect(__any(rm>(float)THRL),0)){ const float dl=__builtin_fmaxf(rm,0.f); mhat+=dl; \
        const float f=__builtin_amdgcn_exp2f(-dl); l_reg*=f; if(hi==0)wsf[r32]=f; resc=true; } } \
    SBAR(); \
    o[0]=__builtin_amdgcn_mfma_f32_32x32x16_bf16(PAF(0),VFR(0),o[0],0,0,0); EX2(C0,0);  VRD2(0); SBAR(); \
    o[1]=__builtin_amdgcn_mfma_f32_32x32x16_bf16(PAF(0),VFR(4),o[1],0,0,0); EX2(C0,2);  VRD2(4); SBAR(); \
    o[0]=__builtin_amdgcn_mfma_f32_32x32x16_bf16(PAF(1),VFR(1),o[0],0,0,0); EX2(C0,4);  VRD2(1); SBAR(); \
    o[1]=__builtin_amdgcn_mfma_f32_32x32x16_bf16(PAF(1),VFR(5),o[1],0,0,0); EX2(C0,6);  VRD2(5); SBAR(); \
    o[0]=__builtin_amdgcn_mfma_f32_32x32x16_bf16(PAF(2),VFR(2),o[0],0,0,0); EX2(C0,8);  VRD2(2); SBAR(); \
    o[1]=__builtin_amdgcn_mfma_f32_32x32x16_bf16(PAF(2),VFR(6),o[1],0,0,0); EX2(C0,10); VRD2(6); SBAR(); \
    o[0]=__builtin_amdgcn_mfma_f32_32x32x16_bf16(PAF(3),VFR(3),o[0],0,0,0); EX2(C0,12); VRD2(3); SBAR(); \
    o[1]=__builtin_amdgcn_mfma_f32_32x32x16_bf16(PAF(3),VFR(7),o[1],0,0,0); EX2(C0,14); VRD2(7); SBAR(); \
    sacc=0.f; \
    o[2]=__builtin_amdgcn_mfma_f32_32x32x16_bf16(PAF(0),VFR(0),o[2],0,0,0); EX2(C1,0);  ADD2(C0[0],C0[1]);   KRD(GL,0); SBAR(); \
    o[3]=__builtin_amdgcn_mfma_f32_32x32x16_bf16(PAF(0),VFR(4),o[3],0,0,0); EX2(C1,2);  ADD2(C0[2],C0[3]);   KRD(GL,1); SBAR(); \
    o[2]=__builtin_amdgcn_mfma_f32_32x32x16_bf16(PAF(1),VFR(1),o[2],0,0,0); EX2(C1,4);  ADD2(C0[4],C0[5]);   pw0[0]=PKW(C0,0); pw0[1]=PKW(C0,2); PIN(pw0); KRD(GL,2); SBAR(); \
    o[3]=__builtin_amdgcn_mfma_f32_32x32x16_bf16(PAF(1),VFR(5),o[3],0,0,0); EX2(C1,6);  ADD2(C0[6],C0[7]);   pw0[2]=PKW(C0,4); pw0[3]=PKW(C0,6); PIN(pw0); KRD(GL,3); SBAR(); \
    o[2]=__builtin_amdgcn_mfma_f32_32x32x16_bf16(PAF(2),VFR(2),o[2],0,0,0); EX2(C1,8);  ADD2(C0[8],C0[9]);   pw1[0]=PKW(C0,8); pw1[1]=PKW(C0,10); PIN(pw1); SBAR(); \
    o[3]=__builtin_amdgcn_mfma_f32_32x32x16_bf16(PAF(2),VFR(6),o[3],0,0,0); EX2(C1,10); ADD2(C0[10],C0[11]); pw1[2]=PKW(C0,12); pw1[3]=PKW(C0,14); PIN(pw1); SBAR(); \
    o[2]=__builtin_amdgcn_mfma_f32_32x32x16_bf16(PAF(3),VFR(3),o[2],0,0,0); EX2(C1,12); ADD2(C0[12],C0[13]); SBAR(); \
    o[3]=__builtin_amdgcn_mfma_f32_32x32x16_bf16(PAF(3),VFR(7),o[3],0,0,0); EX2(C1,14); ADD2(C0[14],C0[15]); SBAR(); \
    }while(0)
  #define ENDW(tt) do{ if((tt)+3<NT){WAIT_BAR(3);} else if((tt)+2<NT){WAIT_BAR(2);} else {WAIT_BAR(0);} }while(0)
  int t=1;
  #undef CMASK
  #define CMASK(P0,P1,t) do{}while(0)
  for(;t+4<NT;++t){ STEP2(t,true,true,true); WAIT_BAR(3); RESC(); ROT(); }
  #undef CMASK
  #define CMASK(P0,P1,t) do{int jb_=(t)-(NT-4); if(jb_>=0)cmask(P0,P1,jb_,qrel,hi);}while(0)
  for(;t+1<NT;++t){ STEP2(t,(t+3<NT),(t+1<NT),(t+1<NT)); ENDW(t); RESC(); ROT(); }
  STEP2(NT-1,false,false,false); RESC();
  { _Pragma("unroll") for(int r=0;r<16;++r)sacc+=C1[r]; l_reg+=sacc;
    pw2=(u32x4){PKW(C1,0),PKW(C1,2),PKW(C1,4),PKW(C1,6)};pw3=(u32x4){PKW(C1,8),PKW(C1,10),PKW(C1,12),PKW(C1,14)}; }
  { SBAR(); const int vb=vb0+2*sl_cur;
    #pragma unroll
    for(int d0=0;d0<4;++d0){s16x4 lo[4],hi4[4];
      #pragma unroll
      for(int ks=0;ks<4;++ks){
        asm volatile("ds_read_b64_tr_b16 %0,%1 offset:%c2":"=&v"(lo[ks]):"v"(vb),"i"(d0*4096+ks*1024):"memory");
        asm volatile("ds_read_b64_tr_b16 %0,%1 offset:%c2":"=&v"(hi4[ks]):"v"(vb),"i"(d0*4096+ks*1024+512):"memory");}
      asm volatile("s_waitcnt lgkmcnt(0)":::"memory");SBAR();
      #define PK(k) (bf16x8){lo[k][0],lo[k][1],lo[k][2],lo[k][3],hi4[k][0],hi4[k][1],hi4[k][2],hi4[k][3]}
      o[d0]=__builtin_amdgcn_mfma_f32_32x32x16_bf16(PAF(0),PK(0),o[d0],0,0,0);
      o[d0]=__builtin_amdgcn_mfma_f32_32x32x16_bf16(PAF(1),PK(1),o[d0],0,0,0);
      o[d0]=__builtin_amdgcn_mfma_f32_32x32x16_bf16(PAF(2),PK(2),o[d0],0,0,0);
      o[d0]=__builtin_amdgcn_mfma_f32_32x32x16_bf16(PAF(3),PK(3),o[d0],0,0,0);
      #undef PK
    } }
  {auto rr=__builtin_amdgcn_permlane32_swap(__float_as_uint(l_reg),__float_as_uint(l_reg),false,false);l_reg=__uint_as_float(rr[0])+__uint_as_float(rr[1]);}
  if(hi==0)wsf[32+r32]=l_reg;asm volatile("s_waitcnt lgkmcnt(0)":::"memory");
  float rli[16];
  #pragma unroll
  for(int r=0;r<16;++r)rli[r]=__builtin_amdgcn_rcpf(wsf[32+crow(r,hi)]);
  bf16*Ow=Oh+(long)(q0+wid*QBLK)*PO;
  { bf16*stg=(bf16*)(shm+L2_OST)+wid*2048;
    #pragma unroll
    for(int hf=0;hf<2;++hf){
      #pragma unroll
      for(int r=0;r<16;++r){const int orow=crow(r,hi);
        #pragma unroll
        for(int d0=0;d0<2;++d0)stg[orow*64+d0*32+r32]=__float2bfloat16(o[2*hf+d0][r]*rli[r]);}
      asm volatile("s_waitcnt lgkmcnt(0)":::"memory");
      #pragma unroll
      for(int i=0;i<4;++i){const int row=i*8+(lane>>3),ch=lane&7; const u32x4 v=*(const u32x4*)(stg+row*64+ch*8); ATTN_STORE16(Ow+(long)row*PO+hf*64+ch*8,v);}
      asm volatile("s_waitcnt lgkmcnt(0)":::"memory");
    } }
  asm volatile("s_waitcnt lgkmcnt(0)\n\ts_barrier":::"memory");
  #undef DMA_K
  #undef DMA_V
  #undef CMASK
  #undef RESC
  #undef ROT
  #undef PKW
  #undef PAF
  #undef VFR
  #undef PIN
  #undef MX3
  #undef EX
  #undef GAPA
  #undef GAPAF
  #undef EX2
  #undef ADD2
  #undef VRD
  #undef VRD2
  #undef KRD
  #undef STEP2
  #undef ENDW
}
#undef SBAR
#undef WAIT_BAR
}
#define GAS __attribute__((address_space(1)))
#define LAS __attribute__((address_space(3)))
typedef unsigned short bf16;
typedef unsigned v4u __attribute__((ext_vector_type(4)));
typedef float f32x4 __attribute__((ext_vector_type(4)));
typedef short bf16x8 __attribute__((ext_vector_type(8)));
typedef GAS unsigned gu32;
typedef GAS unsigned long long gu64;
#define RLX_AGENT __ATOMIC_RELAXED, __HIP_MEMORY_SCOPE_AGENT
#define LDS_WAIT() asm volatile("s_waitcnt lgkmcnt(0)" ::: "memory")
#define VM_WAIT() asm volatile("s_waitcnt vmcnt(0)" ::: "memory")
__device__ __forceinline__ unsigned long long rt() { return __builtin_amdgcn_s_memrealtime(); }
__device__ __forceinline__ unsigned f2bf(float f) { unsigned u = __builtin_bit_cast(unsigned, f); return (u + 0x7fffu + ((u >> 16) & 1u)) >> 16; }
__device__ __forceinline__ unsigned pk2(float lo, float hi) { return f2bf(lo) | (f2bf(hi) << 16); }

#define XB_TMO      128
#define XB_XCNT(j)  (256  + 64 * (j))
#define XB_XSUB(j)  (1280 + 64 * (j))
#define XB_XGEN(j)  (2304 + 64 * (j))
#define XB_TOP      3328
#define XB_TOPGEN   3392
#define XCD_BAR_WORDS 3456
#define XB_SPIN_CAP (1u << 18)

__device__ __forceinline__ unsigned xb_ld(unsigned* p)              { return __hip_atomic_load(p, __ATOMIC_RELAXED, __HIP_MEMORY_SCOPE_AGENT); }
__device__ __forceinline__ unsigned xb_add(unsigned* p, unsigned v) { return __hip_atomic_fetch_add(p, v, __ATOMIC_RELAXED, __HIP_MEMORY_SCOPE_AGENT); }
__device__ __forceinline__ unsigned xb_xcc_id() { return (unsigned)__builtin_amdgcn_s_getreg((3 << 11) | 20) & 0xFu; }
#define XB_SPIN(cond, bar) do { unsigned _sp = 0; while (cond) { __builtin_amdgcn_s_sleep(1); \
    if ((++_sp & 255u) == 0u) { if (xb_ld(&(bar)[XB_TMO])) break; if (_sp > XB_SPIN_CAP) { atomicAdd(&(bar)[XB_TMO], 1u); break; } } } } while (0)

struct XcdBarrier {
    unsigned* bar; unsigned x;
    volatile LAS unsigned* st;
};

__device__ __forceinline__ XcdBarrier xcd_barrier_post(unsigned* bar, volatile LAS unsigned* st, const int tid) {
    XcdBarrier b; b.bar = bar; b.x = xb_xcc_id(); b.st = st;
    if (tid == 0) (void)xb_add(&bar[XB_XCNT(b.x)], 1u);
    return b;
}
__device__ __forceinline__ void xcd_barrier_complete(unsigned* bar, unsigned x, unsigned& nloc, unsigned& nx) {
    const unsigned G = gridDim.x * gridDim.y * gridDim.z;
    unsigned sum, cnt, mine, sp = 0u;
    for (;;) {
        sum = 0u; cnt = 0u; mine = 0u;
#pragma unroll
        for (unsigned j = 0; j < 16; ++j) { const unsigned c = xb_ld(&bar[XB_XCNT(j)]); sum += c; cnt += (c > 0u) ? 1u : 0u; mine = (j == x) ? c : mine; }
        if (sum == G) break;
        __builtin_amdgcn_s_sleep(1);
        if ((++sp & 255u) == 0u) { if (xb_ld(&bar[XB_TMO])) break; if (sp > XB_SPIN_CAP) { atomicAdd(&bar[XB_TMO], 1u); break; } }
    }
    nloc = mine > 0u ? mine : 1u; nx = cnt > 0u ? cnt : 1u;
}

__device__ __forceinline__ void xcd_barrier(const XcdBarrier& b, const int tid) {
    asm volatile("s_waitcnt vmcnt(0)" ::: "memory");
    __syncthreads();
    if (tid == 0) {
        unsigned* bar = b.bar;
        __builtin_amdgcn_s_waitcnt(0);
        unsigned nloc = b.st[0], nx = b.st[1];
        if (nloc == 0u) { xcd_barrier_complete(bar, b.x, nloc, nx); b.st[0] = nloc; b.st[1] = nx; }
        const unsigned old = xb_add(&bar[XB_XSUB(b.x)], 1u);
        const unsigned gen = old / nloc;
        if (old + 1u == (gen + 1u) * nloc) {
            __builtin_amdgcn_fence(__ATOMIC_RELEASE, "agent");
            asm volatile("s_waitcnt vmcnt(0)" ::: "memory");
            const unsigned og = xb_add(&bar[XB_TOP], 1u);
            const unsigned tg = og / nx;
            if (og + 1u == (tg + 1u) * nx) xb_add(&bar[XB_TOPGEN], 1u);
            else XB_SPIN(xb_ld(&bar[XB_TOPGEN]) == tg, bar);
            __builtin_amdgcn_fence(__ATOMIC_ACQUIRE, "agent");
            xb_add(&bar[XB_XGEN(b.x)], 1u);
            asm volatile("s_waitcnt vmcnt(0)" ::: "memory");
        } else {
            XB_SPIN(xb_ld(&bar[XB_XGEN(b.x)]) == gen, bar);
            __builtin_amdgcn_fence(__ATOMIC_ACQUIRE, "agent");
            asm volatile("s_waitcnt vmcnt(0)" ::: "memory");
        }
    }
    __syncthreads();
}
constexpr int NWAVES = 8;
#ifndef MK_N_LAUNCHES
#define MK_N_LAUNCHES 1
#endif
constexpr int NPH_LAYER = 11, NPH = 2 + 2 * NPH_LAYER;
constexpr int N_LAUNCHES = MK_N_LAUNCHES;
static_assert(N_LAUNCHES == 1 || N_LAUNCHES == NPH, "MK_N_LAUNCHES is 1 or NPH");

constexpr int SEQ = 16384, DMODEL = 1024, DIN = 2816, FFD = 2816, NEXP = 8, EDIM = 3584, DEPTH = 2;
constexpr int M = SEQ;
constexpr float LN_EPS = 1e-5f;
constexpr float ALPHA = 1.4142135623730951f;
constexpr int MAXSLOT = 135 * 256;
#ifndef FP8_DENSE
#define FP8_DENSE 0
#endif
#ifndef FP8_MOE
#define FP8_MOE 1
#endif
constexpr float SA_H = 16.0f, SW_UP = 256.0f, S_HID = 8.0f, SW_DN = 512.0f, UP_DESCALE = 1.0f / (16.0f * 256.0f), DN_DESCALE = 1.0f / (8.0f * 512.0f);

constexpr size_t MiB = 1u << 20;
constexpr size_t WS_CTL = 0, CTL_ZERO_BYTES = 1 * MiB;
constexpr size_t WS_SMALL = 1 * MiB;
constexpr size_t SM_MOD = 0, SM_LBS = 49152, SM_LAM = 51200, SM_TOK = 65536, SM_PERM = 327680;
constexpr size_t WS_ROPE = 2 * MiB;
constexpr size_t WS_EXP13 = 6 * MiB, WS_EXP2 = 118 * MiB;
constexpr size_t WS_HPERM = 174 * MiB;
constexpr size_t WS_YSLOT = 174 * MiB;
constexpr size_t WS_HID = 242 * MiB;
constexpr size_t WS_PROJ = 242 * MiB, WS_DHID = 242 * MiB;
constexpr size_t WS_ATTNO = 330 * MiB, WS_HBUF = 330 * MiB;
constexpr size_t WS_MIX = 362 * MiB, WS_HGS = 394 * MiB, WS_HGD = 410 * MiB;
constexpr size_t WS_WIN = 411 * MiB, WS_WOUT = 422 * MiB, WS_FFN13 = 426 * MiB, WS_FFN2 = 437 * MiB;
constexpr size_t WS_END = 479 * MiB;
static_assert(WS_YSLOT + (size_t)MAXSLOT * 1024 * 2 <= WS_HID && WS_HID + (size_t)MAXSLOT * 3584 * 2 <= WS_END && WS_FFN2 + (size_t)1024 * 2816 * 2 <= WS_END, "d_ws map");
constexpr int CW_TMO = 0, CW_CODE = 1;
constexpr int CW_CNT = 64;
constexpr int CW_BAR = 4096;

constexpr int RING_OFF = 0, RING_BYTES = 131072;
constexpr int LDSCTL_OFF = RING_BYTES, MISC_OFF = LDSCTL_OFF + 320;
constexpr int XTRA_OFF = LDSCTL_OFF + 1024;
constexpr int LDS_BYTES = 147456;

__device__ __forceinline__ float bf2f(unsigned short b) { return __uint_as_float((unsigned)b << 16); }
template <int O> __device__ __forceinline__ float swzx(float v) { return __int_as_float(__builtin_amdgcn_ds_swizzle(__float_as_int(v), (O << 10) | 0x1f)); }
__device__ __forceinline__ float wave_sum(float v) {
    v += swzx<1>(v); v += swzx<2>(v); v += swzx<4>(v); v += swzx<8>(v); v += swzx<16>(v);
    auto rr = __builtin_amdgcn_permlane32_swap(__float_as_uint(v), __float_as_uint(v), false, false);
    return __uint_as_float(rr[0]) + __uint_as_float(rr[1]);
}
__device__ __forceinline__ float sigmoid_f(float z) { return __builtin_amdgcn_rcpf(1.0f + __builtin_amdgcn_exp2f(-1.4426950408889634f * z)); }
__device__ __forceinline__ float silu_ff(float a) { return a * sigmoid_f(a); }

struct Args { const float* in[23]; float* out; unsigned char* ws; int ph_lo, ph_hi, li, pad; };
enum { I_X = 0, I_C, I_WADA, I_BADA, I_WIN, I_LAMQK, I_ATTNG, I_HGLB, I_HGG, I_POOLW, I_POOLS, I_WOUT, I_LN1G, I_LN1B, I_LN2G, I_LN2B, I_FW1, I_FW3, I_FW2, I_RW, I_EW1, I_EW3, I_EW2 };

struct Frame {
    LAS unsigned char* lds; volatile LAS unsigned* MISC; gu32* ctl; unsigned char* ws;
    int tid, lane, wave, vcu, G, bid;
};

__device__ const float kInvFreq[32] = {1.f, 0.749894202f, 0.562341332f, 0.421696514f, 0.316227764f, 0.237137392f, 0.177827939f, 0.133352146f, 0.100000001f, 0.0749894157f, 0.0562341288f, 0.0421696492f,
    0.0316227786f, 0.0237137359f, 0.0177827943f, 0.0133352149f, 0.00999999978f, 0.00749894232f, 0.00562341325f, 0.00421696482f, 0.00316227786f, 0.00237137382f, 0.00177827943f, 0.00133352145f,
    0.00100000005f, 0.000749894185f, 0.000562341302f, 0.000421696546f, 0.000316227786f, 0.000237137385f, 0.00017782794f, 0.00013335215f};

template <int KIND> __device__ __forceinline__ int rowmap(int n) {
    if (KIND == 0) { if (n >= 1024) return n; const int d = n & 63; return (n & ~63) + ((d < 32) ? 2 * d : 2 * (d - 32) + 1); }
    if (KIND == 2) return ((n >> 7) << 8) + (n & 127);
    if (KIND == 3) return ((n >> 7) << 8) + 128 + (n & 127);
    return n;
}
template <int KIND> __device__ __forceinline__ void transpose_item(const float* W_, int K, int N, bf16* WT, LAS float* scr, int item, int lane) {
    const GAS float* W = (const GAS float*)W_;
    const int nblk = N / 32, kb = item / nblk, nb = item % nblk, k0 = 64 * kb, n0 = 32 * nb;
#pragma unroll 8
    for (int i = 0; i < 32; ++i) { const int kk = 2 * i + (lane >> 5); scr[kk * 33 + (lane & 31)] = W[(size_t)(k0 + kk) * N + n0 + (lane & 31)]; }
    LDS_WAIT(); asm volatile("" ::: "memory");
    const int c = lane & 7;
#pragma unroll
    for (int j = 0; j < 4; ++j) { const int n = (lane >> 3) + 8 * j; const LAS float* s = scr + (8 * c) * 33 + n;
        v4u o; o.x = pk2(s[0 * 33], s[1 * 33]); o.y = pk2(s[2 * 33], s[3 * 33]); o.z = pk2(s[4 * 33], s[5 * 33]); o.w = pk2(s[6 * 33], s[7 * 33]);
        *(GAS v4u*)(WT + (size_t)rowmap<KIND>(n0 + n) * K + k0 + 8 * c) = o; }
    LDS_WAIT(); asm volatile("" ::: "memory");
}
template <int KIND> __device__ __forceinline__ void transpose_item8(const float* W_, int K, int N, unsigned char* WT, LAS float* scr, int item, int lane, float scale) {
    const GAS float* W = (const GAS float*)W_;
    const int nblk = N / 32, kb = item / nblk, nb = item % nblk, k0 = 64 * kb, n0 = 32 * nb;
#pragma unroll 8
    for (int i = 0; i < 32; ++i) { const int kk = 2 * i + (lane >> 5); scr[kk * 33 + (lane & 31)] = W[(size_t)(k0 + kk) * N + n0 + (lane & 31)]; }
    LDS_WAIT(); asm volatile("" ::: "memory");
    const int c = lane & 7;
#pragma unroll
    for (int j = 0; j < 4; ++j) { const int n = (lane >> 3) + 8 * j; const LAS float* s = scr + (8 * c) * 33 + n;
        pg8::u32x2 o; o.x = pg8::pk4_fp8(s[0 * 33] * scale, s[1 * 33] * scale, s[2 * 33] * scale, s[3 * 33] * scale); o.y = pg8::pk4_fp8(s[4 * 33] * scale, s[5 * 33] * scale, s[6 * 33] * scale, s[7 * 33] * scale);
        *(GAS pg8::u32x2*)(WT + (size_t)rowmap<KIND>(n0 + n) * K + k0 + 8 * c) = o; }
    LDS_WAIT(); asm volatile("" ::: "memory");
}
__device__ __forceinline__ void sincos_acc(float ang, float& s, float& c) {
    const double a = (double)ang; const double n = __builtin_rint(a * 0.63661977236758134308);
    double r = __builtin_fma(-n, 1.57079632679489655800, a); r = __builtin_fma(-n, 6.12323399573676603587e-17, r);
    const double r2 = r * r;
    double sp = -1.0 / 1307674368000.0; sp = sp * r2 + 1.0 / 6227020800.0; sp = sp * r2 - 1.0 / 39916800.0; sp = sp * r2 + 1.0 / 362880.0; sp = sp * r2 - 1.0 / 5040.0; sp = sp * r2 + 1.0 / 120.0; sp = sp * r2 - 1.0 / 6.0;
    const double sr = r + r * r2 * sp;
    double cp = 1.0 / 20922789888000.0; cp = cp * r2 - 1.0 / 87178291200.0; cp = cp * r2 + 1.0 / 479001600.0; cp = cp * r2 - 1.0 / 3628800.0; cp = cp * r2 + 1.0 / 40320.0; cp = cp * r2 - 1.0 / 720.0; cp = cp * r2 + 1.0 / 24.0; cp = cp * r2 - 0.5;
    const double cr = 1.0 + r2 * cp;
    const int q = ((int)n) & 3;
    const double ss = (q == 0) ? sr : (q == 1) ? cr : (q == 2) ? -sr : -cr;
    const double cc = (q == 0) ? cr : (q == 1) ? -sr : (q == 2) ? -cr : sr;
    s = (float)ss; c = (float)cc;
}
__device__ __forceinline__ void p0a_prologue(Frame& F, const Args& A) {
    const int gw = F.vcu * NWAVES + F.wave, NGW = F.G * NWAVES;
    {
        LAS float* red = (LAS float*)(F.lds + XTRA_OFF);
        for (int cb = F.bid; cb < 256; cb += F.G) {
            const int fc = cb * 48 + F.lane; const int l = fc / 6144, j = fc % 6144; float acc = 0.f;
            if (F.lane < 48) {
                const float* w = A.in[I_WADA] + (size_t)l * 1024 * 6144 + j; const float* c = A.in[I_C];
#pragma unroll 8
                for (int k = F.wave * 128; k < F.wave * 128 + 128; ++k) acc += silu_ff(c[k]) * w[(size_t)k * 6144];
            }
            red[F.wave * 64 + F.lane] = acc;
            __syncthreads();
            if (F.wave == 0 && F.lane < 48) { float s = 0.f;
#pragma unroll
                for (int w8 = 0; w8 < 8; ++w8) s += red[w8 * 64 + F.lane];
                ((float*)(F.ws + WS_SMALL + SM_MOD))[fc] = s + A.in[I_BADA][fc]; }
            __syncthreads();
        }
    }
    {
        float* cosT = (float*)(F.ws + WS_ROPE); float* sinT = cosT + (size_t)SEQ * 32;
        for (int idx = F.bid * (NWAVES * 64) + F.tid; idx < SEQ * 32; idx += F.G * NWAVES * 64) {
            const int pos = idx >> 5, i = idx & 31; const float ang = (float)pos * kInvFreq[i]; float s, c; sincos_acc(ang, s, c);
            cosT[idx] = c; sinT[idx] = s; }
    }
    if (F.bid == 0) {
        float* lbs = (float*)(F.ws + WS_SMALL + SM_LBS); float* lam = (float*)(F.ws + WS_SMALL + SM_LAM);
        if (F.tid < 256) { const float a0 = A.in[I_HGLB][F.tid], a1 = A.in[I_HGLB][256 + F.tid]; const float mx = fmaxf(a0, a1); const float e0 = __expf(a0 - mx), e1 = __expf(a1 - mx);
            lbs[F.tid] = 0.f; lbs[256 + F.tid] = e1 / (e0 + e1); }
        if (F.tid >= 256 && F.tid < 258) { const int l = F.tid - 256; const float* q = A.in[I_LAMQK] + l * 256; float s1 = 0.f, s2 = 0.f;
            for (int j = 0; j < 64; ++j) { s1 += q[j] * q[64 + j]; s2 += q[128 + j] * q[192 + j]; }
            const float li = 0.8f - 0.6f * expf(-0.3f * (float)l); lam[l] = expf(s1) - expf(s2) + li; lam[2 + l] = li; }
    }
    LAS float* scr = (LAS float*)(F.lds + RING_OFF + F.wave * 16384);
    constexpr int I_WI = 16 * 88, I_WO = 16 * 32, I_F13 = 16 * 88, I_F2 = 44 * 32, I_E13 = 16 * 112, I_E2 = 56 * 32;
    constexpr int NITEMS = 2 * I_WI + 2 * I_WO + 2 * I_F13 + I_F2 + 16 * I_E13 + 8 * I_E2;
    for (int it = gw; it < NITEMS; it += NGW) {
        int r = it;
        if (r < 2 * I_WI) { const int l = r / I_WI; transpose_item<0>(A.in[I_WIN] + (size_t)l * 1024 * DIN, 1024, DIN, (bf16*)(F.ws + WS_WIN) + (size_t)l * DIN * 1024, scr, r % I_WI, F.lane); continue; } r -= 2 * I_WI;
        if (r < 2 * I_WO) { const int l = r / I_WO; transpose_item<1>(A.in[I_WOUT] + (size_t)l * 1024 * 1024, 1024, 1024, (bf16*)(F.ws + WS_WOUT) + (size_t)l * 1024 * 1024, scr, r % I_WO, F.lane); continue; } r -= 2 * I_WO;
#if FP8_DENSE
        if (r < I_F13) { transpose_item8<2>(A.in[I_FW1], 1024, FFD, F.ws + WS_FFN13, scr, r, F.lane, SW_UP); continue; } r -= I_F13;
        if (r < I_F13) { transpose_item8<3>(A.in[I_FW3], 1024, FFD, F.ws + WS_FFN13, scr, r, F.lane, SW_UP); continue; } r -= I_F13;
        if (r < I_F2) { transpose_item8<1>(A.in[I_FW2], FFD, 1024, F.ws + WS_FFN2, scr, r, F.lane, SW_DN); continue; } r -= I_F2;
#else
        if (r < I_F13) { transpose_item<2>(A.in[I_FW1], 1024, FFD, (bf16*)(F.ws + WS_FFN13), scr, r, F.lane); continue; } r -= I_F13;
        if (r < I_F13) { transpose_item<3>(A.in[I_FW3], 1024, FFD, (bf16*)(F.ws + WS_FFN13), scr, r, F.lane); continue; } r -= I_F13;
        if (r < I_F2) { transpose_item<1>(A.in[I_FW2], FFD, 1024, (bf16*)(F.ws + WS_FFN2), scr, r, F.lane); continue; } r -= I_F2;
#endif
#if FP8_MOE
        if (r < 8 * I_E13) { const int e = r / I_E13; transpose_item8<2>(A.in[I_EW1] + (size_t)e * 1024 * EDIM, 1024, EDIM, F.ws + WS_EXP13 + (size_t)e * 2 * EDIM * 1024, scr, r % I_E13, F.lane, SW_UP); continue; } r -= 8 * I_E13;
        if (r < 8 * I_E13) { const int e = r / I_E13; transpose_item8<3>(A.in[I_EW3] + (size_t)e * 1024 * EDIM, 1024, EDIM, F.ws + WS_EXP13 + (size_t)e * 2 * EDIM * 1024, scr, r % I_E13, F.lane, SW_UP); continue; } r -= 8 * I_E13;
        { const int e = r / I_E2; transpose_item8<1>(A.in[I_EW2] + (size_t)e * EDIM * 1024, EDIM, 1024, F.ws + WS_EXP2 + (size_t)e * 1024 * EDIM, scr, r % I_E2, F.lane, SW_DN); }
#else
        if (r < 8 * I_E13) { const int e = r / I_E13; transpose_item<2>(A.in[I_EW1] + (size_t)e * 1024 * EDIM, 1024, EDIM, (bf16*)(F.ws + WS_EXP13) + (size_t)e * 2 * EDIM * 1024, scr, r % I_E13, F.lane); continue; } r -= 8 * I_E13;
        if (r < 8 * I_E13) { const int e = r / I_E13; transpose_item<3>(A.in[I_EW3] + (size_t)e * 1024 * EDIM, 1024, EDIM, (bf16*)(F.ws + WS_EXP13) + (size_t)e * 2 * EDIM * 1024, scr, r % I_E13, F.lane); continue; } r -= 8 * I_E13;
        { const int e = r / I_E2; transpose_item<1>(A.in[I_EW2] + (size_t)e * EDIM * 1024, EDIM, 1024, (bf16*)(F.ws + WS_EXP2) + (size_t)e * 1024 * EDIM, scr, r % I_E2, F.lane); }
#endif
    }
}

__device__ __forceinline__ void load4(f32x4 (&v)[4], const float* p, int lane) { const GAS f32x4* q = (const GAS f32x4*)p + lane;
#pragma unroll
    for (int j = 0; j < 4; ++j) v[j] = q[64 * j]; }
__device__ __forceinline__ void store_bf16_row(bf16* orow, const f32x4 (&v)[4], int lane) {
    GAS unsigned long long* o8 = (GAS unsigned long long*)orow + lane;
#pragma unroll
    for (int j = 0; j < 4; ++j) o8[64 * j] = (unsigned long long)pk2(v[j].x, v[j].y) | ((unsigned long long)pk2(v[j].z, v[j].w) << 32);
}
__device__ __forceinline__ void store_f32_row(float* orow, const f32x4 (&v)[4], int lane) { GAS f32x4* o = (GAS f32x4*)orow + lane;
#pragma unroll
    for (int j = 0; j < 4; ++j) o[64 * j] = v[j]; }
__device__ __forceinline__ void store_fp8_row(unsigned char* orow, const f32x4 (&v)[4], int lane, float scale) {
    GAS unsigned* o4 = (GAS unsigned*)orow + lane;
#pragma unroll
    for (int j = 0; j < 4; ++j) o4[64 * j] = pg8::pk4_fp8(v[j].x * scale, v[j].y * scale, v[j].z * scale, v[j].w * scale);
}
__device__ __forceinline__ void ln_row(f32x4 (&v)[4], const f32x4 (&g)[4], const f32x4 (&b)[4]) {
    float s = 0.f;
#pragma unroll
    for (int j = 0; j < 4; ++j) s += (v[j].x + v[j].y) + (v[j].z + v[j].w);
    const float mean = wave_sum(s) * (1.f / DMODEL); float s2 = 0.f;
#pragma unroll
    for (int j = 0; j < 4; ++j) { v[j] = v[j] - mean; s2 += (v[j].x * v[j].x + v[j].y * v[j].y) + (v[j].z * v[j].z + v[j].w * v[j].w); }
    const float rstd = 1.f / sqrtf(wave_sum(s2) * (1.f / DMODEL) + LN_EPS);
#pragma unroll
    for (int j = 0; j < 4; ++j) v[j] = v[j] * rstd * g[j] + b[j];
}
__device__ __forceinline__ void p_modulate(Frame& F, const float* x, const float* mod  , bf16* H) {
    const int gw = F.vcu * NWAVES + F.wave, NGW = F.G * NWAVES;
    f32x4 sh[4], sc[4]; load4(sh, mod, F.lane); load4(sc, mod + 1024, F.lane);
    for (int m = gw; m < M; m += NGW) { f32x4 v[4]; load4(v, x + (size_t)m * DMODEL, F.lane);
#pragma unroll
        for (int j = 0; j < 4; ++j) v[j] = v[j] * (sc[j] + 1.0f) + sh[j];
        store_bf16_row(H + (size_t)m * DMODEL, v, F.lane); }
}
template <bool ROUTE, bool H8> __device__ __forceinline__ void p_ln(Frame& F, float* xio, const float* lg, const float* lb, const float* mod, bf16* H, const float* rw) {
    const int gw = F.vcu * NWAVES + F.wave, NGW = F.G * NWAVES;
    f32x4 g[4], b[4], sh[4], sc[4]; load4(g, lg, F.lane); load4(b, lb, F.lane);
    if (mod) { load4(sh, mod, F.lane); load4(sc, mod + 1024, F.lane); }
    LAS float* rwT = (LAS float*)(F.lds + RING_OFF);
    LAS int* lcnt = (LAS int*)(F.lds + RING_OFF + 32768);
    LAS int* rinfo = (LAS int*)(F.lds + RING_OFF + 32768 + 256) + F.wave * 64;
    if (ROUTE) {
        for (int i = F.tid; i < 8192; i += NWAVES * 64) { const int k = i >> 3, e = i & 7; rwT[e * 1024 + k] = rw[i]; }
        if (F.tid < 16) lcnt[F.tid] = 0;
        __syncthreads();
    }
    int nr = 0;
    for (int m = gw; m < M; m += NGW) { f32x4 v[4]; load4(v, xio + (size_t)m * DMODEL, F.lane);
        ln_row(v, g, b);
        store_f32_row(xio + (size_t)m * DMODEL, v, F.lane);
        if (mod) {
#pragma unroll
            for (int j = 0; j < 4; ++j) v[j] = v[j] * (sc[j] + 1.0f) + sh[j];
            if (H8) store_fp8_row((unsigned char*)H + (size_t)m * DMODEL, v, F.lane, SA_H); else store_bf16_row(H + (size_t)m * DMODEL, v, F.lane);
        }
        if (ROUTE) {
            float lgt[8];
#pragma unroll
            for (int e = 0; e < 8; ++e) { float s = 0.f;
#pragma unroll
                for (int j = 0; j < 4; ++j) { const f32x4 w = *(const LAS f32x4*)(rwT + e * 1024 + 256 * j + 4 * F.lane); s += (v[j].x * w.x + v[j].y * w.y) + (v[j].z * w.z + v[j].w * w.w); }
                lgt[e] = wave_sum(s); }
            int e0 = 0; float v0 = lgt[0];
#pragma unroll
            for (int e = 1; e < 8; ++e) if (lgt[e] > v0) { v0 = lgt[e]; e0 = e; }
            int e1 = -1; float v1 = -INFINITY;
#pragma unroll
            for (int e = 0; e < 8; ++e) if (e != e0 && (e1 < 0 || lgt[e] > v1)) { v1 = lgt[e]; e1 = e; }
            const float g0 = 1.0f / (1.0f + __expf(v1 - v0));
            if (F.lane == 0) { const int p0 = atomicAdd((int*)&lcnt[e0], 1), p1 = atomicAdd((int*)&lcnt[e1], 1);
                rinfo[nr * 8 + 0] = m; rinfo[nr * 8 + 1] = e0; rinfo[nr * 8 + 2] = e1; rinfo[nr * 8 + 3] = p0; rinfo[nr * 8 + 4] = p1; rinfo[nr * 8 + 5] = __float_as_int(g0); }
            ++nr;
        }
    }
    if (ROUTE) {
        __syncthreads();
        if (F.tid < 8) lcnt[8 + F.tid] = (int)__hip_atomic_fetch_add((unsigned*)(F.ctl + CW_CNT + 64 * F.tid), (unsigned)lcnt[F.tid], __ATOMIC_RELAXED, __HIP_MEMORY_SCOPE_AGENT);
        __syncthreads();
        int* perm = (int*)(F.ws + WS_SMALL + SM_PERM); int* tok = (int*)(F.ws + WS_SMALL + SM_TOK);
        if (F.lane == 0) for (int i = 0; i < nr; ++i) { const int m = rinfo[i * 8 + 0], e0 = rinfo[i * 8 + 1], e1 = rinfo[i * 8 + 2];
            const int p0 = lcnt[8 + e0] + rinfo[i * 8 + 3], p1 = lcnt[8 + e1] + rinfo[i * 8 + 4];
            perm[e0 * SEQ + p0] = m; perm[e1 * SEQ + p1] = m;
            tok[m * 4 + 0] = e0 | (e1 << 8); tok[m * 4 + 1] = p0; tok[m * 4 + 2] = p1; tok[m * 4 + 3] = rinfo[i * 8 + 5]; }
    }
}
__device__ __forceinline__ void p_ln_moe(Frame& F, float* xio, const float* lg, const float* lb, const float* g2v) {
    const int gw = F.vcu * NWAVES + F.wave, NGW = F.G * NWAVES;
    f32x4 g[4], b[4], gg[4]; load4(g, lg, F.lane); load4(b, lb, F.lane); load4(gg, g2v, F.lane);
    int tb[8]; { int acc = 0;
#pragma unroll
        for (int e = 0; e < 8; ++e) { tb[e] = acc; acc += ((int)__hip_atomic_load(F.ctl + CW_CNT + 64 * e, RLX_AGENT) + 255) >> 8; } }
    const int* tok = (const int*)(F.ws + WS_SMALL + SM_TOK); const bf16* Y = (const bf16*)(F.ws + WS_YSLOT);
    for (int m = gw; m < M; m += NGW) {
        const int ee = tok[m * 4 + 0], p0 = tok[m * 4 + 1], p1 = tok[m * 4 + 2]; const float g0 = __int_as_float(tok[m * 4 + 3]), g1 = 1.0f - g0;
        const int e0 = ee & 255, e1 = ee >> 8; int t0 = 0, t1 = 0;
#pragma unroll
        for (int e = 0; e < 8; ++e) { t0 = (e0 == e) ? tb[e] : t0; t1 = (e1 == e) ? tb[e] : t1; }
        const size_t s0 = (size_t)(t0 * 256 + p0), s1 = (size_t)(t1 * 256 + p1);
        f32x4 v[4]; load4(v, xio + (size_t)m * DMODEL, F.lane);
        const GAS unsigned long long* y0 = (const GAS unsigned long long*)(Y + s0 * DMODEL) + F.lane; const GAS unsigned long long* y1 = (const GAS unsigned long long*)(Y + s1 * DMODEL) + F.lane;
#pragma unroll
        for (int j = 0; j < 4; ++j) { const unsigned long long a = y0[64 * j], c = y1[64 * j];
            f32x4 f; f.x = g0 * bf2f((unsigned short)a) + g1 * bf2f((unsigned short)c); f.y = g0 * bf2f((unsigned short)(a >> 16)) + g1 * bf2f((unsigned short)(c >> 16));
            f.z = g0 * bf2f((unsigned short)(a >> 32)) + g1 * bf2f((unsigned short)(c >> 32)); f.w = g0 * bf2f((unsigned short)(a >> 48)) + g1 * bf2f((unsigned short)(c >> 48));
            v[j] = v[j] * ALPHA + (gg[j] + 1.0f) * f; }
        ln_row(v, g, b);
        store_f32_row(xio + (size_t)m * DMODEL, v, F.lane);
    }
}

__device__ __forceinline__ void hg_pass1(Frame& F, int l) {
    const bf16* P = (const bf16*)(F.ws + WS_PROJ); const float* lbs = (const float*)(F.ws + WS_SMALL + SM_LBS) + l * 256;
    float* HGS = (float*)(F.ws + WS_HGS); float* HGD = (float*)(F.ws + WS_HGD);
    LAS float* fk = (LAS float*)(F.lds + RING_OFF + F.wave * 16384);
    LAS float* vl = fk + 1024;
    const int kh = F.wave & 1;
    for (int tk = F.bid * 4 + (F.wave >> 1); tk < 1024; tk += F.G * 4) {
        const int c = tk >> 2, h = tk & 3;
        float S[32];
#pragma unroll
        for (int k = 0; k < 32; ++k) S[k] = 0.f;
        float dp = 1.f;
        for (int sb = 0; sb < 4; ++sb) {
            const int row0 = c * 64 + sb * 16;
#pragma unroll
            for (int j = 0; j < 8; ++j) { const int p = j * 64 + F.lane, tt = p >> 5, kk = p & 31, k = h * 64 + kh * 32 + kk;
                const float z = bf2f(P[(size_t)(row0 + tt) * DIN + 1792 + k]); const float lbv = lbs[k];
                const float f = lbv + (1.0f - lbv) * sigmoid_f(z), key = (1.0f - lbv) * sigmoid_f(-z);
                fk[(tt * 32 + kk) * 2] = f; fk[(tt * 32 + kk) * 2 + 1] = key; }
#pragma unroll
            for (int tt = 0; tt < 16; ++tt) vl[tt * 64 + F.lane] = silu_ff(bf2f(P[(size_t)(row0 + tt) * DIN + 2048 + h * 64 + F.lane]));
            for (int tt = 0; tt < 16; ++tt) {
                const float v = vl[tt * 64 + F.lane];
#pragma unroll
                for (int kk = 0; kk < 32; kk += 2) { const f32x4 q = *(const LAS f32x4*)(fk + (tt * 32 + kk) * 2);
                    S[kk] = q.x * S[kk] + q.y * v; S[kk + 1] = q.z * S[kk + 1] + q.w * v; }
            }
            if (F.lane < 32) {
#pragma unroll
                for (int tt = 0; tt < 16; ++tt) dp *= fk[(tt * 32 + F.lane) * 2]; }
        }
        float* Lp = HGS + ((size_t)(c * 4 + h) * 64 + kh * 32) * 64 + F.lane;
#pragma unroll
        for (int k = 0; k < 32; ++k) Lp[k * 64] = S[k];
        if (F.lane < 32) HGD[c * 256 + h * 64 + kh * 32 + F.lane] = dp;
    }
}
__device__ __forceinline__ void hg_pass2(Frame& F) {
    float* HGS = (float*)(F.ws + WS_HGS); const float* HGD = (const float*)(F.ws + WS_HGD);
    if (F.wave == 0) for (int b = F.bid; b < 256; b += F.G) {
        float carry = 0.f;
        for (int c0 = 0; c0 < 256; c0 += 16) { float Lv[16], Dv[16];
#pragma unroll
            for (int u = 0; u < 16; ++u) { Lv[u] = HGS[(size_t)(c0 + u) * 16384 + b * 64 + F.lane]; Dv[u] = HGD[(c0 + u) * 256 + b]; }
#pragma unroll
            for (int u = 0; u < 16; ++u) { HGS[(size_t)(c0 + u) * 16384 + b * 64 + F.lane] = carry; carry = Dv[u] * carry + Lv[u]; }
        }
    }
}
__device__ __forceinline__ void hg_pass3(Frame& F, int l, const float* hgg) {
    const bf16* P = (const bf16*)(F.ws + WS_PROJ); const float* lbs = (const float*)(F.ws + WS_SMALL + SM_LBS) + l * 256;
    const float* HGS = (const float*)(F.ws + WS_HGS); bf16* MIX = (bf16*)(F.ws + WS_MIX);
    LAS float* fk = (LAS float*)(F.lds + RING_OFF + F.wave * 16384);
    LAS float* vl = fk + 2048;
    LAS float* op = fk + 3072;
    LAS float* opp = (LAS float*)(F.lds + RING_OFF + (F.wave ^ 1) * 16384) + 3072;
    const int kh = F.wave & 1; const float gn = hgg[F.lane];
    for (int tk0 = F.bid * 4; tk0 < 1024; tk0 += F.G * 4) {
        const int tk = tk0 + (F.wave >> 1); const int c = tk >> 2, h = tk & 3;
        float S[32];
        { const float* Sp = HGS + ((size_t)(c * 4 + h) * 64 + kh * 32) * 64 + F.lane;
#pragma unroll
          for (int k = 0; k < 32; ++k) S[k] = Sp[k * 64]; }
        for (int sb = 0; sb < 4; ++sb) {
            const int row0 = c * 64 + sb * 16;
#pragma unroll
            for (int j = 0; j < 8; ++j) { const int p = j * 64 + F.lane, tt = p >> 5, kk = p & 31, k = h * 64 + kh * 32 + kk;
                const float z = bf2f(P[(size_t)(row0 + tt) * DIN + 1792 + k]); const float qv = bf2f(P[(size_t)(row0 + tt) * DIN + 1536 + k]); const float lbv = lbs[k];
                const float f = lbv + (1.0f - lbv) * sigmoid_f(z), key = (1.0f - lbv) * sigmoid_f(-z);
                *(LAS f32x4*)(fk + (tt * 32 + kk) * 4) = (f32x4){f, key, qv, 0.f}; }
#pragma unroll
            for (int tt = 0; tt < 16; ++tt) vl[tt * 64 + F.lane] = silu_ff(bf2f(P[(size_t)(row0 + tt) * DIN + 2048 + h * 64 + F.lane]));
            for (int tt = 0; tt < 16; ++tt) {
                const float v = vl[tt * 64 + F.lane]; float o = 0.f;
#pragma unroll
                for (int kk = 0; kk < 32; ++kk) { const f32x4 q = *(const LAS f32x4*)(fk + (tt * 32 + kk) * 4);
                    S[kk] = q.x * S[kk] + q.y * v; o += q.z * S[kk]; }
                op[tt * 64 + F.lane] = o;
            }
            __syncthreads();
#pragma unroll
            for (int t8 = 0; t8 < 8; ++t8) { const int tt = kh * 8 + t8; const float o = op[tt * 64 + F.lane] + opp[tt * 64 + F.lane];
                const float ss = wave_sum(o * o); const float rstd = 1.0f / sqrtf(ss * (1.0f / 64.0f) + LN_EPS);
                const float gt = bf2f(P[(size_t)(row0 + tt) * DIN + 2304 + h * 64 + F.lane]);
                MIX[(size_t)(row0 + tt) * DMODEL + 512 + h * 64 + F.lane] = (bf16)f2bf(o * rstd * gn * silu_ff(gt)); }
            __syncthreads();
        }
    }
}
__device__ __forceinline__ void pool_phase(Frame& F, const float* pw, const float* ps) {
    const bf16* P = (const bf16*)(F.ws + WS_PROJ); bf16* MIX = (bf16*)(F.ws + WS_MIX);
    LAS float* U = (LAS float*)(F.lds + RING_OFF + F.wave * 16384);
    LAS float* PL = U + 2048;
    const int gw = F.vcu * NWAVES + F.wave, NGW = F.G * NWAVES;
    for (int task = gw; task < 4096; task += NGW) {
        const int tg = task >> 2, gi = task & 3, t0 = tg * 16, win = 2 << gi;
        float wcol[64];
#pragma unroll
        for (int c = 0; c < 64; ++c) wcol[c] = pw[(size_t)(gi * 64 + c) * 64 + F.lane];
        const float scl = ps[gi * 64 + F.lane];
        for (int r = 0; r < 31; ++r) { const int t = t0 - 15 + r; U[r * 64 + F.lane] = (t >= 0) ? bf2f(P[(size_t)t * DIN + 2560 + gi * 64 + F.lane]) : 0.f; }
        for (int tt = 0; tt < 16; ++tt) { float s = 0.f;
            for (int j = 0; j < win; ++j) s += U[(15 + tt - j) * 64 + F.lane];
            const int t = t0 + tt; const float cntw = (float)((t + 1 < win) ? (t + 1) : win);
            PL[tt * 64 + F.lane] = s / cntw - U[(15 + tt) * 64 + F.lane]; }
        for (int tt = 0; tt < 16; ++tt) { float acc = 0.f;
#pragma unroll
            for (int c = 0; c < 64; c += 4) { const f32x4 p4 = *(const LAS f32x4*)(PL + tt * 64 + c);
                acc += p4.x * wcol[c]; acc += p4.y * wcol[c + 1]; acc += p4.z * wcol[c + 2]; acc += p4.w * wcol[c + 3]; }
            MIX[(size_t)(t0 + tt) * DMODEL + 768 + gi * 64 + F.lane] = (bf16)f2bf(acc * scl); }
    }
}
__device__ __forceinline__ void moe_gather(Frame& F) {
    const int gw = F.vcu * NWAVES + F.wave, NGW = F.G * NWAVES;
    int cn[8], tb[9]; tb[0] = 0;
#pragma unroll
    for (int e = 0; e < 8; ++e) { cn[e] = (int)__hip_atomic_load(F.ctl + CW_CNT + 64 * e, RLX_AGENT); tb[e + 1] = tb[e] + ((cn[e] + 255) >> 8); }
    const int* perm = (const int*)(F.ws + WS_SMALL + SM_PERM); const bf16* H = (const bf16*)(F.ws + WS_HBUF); bf16* HP = (bf16*)(F.ws + WS_HPERM);
    for (int slot = gw; slot < tb[8] * 256; slot += NGW) {
        const int T = slot >> 8; int e = 0, tbe = 0, ce = cn[0];
#pragma unroll
        for (int j = 1; j < 8; ++j) if (T >= tb[j]) { e = j; tbe = tb[j]; ce = cn[j]; }
        const int pos = ((T - tbe) << 8) + (slot & 255);
        const int tokn = (pos < ce) ? perm[e * SEQ + pos] : 0;
#if FP8_MOE
        const GAS v4u* src = (const GAS v4u*)((const unsigned char*)H + (size_t)tokn * DMODEL) + F.lane; GAS v4u* dst = (GAS v4u*)((unsigned char*)HP + (size_t)slot * DMODEL) + F.lane;
        dst[0] = src[0];
#else
        const GAS v4u* src = (const GAS v4u*)(H + (size_t)tokn * DMODEL) + F.lane; GAS v4u* dst = (GAS v4u*)(HP + (size_t)slot * DMODEL) + F.lane;
        const v4u a = src[0], b = src[64]; dst[0] = a; dst[64] = b;
#endif
    }
}
__device__ __forceinline__ void attn_finalize(Frame& F, int l, const float* ag) {
    const bf16* O1 = (const bf16*)(F.ws + WS_ATTNO); const bf16* O2 = O1 + (size_t)SEQ * 512; bf16* MIX = (bf16*)(F.ws + WS_MIX);
    const float* lamv = (const float*)(F.ws + WS_SMALL + SM_LAM); const float lam = lamv[l], osc = 1.0f - lamv[2 + l];
    const int gw = F.vcu * NWAVES + F.wave, NGW = F.G * NWAVES;
    float gv[8];
#pragma unroll
    for (int j = 0; j < 8; ++j) gv[j] = ag[(F.lane & 15) * 8 + j] * osc;
    for (int m = gw; m < M; m += NGW) {
        const v4u a = *(const GAS v4u*)(O1 + (size_t)m * 512 + F.lane * 8), b = *(const GAS v4u*)(O2 + (size_t)m * 512 + F.lane * 8);
        float d[8];
        d[0] = __uint_as_float(a.x << 16) - lam * __uint_as_float(b.x << 16); d[1] = __uint_as_float(a.x & 0xffff0000u) - lam * __uint_as_float(b.x & 0xffff0000u);
        d[2] = __uint_as_float(a.y << 16) - lam * __uint_as_float(b.y << 16); d[3] = __uint_as_float(a.y & 0xffff0000u) - lam * __uint_as_float(b.y & 0xffff0000u);
        d[4] = __uint_as_float(a.z << 16) - lam * __uint_as_float(b.z << 16); d[5] = __uint_as_float(a.z & 0xffff0000u) - lam * __uint_as_float(b.z & 0xffff0000u);
        d[6] = __uint_as_float(a.w << 16) - lam * __uint_as_float(b.w << 16); d[7] = __uint_as_float(a.w & 0xffff0000u) - lam * __uint_as_float(b.w & 0xffff0000u);
        float ss = 0.f;
#pragma unroll
        for (int j = 0; j < 8; ++j) ss += d[j] * d[j];
        ss += swzx<1>(ss); ss += swzx<2>(ss); ss += swzx<4>(ss); ss += swzx<8>(ss);
        const float rstd = 1.0f / sqrtf(ss * (1.0f / 128.0f) + LN_EPS);
        v4u o; o.x = pk2(d[0] * rstd * gv[0], d[1] * rstd * gv[1]); o.y = pk2(d[2] * rstd * gv[2], d[3] * rstd * gv[3]);
        o.z = pk2(d[4] * rstd * gv[4], d[5] * rstd * gv[5]); o.w = pk2(d[6] * rstd * gv[6], d[7] * rstd * gv[7]);
        *(GAS v4u*)(MIX + (size_t)m * DMODEL + F.lane * 8) = o;
    }
}

typedef float f32x16v __attribute__((ext_vector_type(16)));
typedef __bf16 bf16x2v __attribute__((ext_vector_type(2)));
typedef float f32x2v_ __attribute__((ext_vector_type(2)));
typedef short s16x4v __attribute__((ext_vector_type(4)));
__device__ __forceinline__ int crow16(int i, int hh) { return (i & 3) + 8 * (i >> 2) + 4 * hh; }
__device__ __forceinline__ unsigned pkbf(float lo, float hi) { f32x2v_ v = {lo, hi}; bf16x2v b = __builtin_convertvector(v, bf16x2v); return __builtin_bit_cast(unsigned, b); }
__device__ __forceinline__ bf16x8 pk8(const float (&x)[8]) { v4u w; w.x = pkbf(x[0], x[1]); w.y = pkbf(x[2], x[3]); w.z = pkbf(x[4], x[5]); w.w = pkbf(x[6], x[7]); return __builtin_bit_cast(bf16x8, w); }
__device__ __forceinline__ void unpk8(const v4u w, float (&x)[8]) {
    x[0] = __uint_as_float(w.x << 16); x[1] = __uint_as_float(w.x & 0xffff0000u); x[2] = __uint_as_float(w.y << 16); x[3] = __uint_as_float(w.y & 0xffff0000u);
    x[4] = __uint_as_float(w.z << 16); x[5] = __uint_as_float(w.z & 0xffff0000u); x[6] = __uint_as_float(w.w << 16); x[7] = __uint_as_float(w.w & 0xffff0000u); }
#define MFMA32(a, b, c) __builtin_amdgcn_mfma_f32_32x32x16_bf16((a), (b), (c), 0, 0, 0)
constexpr int HG_LDS = 26624, VT_PITCH = 72;
constexpr float HG_CLAMP = 80.0f;

__device__ __forceinline__ void hg_build_vt(LAS bf16* VT, const GAS bf16* P, int row0, int h, int lane) {
    const GAS bf16* vp = P + (size_t)row0 * DIN + 2048 + h * 64 + lane;
    for (int t0 = 0; t0 < 64; t0 += 16) { bf16 vr[16];
#pragma unroll
        for (int j = 0; j < 16; ++j) vr[j] = vp[(size_t)(t0 + j) * DIN];
#pragma unroll
        for (int t8 = 0; t8 < 2; ++t8) { float x[8];
#pragma unroll
            for (int j = 0; j < 8; ++j) x[j] = silu_ff(bf2f(vr[t8 * 8 + j]));
            *(LAS bf16x8*)(VT + lane * VT_PITCH + t0 + t8 * 8) = pk8(x); } }
}
__device__ __forceinline__ void hg_pass1_mfma(Frame& F, int l) {
    const GAS bf16* P = (const GAS bf16*)(F.ws + WS_PROJ); const GAS float* lbs = (const GAS float*)(F.ws + WS_SMALL + SM_LBS) + l * 256;
    GAS float* HGS = (GAS float*)(F.ws + WS_HGS); GAS float* HGD = (GAS float*)(F.ws + WS_HGD);
    if (F.wave >= 4) return;
    LAS bf16* KH = (LAS bf16*)(F.lds + RING_OFF + F.wave * HG_LDS);
    LAS bf16* VT = KH + 64 * VT_PITCH;
    const int lane = F.lane, r = lane & 31, hh = lane >> 5;
    for (int tk = F.bid * 4 + F.wave; tk < 1024; tk += F.G * 4) {
        const int c = tk >> 2, h = tk & 3, row0 = c * 64;
        const float lbv = lbs[h * 64 + lane];
        const GAS bf16* zp = P + (size_t)row0 * DIN + 1792 + h * 64 + lane;
        float b = 0.f;
        for (int t0 = 0; t0 < 64; t0 += 16) { bf16 zr[16];
#pragma unroll
            for (int j = 0; j < 16; ++j) zr[j] = zp[(size_t)(t0 + j) * DIN];
#pragma unroll
            for (int j = 0; j < 16; ++j) { const float f = lbv + (1.0f - lbv) * sigmoid_f(bf2f(zr[j])); b += (0.6931471805599453f * __builtin_amdgcn_logf(fmaxf(f, 1e-30f))); } }
        float bt = 0.f;
        for (int t0 = 0; t0 < 64; t0 += 16) { bf16 zr[16];
#pragma unroll
            for (int j = 0; j < 16; ++j) zr[j] = zp[(size_t)(t0 + j) * DIN];
#pragma unroll
            for (int t8 = 0; t8 < 2; ++t8) { float x[8];
#pragma unroll
                for (int j = 0; j < 8; ++j) { const float z = bf2f(zr[t8 * 8 + j]); const float f = lbv + (1.0f - lbv) * sigmoid_f(z); bt += (0.6931471805599453f * __builtin_amdgcn_logf(fmaxf(f, 1e-30f)));
                    x[j] = (1.0f - lbv) * sigmoid_f(-z) * __expf(b - bt); }
                *(LAS bf16x8*)(KH + lane * VT_PITCH + t0 + t8 * 8) = pk8(x); } }
        HGD[c * 256 + h * 64 + lane] = __expf(b);
        hg_build_vt(VT, P, row0, h, lane);
#pragma unroll
        for (int kb = 0; kb < 2; ++kb)
#pragma unroll
            for (int vb = 0; vb < 2; ++vb) { f32x16v acc = {};
#pragma unroll
                for (int ss = 0; ss < 4; ++ss) { const bf16x8 a = *(const LAS bf16x8*)(KH + (32 * kb + r) * VT_PITCH + 16 * ss + 8 * hh); const bf16x8 bq = *(const LAS bf16x8*)(VT + (32 * vb + r) * VT_PITCH + 16 * ss + 8 * hh);
                    acc = MFMA32(a, bq, acc); }
                GAS float* Lp = HGS + ((size_t)(c * 4 + h) * 64 + 32 * kb) * 64 + 32 * vb + r;
#pragma unroll
                for (int i = 0; i < 16; ++i) Lp[crow16(i, hh) * 64] = acc[i]; }
    }
}
__device__ __forceinline__ void hg_pass3_mfma(Frame& F, int l, const float* hgg) {
    const GAS bf16* P = (const GAS bf16*)(F.ws + WS_PROJ); const GAS float* lbs = (const GAS float*)(F.ws + WS_SMALL + SM_LBS) + l * 256;
    const GAS float* HGS = (const GAS float*)(F.ws + WS_HGS); GAS bf16* MIX = (GAS bf16*)(F.ws + WS_MIX); const GAS float* hgg_g = (const GAS float*)hgg;
    if (F.wave >= 4) return;
    LAS float* BL = (LAS float*)(F.lds + RING_OFF + F.wave * HG_LDS);
    LAS bf16* VT = (LAS bf16*)(BL + 4096);
    LAS float* R1 = (LAS float*)(VT + 64 * VT_PITCH);
    const int lane = F.lane, r = lane & 31, hh = lane >> 5;
    for (int tk = F.bid * 4 + F.wave; tk < 1024; tk += F.G * 4) {
        const int c = tk >> 2, h = tk & 3, row0 = c * 64;
        { const float lbv = lbs[h * 64 + lane]; float b = 0.f; const GAS bf16* zp = P + (size_t)row0 * DIN + 1792 + h * 64 + lane;
          for (int t0 = 0; t0 < 64; t0 += 16) { bf16 zr[16];
#pragma unroll
              for (int j = 0; j < 16; ++j) zr[j] = zp[(size_t)(t0 + j) * DIN];
#pragma unroll
              for (int j = 0; j < 16; ++j) { const float f = lbv + (1.0f - lbv) * sigmoid_f(bf2f(zr[j])); b += (0.6931471805599453f * __builtin_amdgcn_logf(fmaxf(f, 1e-30f))); BL[(t0 + j) * 64 + lane] = b; }
              if (t0 == 16) R1[lane] = b; } }
        hg_build_vt(VT, P, row0, h, lane);
        bf16x8 Qt[2][4], Qh1[4];
#pragma unroll
        for (int tb = 0; tb < 2; ++tb)
#pragma unroll
            for (int ks = 0; ks < 4; ++ks) { const int t = 32 * tb + r, k0 = 16 * ks + 8 * hh; float q[8], e[8];
                unpk8(*(const GAS v4u*)(P + (size_t)(row0 + t) * DIN + 1536 + h * 64 + k0), q);
                const f32x4 b0 = *(const LAS f32x4*)(BL + t * 64 + k0), b1 = *(const LAS f32x4*)(BL + t * 64 + k0 + 4);
                e[0] = b0.x; e[1] = b0.y; e[2] = b0.z; e[3] = b0.w; e[4] = b1.x; e[5] = b1.y; e[6] = b1.z; e[7] = b1.w;
                if (tb == 1) { const f32x4 r0 = *(const LAS f32x4*)(R1 + k0), r1 = *(const LAS f32x4*)(R1 + k0 + 4); const float rr[8] = {r0.x, r0.y, r0.z, r0.w, r1.x, r1.y, r1.z, r1.w}; float qh[8];
#pragma unroll
                    for (int j = 0; j < 8; ++j) { q[j] *= __expf(e[j] - rr[j]); qh[j] = q[j] * __expf(rr[j]); }
                    Qh1[ks] = pk8(qh);
                } else {
#pragma unroll
                    for (int j = 0; j < 8; ++j) q[j] *= __expf(e[j]);
                }
                Qt[tb][ks] = pk8(q); }
        f32x16v X00 = {}, X01 = {}, X11 = {};
#pragma unroll
        for (int ks = 0; ks < 4; ++ks) { const int k0 = 16 * ks + 8 * hh;
            const f32x4 l0 = *(const GAS f32x4*)(lbs + h * 64 + k0), l1 = *(const GAS f32x4*)(lbs + h * 64 + k0 + 4); const float lb8[8] = {l0.x, l0.y, l0.z, l0.w, l1.x, l1.y, l1.z, l1.w};
            const f32x4 r0 = *(const LAS f32x4*)(R1 + k0), r1 = *(const LAS f32x4*)(R1 + k0 + 4); const float rr[8] = {r0.x, r0.y, r0.z, r0.w, r1.x, r1.y, r1.z, r1.w};
            float key[8], bs[8], x0[8], x1[8];
            unpk8(*(const GAS v4u*)(P + (size_t)(row0 + r) * DIN + 1792 + h * 64 + k0), key);
            { const f32x4 b0 = *(const LAS f32x4*)(BL + r * 64 + k0), b1 = *(const LAS f32x4*)(BL + r * 64 + k0 + 4); bs[0] = b0.x; bs[1] = b0.y; bs[2] = b0.z; bs[3] = b0.w; bs[4] = b1.x; bs[5] = b1.y; bs[6] = b1.z; bs[7] = b1.w; }
#pragma unroll
            for (int j = 0; j < 8; ++j) { const float ky = (1.0f - lb8[j]) * sigmoid_f(-key[j]); x0[j] = ky * __expf(fminf(-bs[j], HG_CLAMP)); x1[j] = ky * __expf(rr[j] - bs[j]); }
            X00 = MFMA32(pk8(x0), Qt[0][ks], X00);
            X01 = MFMA32(pk8(x1), Qt[1][ks], X01);
            unpk8(*(const GAS v4u*)(P + (size_t)(row0 + 32 + r) * DIN + 1792 + h * 64 + k0), key);
            { const f32x4 b0 = *(const LAS f32x4*)(BL + (32 + r) * 64 + k0), b1 = *(const LAS f32x4*)(BL + (32 + r) * 64 + k0 + 4); bs[0] = b0.x; bs[1] = b0.y; bs[2] = b0.z; bs[3] = b0.w; bs[4] = b1.x; bs[5] = b1.y; bs[6] = b1.z; bs[7] = b1.w; }
#pragma unroll
            for (int j = 0; j < 8; ++j) { const float ky = (1.0f - lb8[j]) * sigmoid_f(-key[j]); x1[j] = ky * __expf(fminf(rr[j] - bs[j], HG_CLAMP)); }
            X11 = MFMA32(pk8(x1), Qt[1][ks], X11);
        }
#pragma unroll
        for (int i = 0; i < 16; ++i) { const bool keep = crow16(i, hh) <= r; X00[i] = keep ? X00[i] : 0.f; X11[i] = keep ? X11[i] : 0.f; }
        f32x16v O[2][2] = {};
#pragma unroll
        for (int sp = 0; sp < 2; ++sp) {
            float p[8]; bf16x8 P00, P01, P11;
#pragma unroll
            for (int j = 0; j < 8; ++j) p[j] = X00[8 * sp + j]; P00 = pk8(p);
#pragma unroll
            for (int j = 0; j < 8; ++j) p[j] = X01[8 * sp + j]; P01 = pk8(p);
#pragma unroll
            for (int j = 0; j < 8; ++j) p[j] = X11[8 * sp + j]; P11 = pk8(p);
#pragma unroll
            for (int vb = 0; vb < 2; ++vb) {
                const LAS bf16* vrow = VT + (32 * vb + r) * VT_PITCH + 16 * sp + 4 * hh;
                const s16x4v a0 = *(const LAS s16x4v*)(vrow), a1 = *(const LAS s16x4v*)(vrow + 8);
                const s16x4v c0 = *(const LAS s16x4v*)(vrow + 32), c1 = *(const LAS s16x4v*)(vrow + 40);
                const bf16x8 V0 = (bf16x8){a0[0], a0[1], a0[2], a0[3], a1[0], a1[1], a1[2], a1[3]}, V1 = (bf16x8){c0[0], c0[1], c0[2], c0[3], c1[0], c1[1], c1[2], c1[3]};
                O[0][vb] = MFMA32(P00, V0, O[0][vb]);
                O[1][vb] = MFMA32(P01, V0, O[1][vb]);
                O[1][vb] = MFMA32(P11, V1, O[1][vb]);
            }
        }
#pragma unroll
        for (int ks = 0; ks < 4; ++ks)
#pragma unroll
            for (int vb = 0; vb < 2; ++vb) { float sv[8]; const GAS float* Sp = HGS + ((size_t)(c * 4 + h) * 64 + 16 * ks + 8 * hh) * 64 + 32 * vb + r;
#pragma unroll
                for (int j = 0; j < 8; ++j) sv[j] = Sp[j * 64];
                const bf16x8 sf = pk8(sv);
                O[0][vb] = MFMA32(Qt[0][ks], sf, O[0][vb]);
                O[1][vb] = MFMA32(Qh1[ks], sf, O[1][vb]); }
        const float gn0 = hgg_g[r], gn1 = hgg_g[32 + r];
#pragma unroll
        for (int tb = 0; tb < 2; ++tb) {
            bf16 gr[16][2]; float rs[16];
#pragma unroll
            for (int i = 0; i < 16; ++i) { const GAS bf16* gp = P + (size_t)(row0 + 32 * tb + crow16(i, hh)) * DIN + 2304 + h * 64 + r; gr[i][0] = gp[0]; gr[i][1] = gp[32]; }
#pragma unroll
            for (int i = 0; i < 16; ++i) { const float o0 = O[tb][0][i], o1 = O[tb][1][i]; rs[i] = o0 * o0 + o1 * o1; }
#pragma unroll
            for (int i = 0; i < 16; ++i) rs[i] += swzx<1>(rs[i]);
#pragma unroll
            for (int i = 0; i < 16; ++i) rs[i] += swzx<2>(rs[i]);
#pragma unroll
            for (int i = 0; i < 16; ++i) rs[i] += swzx<4>(rs[i]);
#pragma unroll
            for (int i = 0; i < 16; ++i) rs[i] += swzx<8>(rs[i]);
#pragma unroll
            for (int i = 0; i < 16; ++i) rs[i] += swzx<16>(rs[i]);
#pragma unroll
            for (int i = 0; i < 16; ++i) { const int t = 32 * tb + crow16(i, hh); const float rstd = __builtin_amdgcn_rsqf(rs[i] * (1.0f / 64.0f) + LN_EPS);
                GAS bf16* op = MIX + (size_t)(row0 + t) * DMODEL + 512 + h * 64 + r;
                op[0] = (bf16)f2bf(O[tb][0][i] * rstd * gn0 * silu_ff(bf2f(gr[i][0]))); op[32] = (bf16)f2bf(O[tb][1][i] * rstd * gn1 * silu_ff(bf2f(gr[i][1]))); }
        }
    }
}
__device__ __forceinline__ void pool_mfma(Frame& F, const float* pw, const float* ps) {
    const GAS bf16* P = (const GAS bf16*)(F.ws + WS_PROJ); GAS bf16* MIX = (GAS bf16*)(F.ws + WS_MIX); const GAS float* pwg = (const GAS float*)pw; const GAS float* psg = (const GAS float*)ps;
    LAS float* ZL = (LAS float*)(F.lds + RING_OFF + F.wave * 12288);
    const int lane = F.lane, r = lane & 31, hh = lane >> 5, gi = F.wave >> 1, db = F.wave & 1, win = 2 << gi;
    bf16x8 wf[4];
#pragma unroll
    for (int ks = 0; ks < 4; ++ks) { float x[8];
#pragma unroll
        for (int j = 0; j < 8; ++j) x[j] = pwg[(size_t)(gi * 64 + 16 * ks + 8 * hh + j) * 64 + 32 * db + r];
        wf[ks] = pk8(x); }
    const float scl = psg[gi * 64 + 32 * db + r];
    for (int tile = F.bid; tile < SEQ / 64; tile += F.G) {
        const int t0 = tile * 64 - 32;
#pragma unroll
        for (int rt = 0; rt < 3; ++rt) { f32x16v acc = {}; const int t = t0 + 32 * rt + r;
#pragma unroll
            for (int ks = 0; ks < 4; ++ks) { v4u a = {0u, 0u, 0u, 0u}; if (t >= 0) a = *(const GAS v4u*)(P + (size_t)t * DIN + 2560 + gi * 64 + 16 * ks + 8 * hh);
                acc = MFMA32(__builtin_bit_cast(bf16x8, a), wf[ks], acc); }
#pragma unroll
            for (int i = 0; i < 16; ++i) ZL[(32 * rt + crow16(i, hh)) * 32 + r] = acc[i]; }
        const int tl0 = 32 + 32 * hh; float s = 0.f;
        for (int j = 1; j < win; ++j) s += ZL[(tl0 - j) * 32 + r];
        for (int tt = 0; tt < 32; ++tt) { const int tl = tl0 + tt; const float zc = ZL[tl * 32 + r]; s += zc;
            const int tg = t0 + tl; const float cntw = (float)((tg + 1 < win) ? (tg + 1) : win);
            MIX[(size_t)tg * DMODEL + 768 + gi * 64 + 32 * db + r] = (bf16)f2bf((s / cntw - zc) * scl);
            s -= ZL[(tl - win + 1) * 32 + r]; }
    }
}
#ifndef DIS
#define DIS 0
#endif
#ifndef DUP
#define DUP 0
#endif
#ifndef ATTN_B
#define ATTN_B 1
#endif
#ifndef HG_MFMA
#define HG_MFMA 1
#endif
#ifndef POOL_MFMA
#define POOL_MFMA 1
#endif
#if HG_MFMA
#define HG1 hg_pass1_mfma
#define HG3 hg_pass3_mfma
#else
#define HG1 hg_pass1
#define HG3 hg_pass3
#endif
#if POOL_MFMA
#define POOLF pool_mfma
#else
#define POOLF pool_phase
#endif
#define RELOAD_ARGS() do { asm volatile("" : "+s"(argp), "+s"(F.ws), "+s"(F.ctl), "+s"(bar.bar), "+s"(bar.x), "+s"(F.G), "+s"(F.vcu), "+s"(F.bid)); { unsigned z_ = 0u; asm volatile("" : "+s"(z_)); F.lane = (int)__builtin_amdgcn_mbcnt_hi(~0u, __builtin_amdgcn_mbcnt_lo(~0u, z_)); } asm volatile("" : "+v"(F.lane)); F.tid = F.wave * 64 + F.lane; } while (0)
#define args (*argp)
__global__ void __launch_bounds__(NWAVES * 64, 2) mk_fwd(Args args_) {
    const Args* argp = (const Args*)__builtin_amdgcn_kernarg_segment_ptr();
    extern __shared__ __attribute__((aligned(16))) unsigned char lds[];
    Frame F;
    F.lds = (LAS unsigned char*)lds;
    F.MISC = (volatile LAS unsigned*)(F.lds + MISC_OFF);
    F.tid = threadIdx.x; F.lane = F.tid & 63; F.wave = __builtin_amdgcn_readfirstlane(F.tid >> 6);
    F.G = gridDim.x; F.bid = blockIdx.x; { const int bx = blockIdx.x; F.vcu = (F.G % 8 == 0) ? (bx % 8) * (F.G / 8) + bx / 8 : bx; }
    F.ws = args.ws; F.ctl = (gu32*)(args.ws + WS_CTL);
    for (int u = F.tid; u < (LDS_BYTES - LDSCTL_OFF) / 4; u += NWAVES * 64) ((LAS unsigned*)(F.lds + LDSCTL_OFF))[u] = 0u;
    __syncthreads();
    XcdBarrier bar; bar.bar = (unsigned*)(F.ctl + CW_BAR); bar.x = 0; bar.st = nullptr;
    if (N_LAUNCHES == 1) bar = xcd_barrier_post((unsigned*)(F.ctl + CW_BAR), F.MISC + 8, F.tid);
    const int lo = (N_LAUNCHES == 1) ? 0 : args.ph_lo, hi = (N_LAUNCHES == 1) ? NPH : args.ph_hi;
#define IN(k) (lo <= (k) && (k) < hi)
#define SEAM(k) do { if (IN(k) && IN((k) + 1)) xcd_barrier(bar, F.tid); RELOAD_ARGS(); } while (0)
#define MOD ((const float*)(F.ws + WS_SMALL + SM_MOD))
#define HB ((bf16*)(F.ws + WS_HBUF))

    if (IN(0)) {
#if !(DIS&1)
        p0a_prologue(F, args);
#if (DUP&1)
            __syncthreads();
            p0a_prologue(F, args);
#endif

#endif
    } SEAM(0);
    if (IN(1)) { p_modulate(F, args.in[I_X], MOD, HB); } SEAM(1);

    for (int l = 0; l < DEPTH; ++l) {
        const int pb = 2 + NPH_LAYER * l;
#define mod (MOD + l * 6144)
#define xin ((l == 0) ? args.in[I_X] : (const float*)args.out)
        if (IN(pb + 0)) {
            pg8::Gemm g{HB, (const bf16*)(F.ws + WS_WIN) + (size_t)l * DIN * 1024, 1024}; pg8::StaticOrder S; S.init(M, DIN, F.G, F.bid);
            pg8::EpiProj E{(bf16*)(F.ws + WS_PROJ), DIN, (const float*)(F.ws + WS_ROPE), (const float*)(F.ws + WS_ROPE) + (size_t)SEQ * 32, attn_body::C2};
#if !(DIS&2)
            pg8::gemm_phase<pg8::EpiProj, pg8::StaticOrder, true>(F.lds + RING_OFF, g, S, E, F.tid);
#if (DUP&2)
            __syncthreads();
            pg8::gemm_phase<pg8::EpiProj, pg8::StaticOrder, true>(F.lds + RING_OFF, g, S, E, F.tid);
#endif

#endif
        } SEAM(pb + 0);
        if (IN(pb + 1)) {
#if !(DIS&4)
            HG1(F, l);
#if (DUP&4)
            __syncthreads();
            HG1(F, l);
#endif

#endif
            __syncthreads(); RELOAD_ARGS();
#if !(DIS&8)
            POOLF(F, args.in[I_POOLW] + (size_t)l * 4 * 64 * 64, args.in[I_POOLS] + l * 256);
#if (DUP&8)
            __syncthreads();
            POOLF(F, args.in[I_POOLW] + (size_t)l * 4 * 64 * 64, args.in[I_POOLS] + l * 256);
#endif

#endif
        } SEAM(pb + 1);
        if (IN(pb + 2)) {
#if !(DIS&16)
            hg_pass2(F);
#endif
        } SEAM(pb + 2);
        if (IN(pb + 3)) {
            const attn_body::bf16* PJ = (const attn_body::bf16*)(F.ws + WS_PROJ); attn_body::bf16* AO = (attn_body::bf16*)(F.ws + WS_ATTNO);
#if ATTN_B
            for (int rep_ = 0; rep_ < ((DUP&32) ? 2 : 1); ++rep_)
            for (int i = 0; i < 2; ++i) { const int j = i * F.G + F.vcu; if (j >= 512) break;
                const int v = j & 255, ii = j >> 8, mpi = v >> 5, s = v & 31; const int qb = (ii == 0) ? s : 63 - s;
                const int h = mpi >> 1, mp = mpi & 1;
#if !(DIS&32)
                attn_body::attn_unit2<8>(F.tid, qb, PJ + mpi * 64, PJ + 512 + mpi * 64, PJ + 1024 + h * 128, AO + (size_t)mp * SEQ * 512 + h * 128, (char*)lds + RING_OFF);
#endif
            }
#else
            for (int rep_ = 0; rep_ < ((DUP&32) ? 2 : 1); ++rep_)
            for (int i = 0; i < 4; ++i) { const int j = i * F.G + F.vcu; if (j >= 1024) break;
                const int v = j & 255, ii = j >> 8, vh = v >> 4, s = v & 15; const int qb = (ii == 0) ? s : (ii == 1) ? 31 - s : (ii == 2) ? 32 + s : 63 - s;
                const int h = vh >> 2, mp = (vh >> 1) & 1, vf = vh & 1;
#if !(DIS&32)
                attn_body::attn_unit<8>(F.tid, qb, PJ + (h * 2 + mp) * 64, PJ + 512 + (h * 2 + mp) * 64, PJ + 1024 + h * 128 + vf * 64, AO + (size_t)mp * SEQ * 512 + h * 128 + vf * 64, (char*)lds + RING_OFF);
#endif
            }
#endif
            __syncthreads(); RELOAD_ARGS();
#if !(DIS&64)
            HG3(F, l, args.in[I_HGG] + l * 64);
#if (DUP&64)
            __syncthreads();
            HG3(F, l, args.in[I_HGG] + l * 64);
#endif

#endif
        } SEAM(pb + 3);
        if (IN(pb + 4)) {
#if !(DIS&128)
            attn_finalize(F, l, args.in[I_ATTNG] + l * 128);
#if (DUP&128)
            __syncthreads();
            attn_finalize(F, l, args.in[I_ATTNG] + l * 128);
#endif

#endif
        } SEAM(pb + 4);
        if (IN(pb + 5)) {
            pg8::Gemm g{(const bf16*)(F.ws + WS_MIX), (const bf16*)(F.ws + WS_WOUT) + (size_t)l * 1024 * 1024, 1024}; pg8::StaticOrder S; S.init(M, DMODEL, F.G, F.bid);
            pg8::EpiResid E{xin, args.out, DMODEL, mod + 2048, ALPHA, 1.0f};
#if !(DIS&256)
            pg8::gemm_phase<pg8::EpiResid, pg8::StaticOrder, false>(F.lds + RING_OFF, g, S, E, F.tid);
#endif
        } SEAM(pb + 5);
        if (IN(pb + 6)) {
#if !(DIS&512)
            if (l & 1) p_ln<true, FP8_MOE != 0>(F, args.out, args.in[I_LN1G] + l * 1024, args.in[I_LN1B] + l * 1024, mod + 3072, HB, args.in[I_RW] + (size_t)(l >> 1) * 1024 * 8);
#endif
#if !(DIS&1024)
            if (!(l & 1)) p_ln<false, FP8_DENSE != 0>(F, args.out, args.in[I_LN1G] + l * 1024, args.in[I_LN1B] + l * 1024, mod + 3072, HB, nullptr);
#endif
        } SEAM(pb + 6);
        if (!(l & 1)) {
            if (IN(pb + 8)) {
#if FP8_DENSE
                pg8::Gemm g{HB, (const bf16*)(F.ws + WS_FFN13), 1024 / 2}; pg8::StaticOrder S; S.init(M, 2 * FFD, F.G, F.bid);
                pg8::EpiSwiglu8 E{F.ws + WS_DHID, FFD, UP_DESCALE, S_HID};
#if !(DIS&2048)
                pg8::gemm_phase<pg8::EpiSwiglu8, pg8::StaticOrder, true, true>(F.lds + RING_OFF, g, S, E, F.tid);
#if (DUP&2048)
            __syncthreads();
            pg8::gemm_phase<pg8::EpiSwiglu8, pg8::StaticOrder, true, true>(F.lds + RING_OFF, g, S, E, F.tid);
#endif

#endif
#else
                pg8::Gemm g{HB, (const bf16*)(F.ws + WS_FFN13), 1024}; pg8::StaticOrder S; S.init(M, 2 * FFD, F.G, F.bid);
                pg8::EpiSwiglu E{(bf16*)(F.ws + WS_DHID), FFD};
#if !(DIS&2048)
                pg8::gemm_phase<pg8::EpiSwiglu, pg8::StaticOrder, true>(F.lds + RING_OFF, g, S, E, F.tid);
#endif
#endif
            } SEAM(pb + 8);
            if (IN(pb + 9)) {
#if FP8_DENSE
                pg8::Gemm g{(const bf16*)(F.ws + WS_DHID), (const bf16*)(F.ws + WS_FFN2), FFD / 2}; pg8::StaticOrder S; S.init(M, DMODEL, F.G, F.bid);
                pg8::EpiResid E{args.out, args.out, DMODEL, mod + 5120, ALPHA, DN_DESCALE};
#if !(DIS&4096)
                pg8::gemm_phase<pg8::EpiResid, pg8::StaticOrder, false, true>(F.lds + RING_OFF, g, S, E, F.tid);
#endif
#else
                pg8::Gemm g{(const bf16*)(F.ws + WS_DHID), (const bf16*)(F.ws + WS_FFN2), FFD}; pg8::StaticOrder S; S.init(M, DMODEL, F.G, F.bid);
                pg8::EpiResid E{args.out, args.out, DMODEL, mod + 5120, ALPHA, 1.0f};
#if !(DIS&4096)
                pg8::gemm_phase<pg8::EpiResid, pg8::StaticOrder, false>(F.lds + RING_OFF, g, S, E, F.tid);
#endif
#endif
            } SEAM(pb + 9);
            if (IN(pb + 10)) {
                p_ln<false, false>(F, args.out, args.in[I_LN2G] + l * 1024, args.in[I_LN2B] + l * 1024, (l + 1 < DEPTH) ? MOD + (l + 1) * 6144 : nullptr, HB, nullptr);
            } SEAM(pb + 10);
        } else {
            const unsigned* cnt = (const unsigned*)(F.ctl + CW_CNT);
            if (IN(pb + 7)) {
#if !(DIS&65536)
                moe_gather(F);
#if (DUP&65536)
            __syncthreads();
            moe_gather(F);
#endif

#endif
            } SEAM(pb + 7);
            if (IN(pb + 8)) {
                pg8::Gemm g{(const bf16*)(F.ws + WS_HPERM), (const bf16*)(F.ws + WS_EXP13), 1024 / 2}; pg8::MoeOrder S; S.init(cnt, 2 * EDIM / 256, F.G, F.bid);
                pg8::EpiSwiglu8 E{F.ws + WS_HID, EDIM, UP_DESCALE, S_HID};
#if !(DIS&8192)
                pg8::gemm_phase<pg8::EpiSwiglu8, pg8::MoeOrder, true, true>(F.lds + RING_OFF, g, S, E, F.tid);
#if (DUP&8192)
            __syncthreads();
            pg8::gemm_phase<pg8::EpiSwiglu8, pg8::MoeOrder, true, true>(F.lds + RING_OFF, g, S, E, F.tid);
#endif

#endif
            } SEAM(pb + 8);
            if (IN(pb + 9)) {
                pg8::Gemm g{(const bf16*)(F.ws + WS_HID), (const bf16*)(F.ws + WS_EXP2), EDIM / 2}; pg8::MoeOrder S; S.init(cnt, DMODEL / 256, F.G, F.bid);
                pg8::EpiBf16 E{(bf16*)(F.ws + WS_YSLOT), DMODEL, DN_DESCALE};
#if !(DIS&16384)
                pg8::gemm_phase<pg8::EpiBf16, pg8::MoeOrder, true, true>(F.lds + RING_OFF, g, S, E, F.tid);
#if (DUP&16384)
            __syncthreads();
            pg8::gemm_phase<pg8::EpiBf16, pg8::MoeOrder, true, true>(F.lds + RING_OFF, g, S, E, F.tid);
#endif

#endif
            } SEAM(pb + 9);
            if (IN(pb + 10)) {
#if !(DIS&32768)
                p_ln_moe(F, args.out, args.in[I_LN2G] + l * 1024, args.in[I_LN2B] + l * 1024, mod + 5120);
#endif
            } SEAM(pb + 10);
        }
    }
#undef IN
#undef SEAM
#undef args
#undef MOD
#undef HB
#undef mod
#undef xin
}

extern "C" void kernel_launch(void* const* d_in, const int* in_sizes, int n_in, void* d_out, int out_size, void* d_ws, size_t ws_size, hipStream_t stream) {
    static int grid = 0;
    if (grid == 0) {
        if (n_in != 23 || in_sizes[0] != M * DMODEL || out_size != M * DMODEL || ws_size < WS_END) { fprintf(stderr, "kernel_launch: unexpected shapes (n_in %d, out %d, ws %zu); nothing launched\n", n_in, out_size, ws_size); grid = -1; return; }
        int dev = 0, cus = 0, per_cu = 0;
        if (hipGetDevice(&dev) != hipSuccess || hipDeviceGetAttribute(&cus, hipDeviceAttributeMultiprocessorCount, dev) != hipSuccess) { grid = -1; return; }
        if (hipFuncSetAttribute((const void*)mk_fwd, hipFuncAttributeMaxDynamicSharedMemorySize, LDS_BYTES) != hipSuccess) { fprintf(stderr, "kernel_launch: hipFuncSetAttribute failed\n"); grid = -1; return; }
        if (hipOccupancyMaxActiveBlocksPerMultiprocessor(&per_cu, (const void*)mk_fwd, NWAVES * 64, LDS_BYTES) != hipSuccess || per_cu < 1) { fprintf(stderr, "kernel_launch: occupancy query says %d\n", per_cu); }
        (void)hipGetLastError();
        grid = cus;
    }
    if (grid < 0) return;
    if (hipMemsetAsync((char*)d_ws + WS_CTL, 0, CTL_ZERO_BYTES, stream) != hipSuccess) return;
    Args a{};
    for (int i = 0; i < 23; ++i) a.in[i] = (const float*)d_in[i];
    a.out = (float*)d_out; a.ws = (unsigned char*)d_ws;
    for (int li = 0; li < N_LAUNCHES; ++li) {
        a.ph_lo = (N_LAUNCHES == 1) ? 0 : li; a.ph_hi = (N_LAUNCHES == 1) ? NPH : li + 1; a.li = li; a.pad = 0;
        hipLaunchKernelGGL(mk_fwd, dim3(grid), dim3(NWAVES * 64), LDS_BYTES, stream, a);
    }
}
```

```cpp
#define MK_N_LAUNCHES 1
#include <hip/hip_runtime.h>
#include <hip/hip_bf16.h>
#include <cstdio>
#include <cstdint>
#include <cmath>
namespace pg8 {
#define PG8_LAS __attribute__((address_space(3)))
typedef unsigned short bf16_t;
typedef short bf16x8 __attribute__((ext_vector_type(8)));
typedef float f32x4 __attribute__((ext_vector_type(4)));
typedef unsigned u32x4 __attribute__((ext_vector_type(4)));
constexpr int BM = 256, BK = 64, HALF = 128, HTB = HALF * BK * 2  , STAGE_BYTES = 8 * HTB, NXCD = 8, WGM = 8;

__host__ __device__ __forceinline__ int lds_byte(int r, int c) { const int st = (r >> 4) * 2 + (c >> 5), rr = r & 15, cc = c & 31, ob = rr * 64 + cc * 2; return st * 1024 + (ob ^ (((ob >> 9) & 1) << 5)); }
__host__ __device__ __forceinline__ void stage_rc(int b, int& R, int& C) { const int st = b / 1024, sb = b % 1024, swz = sb ^ (((sb >> 9) & 1) << 5); R = (st >> 1) * 16 + swz / 64; C = (st & 1) * 32 + (swz % 64) / 2; }
__host__ __device__ __forceinline__ int perm32(int rho) { const int n = rho >> 4, i = rho & 15; return 8 * (i >> 2) + 4 * n + (i & 3); }

struct Unit { int pm, pn, pb; };
struct Gemm { const bf16_t* A; const bf16_t* Bt; int K; };

struct StaticOrder {
    int nM, nN, nwg, G, c;
    __host__ __device__ void init(int M, int N, int G_, int c_) { nM = M / BM; nN = N / BM; nwg = nM * nN; G = G_; c = c_; }
    __host__ __device__ bool next(int i, Unit& u) const {
        const long L = (long)i * G + c; if (L >= nwg) return false;
        int wgid = (int)L; { const int q = nwg / NXCD, r = nwg % NXCD, xcd = wgid % NXCD, off = wgid / NXCD; wgid = (xcd < r ? xcd * (q + 1) : r * (q + 1) + (xcd - r) * q) + off; }
        const int nig = WGM * nN, gid = wgid / nig, fm = gid * WGM, gsz = (nM - fm) < WGM ? (nM - fm) : WGM;
        u.pm = fm + ((wgid % nig) % gsz); u.pn = (wgid % nig) / gsz; u.pb = u.pn; return true;
    }
};

struct MoeOrder {
    int tb1, tb2, tb3, tb4, tb5, tb6, tb7, tb8;
    int nN, G, c;
    __device__ __forceinline__ void init(const unsigned* cnt, int nN_, int G_, int c_) {
        tb1 = ((int)cnt[0] + 255) >> 8; tb2 = tb1 + (((int)cnt[64] + 255) >> 8); tb3 = tb2 + (((int)cnt[128] + 255) >> 8); tb4 = tb3 + (((int)cnt[192] + 255) >> 8);
        tb5 = tb4 + (((int)cnt[256] + 255) >> 8); tb6 = tb5 + (((int)cnt[320] + 255) >> 8); tb7 = tb6 + (((int)cnt[384] + 255) >> 8); tb8 = tb7 + (((int)cnt[448] + 255) >> 8);
        nN = nN_; G = G_; c = c_;
    }
    __device__ __forceinline__ bool next(int i, Unit& u) const {
        const int L = i * G + c; const int T = L / nN; if (T >= tb8) return false;
        const int pn = L - T * nN;
        const int e = (T >= tb1) + (T >= tb2) + (T >= tb3) + (T >= tb4) + (T >= tb5) + (T >= tb6) + (T >= tb7);
        u.pm = T; u.pn = pn; u.pb = e * nN + pn; return true;
    }
};

__device__ __forceinline__ unsigned cvt_pk_bf16(float lo, float hi) { unsigned r; asm volatile("v_cvt_pk_bf16_f32 %0, %1, %2" : "=v"(r) : "v"(lo), "v"(hi)); return r; }

typedef int v4i_ __attribute__((ext_vector_type(4)));
typedef int v8i_ __attribute__((ext_vector_type(8)));
typedef unsigned u32x2 __attribute__((ext_vector_type(2)));
__device__ __forceinline__ v8i_ cat8(bf16x8 lo, bf16x8 hi) { const v4i_ a = __builtin_bit_cast(v4i_, lo), b = __builtin_bit_cast(v4i_, hi); return __builtin_shufflevector(a, b, 0, 1, 2, 3, 4, 5, 6, 7); }
__device__ __forceinline__ void mfma_f8(f32x4& acc, const v8i_& a, const v8i_& b) { asm volatile("s_nop 1\n\tv_mfma_f32_16x16x128_f8f6f4 %0, %1, %2, %0" : "+v"(acc) : "v"(a), "v"(b)); }
__device__ __forceinline__ float clamp8(float x) { return __builtin_fminf(__builtin_fmaxf(x, -448.0f), 448.0f); }
__device__ __forceinline__ unsigned pk4_fp8(float a, float b, float c, float d) { int w = 0; w = __builtin_amdgcn_cvt_pk_fp8_f32(clamp8(a), clamp8(b), w, false); w = __builtin_amdgcn_cvt_pk_fp8_f32(clamp8(c), clamp8(d), w, true); return (unsigned)w; }

struct EpiBf16 {
    static constexpr bool PERM = true;
    bf16_t* O; int ldc; float sc;
    __device__ __forceinline__ void operator()(const f32x4 (&acc)[2][2][4][2], const Unit& u, int wr, int wc, int fr, int fq) const {
        const int row0 = u.pm * BM + wr * 64 + fr; const int col0 = u.pn * BM + wc * 32 + 8 * fq;
#pragma unroll
        for (int ai = 0; ai < 2; ++ai)
#pragma unroll
            for (int m = 0; m < 4; ++m) { bf16_t* rowp = O + (size_t)(row0 + ai * HALF + m * 16) * ldc + col0;
#pragma unroll
                for (int bj = 0; bj < 2; ++bj) { const f32x4 v0 = acc[ai][bj][m][0] * sc, v1 = acc[ai][bj][m][1] * sc;
                    u32x4 w; w.x = cvt_pk_bf16(v0[0], v0[1]); w.y = cvt_pk_bf16(v0[2], v0[3]); w.z = cvt_pk_bf16(v1[0], v1[1]); w.w = cvt_pk_bf16(v1[2], v1[3]);
                    *(u32x4*)(rowp + bj * HALF) = w; } }
    }
};

struct EpiProj {
    static constexpr bool PERM = true;
    bf16_t* O; int ldc; const float* cosT; const float* sinT; float qscale;
    __device__ __forceinline__ void operator()(const f32x4 (&acc)[2][2][4][2], const Unit& u, int wr, int wc, int fr, int fq) const {
        const int row0 = u.pm * BM + wr * 64 + fr; const int col0 = u.pn * BM + wc * 32 + 8 * fq;
        if (u.pn < 4) {
            const int i0 = 16 * (wc & 1) + 4 * fq; const float sc = (u.pn < 2) ? qscale : 1.0f;
#pragma unroll
            for (int ai = 0; ai < 2; ++ai)
#pragma unroll
                for (int m = 0; m < 4; ++m) { const int row = row0 + ai * HALF + m * 16; bf16_t* rowp = O + (size_t)row * ldc + col0;
                    f32x4 c4 = *(const f32x4*)(cosT + (size_t)row * 32 + i0), s4 = *(const f32x4*)(sinT + (size_t)row * 32 + i0);
                    c4 = c4 * sc; s4 = s4 * sc;
#pragma unroll
                    for (int bj = 0; bj < 2; ++bj) { const f32x4 v0 = acc[ai][bj][m][0], v1 = acc[ai][bj][m][1];
                        const float o0 = v0[0] * c4[0] - v0[1] * s4[0], o1 = v0[1] * c4[0] + v0[0] * s4[0];
                        const float o2 = v0[2] * c4[1] - v0[3] * s4[1], o3 = v0[3] * c4[1] + v0[2] * s4[1];
                        const float o4 = v1[0] * c4[2] - v1[1] * s4[2], o5 = v1[1] * c4[2] + v1[0] * s4[2];
                        const float o6 = v1[2] * c4[3] - v1[3] * s4[3], o7 = v1[3] * c4[3] + v1[2] * s4[3];
                        u32x4 w; w.x = cvt_pk_bf16(o0, o1); w.y = cvt_pk_bf16(o2, o3); w.z = cvt_pk_bf16(o4, o5); w.w = cvt_pk_bf16(o6, o7);
                        *(u32x4*)(rowp + bj * HALF) = w; } }
        } else {
#pragma unroll
            for (int ai = 0; ai < 2; ++ai)
#pragma unroll
                for (int m = 0; m < 4; ++m) { bf16_t* rowp = O + (size_t)(row0 + ai * HALF + m * 16) * ldc + col0;
#pragma unroll
                    for (int bj = 0; bj < 2; ++bj) { const f32x4 v0 = acc[ai][bj][m][0], v1 = acc[ai][bj][m][1];
                        u32x4 w; w.x = cvt_pk_bf16(v0[0], v0[1]); w.y = cvt_pk_bf16(v0[2], v0[3]); w.z = cvt_pk_bf16(v1[0], v1[1]); w.w = cvt_pk_bf16(v1[2], v1[3]);
                        *(u32x4*)(rowp + bj * HALF) = w; } }
        }
    }
};

__device__ __forceinline__ float silu_f(float a) { return a * __builtin_amdgcn_rcpf(1.0f + __builtin_amdgcn_exp2f(-1.4426950408889634f * a)); }
struct EpiSwiglu {
    static constexpr bool PERM = true;
    bf16_t* O; int ldc;
    __device__ __forceinline__ void operator()(const f32x4 (&acc)[2][2][4][2], const Unit& u, int wr, int wc, int fr, int fq) const {
        const int row0 = u.pm * BM + wr * 64 + fr; const int col0 = u.pn * HALF + wc * 32 + 8 * fq;
#pragma unroll
        for (int ai = 0; ai < 2; ++ai)
#pragma unroll
            for (int m = 0; m < 4; ++m) { bf16_t* rowp = O + (size_t)(row0 + ai * HALF + m * 16) * ldc + col0;
                const f32x4 a0 = acc[ai][0][m][0], a1 = acc[ai][0][m][1], b0 = acc[ai][1][m][0], b1 = acc[ai][1][m][1];
                u32x4 w;
                w.x = cvt_pk_bf16(silu_f(a0[0]) * b0[0], silu_f(a0[1]) * b0[1]); w.y = cvt_pk_bf16(silu_f(a0[2]) * b0[2], silu_f(a0[3]) * b0[3]);
                w.z = cvt_pk_bf16(silu_f(a1[0]) * b1[0], silu_f(a1[1]) * b1[1]); w.w = cvt_pk_bf16(silu_f(a1[2]) * b1[2], silu_f(a1[3]) * b1[3]);
                *(u32x4*)rowp = w; }
    }
};

struct EpiSwiglu8 {
    static constexpr bool PERM = true;
    unsigned char* O; int ldc; float inscale, outscale;
    __device__ __forceinline__ void operator()(const f32x4 (&acc)[2][2][4][2], const Unit& u, int wr, int wc, int fr, int fq) const {
        const int row0 = u.pm * BM + wr * 64 + fr; const int col0 = u.pn * HALF + wc * 32 + 8 * fq; const float s2 = inscale * outscale;
#pragma unroll
        for (int ai = 0; ai < 2; ++ai)
#pragma unroll
            for (int m = 0; m < 4; ++m) { unsigned char* rowp = O + (size_t)(row0 + ai * HALF + m * 16) * ldc + col0;
                const f32x4 a0 = acc[ai][0][m][0], a1 = acc[ai][0][m][1], b0 = acc[ai][1][m][0], b1 = acc[ai][1][m][1];
                u32x2 w;
                w.x = pk4_fp8(silu_f(a0[0] * inscale) * (b0[0] * s2), silu_f(a0[1] * inscale) * (b0[1] * s2), silu_f(a0[2] * inscale) * (b0[2] * s2), silu_f(a0[3] * inscale) * (b0[3] * s2));
                w.y = pk4_fp8(silu_f(a1[0] * inscale) * (b1[0] * s2), silu_f(a1[1] * inscale) * (b1[1] * s2), silu_f(a1[2] * inscale) * (b1[2] * s2), silu_f(a1[3] * inscale) * (b1[3] * s2));
                *(u32x2*)rowp = w; __builtin_amdgcn_sched_barrier(0); }
    }
};

struct EpiResid {
    static constexpr bool PERM = false;
    const float* xin; float* out; int ldc; const float* gate; float alpha; float accscale;
    __device__ __forceinline__ void operator()(const f32x4 (&acc)[2][2][4][2], const Unit& u, int wr, int wc, int fr, int fq) const {
        const int col0 = u.pn * BM + wc * 32 + 4 * fq;
        f32x4 gv[2][2];
#pragma unroll
        for (int bj = 0; bj < 2; ++bj)
#pragma unroll
            for (int n = 0; n < 2; ++n) gv[bj][n] = (*(const f32x4*)(gate + col0 + bj * HALF + n * 16) + 1.0f) * accscale;
#pragma unroll
        for (int ai = 0; ai < 2; ++ai)
#pragma unroll
            for (int m = 0; m < 4; ++m) { const size_t off = (size_t)(u.pm * BM + ai * HALF + wr * 64 + m * 16 + fr) * ldc + col0;
#pragma unroll
                for (int bj = 0; bj < 2; ++bj)
#pragma unroll
                    for (int n = 0; n < 2; ++n) { const f32x4 x = *(const f32x4*)(xin + off + bj * HALF + n * 16);
                        *(f32x4*)(out + off + bj * HALF + n * 16) = x * alpha + gv[bj][n] * acc[ai][bj][m][n]; }
                if (m & 1) asm volatile("" ::: "memory"); }
    }
};

template <class Epi, class Sched, bool ALIGN_EPI, bool FP8 = false>
__device__ __forceinline__ void gemm_phase(PG8_LAS unsigned char* lds, const Gemm g, const Sched& S, const Epi& E, const int tid) {
    const int wid = __builtin_amdgcn_readfirstlane(tid >> 6), lane = tid & 63, wr = wid >> 2, wc = wid & 3, fr = lane & 15, fq = lane >> 4;
    const int K = g.K, nt = K / BK;
    unsigned voffA[2], voffB[2];
#pragma unroll
    for (int i = 0; i < 2; ++i) { int R, C; stage_rc(tid * 16 + i * 8192, R, C); const int Rb = Epi::PERM ? ((R & ~31) + perm32(R & 31)) : R;
        voffA[i] = (unsigned)(R * K + C) * 2u; voffB[i] = (unsigned)(Rb * K + C) * 2u; }
    const size_t kstep = (size_t)(BK * 2);
    const size_t hstep = (size_t)HALF * K * 2;
    const size_t tstep = 2 * hstep;
    const unsigned ldsw = (unsigned)wid * 1024u;
    const int fcol = FP8 ? (32 * (fq >> 1) + 16 * (fq & 1)) : fq * 8;
    const int aoff = lds_byte(wr * 64 + fr, fcol), boff = lds_byte(wc * 32 + fr, fcol);
#define PG8_SA(b, h) (((b) * 2 + (h)) * HTB)
#define PG8_SB(b, h) ((4 + (b) * 2 + (h)) * HTB)
#define PG8_STAGE(bufoff, gbase, voff) do { _Pragma("unroll") for (int _i = 0; _i < 2; ++_i) \
        __builtin_amdgcn_global_load_lds((const unsigned*)((const char*)(gbase) + (voff)[_i]), (PG8_LAS unsigned*)(lds + (bufoff) + ldsw + _i * 8192), 16, 0, 0); } while (0)
#define PG8_LDA(dst, b, h) do { if constexpr (FP8) { _Pragma("unroll") for (int m = 0; m < 4; ++m) { const v4i_ lo_ = *(const PG8_LAS v4i_*)(lds + PG8_SA(b, h) + aoff + m * 2048), hi_ = *(const PG8_LAS v4i_*)(lds + PG8_SA(b, h) + aoff + m * 2048 + 16); dst##8[m] = __builtin_shufflevector(lo_, hi_, 0, 1, 2, 3, 4, 5, 6, 7); } } \
    else { _Pragma("unroll") for (int m = 0; m < 4; ++m) _Pragma("unroll") for (int k = 0; k < 2; ++k) dst[m][k] = *(const PG8_LAS bf16x8*)(lds + PG8_SA(b, h) + aoff + m * 2048 + k * 1024); } } while (0)
#define PG8_LDB(dst, b, h) do { if constexpr (FP8) { _Pragma("unroll") for (int n = 0; n < 2; ++n) { const v4i_ lo_ = *(const PG8_LAS v4i_*)(lds + PG8_SB(b, h) + boff + n * 2048), hi_ = *(const PG8_LAS v4i_*)(lds + PG8_SB(b, h) + boff + n * 2048 + 16); dst##8[n] = __builtin_shufflevector(lo_, hi_, 0, 1, 2, 3, 4, 5, 6, 7); } } \
    else { _Pragma("unroll") for (int n = 0; n < 2; ++n) _Pragma("unroll") for (int k = 0; k < 2; ++k) dst[n][k] = *(const PG8_LAS bf16x8*)(lds + PG8_SB(b, h) + boff + n * 2048 + k * 1024); } } while (0)
#define PG8_MMA(ai, bj, At, Bt) do { __builtin_amdgcn_s_setprio(1); if constexpr (FP8) { _Pragma("unroll") for (int m = 0; m < 4; ++m) _Pragma("unroll") for (int n = 0; n < 2; ++n) \
        mfma_f8(acc[ai][bj][m][n], Bt##8[n], At##8[m]); } \
    else { _Pragma("unroll") for (int m = 0; m < 4; ++m) _Pragma("unroll") for (int n = 0; n < 2; ++n) _Pragma("unroll") for (int k = 0; k < 2; ++k) \
        acc[ai][bj][m][n] = __builtin_amdgcn_mfma_f32_16x16x32_bf16(Bt[n][k], At[m][k], acc[ai][bj][m][n], 0, 0, 0); } __builtin_amdgcn_s_setprio(0); } while (0)
#define PG8_WAIT_V(n) asm volatile("s_waitcnt vmcnt(" #n ")" ::: "memory")
#define PG8_WAIT_L(n) asm volatile("s_waitcnt lgkmcnt(" #n ")" ::: "memory")
#define PG8_BAR __builtin_amdgcn_s_barrier()
#define PG8_SCHED __builtin_amdgcn_sched_barrier(0)
    Unit cur, nxt; int ui = 0;
    if (!S.next(0, cur)) return;
    f32x4 acc[2][2][4][2];
#pragma unroll
    for (int a = 0; a < 2; ++a)
#pragma unroll
        for (int b = 0; b < 2; ++b)
#pragma unroll
            for (int m = 0; m < 4; ++m)
#pragma unroll
                for (int n = 0; n < 2; ++n) acc[a][b][m][n] = (f32x4){0.f, 0.f, 0.f, 0.f};
    bf16x8 At[4][2], B0[2][2], B1[2][2];
    v8i_ At8[4], B08[2], B18[2];
    const char* cA = (const char*)g.A + (size_t)cur.pm * tstep; const char* cB = (const char*)g.Bt + (size_t)cur.pb * tstep;
    PG8_STAGE(PG8_SB(0, 0), cB, voffB); PG8_STAGE(PG8_SB(0, 1), cB + hstep, voffB); PG8_STAGE(PG8_SA(0, 0), cA, voffA); PG8_STAGE(PG8_SA(0, 1), cA + hstep, voffA);
    if (wr == 1) PG8_BAR;
    PG8_WAIT_V(2); PG8_BAR;
    PG8_STAGE(PG8_SB(1, 0), cB + kstep, voffB); PG8_STAGE(PG8_SA(1, 0), cA + kstep, voffA); PG8_STAGE(PG8_SB(1, 1), cB + hstep + kstep, voffB);
    PG8_WAIT_V(6); PG8_BAR;
    for (;;) {
        const bool has_next = S.next(ui + 1, nxt);
        const char* nA = has_next ? (const char*)g.A + (size_t)nxt.pm * tstep : cA; const char* nB = has_next ? (const char*)g.Bt + (size_t)nxt.pb * tstep : cB;
        for (int t = 0; t < nt; t += 2) {
            const bool last = (t == nt - 2);
            const char* a1 = cA + (size_t)(t + 1) * kstep;
            const char* a2 = last ? nA : cA + (size_t)(t + 2) * kstep; const char* b2 = last ? nB : cB + (size_t)(t + 2) * kstep;
            const char* a3 = a2 + kstep; const char* b3 = b2 + kstep;
            PG8_LDB(B0, 0, 0); PG8_LDB(B1, 0, 1); PG8_SCHED; PG8_LDA(At, 0, 0); PG8_STAGE(PG8_SA(1, 1), a1 + hstep, voffA);
            PG8_WAIT_V(8); PG8_WAIT_L(0); PG8_BAR; PG8_MMA(0, 0, At, B0); PG8_MMA(0, 1, At, B1); PG8_BAR; PG8_SCHED;
            PG8_LDA(At, 0, 1); PG8_STAGE(PG8_SB(0, 0), b2, voffB); PG8_STAGE(PG8_SB(0, 1), b2 + hstep, voffB); PG8_STAGE(PG8_SA(0, 0), a2, voffA);
            PG8_WAIT_V(8); PG8_WAIT_L(0); PG8_BAR; PG8_MMA(1, 0, At, B0); PG8_MMA(1, 1, At, B1); PG8_BAR; PG8_SCHED;
            PG8_LDB(B0, 1, 0); PG8_LDB(B1, 1, 1); PG8_SCHED; PG8_LDA(At, 1, 0); PG8_STAGE(PG8_SA(0, 1), a2 + hstep, voffA);
            PG8_WAIT_V(8); PG8_WAIT_L(0); PG8_BAR; PG8_MMA(0, 0, At, B0); PG8_MMA(0, 1, At, B1); PG8_BAR; PG8_SCHED;
            PG8_LDA(At, 1, 1); PG8_STAGE(PG8_SB(1, 0), b3, voffB); PG8_STAGE(PG8_SB(1, 1), b3 + hstep, voffB); PG8_STAGE(PG8_SA(1, 0), a3, voffA);
            PG8_WAIT_V(8); PG8_WAIT_L(0); PG8_BAR; PG8_MMA(1, 0, At, B0); PG8_MMA(1, 1, At, B1); PG8_BAR; PG8_SCHED;
        }
        if constexpr (ALIGN_EPI) { if (wr == 0) PG8_BAR; }
        if constexpr (FP8) asm volatile("s_nop 15\n\ts_nop 15" ::: "memory");
        E(acc, cur, wr, wc, fr, fq);
        if (!has_next) break;
#pragma unroll
        for (int a = 0; a < 2; ++a)
#pragma unroll
            for (int b = 0; b < 2; ++b)
#pragma unroll
                for (int m = 0; m < 4; ++m)
#pragma unroll
                    for (int n = 0; n < 2; ++n) acc[a][b][m][n] = (f32x4){0.f, 0.f, 0.f, 0.f};
        cur = nxt; cA = nA; cB = nB; ++ui;
        if constexpr (ALIGN_EPI) { if (wr == 1) PG8_BAR; }
    }
    PG8_WAIT_V(0);
    if constexpr (!ALIGN_EPI) { if (wr == 0) PG8_BAR; }
    PG8_BAR;
#undef PG8_SA
#undef PG8_SB
#undef PG8_STAGE
#undef PG8_LDA
#undef PG8_LDB
#undef PG8_MMA
#undef PG8_WAIT_V
#undef PG8_WAIT_L
#undef PG8_BAR
#undef PG8_SCHED
}
}
namespace attn_body {
using bf16=__hip_bfloat16;
using bf16x8=__attribute__((ext_vector_type(8)))short;
using s16x4=__attribute__((ext_vector_type(4)))short;
using f32x16=__attribute__((ext_vector_type(16)))float;
using u32x4=__attribute__((ext_vector_type(4)))unsigned;
constexpr int SEQ=16384,D=64,PQ=2816,PO=512;
constexpr int NW=8,QBLK=32,QB=QBLK*NW,KVBLK=64,NQB=SEQ/QB;
constexpr int ATTN_UNIT_ROWS=QB;
__device__ __forceinline__ int crow(int r,int hi){return (r&3)+8*(r>>2)+4*hi;}
#define SBAR() __builtin_amdgcn_sched_barrier(0)
__device__ __forceinline__ void cmask(f32x16&p0,f32x16&p1,int jb,int qrel,int hi){
  const float NEG=-INFINITY; int kb=64*jb+4*hi;
  #pragma unroll
  for(int r=0;r<16;++r){int kv=kb+(r&3)+8*(r>>2); if(kv>qrel)p0[r]=NEG; if(kv+32>qrel)p1[r]=NEG;}
}

constexpr int NSLOT=3, SLOTB=8192;
constexpr int LDS_K=0, LDS_V=NSLOT*SLOTB, LDS_WS=2*NSLOT*SLOTB, LDS_OST=LDS_WS+NW*64*4, LDS_BYTES=LDS_OST+NW*4096;
constexpr float C2=0.125f*1.4426950408889634f;
__device__ __forceinline__ void glds16(const void*gsrc,unsigned lds_dst){unsigned keep;
  asm volatile("s_mov_b32 %0, m0\n\ts_mov_b32 m0, %2\n\ts_nop 0\n\tglobal_load_lds_dwordx4 %1, off\n\ts_mov_b32 m0, %0":"=&s"(keep):"v"(gsrc),"s"(lds_dst):"memory");}
__device__ __forceinline__ float max3f(float a,float b,float c){float r;asm("v_max3_f32 %0, %1, %2, %3":"=v"(r):"v"(a),"v"(b),"v"(c));return r;}
__device__ __forceinline__ float max2f(float a,float b){float r;asm("v_max_f32_e32 %0, %1, %2":"=v"(r):"v"(a),"v"(b));return r;}
__device__ __forceinline__ float fadd_s(float a,float b){float r;asm("v_add_f32_e32 %0, %1, %2":"=v"(r):"v"(a),"v"(b));return r;}
__device__ __forceinline__ float fsub_s(float a,float b){float r;asm("v_sub_f32_e32 %0, %1, %2":"=v"(r):"v"(a),"v"(b));return r;}
typedef float f32x2_t __attribute__((ext_vector_type(2))); typedef __bf16 bf16x2_t __attribute__((ext_vector_type(2)));
__device__ __forceinline__ unsigned cvtpk_s(float lo,float hi){f32x2_t v={lo,hi};bf16x2_t b=__builtin_convertvector(v,bf16x2_t);return __builtin_bit_cast(unsigned,b);}
#define WAIT_BAR(N) asm volatile("s_waitcnt vmcnt(" #N ") lgkmcnt(0)\n\ts_barrier":::"memory")

__device__ __forceinline__ void qkt(f32x16&p0,f32x16&p1,const char*Kslot,const bf16x8*qr,const f32x16&negm,int r32,int hi){
  const char*kb=Kslot+hi*1024+r32*16;
  #pragma unroll
  for(int d0=0;d0<4;++d0){
    const bf16x8 b0=*reinterpret_cast<const bf16x8*>(kb+d0*2048);
    const bf16x8 b1=*reinterpret_cast<const bf16x8*>(kb+d0*2048+512);
    if(d0==0){p0=__builtin_amdgcn_mfma_f32_32x32x16_bf16(b0,qr[0],negm,0,0,0);p1=__builtin_amdgcn_mfma_f32_32x32x16_bf16(b1,qr[0],negm,0,0,0);}
    else{p0=__builtin_amdgcn_mfma_f32_32x32x16_bf16(b0,qr[d0],p0,0,0,0);p1=__builtin_amdgcn_mfma_f32_32x32x16_bf16(b1,qr[d0],p1,0,0,0);}}
}
typedef __attribute__((address_space(3))) const char* lds_cptr;
typedef short v4i16_t __attribute__((ext_vector_type(4)));
__device__ __forceinline__ void kload8(bf16x8*kf,lds_cptr kp){
  kf[0]=*(const __attribute__((address_space(3))) bf16x8*)(kp);      kf[1]=*(const __attribute__((address_space(3))) bf16x8*)(kp+512);
  kf[2]=*(const __attribute__((address_space(3))) bf16x8*)(kp+2048); kf[3]=*(const __attribute__((address_space(3))) bf16x8*)(kp+2560);
  kf[4]=*(const __attribute__((address_space(3))) bf16x8*)(kp+4096); kf[5]=*(const __attribute__((address_space(3))) bf16x8*)(kp+4608);
  kf[6]=*(const __attribute__((address_space(3))) bf16x8*)(kp+6144); kf[7]=*(const __attribute__((address_space(3))) bf16x8*)(kp+6656);
}
__device__ __forceinline__ void kload2(bf16x8*kf,lds_cptr kp,int j){ kf[2*j]=*(const __attribute__((address_space(3))) bf16x8*)(kp+j*2048); kf[2*j+1]=*(const __attribute__((address_space(3))) bf16x8*)(kp+j*2048+512); }
__device__ __forceinline__ s16x4 vtr(lds_cptr p){ return __builtin_bit_cast(s16x4,__builtin_amdgcn_ds_read_tr16_b64_v4i16((__attribute__((address_space(3))) v4i16_t*)p)); }
__device__ __forceinline__ float rowmax(const f32x16&p0,const f32x16&p1){
  float a=max3f(p0[0],p0[1],p1[0]),b=max3f(p0[2],p0[3],p1[1]);a=max3f(a,p1[2],p1[3]);
  #pragma unroll
  for(int r=4;r<16;r+=4){a=max3f(a,p0[r],p0[r+1]);b=max3f(b,p0[r+2],p0[r+3]);a=max3f(a,p1[r],p1[r+1]);b=max3f(b,p1[r+2],p1[r+3]);}
  const float m=max2f(a,b);
  auto rr=__builtin_amdgcn_permlane32_swap(__float_as_uint(m),__float_as_uint(m),false,false);
  return max2f(__uint_as_float(rr[0]),__uint_as_float(rr[1]));
}
__device__ __forceinline__ void pv(f32x16*o,int vb,bf16x8 pa0,bf16x8 pa1,bf16x8 pa2,bf16x8 pa3){
  #pragma unroll
  for(int d0=0;d0<2;++d0){s16x4 lo[4],hi[4];
    #pragma unroll
    for(int ks=0;ks<4;++ks){
      asm volatile("ds_read_b64_tr_b16 %0,%1 offset:%c2":"=&v"(lo[ks]):"v"(vb),"i"(d0*4096+ks*1024):"memory");
      asm volatile("ds_read_b64_tr_b16 %0,%1 offset:%c2":"=&v"(hi[ks]):"v"(vb),"i"(d0*4096+ks*1024+512):"memory");}
    asm volatile("s_waitcnt lgkmcnt(0)":::"memory");SBAR();
    #define PK(k) (bf16x8){lo[k][0],lo[k][1],lo[k][2],lo[k][3],hi[k][0],hi[k][1],hi[k][2],hi[k][3]}
    o[d0]=__builtin_amdgcn_mfma_f32_32x32x16_bf16(pa0,PK(0),o[d0],0,0,0);
    o[d0]=__builtin_amdgcn_mfma_f32_32x32x16_bf16(pa1,PK(1),o[d0],0,0,0);
    o[d0]=__builtin_amdgcn_mfma_f32_32x32x16_bf16(pa2,PK(2),o[d0],0,0,0);
    o[d0]=__builtin_amdgcn_mfma_f32_32x32x16_bf16(pa3,PK(3),o[d0],0,0,0);
    #undef PK
  }
}

#ifndef ATTN_STORE16
#define ATTN_STORE16(p,v) (*(u32x4*)(p)=(v))
#endif
template<int THRL> __device__ __forceinline__ void attn_unit(const int tid,int qb,const bf16*Qh,const bf16*__restrict__ Kh,const bf16*__restrict__ Vh,bf16*Oh,char*shm){
  const int lane=tid&63,r32=lane&31,hi=lane>>5; const int wid=__builtin_amdgcn_readfirstlane(tid>>6);
  const int q0=qb*QB;
  const bf16*Qw=Qh+(long)(q0+wid*QBLK)*PQ;
  const unsigned lds0=(unsigned)(uintptr_t)shm;
  float*wsf=(float*)(shm+LDS_WS)+wid*64;
  const bf16*ksrc=Kh+(long)lane*PQ+wid*8;
  const bf16*vsrc=Vh+(long)(16*(wid&3)+(lane>>2))*PQ+(wid>>2)*32+(lane&3)*8;
  const unsigned kdst=lds0+LDS_K+wid*1024, vdst=lds0+LDS_V+wid*1024;
  #define DMA_K(t,slot) glds16(ksrc+(long)(t)*KVBLK*PQ,(unsigned)__builtin_amdgcn_readfirstlane(kdst+(slot)))
  #define DMA_V(t,slot) glds16(vsrc+(long)(t)*KVBLK*PQ,(unsigned)__builtin_amdgcn_readfirstlane(vdst+(slot)))
  const int vb0=(int)(lds0+LDS_V)+((lane>>4)&1)*32+(lane&3)*8+(4*hi+((lane&15)>>2))*64;
  const char*Kbase=shm+LDS_K; bf16x8 kf[8];
  const lds_cptr shm3=(lds_cptr)shm; const lds_cptr kp0=shm3+LDS_K+hi*1024+r32*16; const lds_cptr vp0=shm3+LDS_V+((lane>>4)&1)*32+(lane&3)*8+(4*hi+((lane&15)>>2))*64;
  const int NT=(q0+QB)/KVBLK;
  DMA_K(0,0);DMA_V(0,0);DMA_K(1,SLOTB);
  bf16x8 qr[4];
  #pragma unroll
  for(int d0=0;d0<4;++d0)qr[d0]=*reinterpret_cast<const bf16x8*>(&Qw[(long)r32*PQ+d0*16+hi*8]);
  float mhat=0.f,l_reg=0.f;f32x16 o[2];o[0]=f32x16{};o[1]=f32x16{};const f32x16 negm=f32x16{};
  const int qrel=wid*QBLK+r32;
  #define CMASK(P0,P1,t) do{int jb_=(t)-(NT-4); if(jb_>=0)cmask(P0,P1,jb_,qrel,hi);}while(0)
  bool resc=false;
  #define START(P0,P1) do{ const float rm=rowmax(P0,P1); resc=false; \
    { const float dl=rm; mhat=fadd_s(mhat,dl); \
      _Pragma("unroll") for(int r=0;r<16;++r){P0[r]=fsub_s(P0[r],dl);P1[r]=fsub_s(P1[r],dl);} \
      } \
    _Pragma("unroll") for(int r=0;r<16;++r)P0[r]=__builtin_amdgcn_exp2f(P0[r]); }while(0)
  #define RESC() do{ if(resc){ asm volatile("s_waitcnt lgkmcnt(0)":::"memory"); \
      _Pragma("unroll") for(int d_=0;d_<2;++d_) _Pragma("unroll") for(int r=0;r<16;++r)o[d_][r]*=wsf[crow(r,hi)]; } }while(0)
  f32x16 pA0,pA1,pB0,pB1;
  int sl_prev=0,sl_cur=0,sl_next=SLOTB;
  #define ROT() do{sl_prev=sl_cur;sl_cur=sl_next;sl_next=(sl_next==(NSLOT-1)*SLOTB)?0:sl_next+SLOTB;}while(0)
  DMA_K(2,2*SLOTB);
  WAIT_BAR(3);
  qkt(pA0,pA1,Kbase,qr,negm,r32,hi);asm volatile("s_nop 15\n\ts_nop 7":"+v"(pA0),"+v"(pA1));CMASK(pA0,pA1,0);
  START(pA0,pA1);
  _Pragma("unroll") for(int r=0;r<16;++r)pA1[r]=__builtin_amdgcn_exp2f(pA1[r]);
  WAIT_BAR(0);
  DMA_K(3,0);DMA_V(1,SLOTB);
  ROT();
  kload8(kf,kp0+sl_cur);
  WAIT_BAR(2);
  s16x4 vlo[8],vhi[8]; u32x4 pw0,pw1,pw2,pw3;
  #define PKW(P,B) cvtpk_s(P[B],P[B+1])
  #define PAF(k) __builtin_bit_cast(bf16x8,pw##k)
  #define VFR(i) (bf16x8){vlo[i][0],vlo[i][1],vlo[i][2],vlo[i][3],vhi[i][0],vhi[i][1],vhi[i][2],vhi[i][3]}
  #define PIN(x) asm volatile("":"+v"(x))
  #define MX3(a,b,c) __builtin_fmaxf(__builtin_fmaxf((a),(b)),(c))
  #define GAPA(MF,A0,A1,A2,A3,W0,W1,PW) do{ MF; sacc+=A0; sacc+=A1; sacc+=A2; sacc+=A3; PIN(sacc); W0; W1; PIN(PW); SBAR(); }while(0)
  #define EX(v) __builtin_amdgcn_exp2f(v)
  #define GAPB(MF,X,B) do{ MF; X[B]=EX(X[B]-mhat); X[B+1]=EX(X[B+1]-mhat); X[B+2]=EX(X[B+2]-mhat); X[B+3]=EX(X[B+3]-mhat); PIN(X); SBAR(); }while(0)
  #define VRD(i) do{ vlo[i]=vtr(vp_+(((i)>>2)*4096+((i)&3)*1024)); vhi[i]=vtr(vp_+(((i)>>2)*4096+((i)&3)*1024+512)); }while(0)
  #define KRD(G,j) do{ if(G){ kload2(kf,kp0+sl_next,j); SBAR(); } }while(0)
  #define STEP(C0,C1,P0,P1,t,GK,GV,GL) do{ SBAR(); \
    const lds_cptr vp_=vp0+sl_prev; \
    VRD(0); SBAR(); float sacc=(P0[0]+P0[1]); \
    GAPA(C0=__builtin_amdgcn_mfma_f32_32x32x16_bf16(kf[0],qr[0],negm,0,0,0), P0[2],P0[3],P0[4],P0[5],     pw0[0]=PKW(P0,0), pw0[1]=PKW(P0,2), pw0); \
    VRD(4); SBAR(); GAPA(C1=__builtin_amdgcn_mfma_f32_32x32x16_bf16(kf[1],qr[0],negm,0,0,0), P0[6],P0[7],P0[8],P0[9],     pw0[2]=PKW(P0,4), pw0[3]=PKW(P0,6), pw0); \
    VRD(1); SBAR(); GAPA(C0=__builtin_amdgcn_mfma_f32_32x32x16_bf16(kf[2],qr[1],C0,0,0,0),   P0[10],P0[11],P0[12],P0[13], pw1[0]=PKW(P0,8), pw1[1]=PKW(P0,10), pw1); \
    VRD(5); SBAR(); GAPA(C1=__builtin_amdgcn_mfma_f32_32x32x16_bf16(kf[3],qr[1],C1,0,0,0),   P0[14],P0[15],P1[0],P1[1],   pw1[2]=PKW(P0,12),pw1[3]=PKW(P0,14), pw1); \
    VRD(2); SBAR(); GAPA(C0=__builtin_amdgcn_mfma_f32_32x32x16_bf16(kf[4],qr[2],C0,0,0,0),   P1[2],P1[3],P1[4],P1[5],     pw2[0]=PKW(P1,0), pw2[1]=PKW(P1,2), pw2); \
    VRD(6); SBAR(); GAPA(C1=__builtin_amdgcn_mfma_f32_32x32x16_bf16(kf[5],qr[2],C1,0,0,0),   P1[6],P1[7],P1[8],P1[9],     pw2[2]=PKW(P1,4), pw2[3]=PKW(P1,6), pw2); \
    VRD(3); SBAR(); GAPA(C0=__builtin_amdgcn_mfma_f32_32x32x16_bf16(kf[6],qr[3],C0,0,0,0),   P1[10],P1[11],P1[12],P1[13], pw3[0]=PKW(P1,8), pw3[1]=PKW(P1,10), pw3); \
    VRD(7); SBAR(); GAPA(C1=__builtin_amdgcn_mfma_f32_32x32x16_bf16(kf[7],qr[3],C1,0,0,0),   P1[14],P1[15],0.f,0.f,       pw3[2]=PKW(P1,12),pw3[3]=PKW(P1,14), pw3); \
    l_reg+=sacc; \
    if(GK){DMA_K((t)+3,sl_cur);} if(GV){DMA_V((t)+1,sl_next);} \
    CMASK(C0,C1,t); \
    { float a=MX3(C0[0],C0[1],C1[0]),b=MX3(C0[2],C0[3],C1[1]); a=MX3(a,C1[2],C1[3]); \
      _Pragma("unroll") for(int r=4;r<16;r+=4){a=MX3(a,C0[r],C0[r+1]);b=MX3(b,C0[r+2],C0[r+3]);a=MX3(a,C1[r],C1[r+1]);b=MX3(b,C1[r+2],C1[r+3]);} \
      float rm=__builtin_fmaxf(a,b); { auto rr=__builtin_amdgcn_permlane32_swap(__float_as_uint(rm),__float_as_uint(rm),false,false); rm=__builtin_fmaxf(__uint_as_float(rr[0]),__uint_as_float(rr[1])); } \
      resc=false; \
      rm-=mhat; \
      if(__builtin_expect(__any(rm>(float)THRL),0)){ const float dl=__builtin_fmaxf(rm,0.f); mhat+=dl; \
        const float f=__builtin_amdgcn_exp2f(-dl); l_reg*=f; if(hi==0)wsf[r32]=f; resc=true; } } \
    SBAR(); \
    GAPB(o[0]=__builtin_amdgcn_mfma_f32_32x32x16_bf16(PAF(0),VFR(0),o[0],0,0,0), C0,0); \
    GAPB(o[1]=__builtin_amdgcn_mfma_f32_32x32x16_bf16(PAF(0),VFR(4),o[1],0,0,0), C0,4); \
    KRD(GL,0); GAPB(o[0]=__builtin_amdgcn_mfma_f32_32x32x16_bf16(PAF(1),VFR(1),o[0],0,0,0), C0,8); \
    KRD(GL,1); GAPB(o[1]=__builtin_amdgcn_mfma_f32_32x32x16_bf16(PAF(1),VFR(5),o[1],0,0,0), C0,12); \
    KRD(GL,2); GAPB(o[0]=__builtin_amdgcn_mfma_f32_32x32x16_bf16(PAF(2),VFR(2),o[0],0,0,0), C1,0); \
    KRD(GL,3); GAPB(o[1]=__builtin_amdgcn_mfma_f32_32x32x16_bf16(PAF(2),VFR(6),o[1],0,0,0), C1,4); \
    GAPB(o[0]=__builtin_amdgcn_mfma_f32_32x32x16_bf16(PAF(3),VFR(3),o[0],0,0,0), C1,8); \
    GAPB(o[1]=__builtin_amdgcn_mfma_f32_32x32x16_bf16(PAF(3),VFR(7),o[1],0,0,0), C1,12); \
    }while(0)
  int t=1;
  #undef CMASK
  #define CMASK(P0,P1,t) do{}while(0)
  for(;t+5<NT;t+=2){
    STEP(pB0,pB1,pA0,pA1,t,true,true,true);     WAIT_BAR(2); RESC(); ROT();
    STEP(pA0,pA1,pB0,pB1,t+1,true,true,true);   WAIT_BAR(2); RESC(); ROT();
  }
  #undef CMASK
  #define CMASK(P0,P1,t) do{int jb_=(t)-(NT-4); if(jb_>=0)cmask(P0,P1,jb_,qrel,hi);}while(0)
  #define ENDW(tt) do{ if((tt)+3<NT){WAIT_BAR(2);} else if((tt)+2<NT){WAIT_BAR(1);} else {WAIT_BAR(0);} }while(0)
  for(;t+1<NT;t+=2){
    STEP(pB0,pB1,pA0,pA1,t,(t+3<NT),(t+1<NT),(t+1<NT));       ENDW(t);   RESC(); ROT();
    STEP(pA0,pA1,pB0,pB1,t+1,(t+4<NT),(t+2<NT),(t+2<NT));     ENDW(t+1); RESC(); ROT();
  }
  STEP(pB0,pB1,pA0,pA1,NT-1,false,false,false); RESC();
  { float sacc=pB0[0]+pB0[1]; _Pragma("unroll") for(int r=2;r<16;++r)sacc+=pB0[r]; _Pragma("unroll") for(int r=0;r<16;++r)sacc+=pB1[r]; l_reg+=sacc;
    pw0=(u32x4){PKW(pB0,0),PKW(pB0,2),PKW(pB0,4),PKW(pB0,6)};pw1=(u32x4){PKW(pB0,8),PKW(pB0,10),PKW(pB0,12),PKW(pB0,14)};pw2=(u32x4){PKW(pB1,0),PKW(pB1,2),PKW(pB1,4),PKW(pB1,6)};pw3=(u32x4){PKW(pB1,8),PKW(pB1,10),PKW(pB1,12),PKW(pB1,14)};
    SBAR(); pv(o,vb0+sl_cur,PAF(0),PAF(1),PAF(2),PAF(3)); }
  #undef PKW
  #undef PAF
  #undef VFR
  #undef PIN
  #undef MX3
  #undef GAPA
  #undef GAPB
  #undef EX
  #undef VRD
  #undef KRD
  #undef STEP
  #undef ENDW
  {auto rr=__builtin_amdgcn_permlane32_swap(__float_as_uint(l_reg),__float_as_uint(l_reg),false,false);l_reg=__uint_as_float(rr[0])+__uint_as_float(rr[1]);}
  if(hi==0)wsf[32+r32]=l_reg;asm volatile("s_waitcnt lgkmcnt(0)":::"memory");
  float rli[16];
  #pragma unroll
  for(int r=0;r<16;++r)rli[r]=__builtin_amdgcn_rcpf(wsf[32+crow(r,hi)]);
  bf16*Ow=Oh+(long)(q0+wid*QBLK)*PO;
  { bf16*stg=(bf16*)(shm+LDS_OST)+wid*2048;
    #pragma unroll
    for(int r=0;r<16;++r){const int orow=crow(r,hi);
      #pragma unroll
      for(int d0=0;d0<2;++d0)stg[orow*64+d0*32+r32]=__float2bfloat16(o[d0][r]*rli[r]);}
    asm volatile("s_waitcnt lgkmcnt(0)":::"memory");
    #pragma unroll
    for(int i=0;i<4;++i){const int row=i*8+(lane>>3),ch=lane&7; const u32x4 v=*(const u32x4*)(stg+row*64+ch*8); ATTN_STORE16(Ow+(long)row*PO+ch*8,v);} }
  asm volatile("s_waitcnt lgkmcnt(0)\n\ts_barrier":::"memory");
  #undef DMA_K
  #undef DMA_V
  #undef CMASK
  #undef START
  #undef RESC
  #undef ROT
}
constexpr int ATTN_LDS_BYTES=LDS_BYTES;
#undef SBAR
#undef WAIT_BAR
}
namespace attn_body {
#define SBAR() __builtin_amdgcn_sched_barrier(0)
#define WAIT_BAR(N) asm volatile("s_waitcnt vmcnt(" #N ") lgkmcnt(0)\n\ts_barrier":::"memory")
constexpr int SLOTV=16384;
constexpr int L2_K=0, L2_V=NSLOT*SLOTB, L2_WS=L2_V+NSLOT*SLOTV, L2_OST=L2_WS+NW*64*4, LDS2_BYTES=L2_OST+NW*4096;
template<int THRL> __device__ __forceinline__ void attn_unit2(const int tid,int qb,const bf16*Qh,const bf16*__restrict__ Kh,const bf16*__restrict__ Vh,bf16*Oh,char*shm){
  const int lane=tid&63,r32=lane&31,hi=lane>>5; const int wid=__builtin_amdgcn_readfirstlane(tid>>6);
  const int q0=qb*QB;
  const bf16*Qw=Qh+(long)(q0+wid*QBLK)*PQ;
  const unsigned lds0=(unsigned)(uintptr_t)shm;
  float*wsf=(float*)(shm+L2_WS)+wid*64;
  const bf16*ksrc=Kh+(long)lane*PQ+wid*8;
  const bf16*vsrc=Vh+(long)(16*(wid&3)+(lane>>2))*PQ+(wid>>2)*32+(lane&3)*8;
  const unsigned kdst=lds0+L2_K+wid*1024, vdst=lds0+L2_V+wid*1024;
  #define DMA_K(t,slot) glds16(ksrc+(long)(t)*KVBLK*PQ,(unsigned)__builtin_amdgcn_readfirstlane(kdst+(slot)))
  #define DMA_V(t,slot) do{ glds16(vsrc+(long)(t)*KVBLK*PQ,(unsigned)__builtin_amdgcn_readfirstlane(vdst+2*(slot))); glds16(vsrc+64+(long)(t)*KVBLK*PQ,(unsigned)__builtin_amdgcn_readfirstlane(vdst+8192+2*(slot))); }while(0)
  const int vb0=(int)(lds0+L2_V)+((lane>>4)&1)*32+(lane&3)*8+(4*hi+((lane&15)>>2))*64;
  const char*Kbase=shm+L2_K; bf16x8 kf[8];
  const lds_cptr shm3=(lds_cptr)shm; const lds_cptr kp0=shm3+L2_K+hi*1024+r32*16; const lds_cptr vp0=shm3+L2_V+((lane>>4)&1)*32+(lane&3)*8+(4*hi+((lane&15)>>2))*64;
  const int NT=(q0+QB)/KVBLK;
  DMA_K(0,0);DMA_V(0,0);DMA_K(1,SLOTB);
  bf16x8 qr[4];
  #pragma unroll
  for(int d0=0;d0<4;++d0)qr[d0]=*reinterpret_cast<const bf16x8*>(&Qw[(long)r32*PQ+d0*16+hi*8]);
  float mhat=0.f,l_reg=0.f;f32x16 o[4];o[0]=f32x16{};o[1]=f32x16{};o[2]=f32x16{};o[3]=f32x16{};const f32x16 zc=f32x16{};
  const int qrel=wid*QBLK+r32;
  #define CMASK(P0,P1,t) do{int jb_=(t)-(NT-4); if(jb_>=0)cmask(P0,P1,jb_,qrel,hi);}while(0)
  bool resc=false;
  #define RESC() do{ if(resc){ asm volatile("s_waitcnt lgkmcnt(0)":::"memory"); \
      _Pragma("unroll") for(int d_=0;d_<4;++d_) _Pragma("unroll") for(int r=0;r<16;++r)o[d_][r]*=wsf[crow(r,hi)]; } }while(0)
  f32x16 C0,C1;
  int sl_prev=0,sl_cur=0,sl_next=SLOTB;
  #define ROT() do{sl_prev=sl_cur;sl_cur=sl_next;sl_next=(sl_next==(NSLOT-1)*SLOTB)?0:sl_next+SLOTB;}while(0)
  DMA_K(2,2*SLOTB);
  WAIT_BAR(3);
  s16x4 vlo[8],vhi[8]; u32x4 pw0,pw1,pw2,pw3; float sacc=0.f;
  #define PKW(P,B) cvtpk_s(P[B],P[B+1])
  #define PAF(k) __builtin_bit_cast(bf16x8,pw##k)
  #define VFR(i) (bf16x8){vlo[i][0],vlo[i][1],vlo[i][2],vlo[i][3],vhi[i][0],vhi[i][1],vhi[i][2],vhi[i][3]}
  #define PIN(x) asm volatile("":"+v"(x))
  #define MX3(a,b,c) __builtin_fmaxf(__builtin_fmaxf((a),(b)),(c))
  #define EX(v) __builtin_amdgcn_exp2f(v)
  qkt(C0,C1,Kbase,qr,zc,r32,hi);asm volatile("s_nop 15\n\ts_nop 7":"+v"(C0),"+v"(C1));CMASK(C0,C1,0);
  { const float rm=rowmax(C0,C1); mhat=rm;
    _Pragma("unroll") for(int r=0;r<16;++r){C0[r]=EX(C0[r]-rm);C1[r]=EX(C1[r]-rm);}
    sacc=C0[0]+C0[1]; _Pragma("unroll") for(int r=2;r<16;++r)sacc+=C0[r];
    pw0=(u32x4){PKW(C0,0),PKW(C0,2),PKW(C0,4),PKW(C0,6)};pw1=(u32x4){PKW(C0,8),PKW(C0,10),PKW(C0,12),PKW(C0,14)}; }
  WAIT_BAR(0);
  DMA_K(3,0);DMA_V(1,SLOTB);
  ROT();
  kload8(kf,kp0+sl_cur);
  WAIT_BAR(3);
  #define GAPA(MF) do{ MF; SBAR(); }while(0)
  #define GAPAF(MF,A0,A1,A2,A3,W0,W1,PW) do{ MF; sacc+=A0; sacc+=A1; sacc+=A2; sacc+=A3; PIN(sacc); W0; W1; PIN(PW); SBAR(); }while(0)
  #define EX2(X,B) do{ X[B]=EX(X[B]-mhat); X[B+1]=EX(X[B+1]-mhat); PIN(X); }while(0)
  #define VRD(i)  do{ vlo[i]=vtr(vp_+(((i)>>2)*4096+((i)&3)*1024)); vhi[i]=vtr(vp_+(((i)>>2)*4096+((i)&3)*1024+512)); }while(0)
  #define VRD2(i) do{ vlo[i]=vtr(vp_+(8192+((i)>>2)*4096+((i)&3)*1024)); vhi[i]=vtr(vp_+(8192+((i)>>2)*4096+((i)&3)*1024+512)); }while(0)
  #define KRD(G,j) do{ if(G){ kload2(kf,kp0+sl_next,j); } }while(0)
  #define ADD2(a,b) do{ sacc+=a; sacc+=b; PIN(sacc); }while(0)
  #define STEP2(t,GK,GV,GL) do{ SBAR(); \
    const lds_cptr vp_=vp0+2*sl_prev; \
    VRD(0); SBAR(); GAPAF(C0=__builtin_amdgcn_mfma_f32_32x32x16_bf16(kf[0],qr[0],zc,0,0,0), C1[0],C1[1],C1[2],C1[3],     pw2[0]=PKW(C1,0), pw2[1]=PKW(C1,2), pw2); \
    VRD(4); SBAR(); GAPAF(C0=__builtin_amdgcn_mfma_f32_32x32x16_bf16(kf[2],qr[1],C0,0,0,0), C1[4],C1[5],C1[6],C1[7],     pw2[2]=PKW(C1,4), pw2[3]=PKW(C1,6), pw2); \
    VRD(1); SBAR(); GAPAF(C0=__builtin_amdgcn_mfma_f32_32x32x16_bf16(kf[4],qr[2],C0,0,0,0), C1[8],C1[9],C1[10],C1[11],   pw3[0]=PKW(C1,8), pw3[1]=PKW(C1,10), pw3); \
    VRD(5); SBAR(); GAPAF(C0=__builtin_amdgcn_mfma_f32_32x32x16_bf16(kf[6],qr[3],C0,0,0,0), C1[12],C1[13],C1[14],C1[15], pw3[2]=PKW(C1,12),pw3[3]=PKW(C1,14), pw3); \
    l_reg+=sacc; \
    VRD(2); SBAR(); GAPA(C1=__builtin_amdgcn_mfma_f32_32x32x16_bf16(kf[1],qr[0],zc,0,0,0)); \
    VRD(6); SBAR(); GAPA(C1=__builtin_amdgcn_mfma_f32_32x32x16_bf16(kf[3],qr[1],C1,0,0,0)); \
    VRD(3); SBAR(); GAPA(C1=__builtin_amdgcn_mfma_f32_32x32x16_bf16(kf[5],qr[2],C1,0,0,0)); \
    VRD(7); SBAR(); GAPA(C1=__builtin_amdgcn_mfma_f32_32x32x16_bf16(kf[7],qr[3],C1,0,0,0)); \
    if(GK){DMA_K((t)+3,sl_cur);} if(GV){DMA_V((t)+1,sl_next);} \
    CMASK(C0,C1,t); \
    { float a=MX3(C0[0],C0[1],C1[0]),b=MX3(C0[2],C0[3],C1[1]); a=MX3(a,C1[2],C1[3]); \
      _Pragma("unroll") for(int r=4;r<16;r+=4){a=MX3(a,C0[r],C0[r+1]);b=MX3(b,C0[r+2],C0[r+3]);a=MX3(a,C1[r],C1[r+1]);b=MX3(b,C1[r+2],C1[r+3]);} \
      float rm=__builtin_fmaxf(a,b); { auto rr=__builtin_amdgcn_permlane32_swap(__float_as_uint(rm),__float_as_uint(rm),false,false); rm=__builtin_fmaxf(__uint_as_float(rr[0]),__uint_as_float(rr[1])); } \
      resc=false; rm-=mhat; \
      if(__builtin_expect(__any(rm>(float)THRL),0)){ const float dl=__builtin_fmaxf(rm,0.f); mhat+=dl; \
        const float f=__builtin_amdgcn_exp2f(-dl); l_reg*=f; if(hi==0)wsf[r32]=f; resc=true; } } \
    SBAR(); \
    o[0]=__builtin_amdgcn_mfma_f32_32x32x16_bf16(PAF(0),VFR(0),o[0],0,0,0); EX2(C0,0);  VRD2(0); SBAR(); \
    o[1]=__builtin_amdgcn_mfma_f32_32x32x16_bf16(PAF(0),VFR(4),o[1],0,0,0); EX2(C0,2);  VRD2(4); SBAR(); \
    o[0]=__builtin_amdgcn_mfma_f32_32x32x16_bf16(PAF(1),VFR(1),o[0],0,0,0); EX2(C0,4);  VRD2(1); SBAR(); \
    o[1]=__builtin_amdgcn_mfma_f32_32x32x16_bf16(PAF(1),VFR(5),o[1],0,0,0); EX2(C0,6);  VRD2(5); SBAR(); \
    o[0]=__builtin_amdgcn_mfma_f32_32x32x16_bf16(PAF(2),VFR(2),o[0],0,0,0); EX2(C0,8);  VRD2(2); SBAR(); \
    o[1]=__builtin_amdgcn_mfma_f32_32x32x16_bf16(PAF(2),VFR(6),o[1],0,0,0); EX2(C0,10); VRD2(6); SBAR(); \
    o[0]=__builtin_amdgcn_mfma_f32_32x32x16_bf16(PAF(3),VFR(3),o[0],0,0,0); EX2(C0,12); VRD2(3); SBAR(); \
    o[1]=__builtin_amdgcn_mfma_f32_32x32x16_bf16(PAF(3),VFR(7),o[1],0,0,0); EX2(C0,14); VRD2(7); SBAR(); \
    sacc=0.f; \
    o[2]=__builtin_amdgcn_mfma_f32_32x32x16_bf16(PAF(0),VFR(0),o[2],0,0,0); EX2(C1,0);  ADD2(C0[0],C0[1]);   KRD(GL,0); SBAR(); \
    o[3]=__builtin_amdgcn_mfma_f32_32x32x16_bf16(PAF(0),VFR(4),o[3],0,0,0); EX2(C1,2);  ADD2(C0[2],C0[3]);   KRD(GL,1); SBAR(); \
    o[2]=__builtin_amdgcn_mfma_f32_32x32x16_bf16(PAF(1),VFR(1),o[2],0,0,0); EX2(C1,4);  ADD2(C0[4],C0[5]);   pw0[0]=PKW(C0,0); pw0[1]=PKW(C0,2); PIN(pw0); KRD(GL,2); SBAR(); \
    o[3]=__builtin_amdgcn_mfma_f32_32x32x16_bf16(PAF(1),VFR(5),o[3],0,0,0); EX2(C1,6);  ADD2(C0[6],C0[7]);   pw0[2]=PKW(C0,4); pw0[3]=PKW(C0,6); PIN(pw0); KRD(GL,3); SBAR(); \
    o[2]=__builtin_amdgcn_mfma_f32_32x32x16_bf16(PAF(2),VFR(2),o[2],0,0,0); EX2(C1,8);  ADD2(C0[8],C0[9]);   pw1[0]=PKW(C0,8); pw1[1]=PKW(C0,10); PIN(pw1); SBAR(); \
    o[3]=__builtin_amdgcn_mfma_f32_32x32x16_bf16(PAF(2),VFR(6),o[3],0,0,0); EX2(C1,10); ADD2(C0[10],C0[11]); pw1[2]=PKW(C0,12); pw1[3]=PKW(C0,14); PIN(pw1); SBAR(); \
    o[2]=__builtin_amdgcn_mfma_f32_32x32x16_bf16(PAF(3),VFR(3),o[2],0,0,0); EX2(C1,12); ADD2(C0[12],C0[13]); SBAR(); \
    o[3]=__builtin_amdgcn_mfma_f32_32x32x16_bf16(PAF(3),VFR(7),o[3],0,0,0); EX2(C1,14); ADD2(C0[14],C0[15]); SBAR(); \
    }while(0)
  #define ENDW(tt) do{ if((tt)+3<NT){WAIT_BAR(3);} else if((tt)+2<NT){WAIT_BAR(2);} else {WAIT_BAR(0);} }while(0)
  int t=1;
  #undef CMASK
  #define CMASK(P0,P1,t) do{}while(0)
  for(;t+4<NT;++t){ STEP2(t,true,true,true); WAIT_BAR(3); RESC(); ROT(); }
  #undef CMASK
  #define CMASK(P0,P1,t) do{int jb_=(t)-(NT-4); if(jb_>=0)cmask(P0,P1,jb_,qrel,hi);}while(0)
  for(;t+1<NT;++t){ STEP2(t,(t+3<NT),(t+1<NT),(t+1<NT)); ENDW(t); RESC(); ROT(); }
  STEP2(NT-1,false,false,false); RESC();
  { _Pragma("unroll") for(int r=0;r<16;++r)sacc+=C1[r]; l_reg+=sacc;
    pw2=(u32x4){PKW(C1,0),PKW(C1,2),PKW(C1,4),PKW(C1,6)};pw3=(u32x4){PKW(C1,8),PKW(C1,10),PKW(C1,12),PKW(C1,14)}; }
  { SBAR(); const int vb=vb0+2*sl_cur;
    #pragma unroll
    for(int d0=0;d0<4;++d0){s16x4 lo[4],hi4[4];
      #pragma unroll
      for(int ks=0;ks<4;++ks){
        asm volatile("ds_read_b64_tr_b16 %0,%1 offset:%c2":"=&v"(lo[ks]):"v"(vb),"i"(d0*4096+ks*1024):"memory");
        asm volatile("ds_read_b64_tr_b16 %0,%1 offset:%c2":"=&v"(hi4[ks]):"v"(vb),"i"(d0*4096+ks*1024+512):"memory");}
      asm volatile("s_waitcnt lgkmcnt(0)":::"memory");SBAR();
      #define PK(k) (bf16x8){lo[k][0],lo[k][1],lo[k][2],lo[k][3],hi4[k][0],hi4[k][1],hi4[k][2],hi4[k][3]}
      o[d0]=__builtin_amdgcn_mfma_f32_32x32x16_bf16(PAF(0),PK(0),o[d0],0,0,0);
      o[d0]=__builtin_amdgcn_mfma_f32_32x32x16_bf16(PAF(1),PK(1),o[d0],0,0,0);
      o[d0]=__builtin_amdgcn_mfma_f32_32x32x16_bf16(PAF(2),PK(2),o[d0],0,0,0);
      o[d0]=__builtin_amdgcn_mfma_f32_32x32x16_bf16(PAF(3),PK(3),o[d0],0,0,0);
      #undef PK
    } }
  {auto rr=__builtin_amdgcn_permlane32_swap(__float_as_uint(l_reg),__float_as_uint(l_reg),false,false);l_reg=__uint_as_float(rr[0])+__uint_as_float(rr[1]);}
  if(hi==0)wsf[32+r32]=l_reg;asm volatile("s_waitcnt lgkmcnt(0)":::"memory");
  float rli[16];
  #pragma unroll
  for(int r=0;r<16;++r)rli[r]=__builtin_amdgcn_rcpf(wsf[32+crow(r,hi)]);
  bf16*Ow=Oh+(long)(q0+wid*QBLK)*PO;
  { bf16*stg=(bf16*)(shm+L2_OST)+wid*2048;
    #pragma unroll
    for(int hf=0;hf<2;++hf){
      #pragma unroll
      for(int r=0;r<16;++r){const int orow=crow(r,hi);
        #pragma unroll
        for(int d0=0;d0<2;++d0)stg[orow*64+d0*32+r32]=__float2bfloat16(o[2*hf+d0][r]*rli[r]);}
      asm volatile("s_waitcnt lgkmcnt(0)":::"memory");
      #pragma unroll
      for(int i=0;i<4;++i){const int row=i*8+(lane>>3),ch=lane&7; const u32x4 v=*(const u32x4*)(stg+row*64+ch*8); ATTN_STORE16(Ow+(long)row*PO+hf*64+ch*8,v);}
      asm volatile("s_waitcnt lgkmcnt(0)":::"memory");
    } }
  asm volatile("s_waitcnt lgkmcnt(0)\n\ts_barrier":::"memory");
  #undef DMA_K
  #undef DMA_V
  #undef CMASK
  #undef RESC
  #undef ROT
  #undef PKW
  #undef PAF
  #undef VFR
  #undef PIN
  #undef MX3
  #undef EX
  #undef GAPA
  #undef GAPAF
  #undef EX2
  #undef ADD2
  #undef VRD
  #undef VRD2
  #undef KRD
  #undef STEP2
  #undef ENDW
}
#undef SBAR
#undef WAIT_BAR
}
#define GAS __attribute__((address_space(1)))
#define LAS __attribute__((address_space(3)))
typedef unsigned short bf16;
typedef unsigned v4u __attribute__((ext_vector_type(4)));
typedef float f32x4 __attribute__((ext_vector_type(4)));
typedef short bf16x8 __attribute__((ext_vector_type(8)));
typedef GAS unsigned gu32;
typedef GAS unsigned long long gu64;
#define RLX_AGENT __ATOMIC_RELAXED, __HIP_MEMORY_SCOPE_AGENT
#define LDS_WAIT() asm volatile("s_waitcnt lgkmcnt(0)" ::: "memory")
#define VM_WAIT() asm volatile("s_waitcnt vmcnt(0)" ::: "memory")
__device__ __forceinline__ unsigned long long rt() { return __builtin_amdgcn_s_memrealtime(); }
__device__ __forceinline__ unsigned f2bf(float f) { unsigned u = __builtin_bit_cast(unsigned, f); return (u + 0x7fffu + ((u >> 16) & 1u)) >> 16; }
__device__ __forceinline__ unsigned pk2(float lo, float hi) { return f2bf(lo) | (f2bf(hi) << 16); }

#define XB_TMO      128
#define XB_XCNT(j)  (256  + 64 * (j))
#define XB_XSUB(j)  (1280 + 64 * (j))
#define XB_XGEN(j)  (2304 + 64 * (j))
#define XB_TOP      3328
#define XB_TOPGEN   3392
#define XCD_BAR_WORDS 3456
#define XB_SPIN_CAP (1u << 18)

__device__ __forceinline__ unsigned xb_ld(unsigned* p)              { return __hip_atomic_load(p, __ATOMIC_RELAXED, __HIP_MEMORY_SCOPE_AGENT); }
__device__ __forceinline__ unsigned xb_add(unsigned* p, unsigned v) { return __hip_atomic_fetch_add(p, v, __ATOMIC_RELAXED, __HIP_MEMORY_SCOPE_AGENT); }
__device__ __forceinline__ unsigned xb_xcc_id() { return (unsigned)__builtin_amdgcn_s_getreg((3 << 11) | 20) & 0xFu; }
#define XB_SPIN(cond, bar) do { unsigned _sp = 0; while (cond) { __builtin_amdgcn_s_sleep(1); \
    if ((++_sp & 255u) == 0u) { if (xb_ld(&(bar)[XB_TMO])) break; if (_sp > XB_SPIN_CAP) { atomicAdd(&(bar)[XB_TMO], 1u); break; } } } } while (0)

struct XcdBarrier {
    unsigned* bar; unsigned x;
    volatile LAS unsigned* st;
};

__device__ __forceinline__ XcdBarrier xcd_barrier_post(unsigned* bar, volatile LAS unsigned* st, const int tid) {
    XcdBarrier b; b.bar = bar; b.x = xb_xcc_id(); b.st = st;
    if (tid == 0) (void)xb_add(&bar[XB_XCNT(b.x)], 1u);
    return b;
}
__device__ __forceinline__ void xcd_barrier_complete(unsigned* bar, unsigned x, unsigned& nloc, unsigned& nx) {
    const unsigned G = gridDim.x * gridDim.y * gridDim.z;
    unsigned sum, cnt, mine, sp = 0u;
    for (;;) {
        sum = 0u; cnt = 0u; mine = 0u;
#pragma unroll
        for (unsigned j = 0; j < 16; ++j) { const unsigned c = xb_ld(&bar[XB_XCNT(j)]); sum += c; cnt += (c > 0u) ? 1u : 0u; mine = (j == x) ? c : mine; }
        if (sum == G) break;
        __builtin_amdgcn_s_sleep(1);
        if ((++sp & 255u) == 0u) { if (xb_ld(&bar[XB_TMO])) break; if (sp > XB_SPIN_CAP) { atomicAdd(&bar[XB_TMO], 1u); break; } }
    }
    nloc = mine > 0u ? mine : 1u; nx = cnt > 0u ? cnt : 1u;
}

__device__ __forceinline__ void xcd_barrier(const XcdBarrier& b, const int tid) {
    asm volatile("s_waitcnt vmcnt(0)" ::: "memory");
    __syncthreads();
    if (tid == 0) {
        unsigned* bar = b.bar;
        __builtin_amdgcn_s_waitcnt(0);
        unsigned nloc = b.st[0], nx = b.st[1];
        if (nloc == 0u) { xcd_barrier_complete(bar, b.x, nloc, nx); b.st[0] = nloc; b.st[1] = nx; }
        const unsigned old = xb_add(&bar[XB_XSUB(b.x)], 1u);
        const unsigned gen = old / nloc;
        if (old + 1u == (gen + 1u) * nloc) {
            __builtin_amdgcn_fence(__ATOMIC_RELEASE, "agent");
            asm volatile("s_waitcnt vmcnt(0)" ::: "memory");
            const unsigned og = xb_add(&bar[XB_TOP], 1u);
            const unsigned tg = og / nx;
            if (og + 1u == (tg + 1u) * nx) xb_add(&bar[XB_TOPGEN], 1u);
            else XB_SPIN(xb_ld(&bar[XB_TOPGEN]) == tg, bar);
            __builtin_amdgcn_fence(__ATOMIC_ACQUIRE, "agent");
            xb_add(&bar[XB_XGEN(b.x)], 1u);
            asm volatile("s_waitcnt vmcnt(0)" ::: "memory");
        } else {
            XB_SPIN(xb_ld(&bar[XB_XGEN(b.x)]) == gen, bar);
            __builtin_amdgcn_fence(__ATOMIC_ACQUIRE, "agent");
            asm volatile("s_waitcnt vmcnt(0)" ::: "memory");
        }
    }
    __syncthreads();
}
constexpr int NWAVES = 8;
#ifndef MK_N_LAUNCHES
#define MK_N_LAUNCHES 1
#endif
constexpr int NPH_LAYER = 11, NPH = 2 + 2 * NPH_LAYER;
constexpr int N_LAUNCHES = MK_N_LAUNCHES;
static_assert(N_LAUNCHES == 1 || N_LAUNCHES == NPH, "MK_N_LAUNCHES is 1 or NPH");

constexpr int SEQ = 16384, DMODEL = 1024, DIN = 2816, FFD = 2816, NEXP = 8, EDIM = 3584, DEPTH = 2;
constexpr int M = SEQ;
constexpr float LN_EPS = 1e-5f;
constexpr float ALPHA = 1.4142135623730951f;
constexpr int MAXSLOT = 135 * 256;
#ifndef FP8_DENSE
#define FP8_DENSE 0
#endif
#ifndef FP8_MOE
#define FP8_MOE 1
#endif
constexpr float SA_H = 16.0f, SW_UP = 256.0f, S_HID = 8.0f, SW_DN = 512.0f, UP_DESCALE = 1.0f / (16.0f * 256.0f), DN_DESCALE = 1.0f / (8.0f * 512.0f);

constexpr size_t MiB = 1u << 20;
constexpr size_t WS_CTL = 0, CTL_ZERO_BYTES = 1 * MiB;
constexpr size_t WS_SMALL = 1 * MiB;
constexpr size_t SM_MOD = 0, SM_LBS = 49152, SM_LAM = 51200, SM_TOK = 65536, SM_PERM = 327680;
constexpr size_t WS_ROPE = 2 * MiB;
constexpr size_t WS_EXP13 = 6 * MiB, WS_EXP2 = 118 * MiB;
constexpr size_t WS_HPERM = 174 * MiB;
constexpr size_t WS_YSLOT = 174 * MiB;
constexpr size_t WS_HID = 242 * MiB;
constexpr size_t WS_PROJ = 242 * MiB, WS_DHID = 242 * MiB;
constexpr size_t WS_ATTNO = 330 * MiB, WS_HBUF = 330 * MiB;
constexpr size_t WS_MIX = 362 * MiB, WS_HGS = 394 * MiB, WS_HGD = 410 * MiB;
constexpr size_t WS_WIN = 411 * MiB, WS_WOUT = 422 * MiB, WS_FFN13 = 426 * MiB, WS_FFN2 = 437 * MiB;
constexpr size_t WS_END = 479 * MiB;
static_assert(WS_YSLOT + (size_t)MAXSLOT * 1024 * 2 <= WS_HID && WS_HID + (size_t)MAXSLOT * 3584 * 2 <= WS_END && WS_FFN2 + (size_t)1024 * 2816 * 2 <= WS_END, "d_ws map");
constexpr int CW_TMO = 0, CW_CODE = 1;
constexpr int CW_CNT = 64;
constexpr int CW_BAR = 4096;

constexpr int RING_OFF = 0, RING_BYTES = 131072;
constexpr int LDSCTL_OFF = RING_BYTES, MISC_OFF = LDSCTL_OFF + 320;
constexpr int XTRA_OFF = LDSCTL_OFF + 1024;
constexpr int LDS_BYTES = 147456;

__device__ __forceinline__ float bf2f(unsigned short b) { return __uint_as_float((unsigned)b << 16); }
template <int O> __device__ __forceinline__ float swzx(float v) { return __int_as_float(__builtin_amdgcn_ds_swizzle(__float_as_int(v), (O << 10) | 0x1f)); }
__device__ __forceinline__ float wave_sum(float v) {
    v += swzx<1>(v); v += swzx<2>(v); v += swzx<4>(v); v += swzx<8>(v); v += swzx<16>(v);
    auto rr = __builtin_amdgcn_permlane32_swap(__float_as_uint(v), __float_as_uint(v), false, false);
    return __uint_as_float(rr[0]) + __uint_as_float(rr[1]);
}
__device__ __forceinline__ float sigmoid_f(float z) { return __builtin_amdgcn_rcpf(1.0f + __builtin_amdgcn_exp2f(-1.4426950408889634f * z)); }
__device__ __forceinline__ float silu_ff(float a) { return a * sigmoid_f(a); }

struct Args { const float* in[23]; float* out; unsigned char* ws; int ph_lo, ph_hi, li, pad; };
enum { I_X = 0, I_C, I_WADA, I_BADA, I_WIN, I_LAMQK, I_ATTNG, I_HGLB, I_HGG, I_POOLW, I_POOLS, I_WOUT, I_LN1G, I_LN1B, I_LN2G, I_LN2B, I_FW1, I_FW3, I_FW2, I_RW, I_EW1, I_EW3, I_EW2 };

struct Frame {
    LAS unsigned char* lds; volatile LAS unsigned* MISC; gu32* ctl; unsigned char* ws;
    int tid, lane, wave, vcu, G, bid;
};

__device__ const float kInvFreq[32] = {1.f, 0.749894202f, 0.562341332f, 0.421696514f, 0.316227764f, 0.237137392f, 0.177827939f, 0.133352146f, 0.100000001f, 0.0749894157f, 0.0562341288f, 0.0421696492f,
    0.0316227786f, 0.0237137359f, 0.0177827943f, 0.0133352149f, 0.00999999978f, 0.00749894232f, 0.00562341325f, 0.00421696482f, 0.00316227786f, 0.00237137382f, 0.00177827943f, 0.00133352145f,
    0.00100000005f, 0.000749894185f, 0.000562341302f, 0.000421696546f, 0.000316227786f, 0.000237137385f, 0.00017782794f, 0.00013335215f};

template <int KIND> __device__ __forceinline__ int rowmap(int n) {
    if (KIND == 0) { if (n >= 1024) return n; const int d = n & 63; return (n & ~63) + ((d < 32) ? 2 * d : 2 * (d - 32) + 1); }
    if (KIND == 2) return ((n >> 7) << 8) + (n & 127);
    if (KIND == 3) return ((n >> 7) << 8) + 128 + (n & 127);
    return n;
}
template <int KIND> __device__ __forceinline__ void transpose_item(const float* W_, int K, int N, bf16* WT, LAS float* scr, int item, int lane) {
    const GAS float* W = (const GAS float*)W_;
    const int nblk = N / 32, kb = item / nblk, nb = item % nblk, k0 = 64 * kb, n0 = 32 * nb;
#pragma unroll 8
    for (int i = 0; i < 32; ++i) { const int kk = 2 * i + (lane >> 5); scr[kk * 33 + (lane & 31)] = W[(size_t)(k0 + kk) * N + n0 + (lane & 31)]; }
    LDS_WAIT(); asm volatile("" ::: "memory");
    const int c = lane & 7;
#pragma unroll
    for (int j = 0; j < 4; ++j) { const int n = (lane >> 3) + 8 * j; const LAS float* s = scr + (8 * c) * 33 + n;
        v4u o; o.x = pk2(s[0 * 33], s[1 * 33]); o.y = pk2(s[2 * 33], s[3 * 33]); o.z = pk2(s[4 * 33], s[5 * 33]); o.w = pk2(s[6 * 33], s[7 * 33]);
        *(GAS v4u*)(WT + (size_t)rowmap<KIND>(n0 + n) * K + k0 + 8 * c) = o; }
    LDS_WAIT(); asm volatile("" ::: "memory");
}
template <int KIND> __device__ __forceinline__ void transpose_item8(const float* W_, int K, int N, unsigned char* WT, LAS float* scr, int item, int lane, float scale) {
    const GAS float* W = (const GAS float*)W_;
    const int nblk = N / 32, kb = item / nblk, nb = item % nblk, k0 = 64 * kb, n0 = 32 * nb;
#pragma unroll 8
    for (int i = 0; i < 32; ++i) { const int kk = 2 * i + (lane >> 5); scr[kk * 33 + (lane & 31)] = W[(size_t)(k0 + kk) * N + n0 + (lane & 31)]; }
    LDS_WAIT(); asm volatile("" ::: "memory");
    const int c = lane & 7;
#pragma unroll
    for (int j = 0; j < 4; ++j) { const int n = (lane >> 3) + 8 * j; const LAS float* s = scr + (8 * c) * 33 + n;
        pg8::u32x2 o; o.x = pg8::pk4_fp8(s[0 * 33] * scale, s[1 * 33] * scale, s[2 * 33] * scale, s[3 * 33] * scale); o.y = pg8::pk4_fp8(s[4 * 33] * scale, s[5 * 33] * scale, s[6 * 33] * scale, s[7 * 33] * scale);
        *(GAS pg8::u32x2*)(WT + (size_t)rowmap<KIND>(n0 + n) * K + k0 + 8 * c) = o; }
    LDS_WAIT(); asm volatile("" ::: "memory");
}
__device__ __forceinline__ void sincos_acc(float ang, float& s, float& c) {
    const double a = (double)ang; const double n = __builtin_rint(a * 0.63661977236758134308);
    double r = __builtin_fma(-n, 1.57079632679489655800, a); r = __builtin_fma(-n, 6.12323399573676603587e-17, r);
    const double r2 = r * r;
    double sp = -1.0 / 1307674368000.0; sp = sp * r2 + 1.0 / 6227020800.0; sp = sp * r2 - 1.0 / 39916800.0; sp = sp * r2 + 1.0 / 362880.0; sp = sp * r2 - 1.0 / 5040.0; sp = sp * r2 + 1.0 / 120.0; sp = sp * r2 - 1.0 / 6.0;
    const double sr = r + r * r2 * sp;
    double cp = 1.0 / 20922789888000.0; cp = cp * r2 - 1.0 / 87178291200.0; cp = cp * r2 + 1.0 / 479001600.0; cp = cp * r2 - 1.0 / 3628800.0; cp = cp * r2 + 1.0 / 40320.0; cp = cp * r2 - 1.0 / 720.0; cp = cp * r2 + 1.0 / 24.0; cp = cp * r2 - 0.5;
    const double cr = 1.0 + r2 * cp;
    const int q = ((int)n) & 3;
    const double ss = (q == 0) ? sr : (q == 1) ? cr : (q == 2) ? -sr : -cr;
    const double cc = (q == 0) ? cr : (q == 1) ? -sr : (q == 2) ? -cr : sr;
    s = (float)ss; c = (float)cc;
}
__device__ __forceinline__ void p0a_prologue(Frame& F, const Args& A) {
    const int gw = F.vcu * NWAVES + F.wave, NGW = F.G * NWAVES;
    {
        LAS float* red = (LAS float*)(F.lds + XTRA_OFF);
        for (int cb = F.bid; cb < 256; cb += F.G) {
            const int fc = cb * 48 + F.lane; const int l = fc / 6144, j = fc % 6144; float acc = 0.f;
            if (F.lane < 48) {
                const float* w = A.in[I_WADA] + (size_t)l * 1024 * 6144 + j; const float* c = A.in[I_C];
#pragma unroll 8
                for (int k = F.wave * 128; k < F.wave * 128 + 128; ++k) acc += silu_ff(c[k]) * w[(size_t)k * 6144];
            }
            red[F.wave * 64 + F.lane] = acc;
            __syncthreads();
            if (F.wave == 0 && F.lane < 48) { float s = 0.f;
#pragma unroll
                for (int w8 = 0; w8 < 8; ++w8) s += red[w8 * 64 + F.lane];
                ((float*)(F.ws + WS_SMALL + SM_MOD))[fc] = s + A.in[I_BADA][fc]; }
            __syncthreads();
        }
    }
    {
        float* cosT = (float*)(F.ws + WS_ROPE); float* sinT = cosT + (size_t)SEQ * 32;
        for (int idx = F.bid * (NWAVES * 64) + F.tid; idx < SEQ * 32; idx += F.G * NWAVES * 64) {
            const int pos = idx >> 5, i = idx & 31; const float ang = (float)pos * kInvFreq[i]; float s, c; sincos_acc(ang, s, c);
            cosT[idx] = c; sinT[idx] = s; }
    }
    if (F.bid == 0) {
        float* lbs = (float*)(F.ws + WS_SMALL + SM_LBS); float* lam = (float*)(F.ws + WS_SMALL + SM_LAM);
        if (F.tid < 256) { const float a0 = A.in[I_HGLB][F.tid], a1 = A.in[I_HGLB][256 + F.tid]; const float mx = fmaxf(a0, a1); const float e0 = __expf(a0 - mx), e1 = __expf(a1 - mx);
            lbs[F.tid] = 0.f; lbs[256 + F.tid] = e1 / (e0 + e1); }
        if (F.tid >= 256 && F.tid < 258) { const int l = F.tid - 256; const float* q = A.in[I_LAMQK] + l * 256; float s1 = 0.f, s2 = 0.f;
            for (int j = 0; j < 64; ++j) { s1 += q[j] * q[64 + j]; s2 += q[128 + j] * q[192 + j]; }
            const float li = 0.8f - 0.6f * expf(-0.3f * (float)l); lam[l] = expf(s1) - expf(s2) + li; lam[2 + l] = li; }
    }
    LAS float* scr = (LAS float*)(F.lds + RING_OFF + F.wave * 16384);
    constexpr int I_WI = 16 * 88, I_WO = 16 * 32, I_F13 = 16 * 88, I_F2 = 44 * 32, I_E13 = 16 * 112, I_E2 = 56 * 32;
    constexpr int NITEMS = 2 * I_WI + 2 * I_WO + 2 * I_F13 + I_F2 + 16 * I_E13 + 8 * I_E2;
    for (int it = gw; it < NITEMS; it += NGW) {
        int r = it;
        if (r < 2 * I_WI) { const int l = r / I_WI; transpose_item<0>(A.in[I_WIN] + (size_t)l * 1024 * DIN, 1024, DIN, (bf16*)(F.ws + WS_WIN) + (size_t)l * DIN * 1024, scr, r % I_WI, F.lane); continue; } r -= 2 * I_WI;
        if (r < 2 * I_WO) { const int l = r / I_WO; transpose_item<1>(A.in[I_WOUT] + (size_t)l * 1024 * 1024, 1024, 1024, (bf16*)(F.ws + WS_WOUT) + (size_t)l * 1024 * 1024, scr, r % I_WO, F.lane); continue; } r -= 2 * I_WO;
#if FP8_DENSE
        if (r < I_F13) { transpose_item8<2>(A.in[I_FW1], 1024, FFD, F.ws + WS_FFN13, scr, r, F.lane, SW_UP); continue; } r -= I_F13;
        if (r < I_F13) { transpose_item8<3>(A.in[I_FW3], 1024, FFD, F.ws + WS_FFN13, scr, r, F.lane, SW_UP); continue; } r -= I_F13;
        if (r < I_F2) { transpose_item8<1>(A.in[I_FW2], FFD, 1024, F.ws + WS_FFN2, scr, r, F.lane, SW_DN); continue; } r -= I_F2;
#else
        if (r < I_F13) { transpose_item<2>(A.in[I_FW1], 1024, FFD, (bf16*)(F.ws + WS_FFN13), scr, r, F.lane); continue; } r -= I_F13;
        if (r < I_F13) { transpose_item<3>(A.in[I_FW3], 1024, FFD, (bf16*)(F.ws + WS_FFN13), scr, r, F.lane); continue; } r -= I_F13;
        if (r < I_F2) { transpose_item<1>(A.in[I_FW2], FFD, 1024, (bf16*)(F.ws + WS_FFN2), scr, r, F.lane); continue; } r -= I_F2;
#endif
#if FP8_MOE
        if (r < 8 * I_E13) { const int e = r / I_E13; transpose_item8<2>(A.in[I_EW1] + (size_t)e * 1024 * EDIM, 1024, EDIM, F.ws + WS_EXP13 + (size_t)e * 2 * EDIM * 1024, scr, r % I_E13, F.lane, SW_UP); continue; } r -= 8 * I_E13;
        if (r < 8 * I_E13) { const int e = r / I_E13; transpose_item8<3>(A.in[I_EW3] + (size_t)e * 1024 * EDIM, 1024, EDIM, F.ws + WS_EXP13 + (size_t)e * 2 * EDIM * 1024, scr, r % I_E13, F.lane, SW_UP); continue; } r -= 8 * I_E13;
        { const int e = r / I_E2; transpose_item8<1>(A.in[I_EW2] + (size_t)e * EDIM * 1024, EDIM, 1024, F.ws + WS_EXP2 + (size_t)e * 1024 * EDIM, scr, r % I_E2, F.lane, SW_DN); }
#else
        if (r < 8 * I_E13) { const int e = r / I_E13; transpose_item<2>(A.in[I_EW1] + (size_t)e * 1024 * EDIM, 1024, EDIM, (bf16*)(F.ws + WS_EXP13) + (size_t)e * 2 * EDIM * 1024, scr, r % I_E13, F.lane); continue; } r -= 8 * I_E13;
        if (r < 8 * I_E13) { const int e = r / I_E13; transpose_item<3>(A.in[I_EW3] + (size_t)e * 1024 * EDIM, 1024, EDIM, (bf16*)(F.ws + WS_EXP13) + (size_t)e * 2 * EDIM * 1024, scr, r % I_E13, F.lane); continue; } r -= 8 * I_E13;
        { const int e = r / I_E2; transpose_item<1>(A.in[I_EW2] + (size_t)e * EDIM * 1024, EDIM, 1024, (bf16*)(F.ws + WS_EXP2) + (size_t)e * 1024 * EDIM, scr, r % I_E2, F.lane); }
#endif
    }
}

__device__ __forceinline__ void load4(f32x4 (&v)[4], const float* p, int lane) { const GAS f32x4* q = (const GAS f32x4*)p + lane;
#pragma unroll
    for (int j = 0; j < 4; ++j) v[j] = q[64 * j]; }
__device__ __forceinline__ void store_bf16_row(bf16* orow, const f32x4 (&v)[4], int lane) {
    GAS unsigned long long* o8 = (GAS unsigned long long*)orow + lane;
#pragma unroll
    for (int j = 0; j < 4; ++j) o8[64 * j] = (unsigned long long)pk2(v[j].x, v[j].y) | ((unsigned long long)pk2(v[j].z, v[j].w) << 32);
}
__device__ __forceinline__ void store_f32_row(float* orow, const f32x4 (&v)[4], int lane) { GAS f32x4* o = (GAS f32x4*)orow + lane;
#pragma unroll
    for (int j = 0; j < 4; ++j) o[64 * j] = v[j]; }
__device__ __forceinline__ void store_fp8_row(unsigned char* orow, const f32x4 (&v)[4], int lane, float scale) {
    GAS unsigned* o4 = (GAS unsigned*)orow + lane;
#pragma unroll
    for (int j = 0; j < 4; ++j) o4[64 * j] = pg8::pk4_fp8(v[j].x * scale, v[j].y * scale, v[j].z * scale, v[j].w * scale);
}
__device__ __forceinline__ void ln_row(f32x4 (&v)[4], const f32x4 (&g)[4], const f32x4 (&b)[4]) {
    float s = 0.f;
#pragma unroll
    for (int j = 0; j < 4; ++j) s += (v[j].x + v[j].y) + (v[j].z + v[j].w);
    const float mean = wave_sum(s) * (1.f / DMODEL); float s2 = 0.f;
#pragma unroll
    for (int j = 0; j < 4; ++j) { v[j] = v[j] - mean; s2 += (v[j].x * v[j].x + v[j].y * v[j].y) + (v[j].z * v[j].z + v[j].w * v[j].w); }
    const float rstd = 1.f / sqrtf(wave_sum(s2) * (1.f / DMODEL) + LN_EPS);
#pragma unroll
    for (int j = 0; j < 4; ++j) v[j] = v[j] * rstd * g[j] + b[j];
}
__device__ __forceinline__ void p_modulate(Frame& F, const float* x, const float* mod  , bf16* H) {
    const int gw = F.vcu * NWAVES + F.wave, NGW = F.G * NWAVES;
    f32x4 sh[4], sc[4]; load4(sh, mod, F.lane); load4(sc, mod + 1024, F.lane);
    f32x4 nv[4]; if (gw < M) load4(nv, x + (size_t)gw * DMODEL, F.lane);
    for (int m = gw; m < M; m += NGW) { f32x4 v[4];
#pragma unroll
        for (int j = 0; j < 4; ++j) v[j] = nv[j];
        if (m + NGW < M) load4(nv, x + (size_t)(m + NGW) * DMODEL, F.lane);
#pragma unroll
        for (int j = 0; j < 4; ++j) v[j] = v[j] * (sc[j] + 1.0f) + sh[j];
        store_bf16_row(H + (size_t)m * DMODEL, v, F.lane); }
}
template <bool ROUTE, bool H8> __device__ __forceinline__ void p_ln(Frame& F, float* xio, const float* lg, const float* lb, const float* mod, bf16* H, const float* rw) {
    const int gw = F.vcu * NWAVES + F.wave, NGW = F.G * NWAVES;
    f32x4 g[4], b[4], sh[4], sc[4]; load4(g, lg, F.lane); load4(b, lb, F.lane);
    if (mod) { load4(sh, mod, F.lane); load4(sc, mod + 1024, F.lane); }
    LAS float* rwT = (LAS float*)(F.lds + RING_OFF);
    LAS int* lcnt = (LAS int*)(F.lds + RING_OFF + 32768);
    LAS int* rinfo = (LAS int*)(F.lds + RING_OFF + 32768 + 256) + F.wave * 64;
    if (ROUTE) {
        for (int i = F.tid; i < 8192; i += NWAVES * 64) { const int k = i >> 3, e = i & 7; rwT[e * 1024 + k] = rw[i]; }
        if (F.tid < 16) lcnt[F.tid] = 0;
        __syncthreads();
    }
    int nr = 0;
    f32x4 nv[4]; if (gw < M) load4(nv, xio + (size_t)gw * DMODEL, F.lane);
    for (int m = gw; m < M; m += NGW) { f32x4 v[4];
#pragma unroll
        for (int j = 0; j < 4; ++j) v[j] = nv[j];
        if (m + NGW < M) load4(nv, xio + (size_t)(m + NGW) * DMODEL, F.lane);
        ln_row(v, g, b);
        store_f32_row(xio + (size_t)m * DMODEL, v, F.lane);
        if (mod) {
#pragma unroll
            for (int j = 0; j < 4; ++j) v[j] = v[j] * (sc[j] + 1.0f) + sh[j];
            if (H8) store_fp8_row((unsigned char*)H + (size_t)m * DMODEL, v, F.lane, SA_H); else store_bf16_row(H + (size_t)m * DMODEL, v, F.lane);
        }
        if (ROUTE) {
            float lgt[8];
#pragma unroll
            for (int e = 0; e < 8; ++e) { float s = 0.f;
#pragma unroll
                for (int j = 0; j < 4; ++j) { const f32x4 w = *(const LAS f32x4*)(rwT + e * 1024 + 256 * j + 4 * F.lane); s += (v[j].x * w.x + v[j].y * w.y) + (v[j].z * w.z + v[j].w * w.w); }
                lgt[e] = wave_sum(s); }
            int e0 = 0; float v0 = lgt[0];
#pragma unroll
            for (int e = 1; e < 8; ++e) if (lgt[e] > v0) { v0 = lgt[e]; e0 = e; }
            int e1 = -1; float v1 = -INFINITY;
#pragma unroll
            for (int e = 0; e < 8; ++e) if (e != e0 && (e1 < 0 || lgt[e] > v1)) { v1 = lgt[e]; e1 = e; }
            const float g0 = 1.0f / (1.0f + __expf(v1 - v0));
            if (F.lane == 0) { const int p0 = atomicAdd((int*)&lcnt[e0], 1), p1 = atomicAdd((int*)&lcnt[e1], 1);
                rinfo[nr * 8 + 0] = m; rinfo[nr * 8 + 1] = e0; rinfo[nr * 8 + 2] = e1; rinfo[nr * 8 + 3] = p0; rinfo[nr * 8 + 4] = p1; rinfo[nr * 8 + 5] = __float_as_int(g0); }
            ++nr;
        }
    }
    if (ROUTE) {
        __syncthreads();
        if (F.tid < 8) lcnt[8 + F.tid] = (int)__hip_atomic_fetch_add((unsigned*)(F.ctl + CW_CNT + 64 * F.tid), (unsigned)lcnt[F.tid], __ATOMIC_RELAXED, __HIP_MEMORY_SCOPE_AGENT);
        __syncthreads();
        int* perm = (int*)(F.ws + WS_SMALL + SM_PERM); int* tok = (int*)(F.ws + WS_SMALL + SM_TOK);
        if (F.lane == 0) for (int i = 0; i < nr; ++i) { const int m = rinfo[i * 8 + 0], e0 = rinfo[i * 8 + 1], e1 = rinfo[i * 8 + 2];
            const int p0 = lcnt[8 + e0] + rinfo[i * 8 + 3], p1 = lcnt[8 + e1] + rinfo[i * 8 + 4];
            perm[e0 * SEQ + p0] = m; perm[e1 * SEQ + p1] = m;
            tok[m * 4 + 0] = e0 | (e1 << 8); tok[m * 4 + 1] = p0; tok[m * 4 + 2] = p1; tok[m * 4 + 3] = rinfo[i * 8 + 5]; }
    }
}
__device__ __forceinline__ void p_ln_moe(Frame& F, float* xio, const float* lg, const float* lb, const float* g2v) {
    const int gw = F.vcu * NWAVES + F.wave, NGW = F.G * NWAVES;
    f32x4 g[4], b[4], gg[4]; load4(g, lg, F.lane); load4(b, lb, F.lane); load4(gg, g2v, F.lane);
    int tb[8]; { int acc = 0;
#pragma unroll
        for (int e = 0; e < 8; ++e) { tb[e] = acc; acc += ((int)__hip_atomic_load(F.ctl + CW_CNT + 64 * e, RLX_AGENT) + 255) >> 8; } }
    const int* tok = (const int*)(F.ws + WS_SMALL + SM_TOK); const bf16* Y = (const bf16*)(F.ws + WS_YSLOT);
    for (int m = gw; m < M; m += NGW) {
        const int ee = tok[m * 4 + 0], p0 = tok[m * 4 + 1], p1 = tok[m * 4 + 2]; const float g0 = __int_as_float(tok[m * 4 + 3]), g1 = 1.0f - g0;
        const int e0 = ee & 255, e1 = ee >> 8; int t0 = 0, t1 = 0;
#pragma unroll
        for (int e = 0; e < 8; ++e) { t0 = (e0 == e) ? tb[e] : t0; t1 = (e1 == e) ? tb[e] : t1; }
        const size_t s0 = (size_t)(t0 * 256 + p0), s1 = (size_t)(t1 * 256 + p1);
        f32x4 v[4]; load4(v, xio + (size_t)m * DMODEL, F.lane);
        const GAS unsigned long long* y0 = (const GAS unsigned long long*)(Y + s0 * DMODEL) + F.lane; const GAS unsigned long long* y1 = (const GAS unsigned long long*)(Y + s1 * DMODEL) + F.lane;
#pragma unroll
        for (int j = 0; j < 4; ++j) { const unsigned long long a = y0[64 * j], c = y1[64 * j];
            f32x4 f; f.x = g0 * bf2f((unsigned short)a) + g1 * bf2f((unsigned short)c); f.y = g0 * bf2f((unsigned short)(a >> 16)) + g1 * bf2f((unsigned short)(c >> 16));
            f.z = g0 * bf2f((unsigned short)(a >> 32)) + g1 * bf2f((unsigned short)(c >> 32)); f.w = g0 * bf2f((unsigned short)(a >> 48)) + g1 * bf2f((unsigned short)(c >> 48));
            v[j] = v[j] * ALPHA + (gg[j] + 1.0f) * f; }
        ln_row(v, g, b);
        store_f32_row(xio + (size_t)m * DMODEL, v, F.lane);
    }
}

__device__ __forceinline__ void hg_pass1(Frame& F, int l) {
    const bf16* P = (const bf16*)(F.ws + WS_PROJ); const float* lbs = (const float*)(F.ws + WS_SMALL + SM_LBS) + l * 256;
    float* HGS = (float*)(F.ws + WS_HGS); float* HGD = (float*)(F.ws + WS_HGD);
    LAS float* fk = (LAS float*)(F.lds + RING_OFF + F.wave * 16384);
    LAS float* vl = fk + 1024;
    const int kh = F.wave & 1;
    for (int tk = F.bid * 4 + (F.wave >> 1); tk < 1024; tk += F.G * 4) {
        const int c = tk >> 2, h = tk & 3;
        float S[32];
#pragma unroll
        for (int k = 0; k < 32; ++k) S[k] = 0.f;
        float dp = 1.f;
        for (int sb = 0; sb < 4; ++sb) {
            const int row0 = c * 64 + sb * 16;
#pragma unroll
            for (int j = 0; j < 8; ++j) { const int p = j * 64 + F.lane, tt = p >> 5, kk = p & 31, k = h * 64 + kh * 32 + kk;
                const float z = bf2f(P[(size_t)(row0 + tt) * DIN + 1792 + k]); const float lbv = lbs[k];
                const float f = lbv + (1.0f - lbv) * sigmoid_f(z), key = (1.0f - lbv) * sigmoid_f(-z);
                fk[(tt * 32 + kk) * 2] = f; fk[(tt * 32 + kk) * 2 + 1] = key; }
#pragma unroll
            for (int tt = 0; tt < 16; ++tt) vl[tt * 64 + F.lane] = silu_ff(bf2f(P[(size_t)(row0 + tt) * DIN + 2048 + h * 64 + F.lane]));
            for (int tt = 0; tt < 16; ++tt) {
                const float v = vl[tt * 64 + F.lane];
#pragma unroll
                for (int kk = 0; kk < 32; kk += 2) { const f32x4 q = *(const LAS f32x4*)(fk + (tt * 32 + kk) * 2);
                    S[kk] = q.x * S[kk] + q.y * v; S[kk + 1] = q.z * S[kk + 1] + q.w * v; }
            }
            if (F.lane < 32) {
#pragma unroll
                for (int tt = 0; tt < 16; ++tt) dp *= fk[(tt * 32 + F.lane) * 2]; }
        }
        float* Lp = HGS + ((size_t)(c * 4 + h) * 64 + kh * 32) * 64 + F.lane;
#pragma unroll
        for (int k = 0; k < 32; ++k) Lp[k * 64] = S[k];
        if (F.lane < 32) HGD[c * 256 + h * 64 + kh * 32 + F.lane] = dp;
    }
}
__device__ __forceinline__ void hg_pass2(Frame& F) {
    float* HGS = (float*)(F.ws + WS_HGS); const float* HGD = (const float*)(F.ws + WS_HGD);
    if (F.wave == 0) for (int b = F.bid; b < 256; b += F.G) {
        float carry = 0.f;
        for (int c0 = 0; c0 < 256; c0 += 16) { float Lv[16], Dv[16];
#pragma unroll
            for (int u = 0; u < 16; ++u) { Lv[u] = HGS[(size_t)(c0 + u) * 16384 + b * 64 + F.lane]; Dv[u] = HGD[(c0 + u) * 256 + b]; }
#pragma unroll
            for (int u = 0; u < 16; ++u) { HGS[(size_t)(c0 + u) * 16384 + b * 64 + F.lane] = carry; carry = Dv[u] * carry + Lv[u]; }
        }
    }
}
__device__ __forceinline__ void hg_pass3(Frame& F, int l, const float* hgg) {
    const bf16* P = (const bf16*)(F.ws + WS_PROJ); const float* lbs = (const float*)(F.ws + WS_SMALL + SM_LBS) + l * 256;
    const float* HGS = (const float*)(F.ws + WS_HGS); bf16* MIX = (bf16*)(F.ws + WS_MIX);
    LAS float* fk = (LAS float*)(F.lds + RING_OFF + F.wave * 16384);
    LAS float* vl = fk + 2048;
    LAS float* op = fk + 3072;
    LAS float* opp = (LAS float*)(F.lds + RING_OFF + (F.wave ^ 1) * 16384) + 3072;
    const int kh = F.wave & 1; const float gn = hgg[F.lane];
    for (int tk0 = F.bid * 4; tk0 < 1024; tk0 += F.G * 4) {
        const int tk = tk0 + (F.wave >> 1); const int c = tk >> 2, h = tk & 3;
        float S[32];
        { const float* Sp = HGS + ((size_t)(c * 4 + h) * 64 + kh * 32) * 64 + F.lane;
#pragma unroll
          for (int k = 0; k < 32; ++k) S[k] = Sp[k * 64]; }
        for (int sb = 0; sb < 4; ++sb) {
            const int row0 = c * 64 + sb * 16;
#pragma unroll
            for (int j = 0; j < 8; ++j) { const int p = j * 64 + F.lane, tt = p >> 5, kk = p & 31, k = h * 64 + kh * 32 + kk;
                const float z = bf2f(P[(size_t)(row0 + tt) * DIN + 1792 + k]); const float qv = bf2f(P[(size_t)(row0 + tt) * DIN + 1536 + k]); const float lbv = lbs[k];
                const float f = lbv + (1.0f - lbv) * sigmoid_f(z), key = (1.0f - lbv) * sigmoid_f(-z);
                *(LAS f32x4*)(fk + (tt * 32 + kk) * 4) = (f32x4){f, key, qv, 0.f}; }
#pragma unroll
            for (int tt = 0; tt < 16; ++tt) vl[tt * 64 + F.lane] = silu_ff(bf2f(P[(size_t)(row0 + tt) * DIN + 2048 + h * 64 + F.lane]));
            for (int tt = 0; tt < 16; ++tt) {
                const float v = vl[tt * 64 + F.lane]; float o = 0.f;
#pragma unroll
                for (int kk = 0; kk < 32; ++kk) { const f32x4 q = *(const LAS f32x4*)(fk + (tt * 32 + kk) * 4);
                    S[kk] = q.x * S[kk] + q.y * v; o += q.z * S[kk]; }
                op[tt * 64 + F.lane] = o;
            }
            __syncthreads();
#pragma unroll
            for (int t8 = 0; t8 < 8; ++t8) { const int tt = kh * 8 + t8; const float o = op[tt * 64 + F.lane] + opp[tt * 64 + F.lane];
                const float ss = wave_sum(o * o); const float rstd = 1.0f / sqrtf(ss * (1.0f / 64.0f) + LN_EPS);
                const float gt = bf2f(P[(size_t)(row0 + tt) * DIN + 2304 + h * 64 + F.lane]);
                MIX[(size_t)(row0 + tt) * DMODEL + 512 + h * 64 + F.lane] = (bf16)f2bf(o * rstd * gn * silu_ff(gt)); }
            __syncthreads();
        }
    }
}
__device__ __forceinline__ void pool_phase(Frame& F, const float* pw, const float* ps) {
    const bf16* P = (const bf16*)(F.ws + WS_PROJ); bf16* MIX = (bf16*)(F.ws + WS_MIX);
    LAS float* U = (LAS float*)(F.lds + RING_OFF + F.wave * 16384);
    LAS float* PL = U + 2048;
    const int gw = F.vcu * NWAVES + F.wave, NGW = F.G * NWAVES;
    for (int task = gw; task < 4096; task += NGW) {
        const int tg = task >> 2, gi = task & 3, t0 = tg * 16, win = 2 << gi;
        float wcol[64];
#pragma unroll
        for (int c = 0; c < 64; ++c) wcol[c] = pw[(size_t)(gi * 64 + c) * 64 + F.lane];
        const float scl = ps[gi * 64 + F.lane];
        for (int r = 0; r < 31; ++r) { const int t = t0 - 15 + r; U[r * 64 + F.lane] = (t >= 0) ? bf2f(P[(size_t)t * DIN + 2560 + gi * 64 + F.lane]) : 0.f; }
        for (int tt = 0; tt < 16; ++tt) { float s = 0.f;
            for (int j = 0; j < win; ++j) s += U[(15 + tt - j) * 64 + F.lane];
            const int t = t0 + tt; const float cntw = (float)((t + 1 < win) ? (t + 1) : win);
            PL[tt * 64 + F.lane] = s / cntw - U[(15 + tt) * 64 + F.lane]; }
        for (int tt = 0; tt < 16; ++tt) { float acc = 0.f;
#pragma unroll
            for (int c = 0; c < 64; c += 4) { const f32x4 p4 = *(const LAS f32x4*)(PL + tt * 64 + c);
                acc += p4.x * wcol[c]; acc += p4.y * wcol[c + 1]; acc += p4.z * wcol[c + 2]; acc += p4.w * wcol[c + 3]; }
            MIX[(size_t)(t0 + tt) * DMODEL + 768 + gi * 64 + F.lane] = (bf16)f2bf(acc * scl); }
    }
}
__device__ __forceinline__ void moe_gather(Frame& F) {
    const int gw = F.vcu * NWAVES + F.wave, NGW = F.G * NWAVES;
    int cn[8], tb[9]; tb[0] = 0;
#pragma unroll
    for (int e = 0; e < 8; ++e) { cn[e] = (int)__hip_atomic_load(F.ctl + CW_CNT + 64 * e, RLX_AGENT); tb[e + 1] = tb[e] + ((cn[e] + 255) >> 8); }
    const int* perm = (const int*)(F.ws + WS_SMALL + SM_PERM); const bf16* H = (const bf16*)(F.ws + WS_HBUF); bf16* HP = (bf16*)(F.ws + WS_HPERM);
    for (int slot = gw; slot < tb[8] * 256; slot += NGW) {
        const int T = slot >> 8; int e = 0, tbe = 0, ce = cn[0];
#pragma unroll
        for (int j = 1; j < 8; ++j) if (T >= tb[j]) { e = j; tbe = tb[j]; ce = cn[j]; }
        const int pos = ((T - tbe) << 8) + (slot & 255);
        const int tokn = (pos < ce) ? perm[e * SEQ + pos] : 0;
#if FP8_MOE
        const GAS v4u* src = (const GAS v4u*)((const unsigned char*)H + (size_t)tokn * DMODEL) + F.lane; GAS v4u* dst = (GAS v4u*)((unsigned char*)HP + (size_t)slot * DMODEL) + F.lane;
        dst[0] = src[0];
#else
        const GAS v4u* src = (const GAS v4u*)(H + (size_t)tokn * DMODEL) + F.lane; GAS v4u* dst = (GAS v4u*)(HP + (size_t)slot * DMODEL) + F.lane;
        const v4u a = src[0], b = src[64]; dst[0] = a; dst[64] = b;
#endif
    }
}
__device__ __forceinline__ void attn_finalize(Frame& F, int l, const float* ag) {
    const bf16* O1 = (const bf16*)(F.ws + WS_ATTNO); const bf16* O2 = O1 + (size_t)SEQ * 512; bf16* MIX = (bf16*)(F.ws + WS_MIX);
    const float* lamv = (const float*)(F.ws + WS_SMALL + SM_LAM); const float lam = lamv[l], osc = 1.0f - lamv[2 + l];
    const int gw = F.vcu * NWAVES + F.wave, NGW = F.G * NWAVES;
    float gv[8];
#pragma unroll
    for (int j = 0; j < 8; ++j) gv[j] = ag[(F.lane & 15) * 8 + j] * osc;
    v4u na = {0u, 0u, 0u, 0u}, nb = {0u, 0u, 0u, 0u}; if (gw < M) { na = *(const GAS v4u*)(O1 + (size_t)gw * 512 + F.lane * 8); nb = *(const GAS v4u*)(O2 + (size_t)gw * 512 + F.lane * 8); }
    for (int m = gw; m < M; m += NGW) {
        const v4u a = na, b = nb;
        if (m + NGW < M) { na = *(const GAS v4u*)(O1 + (size_t)(m + NGW) * 512 + F.lane * 8); nb = *(const GAS v4u*)(O2 + (size_t)(m + NGW) * 512 + F.lane * 8); }
        float d[8];
        d[0] = __uint_as_float(a.x << 16) - lam * __uint_as_float(b.x << 16); d[1] = __uint_as_float(a.x & 0xffff0000u) - lam * __uint_as_float(b.x & 0xffff0000u);
        d[2] = __uint_as_float(a.y << 16) - lam * __uint_as_float(b.y << 16); d[3] = __uint_as_float(a.y & 0xffff0000u) - lam * __uint_as_float(b.y & 0xffff0000u);
        d[4] = __uint_as_float(a.z << 16) - lam * __uint_as_float(b.z << 16); d[5] = __uint_as_float(a.z & 0xffff0000u) - lam * __uint_as_float(b.z & 0xffff0000u);
        d[6] = __uint_as_float(a.w << 16) - lam * __uint_as_float(b.w << 16); d[7] = __uint_as_float(a.w & 0xffff0000u) - lam * __uint_as_float(b.w & 0xffff0000u);
        float ss = 0.f;
#pragma unroll
        for (int j = 0; j < 8; ++j) ss += d[j] * d[j];
        ss += swzx<1>(ss); ss += swzx<2>(ss); ss += swzx<4>(ss); ss += swzx<8>(ss);
        const float rstd = __builtin_amdgcn_rsqf(ss * (1.0f / 128.0f) + LN_EPS);
        v4u o; o.x = pk2(d[0] * rstd * gv[0], d[1] * rstd * gv[1]); o.y = pk2(d[2] * rstd * gv[2], d[3] * rstd * gv[3]);
        o.z = pk2(d[4] * rstd * gv[4], d[5] * rstd * gv[5]); o.w = pk2(d[6] * rstd * gv[6], d[7] * rstd * gv[7]);
        *(GAS v4u*)(MIX + (size_t)m * DMODEL + F.lane * 8) = o;
    }
}

typedef float f32x16v __attribute__((ext_vector_type(16)));
typedef __bf16 bf16x2v __attribute__((ext_vector_type(2)));
typedef float f32x2v_ __attribute__((ext_vector_type(2)));
typedef short s16x4v __attribute__((ext_vector_type(4)));
__device__ __forceinline__ int crow16(int i, int hh) { return (i & 3) + 8 * (i >> 2) + 4 * hh; }
__device__ __forceinline__ unsigned pkbf(float lo, float hi) { f32x2v_ v = {lo, hi}; bf16x2v b = __builtin_convertvector(v, bf16x2v); return __builtin_bit_cast(unsigned, b); }
__device__ __forceinline__ bf16x8 pk8(const float (&x)[8]) { v4u w; w.x = pkbf(x[0], x[1]); w.y = pkbf(x[2], x[3]); w.z = pkbf(x[4], x[5]); w.w = pkbf(x[6], x[7]); return __builtin_bit_cast(bf16x8, w); }
__device__ __forceinline__ void unpk8(const v4u w, float (&x)[8]) {
    x[0] = __uint_as_float(w.x << 16); x[1] = __uint_as_float(w.x & 0xffff0000u); x[2] = __uint_as_float(w.y << 16); x[3] = __uint_as_float(w.y & 0xffff0000u);
    x[4] = __uint_as_float(w.z << 16); x[5] = __uint_as_float(w.z & 0xffff0000u); x[6] = __uint_as_float(w.w << 16); x[7] = __uint_as_float(w.w & 0xffff0000u); }
#define MFMA32(a, b, c) __builtin_amdgcn_mfma_f32_32x32x16_bf16((a), (b), (c), 0, 0, 0)
constexpr int HG_LDS = 26624, VT_PITCH = 72;
constexpr float HG_CLAMP = 80.0f;

__device__ __forceinline__ void hg_build_vt(LAS bf16* VT, const GAS bf16* P, int row0, int h, int lane) {
    const GAS bf16* vp = P + (size_t)row0 * DIN + 2048 + h * 64 + lane;
    for (int t0 = 0; t0 < 64; t0 += 16) { bf16 vr[16];
#pragma unroll
        for (int j = 0; j < 16; ++j) vr[j] = vp[(size_t)(t0 + j) * DIN];
#pragma unroll
        for (int t8 = 0; t8 < 2; ++t8) { float x[8];
#pragma unroll
            for (int j = 0; j < 8; ++j) x[j] = silu_ff(bf2f(vr[t8 * 8 + j]));
            *(LAS bf16x8*)(VT + lane * VT_PITCH + t0 + t8 * 8) = pk8(x); } }
}
__device__ __forceinline__ void hg_pass1_mfma(Frame& F, int l) {
    const GAS bf16* P = (const GAS bf16*)(F.ws + WS_PROJ); const GAS float* lbs = (const GAS float*)(F.ws + WS_SMALL + SM_LBS) + l * 256;
    GAS float* HGS = (GAS float*)(F.ws + WS_HGS); GAS float* HGD = (GAS float*)(F.ws + WS_HGD);
    if (F.wave >= 4) return;
    LAS bf16* KH = (LAS bf16*)(F.lds + RING_OFF + F.wave * HG_LDS);
    LAS bf16* VT = KH + 64 * VT_PITCH;
    const int lane = F.lane, r = lane & 31, hh = lane >> 5;
    for (int tk = F.bid * 4 + F.wave; tk < 1024; tk += F.G * 4) {
        const int c = tk >> 2, h = tk & 3, row0 = c * 64;
        const float lbv = lbs[h * 64 + lane];
        const GAS bf16* zp = P + (size_t)row0 * DIN + 1792 + h * 64 + lane;
        float b = 0.f;
        for (int t0 = 0; t0 < 64; t0 += 16) { bf16 zr[16];
#pragma unroll
            for (int j = 0; j < 16; ++j) zr[j] = zp[(size_t)(t0 + j) * DIN];
#pragma unroll
            for (int j = 0; j < 16; ++j) { const float f = lbv + (1.0f - lbv) * sigmoid_f(bf2f(zr[j])); b += (0.6931471805599453f * __builtin_amdgcn_logf(fmaxf(f, 1e-30f))); } }
        float bt = 0.f;
        for (int t0 = 0; t0 < 64; t0 += 16) { bf16 zr[16];
#pragma unroll
            for (int j = 0; j < 16; ++j) zr[j] = zp[(size_t)(t0 + j) * DIN];
#pragma unroll
            for (int t8 = 0; t8 < 2; ++t8) { float x[8];
#pragma unroll
                for (int j = 0; j < 8; ++j) { const float z = bf2f(zr[t8 * 8 + j]); const float f = lbv + (1.0f - lbv) * sigmoid_f(z); bt += (0.6931471805599453f * __builtin_amdgcn_logf(fmaxf(f, 1e-30f)));
                    x[j] = (1.0f - lbv) * sigmoid_f(-z) * __expf(b - bt); }
                *(LAS bf16x8*)(KH + lane * VT_PITCH + t0 + t8 * 8) = pk8(x); } }
        HGD[c * 256 + h * 64 + lane] = __expf(b);
        hg_build_vt(VT, P, row0, h, lane);
#pragma unroll
        for (int kb = 0; kb < 2; ++kb)
#pragma unroll
            for (int vb = 0; vb < 2; ++vb) { f32x16v acc = {};
#pragma unroll
                for (int ss = 0; ss < 4; ++ss) { const bf16x8 a = *(const LAS bf16x8*)(KH + (32 * kb + r) * VT_PITCH + 16 * ss + 8 * hh); const bf16x8 bq = *(const LAS bf16x8*)(VT + (32 * vb + r) * VT_PITCH + 16 * ss + 8 * hh);
                    acc = MFMA32(a, bq, acc); }
                GAS float* Lp = HGS + ((size_t)(c * 4 + h) * 64 + 32 * kb) * 64 + 32 * vb + r;
#pragma unroll
                for (int i = 0; i < 16; ++i) Lp[crow16(i, hh) * 64] = acc[i]; }
    }
}
__device__ __forceinline__ void hg_pass3_mfma(Frame& F, int l, const float* hgg) {
    const GAS bf16* P = (const GAS bf16*)(F.ws + WS_PROJ); const GAS float* lbs = (const GAS float*)(F.ws + WS_SMALL + SM_LBS) + l * 256;
    const GAS float* HGS = (const GAS float*)(F.ws + WS_HGS); GAS bf16* MIX = (GAS bf16*)(F.ws + WS_MIX); const GAS float* hgg_g = (const GAS float*)hgg;
    if (F.wave >= 4) return;
    LAS float* BL = (LAS float*)(F.lds + RING_OFF + F.wave * HG_LDS);
    LAS bf16* VT = (LAS bf16*)(BL + 4096);
    LAS float* R1 = (LAS float*)(VT + 64 * VT_PITCH);
    const int lane = F.lane, r = lane & 31, hh = lane >> 5;
    for (int tk = F.bid * 4 + F.wave; tk < 1024; tk += F.G * 4) {
        const int c = tk >> 2, h = tk & 3, row0 = c * 64;
        { const float lbv = lbs[h * 64 + lane]; float b = 0.f; const GAS bf16* zp = P + (size_t)row0 * DIN + 1792 + h * 64 + lane;
          for (int t0 = 0; t0 < 64; t0 += 16) { bf16 zr[16];
#pragma unroll
              for (int j = 0; j < 16; ++j) zr[j] = zp[(size_t)(t0 + j) * DIN];
#pragma unroll
              for (int j = 0; j < 16; ++j) { const float f = lbv + (1.0f - lbv) * sigmoid_f(bf2f(zr[j])); b += (0.6931471805599453f * __builtin_amdgcn_logf(fmaxf(f, 1e-30f))); BL[(t0 + j) * 64 + lane] = b; }
              if (t0 == 16) R1[lane] = b; } }
        hg_build_vt(VT, P, row0, h, lane);
        bf16x8 Qt[2][4], Qh1[4];
#pragma unroll
        for (int tb = 0; tb < 2; ++tb)
#pragma unroll
            for (int ks = 0; ks < 4; ++ks) { const int t = 32 * tb + r, k0 = 16 * ks + 8 * hh; float q[8], e[8];
                unpk8(*(const GAS v4u*)(P + (size_t)(row0 + t) * DIN + 1536 + h * 64 + k0), q);
                const f32x4 b0 = *(const LAS f32x4*)(BL + t * 64 + k0), b1 = *(const LAS f32x4*)(BL + t * 64 + k0 + 4);
                e[0] = b0.x; e[1] = b0.y; e[2] = b0.z; e[3] = b0.w; e[4] = b1.x; e[5] = b1.y; e[6] = b1.z; e[7] = b1.w;
                if (tb == 1) { const f32x4 r0 = *(const LAS f32x4*)(R1 + k0), r1 = *(const LAS f32x4*)(R1 + k0 + 4); const float rr[8] = {r0.x, r0.y, r0.z, r0.w, r1.x, r1.y, r1.z, r1.w}; float qh[8];
#pragma unroll
                    for (int j = 0; j < 8; ++j) { q[j] *= __expf(e[j] - rr[j]); qh[j] = q[j] * __expf(rr[j]); }
                    Qh1[ks] = pk8(qh);
                } else {
#pragma unroll
                    for (int j = 0; j < 8; ++j) q[j] *= __expf(e[j]);
                }
                Qt[tb][ks] = pk8(q); }
        f32x16v X00 = {}, X01 = {}, X11 = {};
#pragma unroll
        for (int ks = 0; ks < 4; ++ks) { const int k0 = 16 * ks + 8 * hh;
            const f32x4 l0 = *(const GAS f32x4*)(lbs + h * 64 + k0), l1 = *(const GAS f32x4*)(lbs + h * 64 + k0 + 4); const float lb8[8] = {l0.x, l0.y, l0.z, l0.w, l1.x, l1.y, l1.z, l1.w};
            const f32x4 r0 = *(const LAS f32x4*)(R1 + k0), r1 = *(const LAS f32x4*)(R1 + k0 + 4); const float rr[8] = {r0.x, r0.y, r0.z, r0.w, r1.x, r1.y, r1.z, r1.w};
            float key[8], bs[8], x0[8], x1[8];
            unpk8(*(const GAS v4u*)(P + (size_t)(row0 + r) * DIN + 1792 + h * 64 + k0), key);
            { const f32x4 b0 = *(const LAS f32x4*)(BL + r * 64 + k0), b1 = *(const LAS f32x4*)(BL + r * 64 + k0 + 4); bs[0] = b0.x; bs[1] = b0.y; bs[2] = b0.z; bs[3] = b0.w; bs[4] = b1.x; bs[5] = b1.y; bs[6] = b1.z; bs[7] = b1.w; }
#pragma unroll
            for (int j = 0; j < 8; ++j) { const float ky = (1.0f - lb8[j]) * sigmoid_f(-key[j]); x0[j] = ky * __expf(fminf(-bs[j], HG_CLAMP)); x1[j] = ky * __expf(rr[j] - bs[j]); }
            X00 = MFMA32(pk8(x0), Qt[0][ks], X00);
            X01 = MFMA32(pk8(x1), Qt[1][ks], X01);
            unpk8(*(const GAS v4u*)(P + (size_t)(row0 + 32 + r) * DIN + 1792 + h * 64 + k0), key);
            { const f32x4 b0 = *(const LAS f32x4*)(BL + (32 + r) * 64 + k0), b1 = *(const LAS f32x4*)(BL + (32 + r) * 64 + k0 + 4); bs[0] = b0.x; bs[1] = b0.y; bs[2] = b0.z; bs[3] = b0.w; bs[4] = b1.x; bs[5] = b1.y; bs[6] = b1.z; bs[7] = b1.w; }
#pragma unroll
            for (int j = 0; j < 8; ++j) { const float ky = (1.0f - lb8[j]) * sigmoid_f(-key[j]); x1[j] = ky * __expf(fminf(rr[j] - bs[j], HG_CLAMP)); }
            X11 = MFMA32(pk8(x1), Qt[1][ks], X11);
        }
#pragma unroll
        for (int i = 0; i < 16; ++i) { const bool keep = crow16(i, hh) <= r; X00[i] = keep ? X00[i] : 0.f; X11[i] = keep ? X11[i] : 0.f; }
        f32x16v O[2][2] = {};
#pragma unroll
        for (int sp = 0; sp < 2; ++sp) {
            float p[8]; bf16x8 P00, P01, P11;
#pragma unroll
            for (int j = 0; j < 8; ++j) p[j] = X00[8 * sp + j]; P00 = pk8(p);
#pragma unroll
            for (int j = 0; j < 8; ++j) p[j] = X01[8 * sp + j]; P01 = pk8(p);
#pragma unroll
            for (int j = 0; j < 8; ++j) p[j] = X11[8 * sp + j]; P11 = pk8(p);
#pragma unroll
            for (int vb = 0; vb < 2; ++vb) {
                const LAS bf16* vrow = VT + (32 * vb + r) * VT_PITCH + 16 * sp + 4 * hh;
                const s16x4v a0 = *(const LAS s16x4v*)(vrow), a1 = *(const LAS s16x4v*)(vrow + 8);
                const s16x4v c0 = *(const LAS s16x4v*)(vrow + 32), c1 = *(const LAS s16x4v*)(vrow + 40);
                const bf16x8 V0 = (bf16x8){a0[0], a0[1], a0[2], a0[3], a1[0], a1[1], a1[2], a1[3]}, V1 = (bf16x8){c0[0], c0[1], c0[2], c0[3], c1[0], c1[1], c1[2], c1[3]};
                O[0][vb] = MFMA32(P00, V0, O[0][vb]);
                O[1][vb] = MFMA32(P01, V0, O[1][vb]);
                O[1][vb] = MFMA32(P11, V1, O[1][vb]);
            }
        }
#pragma unroll
        for (int ks = 0; ks < 4; ++ks)
#pragma unroll
            for (int vb = 0; vb < 2; ++vb) { float sv[8]; const GAS float* Sp = HGS + ((size_t)(c * 4 + h) * 64 + 16 * ks + 8 * hh) * 64 + 32 * vb + r;
#pragma unroll
                for (int j = 0; j < 8; ++j) sv[j] = Sp[j * 64];
                const bf16x8 sf = pk8(sv);
                O[0][vb] = MFMA32(Qt[0][ks], sf, O[0][vb]);
                O[1][vb] = MFMA32(Qh1[ks], sf, O[1][vb]); }
        const float gn0 = hgg_g[r], gn1 = hgg_g[32 + r];
#pragma unroll
        for (int tb = 0; tb < 2; ++tb) {
            bf16 gr[16][2]; float rs[16];
#pragma unroll
            for (int i = 0; i < 16; ++i) { const GAS bf16* gp = P + (size_t)(row0 + 32 * tb + crow16(i, hh)) * DIN + 2304 + h * 64 + r; gr[i][0] = gp[0]; gr[i][1] = gp[32]; }
#pragma unroll
            for (int i = 0; i < 16; ++i) { const float o0 = O[tb][0][i], o1 = O[tb][1][i]; rs[i] = o0 * o0 + o1 * o1; }
#pragma unroll
            for (int i = 0; i < 16; ++i) rs[i] += swzx<1>(rs[i]);
#pragma unroll
            for (int i = 0; i < 16; ++i) rs[i] += swzx<2>(rs[i]);
#pragma unroll
            for (int i = 0; i < 16; ++i) rs[i] += swzx<4>(rs[i]);
#pragma unroll
            for (int i = 0; i < 16; ++i) rs[i] += swzx<8>(rs[i]);
#pragma unroll
            for (int i = 0; i < 16; ++i) rs[i] += swzx<16>(rs[i]);
#pragma unroll
            for (int i = 0; i < 16; ++i) { const int t = 32 * tb + crow16(i, hh); const float rstd = __builtin_amdgcn_rsqf(rs[i] * (1.0f / 64.0f) + LN_EPS);
                GAS bf16* op = MIX + (size_t)(row0 + t) * DMODEL + 512 + h * 64 + r;
                op[0] = (bf16)f2bf(O[tb][0][i] * rstd * gn0 * silu_ff(bf2f(gr[i][0]))); op[32] = (bf16)f2bf(O[tb][1][i] * rstd * gn1 * silu_ff(bf2f(gr[i][1]))); }
        }
    }
}
__device__ __forceinline__ void pool_mfma(Frame& F, const float* pw, const float* ps) {
    const GAS bf16* P = (const GAS bf16*)(F.ws + WS_PROJ); GAS bf16* MIX = (GAS bf16*)(F.ws + WS_MIX); const GAS float* pwg = (const GAS float*)pw; const GAS float* psg = (const GAS float*)ps;
    LAS float* ZL = (LAS float*)(F.lds + RING_OFF + F.wave * 12288);
    const int lane = F.lane, r = lane & 31, hh = lane >> 5, gi = F.wave >> 1, db = F.wave & 1, win = 2 << gi;
    bf16x8 wf[4];
#pragma unroll
    for (int ks = 0; ks < 4; ++ks) { float x[8];
#pragma unroll
        for (int j = 0; j < 8; ++j) x[j] = pwg[(size_t)(gi * 64 + 16 * ks + 8 * hh + j) * 64 + 32 * db + r];
        wf[ks] = pk8(x); }
    const float scl = psg[gi * 64 + 32 * db + r];
    for (int tile = F.bid; tile < SEQ / 64; tile += F.G) {
        const int t0 = tile * 64 - 32;
#pragma unroll
        for (int rt = 0; rt < 3; ++rt) { f32x16v acc = {}; const int t = t0 + 32 * rt + r;
#pragma unroll
            for (int ks = 0; ks < 4; ++ks) { v4u a = {0u, 0u, 0u, 0u}; if (t >= 0) a = *(const GAS v4u*)(P + (size_t)t * DIN + 2560 + gi * 64 + 16 * ks + 8 * hh);
                acc = MFMA32(__builtin_bit_cast(bf16x8, a), wf[ks], acc); }
#pragma unroll
            for (int i = 0; i < 16; ++i) ZL[(32 * rt + crow16(i, hh)) * 32 + r] = acc[i]; }
        const int tl0 = 32 + 32 * hh; float s = 0.f;
        for (int j = 1; j < win; ++j) s += ZL[(tl0 - j) * 32 + r];
        for (int tt = 0; tt < 32; ++tt) { const int tl = tl0 + tt; const float zc = ZL[tl * 32 + r]; s += zc;
            const int tg = t0 + tl; const float cntw = (float)((tg + 1 < win) ? (tg + 1) : win);
            MIX[(size_t)tg * DMODEL + 768 + gi * 64 + 32 * db + r] = (bf16)f2bf((s / cntw - zc) * scl);
            s -= ZL[(tl - win + 1) * 32 + r]; }
    }
}
#ifndef DIS
#define DIS 0
#endif
#ifndef DUP
#define DUP 0
#endif
#ifndef ATTN_B
#define ATTN_B 1
#endif
#ifndef HG_MFMA
#define HG_MFMA 1
#endif
#ifndef POOL_MFMA
#define POOL_MFMA 1
#endif
#if HG_MFMA
#define HG1 hg_pass1_mfma
#define HG3 hg_pass3_mfma
#else
#define HG1 hg_pass1
#define HG3 hg_pass3
#endif
#if POOL_MFMA
#define POOLF pool_mfma
#else
#define POOLF pool_phase
#endif
#define RELOAD_ARGS() do { asm volatile("" : "+s"(argp), "+s"(F.ws), "+s"(F.ctl), "+s"(bar.bar), "+s"(bar.x), "+s"(F.G), "+s"(F.vcu), "+s"(F.bid)); { unsigned z_ = 0u; asm volatile("" : "+s"(z_)); F.lane = (int)__builtin_amdgcn_mbcnt_hi(~0u, __builtin_amdgcn_mbcnt_lo(~0u, z_)); } asm volatile("" : "+v"(F.lane)); F.tid = F.wave * 64 + F.lane; } while (0)
#define args (*argp)
__global__ void __launch_bounds__(NWAVES * 64, 2) mk_fwd(Args args_) {
    const Args* argp = (const Args*)__builtin_amdgcn_kernarg_segment_ptr();
    extern __shared__ __attribute__((aligned(16))) unsigned char lds[];
    Frame F;
    F.lds = (LAS unsigned char*)lds;
    F.MISC = (volatile LAS unsigned*)(F.lds + MISC_OFF);
    F.tid = threadIdx.x; F.lane = F.tid & 63; F.wave = __builtin_amdgcn_readfirstlane(F.tid >> 6);
    F.G = gridDim.x; F.bid = blockIdx.x; { const int bx = blockIdx.x; F.vcu = (F.G % 8 == 0) ? (bx % 8) * (F.G / 8) + bx / 8 : bx; }
    F.ws = args.ws; F.ctl = (gu32*)(args.ws + WS_CTL);
    for (int u = F.tid; u < (LDS_BYTES - LDSCTL_OFF) / 4; u += NWAVES * 64) ((LAS unsigned*)(F.lds + LDSCTL_OFF))[u] = 0u;
    __syncthreads();
    XcdBarrier bar; bar.bar = (unsigned*)(F.ctl + CW_BAR); bar.x = 0; bar.st = nullptr;
    if (N_LAUNCHES == 1) bar = xcd_barrier_post((unsigned*)(F.ctl + CW_BAR), F.MISC + 8, F.tid);
    const int lo = (N_LAUNCHES == 1) ? 0 : args.ph_lo, hi = (N_LAUNCHES == 1) ? NPH : args.ph_hi;
#define IN(k) (lo <= (k) && (k) < hi)
#define SEAM(k) do { if (IN(k) && IN((k) + 1)) xcd_barrier(bar, F.tid); RELOAD_ARGS(); } while (0)
#define MOD ((const float*)(F.ws + WS_SMALL + SM_MOD))
#define HB ((bf16*)(F.ws + WS_HBUF))

    if (IN(0)) {
#if !(DIS&1)
        p0a_prologue(F, args);
#if (DUP&1)
            __syncthreads();
            p0a_prologue(F, args);
#endif

#endif
    } SEAM(0);
    if (IN(1)) { p_modulate(F, args.in[I_X], MOD, HB); } SEAM(1);

    for (int l = 0; l < DEPTH; ++l) {
        const int pb = 2 + NPH_LAYER * l;
#define mod (MOD + l * 6144)
#define xin ((l == 0) ? args.in[I_X] : (const float*)args.out)
        if (IN(pb + 0)) {
            pg8::Gemm g{HB, (const bf16*)(F.ws + WS_WIN) + (size_t)l * DIN * 1024, 1024}; pg8::StaticOrder S; S.init(M, DIN, F.G, F.bid);
            pg8::EpiProj E{(bf16*)(F.ws + WS_PROJ), DIN, (const float*)(F.ws + WS_ROPE), (const float*)(F.ws + WS_ROPE) + (size_t)SEQ * 32, attn_body::C2};
#if !(DIS&2)
            pg8::gemm_phase<pg8::EpiProj, pg8::StaticOrder, true>(F.lds + RING_OFF, g, S, E, F.tid);
#if (DUP&2)
            __syncthreads();
            pg8::gemm_phase<pg8::EpiProj, pg8::StaticOrder, true>(F.lds + RING_OFF, g, S, E, F.tid);
#endif

#endif
        } SEAM(pb + 0);
        if (IN(pb + 1)) {
#if !(DIS&4)
            HG1(F, l);
#if (DUP&4)
            __syncthreads();
            HG1(F, l);
#endif

#endif
            __syncthreads(); RELOAD_ARGS();
#if !(DIS&8)
            POOLF(F, args.in[I_POOLW] + (size_t)l * 4 * 64 * 64, args.in[I_POOLS] + l * 256);
#if (DUP&8)
            __syncthreads();
            POOLF(F, args.in[I_POOLW] + (size_t)l * 4 * 64 * 64, args.in[I_POOLS] + l * 256);
#endif

#endif
        } SEAM(pb + 1);
        if (IN(pb + 2)) {
#if !(DIS&16)
            hg_pass2(F);
#endif
        } SEAM(pb + 2);
        if (IN(pb + 3)) {
            const attn_body::bf16* PJ = (const attn_body::bf16*)(F.ws + WS_PROJ); attn_body::bf16* AO = (attn_body::bf16*)(F.ws + WS_ATTNO);
#if ATTN_B
            for (int rep_ = 0; rep_ < ((DUP&32) ? 2 : 1); ++rep_)
            for (int i = 0; i < 2; ++i) { const int j = i * F.G + F.vcu; if (j >= 512) break;
                const int v = j & 255, ii = j >> 8, mpi = v >> 5, s = v & 31; const int qb = (ii == 0) ? s : 63 - s;
                const int h = mpi >> 1, mp = mpi & 1;
#if !(DIS&32)
                attn_body::attn_unit2<8>(F.tid, qb, PJ + mpi * 64, PJ + 512 + mpi * 64, PJ + 1024 + h * 128, AO + (size_t)mp * SEQ * 512 + h * 128, (char*)lds + RING_OFF);
#endif
            }
#else
            for (int rep_ = 0; rep_ < ((DUP&32) ? 2 : 1); ++rep_)
            for (int i = 0; i < 4; ++i) { const int j = i * F.G + F.vcu; if (j >= 1024) break;
                const int v = j & 255, ii = j >> 8, vh = v >> 4, s = v & 15; const int qb = (ii == 0) ? s : (ii == 1) ? 31 - s : (ii == 2) ? 32 + s : 63 - s;
                const int h = vh >> 2, mp = (vh >> 1) & 1, vf = vh & 1;
#if !(DIS&32)
                attn_body::attn_unit<8>(F.tid, qb, PJ + (h * 2 + mp) * 64, PJ + 512 + (h * 2 + mp) * 64, PJ + 1024 + h * 128 + vf * 64, AO + (size_t)mp * SEQ * 512 + h * 128 + vf * 64, (char*)lds + RING_OFF);
#endif
            }
#endif
            __syncthreads(); RELOAD_ARGS();
#if !(DIS&64)
            HG3(F, l, args.in[I_HGG] + l * 64);
#if (DUP&64)
            __syncthreads();
            HG3(F, l, args.in[I_HGG] + l * 64);
#endif

#endif
        } SEAM(pb + 3);
        if (IN(pb + 4)) {
#if !(DIS&128)
            attn_finalize(F, l, args.in[I_ATTNG] + l * 128);
#if (DUP&128)
            __syncthreads();
            attn_finalize(F, l, args.in[I_ATTNG] + l * 128);
#endif

#endif
        } SEAM(pb + 4);
        if (IN(pb + 5)) {
            pg8::Gemm g{(const bf16*)(F.ws + WS_MIX), (const bf16*)(F.ws + WS_WOUT) + (size_t)l * 1024 * 1024, 1024}; pg8::StaticOrder S; S.init(M, DMODEL, F.G, F.bid);
            pg8::EpiResid E{xin, args.out, DMODEL, mod + 2048, ALPHA, 1.0f};
#if !(DIS&256)
            pg8::gemm_phase<pg8::EpiResid, pg8::StaticOrder, false>(F.lds + RING_OFF, g, S, E, F.tid);
#endif
        } SEAM(pb + 5);
        if (IN(pb + 6)) {
#if !(DIS&512)
            if (l & 1) p_ln<true, FP8_MOE != 0>(F, args.out, args.in[I_LN1G] + l * 1024, args.in[I_LN1B] + l * 1024, mod + 3072, HB, args.in[I_RW] + (size_t)(l >> 1) * 1024 * 8);
#endif
#if !(DIS&1024)
            if (!(l & 1)) p_ln<false, FP8_DENSE != 0>(F, args.out, args.in[I_LN1G] + l * 1024, args.in[I_LN1B] + l * 1024, mod + 3072, HB, nullptr);
#endif
        } SEAM(pb + 6);
        if (!(l & 1)) {
            if (IN(pb + 8)) {
#if FP8_DENSE
                pg8::Gemm g{HB, (const bf16*)(F.ws + WS_FFN13), 1024 / 2}; pg8::StaticOrder S; S.init(M, 2 * FFD, F.G, F.bid);
                pg8::EpiSwiglu8 E{F.ws + WS_DHID, FFD, UP_DESCALE, S_HID};
#if !(DIS&2048)
                pg8::gemm_phase<pg8::EpiSwiglu8, pg8::StaticOrder, true, true>(F.lds + RING_OFF, g, S, E, F.tid);
#if (DUP&2048)
            __syncthreads();
            pg8::gemm_phase<pg8::EpiSwiglu8, pg8::StaticOrder, true, true>(F.lds + RING_OFF, g, S, E, F.tid);
#endif

#endif
#else
                pg8::Gemm g{HB, (const bf16*)(F.ws + WS_FFN13), 1024}; pg8::StaticOrder S; S.init(M, 2 * FFD, F.G, F.bid);
                pg8::EpiSwiglu E{(bf16*)(F.ws + WS_DHID), FFD};
#if !(DIS&2048)
                pg8::gemm_phase<pg8::EpiSwiglu, pg8::StaticOrder, true>(F.lds + RING_OFF, g, S, E, F.tid);
#endif
#endif
            } SEAM(pb + 8);
            if (IN(pb + 9)) {
#if FP8_DENSE
                pg8::Gemm g{(const bf16*)(F.ws + WS_DHID), (const bf16*)(F.ws + WS_FFN2), FFD / 2}; pg8::StaticOrder S; S.init(M, DMODEL, F.G, F.bid);
                pg8::EpiResid E{args.out, args.out, DMODEL, mod + 5120, ALPHA, DN_DESCALE};
#if !(DIS&4096)
                pg8::gemm_phase<pg8::EpiResid, pg8::StaticOrder, false, true>(F.lds + RING_OFF, g, S, E, F.tid);
#endif
#else
                pg8::Gemm g{(const bf16*)(F.ws + WS_DHID), (const bf16*)(F.ws + WS_FFN2), FFD}; pg8::StaticOrder S; S.init(M, DMODEL, F.G, F.bid);
                pg8::EpiResid E{args.out, args.out, DMODEL, mod + 5120, ALPHA, 1.0f};
#if !(DIS&4096)
                pg8::gemm_phase<pg8::EpiResid, pg8::StaticOrder, false>(F.lds + RING_OFF, g, S, E, F.tid);
#endif
#endif
            } SEAM(pb + 9);
            if (IN(pb + 10)) {
                p_ln<false, false>(F, args.out, args.in[I_LN2G] + l * 1024, args.in[I_LN2B] + l * 1024, (l + 1 < DEPTH) ? MOD + (l + 1) * 6144 : nullptr, HB, nullptr);
            } SEAM(pb + 10);
        } else {
            const unsigned* cnt = (const unsigned*)(F.ctl + CW_CNT);
            if (IN(pb + 7)) {
#if !(DIS&65536)
                moe_gather(F);
#if (DUP&65536)
            __syncthreads();
            moe_gather(F);
#endif

#endif
            } SEAM(pb + 7);
            if (IN(pb + 8)) {
                pg8::Gemm g{(const bf16*)(F.ws + WS_HPERM), (const bf16*)(F.ws + WS_EXP13), 1024 / 2}; pg8::MoeOrder S; S.init(cnt, 2 * EDIM / 256, F.G, F.bid);
                pg8::EpiSwiglu8 E{F.ws + WS_HID, EDIM, UP_DESCALE, S_HID};
#if !(DIS&8192)
                pg8::gemm_phase<pg8::EpiSwiglu8, pg8::MoeOrder, true, true>(F.lds + RING_OFF, g, S, E, F.tid);
#if (DUP&8192)
            __syncthreads();
            pg8::gemm_phase<pg8::EpiSwiglu8, pg8::MoeOrder, true, true>(F.lds + RING_OFF, g, S, E, F.tid);
#endif

#endif
            } SEAM(pb + 8);
            if (IN(pb + 9)) {
                pg8::Gemm g{(const bf16*)(F.ws + WS_HID), (const bf16*)(F.ws + WS_EXP2), EDIM / 2}; pg8::MoeOrder S; S.init(cnt, DMODEL / 256, F.G, F.bid);
                pg8::EpiBf16 E{(bf16*)(F.ws + WS_YSLOT), DMODEL, DN_DESCALE};
#if !(DIS&16384)
                pg8::gemm_phase<pg8::EpiBf16, pg8::MoeOrder, true, true>(F.lds + RING_OFF, g, S, E, F.tid);
#if (DUP&16384)
            __syncthreads();
            pg8::gemm_phase<pg8::EpiBf16, pg8::MoeOrder, true, true>(F.lds + RING_OFF, g, S, E, F.tid);
#endif

#endif
            } SEAM(pb + 9);
            if (IN(pb + 10)) {
#if !(DIS&32768)
                p_ln_moe(F, args.out, args.in[I_LN2G] + l * 1024, args.in[I_LN2B] + l * 1024, mod + 5120);
#endif
            } SEAM(pb + 10);
        }
    }
#undef IN
#undef SEAM
#undef args
#undef MOD
#undef HB
#undef mod
#undef xin
}

extern "C" void kernel_launch(void* const* d_in, const int* in_sizes, int n_in, void* d_out, int out_size, void* d_ws, size_t ws_size, hipStream_t stream) {
    static int grid = 0;
    if (grid == 0) {
        if (n_in != 23 || in_sizes[0] != M * DMODEL || out_size != M * DMODEL || ws_size < WS_END) { fprintf(stderr, "kernel_launch: unexpected shapes (n_in %d, out %d, ws %zu); nothing launched\n", n_in, out_size, ws_size); grid = -1; return; }
        int dev = 0, cus = 0, per_cu = 0;
        if (hipGetDevice(&dev) != hipSuccess || hipDeviceGetAttribute(&cus, hipDeviceAttributeMultiprocessorCount, dev) != hipSuccess) { grid = -1; return; }
        if (hipFuncSetAttribute((const void*)mk_fwd, hipFuncAttributeMaxDynamicSharedMemorySize, LDS_BYTES) != hipSuccess) { fprintf(stderr, "kernel_launch: hipFuncSetAttribute failed\n"); grid = -1; return; }
        if (hipOccupancyMaxActiveBlocksPerMultiprocessor(&per_cu, (const void*)mk_fwd, NWAVES * 64, LDS_BYTES) != hipSuccess || per_cu < 1) { fprintf(stderr, "kernel_launch: occupancy query says %d\n", per_cu); }
        (void)hipGetLastError();
        grid = cus;
    }
    if (grid < 0) return;
    if (hipMemsetAsync((char*)d_ws + WS_CTL, 0, CTL_ZERO_BYTES, stream) != hipSuccess) return;
    Args a{};
    for (int i = 0; i < 23; ++i) a.in[i] = (const float*)d_in[i];
    a.out = (float*)d_out; a.ws = (unsigned char*)d_ws;
    for (int li = 0; li < N_LAUNCHES; ++li) {
        a.ph_lo = (N_LAUNCHES == 1) ? 0 : li; a.ph_hi = (N_LAUNCHES == 1) ? NPH : li + 1; a.li = li; a.pad = 0;
        hipLaunchKernelGGL(mk_fwd, dim3(grid), dim3(NWAVES * 64), LDS_BYTES, stream, a);
    }
}
```

```cpp
#define MK_N_LAUNCHES 1
#include <hip/hip_runtime.h>
#include <hip/hip_bf16.h>
#include <cstdio>
#include <cstdint>
#include <cmath>
namespace pg8 {
#define PG8_LAS __attribute__((address_space(3)))
typedef unsigned short bf16_t;
typedef short bf16x8 __attribute__((ext_vector_type(8)));
typedef float f32x4 __attribute__((ext_vector_type(4)));
typedef unsigned u32x4 __attribute__((ext_vector_type(4)));
constexpr int BM = 256, BK = 64, HALF = 128, HTB = HALF * BK * 2  , STAGE_BYTES = 8 * HTB, NXCD = 8, WGM = 8;

__host__ __device__ __forceinline__ int lds_byte(int r, int c) { const int st = (r >> 4) * 2 + (c >> 5), rr = r & 15, cc = c & 31, ob = rr * 64 + cc * 2; return st * 1024 + (ob ^ (((ob >> 9) & 1) << 5)); }
__host__ __device__ __forceinline__ void stage_rc(int b, int& R, int& C) { const int st = b / 1024, sb = b % 1024, swz = sb ^ (((sb >> 9) & 1) << 5); R = (st >> 1) * 16 + swz / 64; C = (st & 1) * 32 + (swz % 64) / 2; }
__host__ __device__ __forceinline__ int perm32(int rho) { const int n = rho >> 4, i = rho & 15; return 8 * (i >> 2) + 4 * n + (i & 3); }

struct Unit { int pm, pn, pb; };
struct Gemm { const bf16_t* A; const bf16_t* Bt; int K; };

struct StaticOrder {
    int nM, nN, nwg, G, c;
    __host__ __device__ void init(int M, int N, int G_, int c_) { nM = M / BM; nN = N / BM; nwg = nM * nN; G = G_; c = c_; }
    __host__ __device__ bool next(int i, Unit& u) const {
        const long L = (long)i * G + c; if (L >= nwg) return false;
        int wgid = (int)L; { const int q = nwg / NXCD, r = nwg % NXCD, xcd = wgid % NXCD, off = wgid / NXCD; wgid = (xcd < r ? xcd * (q + 1) : r * (q + 1) + (xcd - r) * q) + off; }
        const int nig = WGM * nN, gid = wgid / nig, fm = gid * WGM, gsz = (nM - fm) < WGM ? (nM - fm) : WGM;
        u.pm = fm + ((wgid % nig) % gsz); u.pn = (wgid % nig) / gsz; u.pb = u.pn; return true;
    }
};

struct MoeOrder {
    int tb1, tb2, tb3, tb4, tb5, tb6, tb7, tb8;
    int nN, G, c;
    __device__ __forceinline__ void init(const unsigned* cnt, int nN_, int G_, int c_) {
        tb1 = ((int)cnt[0] + 255) >> 8; tb2 = tb1 + (((int)cnt[64] + 255) >> 8); tb3 = tb2 + (((int)cnt[128] + 255) >> 8); tb4 = tb3 + (((int)cnt[192] + 255) >> 8);
        tb5 = tb4 + (((int)cnt[256] + 255) >> 8); tb6 = tb5 + (((int)cnt[320] + 255) >> 8); tb7 = tb6 + (((int)cnt[384] + 255) >> 8); tb8 = tb7 + (((int)cnt[448] + 255) >> 8);
        nN = nN_; G = G_; c = c_;
    }
    __device__ __forceinline__ bool next(int i, Unit& u) const {
        const int L = i * G + c; const int T = L / nN; if (T >= tb8) return false;
        const int pn = L - T * nN;
        const int e = (T >= tb1) + (T >= tb2) + (T >= tb3) + (T >= tb4) + (T >= tb5) + (T >= tb6) + (T >= tb7);
        u.pm = T; u.pn = pn; u.pb = e * nN + pn; return true;
    }
};

__device__ __forceinline__ unsigned cvt_pk_bf16(float lo, float hi) { unsigned r; asm volatile("v_cvt_pk_bf16_f32 %0, %1, %2" : "=v"(r) : "v"(lo), "v"(hi)); return r; }

typedef int v4i_ __attribute__((ext_vector_type(4)));
typedef int v8i_ __attribute__((ext_vector_type(8)));
typedef unsigned u32x2 __attribute__((ext_vector_type(2)));
__device__ __forceinline__ v8i_ cat8(bf16x8 lo, bf16x8 hi) { const v4i_ a = __builtin_bit_cast(v4i_, lo), b = __builtin_bit_cast(v4i_, hi); return __builtin_shufflevector(a, b, 0, 1, 2, 3, 4, 5, 6, 7); }
__device__ __forceinline__ void mfma_f8(f32x4& acc, const v8i_& a, const v8i_& b) { asm volatile("s_nop 1\n\tv_mfma_f32_16x16x128_f8f6f4 %0, %1, %2, %0" : "+v"(acc) : "v"(a), "v"(b)); }
__device__ __forceinline__ float clamp8(float x) { return __builtin_fminf(__builtin_fmaxf(x, -448.0f), 448.0f); }
__device__ __forceinline__ unsigned pk4_fp8(float a, float b, float c, float d) { int w = 0; w = __builtin_amdgcn_cvt_pk_fp8_f32(clamp8(a), clamp8(b), w, false); w = __builtin_amdgcn_cvt_pk_fp8_f32(clamp8(c), clamp8(d), w, true); return (unsigned)w; }

struct EpiBf16 {
    static constexpr bool PERM = true;
    bf16_t* O; int ldc; float sc;
    __device__ __forceinline__ void operator()(const f32x4 (&acc)[2][2][4][2], const Unit& u, int wr, int wc, int fr, int fq) const {
        const int row0 = u.pm * BM + wr * 64 + fr; const int col0 = u.pn * BM + wc * 32 + 8 * fq;
#pragma unroll
        for (int ai = 0; ai < 2; ++ai)
#pragma unroll
            for (int m = 0; m < 4; ++m) { bf16_t* rowp = O + (size_t)(row0 + ai * HALF + m * 16) * ldc + col0;
#pragma unroll
                for (int bj = 0; bj < 2; ++bj) { const f32x4 v0 = acc[ai][bj][m][0] * sc, v1 = acc[ai][bj][m][1] * sc;
                    u32x4 w; w.x = cvt_pk_bf16(v0[0], v0[1]); w.y = cvt_pk_bf16(v0[2], v0[3]); w.z = cvt_pk_bf16(v1[0], v1[1]); w.w = cvt_pk_bf16(v1[2], v1[3]);
                    *(u32x4*)(rowp + bj * HALF) = w; } }
    }
};

struct EpiProj {
    static constexpr bool PERM = true;
    bf16_t* O; int ldc; const float* cosT; const float* sinT; float qscale;
    __device__ __forceinline__ void operator()(const f32x4 (&acc)[2][2][4][2], const Unit& u, int wr, int wc, int fr, int fq) const {
        const int row0 = u.pm * BM + wr * 64 + fr; const int col0 = u.pn * BM + wc * 32 + 8 * fq;
        if (u.pn < 4) {
            const int i0 = 16 * (wc & 1) + 4 * fq; const float sc = (u.pn < 2) ? qscale : 1.0f;
#pragma unroll
            for (int ai = 0; ai < 2; ++ai)
#pragma unroll
                for (int m = 0; m < 4; ++m) { const int row = row0 + ai * HALF + m * 16; bf16_t* rowp = O + (size_t)row * ldc + col0;
                    f32x4 c4 = *(const f32x4*)(cosT + (size_t)row * 32 + i0), s4 = *(const f32x4*)(sinT + (size_t)row * 32 + i0);
                    c4 = c4 * sc; s4 = s4 * sc;
#pragma unroll
                    for (int bj = 0; bj < 2; ++bj) { const f32x4 v0 = acc[ai][bj][m][0], v1 = acc[ai][bj][m][1];
                        const float o0 = v0[0] * c4[0] - v0[1] * s4[0], o1 = v0[1] * c4[0] + v0[0] * s4[0];
                        const float o2 = v0[2] * c4[1] - v0[3] * s4[1], o3 = v0[3] * c4[1] + v0[2] * s4[1];
                        const float o4 = v1[0] * c4[2] - v1[1] * s4[2], o5 = v1[1] * c4[2] + v1[0] * s4[2];
                        const float o6 = v1[2] * c4[3] - v1[3] * s4[3], o7 = v1[3] * c4[3] + v1[2] * s4[3];
                        u32x4 w; w.x = cvt_pk_bf16(o0, o1); w.y = cvt_pk_bf16(o2, o3); w.z = cvt_pk_bf16(o4, o5); w.w = cvt_pk_bf16(o6, o7);
                        *(u32x4*)(rowp + bj * HALF) = w; } }
        } else {
#pragma unroll
            for (int ai = 0; ai < 2; ++ai)
#pragma unroll
                for (int m = 0; m < 4; ++m) { bf16_t* rowp = O + (size_t)(row0 + ai * HALF + m * 16) * ldc + col0;
#pragma unroll
                    for (int bj = 0; bj < 2; ++bj) { const f32x4 v0 = acc[ai][bj][m][0], v1 = acc[ai][bj][m][1];
                        u32x4 w; w.x = cvt_pk_bf16(v0[0], v0[1]); w.y = cvt_pk_bf16(v0[2], v0[3]); w.z = cvt_pk_bf16(v1[0], v1[1]); w.w = cvt_pk_bf16(v1[2], v1[3]);
                        *(u32x4*)(rowp + bj * HALF) = w; } }
        }
    }
};

__device__ __forceinline__ float silu_f(float a) { return a * __builtin_amdgcn_rcpf(1.0f + __builtin_amdgcn_exp2f(-1.4426950408889634f * a)); }
struct EpiSwiglu {
    static constexpr bool PERM = true;
    bf16_t* O; int ldc;
    __device__ __forceinline__ void operator()(const f32x4 (&acc)[2][2][4][2], const Unit& u, int wr, int wc, int fr, int fq) const {
        const int row0 = u.pm * BM + wr * 64 + fr; const int col0 = u.pn * HALF + wc * 32 + 8 * fq;
#pragma unroll
        for (int ai = 0; ai < 2; ++ai)
#pragma unroll
            for (int m = 0; m < 4; ++m) { bf16_t* rowp = O + (size_t)(row0 + ai * HALF + m * 16) * ldc + col0;
                const f32x4 a0 = acc[ai][0][m][0], a1 = acc[ai][0][m][1], b0 = acc[ai][1][m][0], b1 = acc[ai][1][m][1];
                u32x4 w;
                w.x = cvt_pk_bf16(silu_f(a0[0]) * b0[0], silu_f(a0[1]) * b0[1]); w.y = cvt_pk_bf16(silu_f(a0[2]) * b0[2], silu_f(a0[3]) * b0[3]);
                w.z = cvt_pk_bf16(silu_f(a1[0]) * b1[0], silu_f(a1[1]) * b1[1]); w.w = cvt_pk_bf16(silu_f(a1[2]) * b1[2], silu_f(a1[3]) * b1[3]);
                *(u32x4*)rowp = w; }
    }
};

struct EpiSwiglu8 {
    static constexpr bool PERM = true;
    unsigned char* O; int ldc; float inscale, outscale;
    __device__ __forceinline__ void operator()(const f32x4 (&acc)[2][2][4][2], const Unit& u, int wr, int wc, int fr, int fq) const {
        const int row0 = u.pm * BM + wr * 64 + fr; const int col0 = u.pn * HALF + wc * 32 + 8 * fq; const float s2 = inscale * outscale;
#pragma unroll
        for (int ai = 0; ai < 2; ++ai)
#pragma unroll
            for (int m = 0; m < 4; ++m) { unsigned char* rowp = O + (size_t)(row0 + ai * HALF + m * 16) * ldc + col0;
                const f32x4 a0 = acc[ai][0][m][0], a1 = acc[ai][0][m][1], b0 = acc[ai][1][m][0], b1 = acc[ai][1][m][1];
                u32x2 w;
                w.x = pk4_fp8(silu_f(a0[0] * inscale) * (b0[0] * s2), silu_f(a0[1] * inscale) * (b0[1] * s2), silu_f(a0[2] * inscale) * (b0[2] * s2), silu_f(a0[3] * inscale) * (b0[3] * s2));
                w.y = pk4_fp8(silu_f(a1[0] * inscale) * (b1[0] * s2), silu_f(a1[1] * inscale) * (b1[1] * s2), silu_f(a1[2] * inscale) * (b1[2] * s2), silu_f(a1[3] * inscale) * (b1[3] * s2));
                *(u32x2*)rowp = w; __builtin_amdgcn_sched_barrier(0); }
    }
};

struct EpiResid {
    static constexpr bool PERM = false;
    const float* xin; float* out; int ldc; const float* gate; float alpha; float accscale;
    __device__ __forceinline__ void operator()(const f32x4 (&acc)[2][2][4][2], const Unit& u, int wr, int wc, int fr, int fq) const {
        const int col0 = u.pn * BM + wc * 32 + 4 * fq;
        f32x4 gv[2][2];
#pragma unroll
        for (int bj = 0; bj < 2; ++bj)
#pragma unroll
            for (int n = 0; n < 2; ++n) gv[bj][n] = (*(const f32x4*)(gate + col0 + bj * HALF + n * 16) + 1.0f) * accscale;
#pragma unroll
        for (int ai = 0; ai < 2; ++ai)
#pragma unroll
            for (int m = 0; m < 4; ++m) { const size_t off = (size_t)(u.pm * BM + ai * HALF + wr * 64 + m * 16 + fr) * ldc + col0;
#pragma unroll
                for (int bj = 0; bj < 2; ++bj)
#pragma unroll
                    for (int n = 0; n < 2; ++n) { const f32x4 x = *(const f32x4*)(xin + off + bj * HALF + n * 16);
                        *(f32x4*)(out + off + bj * HALF + n * 16) = x * alpha + gv[bj][n] * acc[ai][bj][m][n]; }
                if (m & 1) asm volatile("" ::: "memory"); }
    }
};

template <class Epi, class Sched, bool ALIGN_EPI, bool FP8 = false>
__device__ __forceinline__ void gemm_phase(PG8_LAS unsigned char* lds, const Gemm g, const Sched& S, const Epi& E, const int tid) {
    const int wid = __builtin_amdgcn_readfirstlane(tid >> 6), lane = tid & 63, wr = wid >> 2, wc = wid & 3, fr = lane & 15, fq = lane >> 4;
    const int K = g.K, nt = K / BK;
    unsigned voffA[2], voffB[2];
#pragma unroll
    for (int i = 0; i < 2; ++i) { int R, C; stage_rc(tid * 16 + i * 8192, R, C); const int Rb = Epi::PERM ? ((R & ~31) + perm32(R & 31)) : R;
        voffA[i] = (unsigned)(R * K + C) * 2u; voffB[i] = (unsigned)(Rb * K + C) * 2u; }
    const size_t kstep = (size_t)(BK * 2);
    const size_t hstep = (size_t)HALF * K * 2;
    const size_t tstep = 2 * hstep;
    const unsigned ldsw = (unsigned)wid * 1024u;
    const int fcol = FP8 ? (32 * (fq >> 1) + 16 * (fq & 1)) : fq * 8;
    const int aoff = lds_byte(wr * 64 + fr, fcol), boff = lds_byte(wc * 32 + fr, fcol);
#define PG8_SA(b, h) (((b) * 2 + (h)) * HTB)
#define PG8_SB(b, h) ((4 + (b) * 2 + (h)) * HTB)
#define PG8_STAGE(bufoff, gbase, voff) do { _Pragma("unroll") for (int _i = 0; _i < 2; ++_i) \
        __builtin_amdgcn_global_load_lds((const unsigned*)((const char*)(gbase) + (voff)[_i]), (PG8_LAS unsigned*)(lds + (bufoff) + ldsw + _i * 8192), 16, 0, 0); } while (0)
#define PG8_LDA(dst, b, h) do { if constexpr (FP8) { _Pragma("unroll") for (int m = 0; m < 4; ++m) { const v4i_ lo_ = *(const PG8_LAS v4i_*)(lds + PG8_SA(b, h) + aoff + m * 2048), hi_ = *(const PG8_LAS v4i_*)(lds + PG8_SA(b, h) + aoff + m * 2048 + 16); dst##8[m] = __builtin_shufflevector(lo_, hi_, 0, 1, 2, 3, 4, 5, 6, 7); } } \
    else { _Pragma("unroll") for (int m = 0; m < 4; ++m) _Pragma("unroll") for (int k = 0; k < 2; ++k) dst[m][k] = *(const PG8_LAS bf16x8*)(lds + PG8_SA(b, h) + aoff + m * 2048 + k * 1024); } } while (0)
#define PG8_LDB(dst, b, h) do { if constexpr (FP8) { _Pragma("unroll") for (int n = 0; n < 2; ++n) { const v4i_ lo_ = *(const PG8_LAS v4i_*)(lds + PG8_SB(b, h) + boff + n * 2048), hi_ = *(const PG8_LAS v4i_*)(lds + PG8_SB(b, h) + boff + n * 2048 + 16); dst##8[n] = __builtin_shufflevector(lo_, hi_, 0, 1, 2, 3, 4, 5, 6, 7); } } \
    else { _Pragma("unroll") for (int n = 0; n < 2; ++n) _Pragma("unroll") for (int k = 0; k < 2; ++k) dst[n][k] = *(const PG8_LAS bf16x8*)(lds + PG8_SB(b, h) + boff + n * 2048 + k * 1024); } } while (0)
#define PG8_MMA(ai, bj, At, Bt) do { __builtin_amdgcn_s_setprio(1); if constexpr (FP8) { _Pragma("unroll") for (int m = 0; m < 4; ++m) _Pragma("unroll") for (int n = 0; n < 2; ++n) \
        mfma_f8(acc[ai][bj][m][n], Bt##8[n], At##8[m]); } \
    else { _Pragma("unroll") for (int m = 0; m < 4; ++m) _Pragma("unroll") for (int n = 0; n < 2; ++n) _Pragma("unroll") for (int k = 0; k < 2; ++k) \
        acc[ai][bj][m][n] = __builtin_amdgcn_mfma_f32_16x16x32_bf16(Bt[n][k], At[m][k], acc[ai][bj][m][n], 0, 0, 0); } __builtin_amdgcn_s_setprio(0); } while (0)
#define PG8_WAIT_V(n) asm volatile("s_waitcnt vmcnt(" #n ")" ::: "memory")
#define PG8_WAIT_L(n) asm volatile("s_waitcnt lgkmcnt(" #n ")" ::: "memory")
#define PG8_BAR __builtin_amdgcn_s_barrier()
#define PG8_SCHED __builtin_amdgcn_sched_barrier(0)
    Unit cur, nxt; int ui = 0;
    if (!S.next(0, cur)) return;
    f32x4 acc[2][2][4][2];
#pragma unroll
    for (int a = 0; a < 2; ++a)
#pragma unroll
        for (int b = 0; b < 2; ++b)
#pragma unroll
            for (int m = 0; m < 4; ++m)
#pragma unroll
                for (int n = 0; n < 2; ++n) acc[a][b][m][n] = (f32x4){0.f, 0.f, 0.f, 0.f};
    bf16x8 At[4][2], B0[2][2], B1[2][2];
    v8i_ At8[4], B08[2], B18[2];
    const char* cA = (const char*)g.A + (size_t)cur.pm * tstep; const char* cB = (const char*)g.Bt + (size_t)cur.pb * tstep;
    PG8_STAGE(PG8_SB(0, 0), cB, voffB); PG8_STAGE(PG8_SB(0, 1), cB + hstep, voffB); PG8_STAGE(PG8_SA(0, 0), cA, voffA); PG8_STAGE(PG8_SA(0, 1), cA + hstep, voffA);
    if (wr == 1) PG8_BAR;
    PG8_WAIT_V(2); PG8_BAR;
    PG8_STAGE(PG8_SB(1, 0), cB + kstep, voffB); PG8_STAGE(PG8_SA(1, 0), cA + kstep, voffA); PG8_STAGE(PG8_SB(1, 1), cB + hstep + kstep, voffB);
    PG8_WAIT_V(6); PG8_BAR;
    for (;;) {
        const bool has_next = S.next(ui + 1, nxt);
        const char* nA = has_next ? (const char*)g.A + (size_t)nxt.pm * tstep : cA; const char* nB = has_next ? (const char*)g.Bt + (size_t)nxt.pb * tstep : cB;
        for (int t = 0; t < nt; t += 2) {
            const bool last = (t == nt - 2);
            const char* a1 = cA + (size_t)(t + 1) * kstep;
            const char* a2 = last ? nA : cA + (size_t)(t + 2) * kstep; const char* b2 = last ? nB : cB + (size_t)(t + 2) * kstep;
            const char* a3 = a2 + kstep; const char* b3 = b2 + kstep;
            PG8_LDB(B0, 0, 0); PG8_LDB(B1, 0, 1); PG8_SCHED; PG8_LDA(At, 0, 0); PG8_STAGE(PG8_SA(1, 1), a1 + hstep, voffA);
            PG8_WAIT_V(8); PG8_WAIT_L(0); PG8_BAR; PG8_MMA(0, 0, At, B0); PG8_MMA(0, 1, At, B1); PG8_BAR; PG8_SCHED;
            PG8_LDA(At, 0, 1); PG8_STAGE(PG8_SB(0, 0), b2, voffB); PG8_STAGE(PG8_SB(0, 1), b2 + hstep, voffB); PG8_STAGE(PG8_SA(0, 0), a2, voffA);
            PG8_WAIT_V(8); PG8_WAIT_L(0); PG8_BAR; PG8_MMA(1, 0, At, B0); PG8_MMA(1, 1, At, B1); PG8_BAR; PG8_SCHED;
            PG8_LDB(B0, 1, 0); PG8_LDB(B1, 1, 1); PG8_SCHED; PG8_LDA(At, 1, 0); PG8_STAGE(PG8_SA(0, 1), a2 + hstep, voffA);
            PG8_WAIT_V(8); PG8_WAIT_L(0); PG8_BAR; PG8_MMA(0, 0, At, B0); PG8_MMA(0, 1, At, B1); PG8_BAR; PG8_SCHED;
            PG8_LDA(At, 1, 1); PG8_STAGE(PG8_SB(1, 0), b3, voffB); PG8_STAGE(PG8_SB(1, 1), b3 + hstep, voffB); PG8_STAGE(PG8_SA(1, 0), a3, voffA);
            PG8_WAIT_V(8); PG8_WAIT_L(0); PG8_BAR; PG8_MMA(1, 0, At, B0); PG8_MMA(1, 1, At, B1); PG8_BAR; PG8_SCHED;
        }
        if constexpr (ALIGN_EPI) { if (wr == 0) PG8_BAR; }
        if constexpr (FP8) asm volatile("s_nop 15\n\ts_nop 15" ::: "memory");
        E(acc, cur, wr, wc, fr, fq);
        if (!has_next) break;
#pragma unroll
        for (int a = 0; a < 2; ++a)
#pragma unroll
            for (int b = 0; b < 2; ++b)
#pragma unroll
                for (int m = 0; m < 4; ++m)
#pragma unroll
                    for (int n = 0; n < 2; ++n) acc[a][b][m][n] = (f32x4){0.f, 0.f, 0.f, 0.f};
        cur = nxt; cA = nA; cB = nB; ++ui;
        if constexpr (ALIGN_EPI) { if (wr == 1) PG8_BAR; }
    }
    PG8_WAIT_V(0);
    if constexpr (!ALIGN_EPI) { if (wr == 0) PG8_BAR; }
    PG8_BAR;
#undef PG8_SA
#undef PG8_SB
#undef PG8_STAGE
#undef PG8_LDA
#undef PG8_LDB
#undef PG8_MMA
#undef PG8_WAIT_V
#undef PG8_WAIT_L
#undef PG8_BAR
#undef PG8_SCHED
}
}
namespace attn_body {
using bf16=__hip_bfloat16;
using bf16x8=__attribute__((ext_vector_type(8)))short;
using s16x4=__attribute__((ext_vector_type(4)))short;
using f32x16=__attribute__((ext_vector_type(16)))float;
using u32x4=__attribute__((ext_vector_type(4)))unsigned;
constexpr int SEQ=16384,D=64,PQ=2816,PO=512;
constexpr int NW=8,QBLK=32,QB=QBLK*NW,KVBLK=64,NQB=SEQ/QB;
constexpr int ATTN_UNIT_ROWS=QB;
__device__ __forceinline__ int crow(int r,int hi){return (r&3)+8*(r>>2)+4*hi;}
#define SBAR() __builtin_amdgcn_sched_barrier(0)
__device__ __forceinline__ void cmask(f32x16&p0,f32x16&p1,int jb,int qrel,int hi){
  const float NEG=-INFINITY; int kb=64*jb+4*hi;
  #pragma unroll
  for(int r=0;r<16;++r){int kv=kb+(r&3)+8*(r>>2); if(kv>qrel)p0[r]=NEG; if(kv+32>qrel)p1[r]=NEG;}
}

constexpr int NSLOT=3, SLOTB=8192;
constexpr int LDS_K=0, LDS_V=NSLOT*SLOTB, LDS_WS=2*NSLOT*SLOTB, LDS_OST=LDS_WS+NW*64*4, LDS_BYTES=LDS_OST+NW*4096;
constexpr float C2=0.125f*1.4426950408889634f;
__device__ __forceinline__ void glds16(const void*gsrc,unsigned lds_dst){unsigned keep;
  asm volatile("s_mov_b32 %0, m0\n\ts_mov_b32 m0, %2\n\ts_nop 0\n\tglobal_load_lds_dwordx4 %1, off\n\ts_mov_b32 m0, %0":"=&s"(keep):"v"(gsrc),"s"(lds_dst):"memory");}
__device__ __forceinline__ float max3f(float a,float b,float c){float r;asm("v_max3_f32 %0, %1, %2, %3":"=v"(r):"v"(a),"v"(b),"v"(c));return r;}
__device__ __forceinline__ float max2f(float a,float b){float r;asm("v_max_f32_e32 %0, %1, %2":"=v"(r):"v"(a),"v"(b));return r;}
__device__ __forceinline__ float fadd_s(float a,float b){float r;asm("v_add_f32_e32 %0, %1, %2":"=v"(r):"v"(a),"v"(b));return r;}
__device__ __forceinline__ float fsub_s(float a,float b){float r;asm("v_sub_f32_e32 %0, %1, %2":"=v"(r):"v"(a),"v"(b));return r;}
typedef float f32x2_t __attribute__((ext_vector_type(2))); typedef __bf16 bf16x2_t __attribute__((ext_vector_type(2)));
__device__ __forceinline__ unsigned cvtpk_s(float lo,float hi){f32x2_t v={lo,hi};bf16x2_t b=__builtin_convertvector(v,bf16x2_t);return __builtin_bit_cast(unsigned,b);}
#define WAIT_BAR(N) asm volatile("s_waitcnt vmcnt(" #N ") lgkmcnt(0)\n\ts_barrier":::"memory")

__device__ __forceinline__ void qkt(f32x16&p0,f32x16&p1,const char*Kslot,const bf16x8*qr,const f32x16&negm,int r32,int hi){
  const char*kb=Kslot+hi*1024+r32*16;
  #pragma unroll
  for(int d0=0;d0<4;++d0){
    const bf16x8 b0=*reinterpret_cast<const bf16x8*>(kb+d0*2048);
    const bf16x8 b1=*reinterpret_cast<const bf16x8*>(kb+d0*2048+512);
    if(d0==0){p0=__builtin_amdgcn_mfma_f32_32x32x16_bf16(b0,qr[0],negm,0,0,0);p1=__builtin_amdgcn_mfma_f32_32x32x16_bf16(b1,qr[0],negm,0,0,0);}
    else{p0=__builtin_amdgcn_mfma_f32_32x32x16_bf16(b0,qr[d0],p0,0,0,0);p1=__builtin_amdgcn_mfma_f32_32x32x16_bf16(b1,qr[d0],p1,0,0,0);}}
}
typedef __attribute__((address_space(3))) const char* lds_cptr;
typedef short v4i16_t __attribute__((ext_vector_type(4)));
__device__ __forceinline__ void kload8(bf16x8*kf,lds_cptr kp){
  kf[0]=*(const __attribute__((address_space(3))) bf16x8*)(kp);      kf[1]=*(const __attribute__((address_space(3))) bf16x8*)(kp+512);
  kf[2]=*(const __attribute__((address_space(3))) bf16x8*)(kp+2048); kf[3]=*(const __attribute__((address_space(3))) bf16x8*)(kp+2560);
  kf[4]=*(const __attribute__((address_space(3))) bf16x8*)(kp+4096); kf[5]=*(const __attribute__((address_space(3))) bf16x8*)(kp+4608);
  kf[6]=*(const __attribute__((address_space(3))) bf16x8*)(kp+6144); kf[7]=*(const __attribute__((address_space(3))) bf16x8*)(kp+6656);
}
__device__ __forceinline__ void kload2(bf16x8*kf,lds_cptr kp,int j){ kf[2*j]=*(const __attribute__((address_space(3))) bf16x8*)(kp+j*2048); kf[2*j+1]=*(const __attribute__((address_space(3))) bf16x8*)(kp+j*2048+512); }
__device__ __forceinline__ s16x4 vtr(lds_cptr p){ return __builtin_bit_cast(s16x4,__builtin_amdgcn_ds_read_tr16_b64_v4i16((__attribute__((address_space(3))) v4i16_t*)p)); }
__device__ __forceinline__ float rowmax(const f32x16&p0,const f32x16&p1){
  float a=max3f(p0[0],p0[1],p1[0]),b=max3f(p0[2],p0[3],p1[1]);a=max3f(a,p1[2],p1[3]);
  #pragma unroll
  for(int r=4;r<16;r+=4){a=max3f(a,p0[r],p0[r+1]);b=max3f(b,p0[r+2],p0[r+3]);a=max3f(a,p1[r],p1[r+1]);b=max3f(b,p1[r+2],p1[r+3]);}
  const float m=max2f(a,b);
  auto rr=__builtin_amdgcn_permlane32_swap(__float_as_uint(m),__float_as_uint(m),false,false);
  return max2f(__uint_as_float(rr[0]),__uint_as_float(rr[1]));
}
__device__ __forceinline__ void pv(f32x16*o,int vb,bf16x8 pa0,bf16x8 pa1,bf16x8 pa2,bf16x8 pa3){
  #pragma unroll
  for(int d0=0;d0<2;++d0){s16x4 lo[4],hi[4];
    #pragma unroll
    for(int ks=0;ks<4;++ks){
      asm volatile("ds_read_b64_tr_b16 %0,%1 offset:%c2":"=&v"(lo[ks]):"v"(vb),"i"(d0*4096+ks*1024):"memory");
      asm volatile("ds_read_b64_tr_b16 %0,%1 offset:%c2":"=&v"(hi[ks]):"v"(vb),"i"(d0*4096+ks*1024+512):"memory");}
    asm volatile("s_waitcnt lgkmcnt(0)":::"memory");SBAR();
    #define PK(k) (bf16x8){lo[k][0],lo[k][1],lo[k][2],lo[k][3],hi[k][0],hi[k][1],hi[k][2],hi[k][3]}
    o[d0]=__builtin_amdgcn_mfma_f32_32x32x16_bf16(pa0,PK(0),o[d0],0,0,0);
    o[d0]=__builtin_amdgcn_mfma_f32_32x32x16_bf16(pa1,PK(1),o[d0],0,0,0);
    o[d0]=__builtin_amdgcn_mfma_f32_32x32x16_bf16(pa2,PK(2),o[d0],0,0,0);
    o[d0]=__builtin_amdgcn_mfma_f32_32x32x16_bf16(pa3,PK(3),o[d0],0,0,0);
    #undef PK
  }
}

#ifndef ATTN_STORE16
#define ATTN_STORE16(p,v) (*(u32x4*)(p)=(v))
#endif
template<int THRL> __device__ __forceinline__ void attn_unit(const int tid,int qb,const bf16*Qh,const bf16*__restrict__ Kh,const bf16*__restrict__ Vh,bf16*Oh,char*shm){
  const int lane=tid&63,r32=lane&31,hi=lane>>5; const int wid=__builtin_amdgcn_readfirstlane(tid>>6);
  const int q0=qb*QB;
  const bf16*Qw=Qh+(long)(q0+wid*QBLK)*PQ;
  const unsigned lds0=(unsigned)(uintptr_t)shm;
  float*wsf=(float*)(shm+LDS_WS)+wid*64;
  const bf16*ksrc=Kh+(long)lane*PQ+wid*8;
  const bf16*vsrc=Vh+(long)(16*(wid&3)+(lane>>2))*PQ+(wid>>2)*32+(lane&3)*8;
  const unsigned kdst=lds0+LDS_K+wid*1024, vdst=lds0+LDS_V+wid*1024;
  #define DMA_K(t,slot) glds16(ksrc+(long)(t)*KVBLK*PQ,(unsigned)__builtin_amdgcn_readfirstlane(kdst+(slot)))
  #define DMA_V(t,slot) glds16(vsrc+(long)(t)*KVBLK*PQ,(unsigned)__builtin_amdgcn_readfirstlane(vdst+(slot)))
  const int vb0=(int)(lds0+LDS_V)+((lane>>4)&1)*32+(lane&3)*8+(4*hi+((lane&15)>>2))*64;
  const char*Kbase=shm+LDS_K; bf16x8 kf[8];
  const lds_cptr shm3=(lds_cptr)shm; const lds_cptr kp0=shm3+LDS_K+hi*1024+r32*16; const lds_cptr vp0=shm3+LDS_V+((lane>>4)&1)*32+(lane&3)*8+(4*hi+((lane&15)>>2))*64;
  const int NT=(q0+QB)/KVBLK;
  DMA_K(0,0);DMA_V(0,0);DMA_K(1,SLOTB);
  bf16x8 qr[4];
  #pragma unroll
  for(int d0=0;d0<4;++d0)qr[d0]=*reinterpret_cast<const bf16x8*>(&Qw[(long)r32*PQ+d0*16+hi*8]);
  float mhat=0.f,l_reg=0.f;f32x16 o[2];o[0]=f32x16{};o[1]=f32x16{};const f32x16 negm=f32x16{};
  const int qrel=wid*QBLK+r32;
  #define CMASK(P0,P1,t) do{int jb_=(t)-(NT-4); if(jb_>=0)cmask(P0,P1,jb_,qrel,hi);}while(0)
  bool resc=false;
  #define START(P0,P1) do{ const float rm=rowmax(P0,P1); resc=false; \
    { const float dl=rm; mhat=fadd_s(mhat,dl); \
      _Pragma("unroll") for(int r=0;r<16;++r){P0[r]=fsub_s(P0[r],dl);P1[r]=fsub_s(P1[r],dl);} \
      } \
    _Pragma("unroll") for(int r=0;r<16;++r)P0[r]=__builtin_amdgcn_exp2f(P0[r]); }while(0)
  #define RESC() do{ if(resc){ asm volatile("s_waitcnt lgkmcnt(0)":::"memory"); \
      _Pragma("unroll") for(int d_=0;d_<2;++d_) _Pragma("unroll") for(int r=0;r<16;++r)o[d_][r]*=wsf[crow(r,hi)]; } }while(0)
  f32x16 pA0,pA1,pB0,pB1;
  int sl_prev=0,sl_cur=0,sl_next=SLOTB;
  #define ROT() do{sl_prev=sl_cur;sl_cur=sl_next;sl_next=(sl_next==(NSLOT-1)*SLOTB)?0:sl_next+SLOTB;}while(0)
  DMA_K(2,2*SLOTB);
  WAIT_BAR(3);
  qkt(pA0,pA1,Kbase,qr,negm,r32,hi);asm volatile("s_nop 15\n\ts_nop 7":"+v"(pA0),"+v"(pA1));CMASK(pA0,pA1,0);
  START(pA0,pA1);
  _Pragma("unroll") for(int r=0;r<16;++r)pA1[r]=__builtin_amdgcn_exp2f(pA1[r]);
  WAIT_BAR(0);
  DMA_K(3,0);DMA_V(1,SLOTB);
  ROT();
  kload8(kf,kp0+sl_cur);
  WAIT_BAR(2);
  s16x4 vlo[8],vhi[8]; u32x4 pw0,pw1,pw2,pw3;
  #define PKW(P,B) cvtpk_s(P[B],P[B+1])
  #define PAF(k) __builtin_bit_cast(bf16x8,pw##k)
  #define VFR(i) (bf16x8){vlo[i][0],vlo[i][1],vlo[i][2],vlo[i][3],vhi[i][0],vhi[i][1],vhi[i][2],vhi[i][3]}
  #define PIN(x) asm volatile("":"+v"(x))
  #define MX3(a,b,c) __builtin_fmaxf(__builtin_fmaxf((a),(b)),(c))
  #define GAPA(MF,A0,A1,A2,A3,W0,W1,PW) do{ MF; sacc+=A0; sacc+=A1; sacc+=A2; sacc+=A3; PIN(sacc); W0; W1; PIN(PW); SBAR(); }while(0)
  #define EX(v) __builtin_amdgcn_exp2f(v)
  #define GAPB(MF,X,B) do{ MF; X[B]=EX(X[B]-mhat); X[B+1]=EX(X[B+1]-mhat); X[B+2]=EX(X[B+2]-mhat); X[B+3]=EX(X[B+3]-mhat); PIN(X); SBAR(); }while(0)
  #define VRD(i) do{ vlo[i]=vtr(vp_+(((i)>>2)*4096+((i)&3)*1024)); vhi[i]=vtr(vp_+(((i)>>2)*4096+((i)&3)*1024+512)); }while(0)
  #define KRD(G,j) do{ if(G){ kload2(kf,kp0+sl_next,j); SBAR(); } }while(0)
  #define STEP(C0,C1,P0,P1,t,GK,GV,GL) do{ SBAR(); \
    const lds_cptr vp_=vp0+sl_prev; \
    VRD(0); SBAR(); float sacc=(P0[0]+P0[1]); \
    GAPA(C0=__builtin_amdgcn_mfma_f32_32x32x16_bf16(kf[0],qr[0],negm,0,0,0), P0[2],P0[3],P0[4],P0[5],     pw0[0]=PKW(P0,0), pw0[1]=PKW(P0,2), pw0); \
    VRD(4); SBAR(); GAPA(C1=__builtin_amdgcn_mfma_f32_32x32x16_bf16(kf[1],qr[0],negm,0,0,0), P0[6],P0[7],P0[8],P0[9],     pw0[2]=PKW(P0,4), pw0[3]=PKW(P0,6), pw0); \
    VRD(1); SBAR(); GAPA(C0=__builtin_amdgcn_mfma_f32_32x32x16_bf16(kf[2],qr[1],C0,0,0,0),   P0[10],P0[11],P0[12],P0[13], pw1[0]=PKW(P0,8), pw1[1]=PKW(P0,10), pw1); \
    VRD(5); SBAR(); GAPA(C1=__builtin_amdgcn_mfma_f32_32x32x16_bf16(kf[3],qr[1],C1,0,0,0),   P0[14],P0[15],P1[0],P1[1],   pw1[2]=PKW(P0,12),pw1[3]=PKW(P0,14), pw1); \
    VRD(2); SBAR(); GAPA(C0=__builtin_amdgcn_mfma_f32_32x32x16_bf16(kf[4],qr[2],C0,0,0,0),   P1[2],P1[3],P1[4],P1[5],     pw2[0]=PKW(P1,0), pw2[1]=PKW(P1,2), pw2); \
    VRD(6); SBAR(); GAPA(C1=__builtin_amdgcn_mfma_f32_32x32x16_bf16(kf[5],qr[2],C1,0,0,0),   P1[6],P1[7],P1[8],P1[9],     pw2[2]=PKW(P1,4), pw2[3]=PKW(P1,6), pw2); \
    VRD(3); SBAR(); GAPA(C0=__builtin_amdgcn_mfma_f32_32x32x16_bf16(kf[6],qr[3],C0,0,0,0),   P1[10],P1[11],P1[12],P1[13], pw3[0]=PKW(P1,8), pw3[1]=PKW(P1,10), pw3); \
    VRD(7); SBAR(); GAPA(C1=__builtin_amdgcn_mfma_f32_32x32x16_bf16(kf[7],qr[3],C1,0,0,0),   P1[14],P1[15],0.f,0.f,       pw3[2]=PKW(P1,12),pw3[3]=PKW(P1,14), pw3); \
    l_reg+=sacc; \
    if(GK){DMA_K((t)+3,sl_cur);} if(GV){DMA_V((t)+1,sl_next);} \
    CMASK(C0,C1,t); \
    { float a=MX3(C0[0],C0[1],C1[0]),b=MX3(C0[2],C0[3],C1[1]); a=MX3(a,C1[2],C1[3]); \
      _Pragma("unroll") for(int r=4;r<16;r+=4){a=MX3(a,C0[r],C0[r+1]);b=MX3(b,C0[r+2],C0[r+3]);a=MX3(a,C1[r],C1[r+1]);b=MX3(b,C1[r+2],C1[r+3]);} \
      float rm=__builtin_fmaxf(a,b); { auto rr=__builtin_amdgcn_permlane32_swap(__float_as_uint(rm),__float_as_uint(rm),false,false); rm=__builtin_fmaxf(__uint_as_float(rr[0]),__uint_as_float(rr[1])); } \
      resc=false; \
      rm-=mhat; \
      if(__builtin_expect(__any(rm>(float)THRL),0)){ const float dl=__builtin_fmaxf(rm,0.f); mhat+=dl; \
        const float f=__builtin_amdgcn_exp2f(-dl); l_reg*=f; if(hi==0)wsf[r32]=f; resc=true; } } \
    SBAR(); \
    GAPB(o[0]=__builtin_amdgcn_mfma_f32_32x32x16_bf16(PAF(0),VFR(0),o[0],0,0,0), C0,0); \
    GAPB(o[1]=__builtin_amdgcn_mfma_f32_32x32x16_bf16(PAF(0),VFR(4),o[1],0,0,0), C0,4); \
    KRD(GL,0); GAPB(o[0]=__builtin_amdgcn_mfma_f32_32x32x16_bf16(PAF(1),VFR(1),o[0],0,0,0), C0,8); \
    KRD(GL,1); GAPB(o[1]=__builtin_amdgcn_mfma_f32_32x32x16_bf16(PAF(1),VFR(5),o[1],0,0,0), C0,12); \
    KRD(GL,2); GAPB(o[0]=__builtin_amdgcn_mfma_f32_32x32x16_bf16(PAF(2),VFR(2),o[0],0,0,0), C1,0); \
    KRD(GL,3); GAPB(o[1]=__builtin_amdgcn_mfma_f32_32x32x16_bf16(PAF(2),VFR(6),o[1],0,0,0), C1,4); \
    GAPB(o[0]=__builtin_amdgcn_mfma_f32_32x32x16_bf16(PAF(3),VFR(3),o[0],0,0,0), C1,8); \
    GAPB(o[1]=__builtin_amdgcn_mfma_f32_32x32x16_bf16(PAF(3),VFR(7),o[1],0,0,0), C1,12); \
    }while(0)
  int t=1;
  #undef CMASK
  #define CMASK(P0,P1,t) do{}while(0)
  for(;t+5<NT;t+=2){
    STEP(pB0,pB1,pA0,pA1,t,true,true,true);     WAIT_BAR(2); RESC(); ROT();
    STEP(pA0,pA1,pB0,pB1,t+1,true,true,true);   WAIT_BAR(2); RESC(); ROT();
  }
  #undef CMASK
  #define CMASK(P0,P1,t) do{int jb_=(t)-(NT-4); if(jb_>=0)cmask(P0,P1,jb_,qrel,hi);}while(0)
  #define ENDW(tt) do{ if((tt)+3<NT){WAIT_BAR(2);} else if((tt)+2<NT){WAIT_BAR(1);} else {WAIT_BAR(0);} }while(0)
  for(;t+1<NT;t+=2){
    STEP(pB0,pB1,pA0,pA1,t,(t+3<NT),(t+1<NT),(t+1<NT));       ENDW(t);   RESC(); ROT();
    STEP(pA0,pA1,pB0,pB1,t+1,(t+4<NT),(t+2<NT),(t+2<NT));     ENDW(t+1); RESC(); ROT();
  }
  STEP(pB0,pB1,pA0,pA1,NT-1,false,false,false); RESC();
  { float sacc=pB0[0]+pB0[1]; _Pragma("unroll") for(int r=2;r<16;++r)sacc+=pB0[r]; _Pragma("unroll") for(int r=0;r<16;++r)sacc+=pB1[r]; l_reg+=sacc;
    pw0=(u32x4){PKW(pB0,0),PKW(pB0,2),PKW(pB0,4),PKW(pB0,6)};pw1=(u32x4){PKW(pB0,8),PKW(pB0,10),PKW(pB0,12),PKW(pB0,14)};pw2=(u32x4){PKW(pB1,0),PKW(pB1,2),PKW(pB1,4),PKW(pB1,6)};pw3=(u32x4){PKW(pB1,8),PKW(pB1,10),PKW(pB1,12),PKW(pB1,14)};
    SBAR(); pv(o,vb0+sl_cur,PAF(0),PAF(1),PAF(2),PAF(3)); }
  #undef PKW
  #undef PAF
  #undef VFR
  #undef PIN
  #undef MX3
  #undef GAPA
  #undef GAPB
  #undef EX
  #undef VRD
  #undef KRD
  #undef STEP
  #undef ENDW
  {auto rr=__builtin_amdgcn_permlane32_swap(__float_as_uint(l_reg),__float_as_uint(l_reg),false,false);l_reg=__uint_as_float(rr[0])+__uint_as_float(rr[1]);}
  if(hi==0)wsf[32+r32]=l_reg;asm volatile("s_waitcnt lgkmcnt(0)":::"memory");
  float rli[16];
  #pragma unroll
  for(int r=0;r<16;++r)rli[r]=__builtin_amdgcn_rcpf(wsf[32+crow(r,hi)]);
  bf16*Ow=Oh+(long)(q0+wid*QBLK)*PO;
  { bf16*stg=(bf16*)(shm+LDS_OST)+wid*2048;
    #pragma unroll
    for(int r=0;r<16;++r){const int orow=crow(r,hi);
      #pragma unroll
      for(int d0=0;d0<2;++d0)stg[orow*64+d0*32+r32]=__float2bfloat16(o[d0][r]*rli[r]);}
    asm volatile("s_waitcnt lgkmcnt(0)":::"memory");
    #pragma unroll
    for(int i=0;i<4;++i){const int row=i*8+(lane>>3),ch=lane&7; const u32x4 v=*(const u32x4*)(stg+row*64+ch*8); ATTN_STORE16(Ow+(long)row*PO+ch*8,v);} }
  asm volatile("s_waitcnt lgkmcnt(0)\n\ts_barrier":::"memory");
  #undef DMA_K
  #undef DMA_V
  #undef CMASK
  #undef START
  #undef RESC
  #undef ROT
}
constexpr int ATTN_LDS_BYTES=LDS_BYTES;
#undef SBAR
#undef WAIT_BAR
}
namespace attn_body {
#define SBAR() __builtin_amdgcn_sched_barrier(0)
#define WAIT_BAR(N) asm volatile("s_waitcnt vmcnt(" #N ") lgkmcnt(0)\n\ts_barrier":::"memory")
constexpr int SLOTV=16384;
constexpr int L2_K=0, L2_V=NSLOT*SLOTB, L2_WS=L2_V+NSLOT*SLOTV, L2_OST=L2_WS+NW*64*4, LDS2_BYTES=L2_OST+NW*4096;
template<int THRL> __device__ __forceinline__ void attn_unit2(const int tid,int qb,const bf16*Qh,const bf16*__restrict__ Kh,const bf16*__restrict__ Vh,bf16*Oh,char*shm){
  const int lane=tid&63,r32=lane&31,hi=lane>>5; const int wid=__builtin_amdgcn_readfirstlane(tid>>6);
  const int q0=qb*QB;
  const bf16*Qw=Qh+(long)(q0+wid*QBLK)*PQ;
  const unsigned lds0=(unsigned)(uintptr_t)shm;
  float*wsf=(float*)(shm+L2_WS)+wid*64;
  const bf16*ksrc=Kh+(long)lane*PQ+wid*8;
  const bf16*vsrc=Vh+(long)(16*(wid&3)+(lane>>2))*PQ+(wid>>2)*32+(lane&3)*8;
  const unsigned kdst=lds0+L2_K+wid*1024, vdst=lds0+L2_V+wid*1024;
  #define DMA_K(t,slot) glds16(ksrc+(long)(t)*KVBLK*PQ,(unsigned)__builtin_amdgcn_readfirstlane(kdst+(slot)))
  #define DMA_V(t,slot) do{ glds16(vsrc+(long)(t)*KVBLK*PQ,(unsigned)__builtin_amdgcn_readfirstlane(vdst+2*(slot))); glds16(vsrc+64+(long)(t)*KVBLK*PQ,(unsigned)__builtin_amdgcn_readfirstlane(vdst+8192+2*(slot))); }while(0)
  const int vb0=(int)(lds0+L2_V)+((lane>>4)&1)*32+(lane&3)*8+(4*hi+((lane&15)>>2))*64;
  const char*Kbase=shm+L2_K; bf16x8 kf[8];
  const lds_cptr shm3=(lds_cptr)shm; const lds_cptr kp0=shm3+L2_K+hi*1024+r32*16; const lds_cptr vp0=shm3+L2_V+((lane>>4)&1)*32+(lane&3)*8+(4*hi+((lane&15)>>2))*64;
  const int NT=(q0+QB)/KVBLK;
  DMA_K(0,0);DMA_V(0,0);DMA_K(1,SLOTB);
  bf16x8 qr[4];
  #pragma unroll
  for(int d0=0;d0<4;++d0)qr[d0]=*reinterpret_cast<const bf16x8*>(&Qw[(long)r32*PQ+d0*16+hi*8]);
  float mhat=0.f,l_reg=0.f;f32x16 o[4];o[0]=f32x16{};o[1]=f32x16{};o[2]=f32x16{};o[3]=f32x16{};const f32x16 zc=f32x16{};
  const int qrel=wid*QBLK+r32;
  #define CMASK(P0,P1,t) do{int jb_=(t)-(NT-4); if(jb_>=0)cmask(P0,P1,jb_,qrel,hi);}while(0)
  bool resc=false;
  #define RESC() do{ if(resc){ asm volatile("s_waitcnt lgkmcnt(0)":::"memory"); \
      _Pragma("unroll") for(int d_=0;d_<4;++d_) _Pragma("unroll") for(int r=0;r<16;++r)o[d_][r]*=wsf[crow(r,hi)]; } }while(0)
  f32x16 C0,C1;
  int sl_prev=0,sl_cur=0,sl_next=SLOTB;
  #define ROT() do{sl_prev=sl_cur;sl_cur=sl_next;sl_next=(sl_next==(NSLOT-1)*SLOTB)?0:sl_next+SLOTB;}while(0)
  DMA_K(2,2*SLOTB);
  WAIT_BAR(3);
  s16x4 vlo[8],vhi[8]; u32x4 pw0,pw1,pw2,pw3; float sacc=0.f;
  #define PKW(P,B) cvtpk_s(P[B],P[B+1])
  #define PAF(k) __builtin_bit_cast(bf16x8,pw##k)
  #define VFR(i) (bf16x8){vlo[i][0],vlo[i][1],vlo[i][2],vlo[i][3],vhi[i][0],vhi[i][1],vhi[i][2],vhi[i][3]}
  #define PIN(x) asm volatile("":"+v"(x))
  #define MX3(a,b,c) __builtin_fmaxf(__builtin_fmaxf((a),(b)),(c))
  #define EX(v) __builtin_amdgcn_exp2f(v)
  qkt(C0,C1,Kbase,qr,zc,r32,hi);asm volatile("s_nop 15\n\ts_nop 7":"+v"(C0),"+v"(C1));CMASK(C0,C1,0);
  { const float rm=rowmax(C0,C1); mhat=rm;
    _Pragma("unroll") for(int r=0;r<16;++r){C0[r]=EX(C0[r]-rm);C1[r]=EX(C1[r]-rm);}
    sacc=C0[0]+C0[1]; _Pragma("unroll") for(int r=2;r<16;++r)sacc+=C0[r];
    pw0=(u32x4){PKW(C0,0),PKW(C0,2),PKW(C0,4),PKW(C0,6)};pw1=(u32x4){PKW(C0,8),PKW(C0,10),PKW(C0,12),PKW(C0,14)}; }
  WAIT_BAR(0);
  DMA_K(3,0);DMA_V(1,SLOTB);
  ROT();
  kload8(kf,kp0+sl_cur);
  WAIT_BAR(3);
  #define GAPA(MF) do{ MF; SBAR(); }while(0)
  #define GAPAF(MF,A0,A1,A2,A3,W0,W1,PW) do{ MF; sacc+=A0; sacc+=A1; sacc+=A2; sacc+=A3; PIN(sacc); W0; W1; PIN(PW); SBAR(); }while(0)
  #define EX2(X,B) do{ X[B]=EX(X[B]-mhat); X[B+1]=EX(X[B+1]-mhat); PIN(X); }while(0)
  #define VRD(i)  do{ vlo[i]=vtr(vp_+(((i)>>2)*4096+((i)&3)*1024)); vhi[i]=vtr(vp_+(((i)>>2)*4096+((i)&3)*1024+512)); }while(0)
  #define VRD2(i) do{ vlo[i]=vtr(vp_+(8192+((i)>>2)*4096+((i)&3)*1024)); vhi[i]=vtr(vp_+(8192+((i)>>2)*4096+((i)&3)*1024+512)); }while(0)
  #define KRD(G,j) do{ if(G){ kload2(kf,kp0+sl_next,j); } }while(0)
  #define ADD2(a,b) do{ sacc+=a; sacc+=b; PIN(sacc); }while(0)
  #define STEP2(t,GK,GV,GL) do{ SBAR(); \
    const lds_cptr vp_=vp0+2*sl_prev; \
    VRD(0); SBAR(); GAPAF(C0=__builtin_amdgcn_mfma_f32_32x32x16_bf16(kf[0],qr[0],zc,0,0,0), C1[0],C1[1],C1[2],C1[3],     pw2[0]=PKW(C1,0), pw2[1]=PKW(C1,2), pw2); \
    VRD(4); SBAR(); GAPAF(C0=__builtin_amdgcn_mfma_f32_32x32x16_bf16(kf[2],qr[1],C0,0,0,0), C1[4],C1[5],C1[6],C1[7],     pw2[2]=PKW(C1,4), pw2[3]=PKW(C1,6), pw2); \
    VRD(1); SBAR(); GAPAF(C0=__builtin_amdgcn_mfma_f32_32x32x16_bf16(kf[4],qr[2],C0,0,0,0), C1[8],C1[9],C1[10],C1[11],   pw3[0]=PKW(C1,8), pw3[1]=PKW(C1,10), pw3); \
    VRD(5); SBAR(); GAPAF(C0=__builtin_amdgcn_mfma_f32_32x32x16_bf16(kf[6],qr[3],C0,0,0,0), C1[12],C1[13],C1[14],C1[15], pw3[2]=PKW(C1,12),pw3[3]=PKW(C1,14), pw3); \
    l_reg+=sacc; \
    VRD(2); SBAR(); GAPA(C1=__builtin_amdgcn_mfma_f32_32x32x16_bf16(kf[1],qr[0],zc,0,0,0)); \
    VRD(6); SBAR(); GAPA(C1=__builtin_amdgcn_mfma_f32_32x32x16_bf16(kf[3],qr[1],C1,0,0,0)); \
    VRD(3); SBAR(); GAPA(C1=__builtin_amdgcn_mfma_f32_32x32x16_bf16(kf[5],qr[2],C1,0,0,0)); \
    VRD(7); SBAR(); GAPA(C1=__builtin_amdgcn_mfma_f32_32x32x16_bf16(kf[7],qr[3],C1,0,0,0)); \
    if(GK){DMA_K((t)+3,sl_cur);} if(GV){DMA_V((t)+1,sl_next);} \
    CMASK(C0,C1,t); \
    { float a=MX3(C0[0],C0[1],C1[0]),b=MX3(C0[2],C0[3],C1[1]); a=MX3(a,C1[2],C1[3]); \
      _Pragma("unroll") for(int r=4;r<16;r+=4){a=MX3(a,C0[r],C0[r+1]);b=MX3(b,C0[r+2],C0[r+3]);a=MX3(a,C1[r],C1[r+1]);b=MX3(b,C1[r+2],C1[r+3]);} \
      float rm=__builtin_fmaxf(a,b); { auto rr=__builtin_amdgcn_permlane32_swap(__float_as_uint(rm),__float_as_uint(rm),false,false); rm=__builtin_fmaxf(__uint_as_float(rr[0]),__uint_as_float(rr[1])); } \
      resc=false; rm-=mhat; \
      if(__builtin_expect(__any(rm>(float)THRL),0)){ const float dl=__builtin_fmaxf(rm,0.f); mhat+=dl; \
        const float f=__builtin_amdgcn_exp2f(-dl); l_reg*=f; if(hi==0)wsf[r32]=f; resc=true; } } \
    SBAR(); \
    o[0]=__builtin_amdgcn_mfma_f32_32x32x16_bf16(PAF(0),VFR(0),o[0],0,0,0); EX2(C0,0);  VRD2(0); SBAR(); \
    o[1]=__builtin_amdgcn_mfma_f32_32x32x16_bf16(PAF(0),VFR(4),o[1],0,0,0); EX2(C0,2);  VRD2(4); SBAR(); \
    o[0]=__builtin_amdgcn_mfma_f32_32x32x16_bf16(PAF(1),VFR(1),o[0],0,0,0); EX2(C0,4);  VRD2(1); SBAR(); \
    o[1]=__builtin_amdgcn_mfma_f32_32x32x16_bf16(PAF(1),VFR(5),o[1],0,0,0); EX2(C0,6);  VRD2(5); SBAR(); \
    o[0]=__builtin_amdgcn_mfma_f32_32x32x16_bf16(PAF(2),VFR(2),o[0],0,0,0); EX2(C0,8);  VRD2(2); SBAR(); \
    o[1]=__builtin_amdgcn_mfma_f32_32x32x16_bf16(PAF(2),VFR(6),o[1],0,0,0); EX2(C0,10); VRD2(6); SBAR(); \
    o[0]=__builtin_amdgcn_mfma_f32_32x32x16_bf16(PAF(3),VFR(3),o[0],0,0,0); EX2(C0,12); VRD2(3); SBAR(); \
    o[1]=__builtin_amdgcn_mfma_f32_32x32x16_bf16(PAF(3),VFR(7),o[1],0,0,0); EX2(C0,14); VRD2(7); SBAR(); \
    sacc=0.f; \
    o[2]=__builtin_amdgcn_mfma_f32_32x32x16_bf16(PAF(0),VFR(0),o[2],0,0,0); EX2(C1,0);  ADD2(C0[0],C0[1]);   KRD(GL,0); SBAR(); \
    o[3]=__builtin_amdgcn_mfma_f32_32x32x16_bf16(PAF(0),VFR(4),o[3],0,0,0); EX2(C1,2);  ADD2(C0[2],C0[3]);   KRD(GL,1); SBAR(); \
    o[2]=__builtin_amdgcn_mfma_f32_32x32x16_bf16(PAF(1),VFR(1),o[2],0,0,0); EX2(C1,4);  ADD2(C0[4],C0[5]);   pw0[0]=PKW(C0,0); pw0[1]=PKW(C0,2); PIN(pw0); KRD(GL,2); SBAR(); \
    o[3]=__builtin_amdgcn_mfma_f32_32x32x16_bf16(PAF(1),VFR(5),o[3],0,0,0); EX2(C1,6);  ADD2(C0[6],C0[7]);   pw0[2]=PKW(C0,4); pw0[3]=PKW(C0,6); PIN(pw0); KRD(GL,3); SBAR(); \
    o[2]=__builtin_amdgcn_mfma_f32_32x32x16_bf16(PAF(2),VFR(2),o[2],0,0,0); EX2(C1,8);  ADD2(C0[8],C0[9]);   pw1[0]=PKW(C0,8); pw1[1]=PKW(C0,10); PIN(pw1); SBAR(); \
    o[3]=__builtin_amdgcn_mfma_f32_32x32x16_bf16(PAF(2),VFR(6),o[3],0,0,0); EX2(C1,10); ADD2(C0[10],C0[11]); pw1[2]=PKW(C0,12); pw1[3]=PKW(C0,14); PIN(pw1); SBAR(); \
    o[2]=__builtin_amdgcn_mfma_f32_32x32x16_bf16(PAF(3),VFR(3),o[2],0,0,0); EX2(C1,12); ADD2(C0[12],C0[13]); SBAR(); \
    o[3]=__builtin_amdgcn_mfma_f32_32x32x16_bf16(PAF(3),VFR(7),o[3],0,0,0); EX2(C1,14); ADD2(C0[14],C0[15]); SBAR(); \
    }while(0)
  #define ENDW(tt) do{ if((tt)+3<NT){WAIT_BAR(3);} else if((tt)+2<NT){WAIT_BAR(2);} else {WAIT_BAR(0);} }while(0)
  int t=1;
  #undef CMASK
  #define CMASK(P0,P1,t) do{}while(0)
  for(;t+4<NT;++t){ STEP2(t,true,true,true); WAIT_BAR(3); RESC(); ROT(); }
  #undef CMASK
  #define CMASK(P0,P1,t) do{int jb_=(t)-(NT-4); if(jb_>=0)cmask(P0,P1,jb_,qrel,hi);}while(0)
  for(;t+1<NT;++t){ STEP2(t,(t+3<NT),(t+1<NT),(t+1<NT)); ENDW(t); RESC(); ROT(); }
  STEP2(NT-1,false,false,false); RESC();
  { _Pragma("unroll") for(int r=0;r<16;++r)sacc+=C1[r]; l_reg+=sacc;
    pw2=(u32x4){PKW(C1,0),PKW(C1,2),PKW(C1,4),PKW(C1,6)};pw3=(u32x4){PKW(C1,8),PKW(C1,10),PKW(C1,12),PKW(C1,14)}; }
  { SBAR(); const int vb=vb0+2*sl_cur;
    #pragma unroll
    for(int d0=0;d0<4;++d0){s16x4 lo[4],hi4[4];
      #pragma unroll
      for(int ks=0;ks<4;++ks){
        asm volatile("ds_read_b64_tr_b16 %0,%1 offset:%c2":"=&v"(lo[ks]):"v"(vb),"i"(d0*4096+ks*1024):"memory");
        asm volatile("ds_read_b64_tr_b16 %0,%1 offset:%c2":"=&v"(hi4[ks]):"v"(vb),"i"(d0*4096+ks*1024+512):"memory");}
      asm volatile("s_waitcnt lgkmcnt(0)":::"memory");SBAR();
      #define PK(k) (bf16x8){lo[k][0],lo[k][1],lo[k][2],lo[k][3],hi4[k][0],hi4[k][1],hi4[k][2],hi4[k][3]}
      o[d0]=__builtin_amdgcn_mfma_f32_32x32x16_bf16(PAF(0),PK(0),o[d0],0,0,0);
      o[d0]=__builtin_amdgcn_mfma_f32_32x32x16_bf16(PAF(1),PK(1),o[d0],0,0,0);
      o[d0]=__builtin_amdgcn_mfma_f32_32x32x16_bf16(PAF(2),PK(2),o[d0],0,0,0);
      o[d0]=__builtin_amdgcn_mfma_f32_32x32x16_bf16(PAF(3),PK(3),o[d0],0,0,0);
      #undef PK
    } }
  {auto rr=__builtin_amdgcn_permlane32_swap(__float_as_uint(l_reg),__float_as_uint(l_reg),false,false);l_reg=__uint_as_float(rr[0])+__uint_as_float(rr[1]);}
  if(hi==0)wsf[32+r32]=l_reg;asm volatile("s_waitcnt lgkmcnt(0)":::"memory");
  float rli[16];
  #pragma unroll
  for(int r=0;r<16;++r)rli[r]=__builtin_amdgcn_rcpf(wsf[32+crow(r,hi)]);
  bf16*Ow=Oh+(long)(q0+wid*QBLK)*PO;
  { bf16*stg=(bf16*)(shm+L2_OST)+wid*2048;
    #pragma unroll
    for(int hf=0;hf<2;++hf){
      #pragma unroll
      for(int r=0;r<16;++r){const int orow=crow(r,hi);
        #pragma unroll
        for(int d0=0;d0<2;++d0)stg[orow*64+d0*32+r32]=__float2bfloat16(o[2*hf+d0][r]*rli[r]);}
      asm volatile("s_waitcnt lgkmcnt(0)":::"memory");
      #pragma unroll
      for(int i=0;i<4;++i){const int row=i*8+(lane>>3),ch=lane&7; const u32x4 v=*(const u32x4*)(stg+row*64+ch*8); ATTN_STORE16(Ow+(long)row*PO+hf*64+ch*8,v);}
      asm volatile("s_waitcnt lgkmcnt(0)":::"memory");
    } }
  asm volatile("s_waitcnt lgkmcnt(0)\n\ts_barrier":::"memory");
  #undef DMA_K
  #undef DMA_V
  #undef CMASK
  #undef RESC
  #undef ROT
  #undef PKW
  #undef PAF
  #undef VFR
  #undef PIN
  #undef MX3
  #undef EX
  #undef GAPA
  #undef GAPAF
  #undef EX2
  #undef ADD2
  #undef VRD
  #undef VRD2
  #undef KRD
  #undef STEP2
  #undef ENDW
}
#undef SBAR
#undef WAIT_BAR
}
#define GAS __attribute__((address_space(1)))
#define LAS __attribute__((address_space(3)))
typedef unsigned short bf16;
typedef unsigned v4u __attribute__((ext_vector_type(4)));
typedef float f32x4 __attribute__((ext_vector_type(4)));
typedef short bf16x8 __attribute__((ext_vector_type(8)));
typedef GAS unsigned gu32;
typedef GAS unsigned long long gu64;
#define RLX_AGENT __ATOMIC_RELAXED, __HIP_MEMORY_SCOPE_AGENT
#define LDS_WAIT() asm volatile("s_waitcnt lgkmcnt(0)" ::: "memory")
#define VM_WAIT() asm volatile("s_waitcnt vmcnt(0)" ::: "memory")
__device__ __forceinline__ unsigned long long rt() { return __builtin_amdgcn_s_memrealtime(); }
__device__ __forceinline__ unsigned f2bf(float f) { unsigned u = __builtin_bit_cast(unsigned, f); return (u + 0x7fffu + ((u >> 16) & 1u)) >> 16; }
__device__ __forceinline__ unsigned pk2(float lo, float hi) { return f2bf(lo) | (f2bf(hi) << 16); }

#define XB_TMO      128
#define XB_XCNT(j)  (256  + 64 * (j))
#define XB_XSUB(j)  (1280 + 64 * (j))
#define XB_XGEN(j)  (2304 + 64 * (j))
#define XB_TOP      3328
#define XB_TOPGEN   3392
#define XCD_BAR_WORDS 3456
#define XB_SPIN_CAP (1u << 18)

__device__ __forceinline__ unsigned xb_ld(unsigned* p)              { return __hip_atomic_load(p, __ATOMIC_RELAXED, __HIP_MEMORY_SCOPE_AGENT); }
__device__ __forceinline__ unsigned xb_add(unsigned* p, unsigned v) { return __hip_atomic_fetch_add(p, v, __ATOMIC_RELAXED, __HIP_MEMORY_SCOPE_AGENT); }
__device__ __forceinline__ unsigned xb_xcc_id() { return (unsigned)__builtin_amdgcn_s_getreg((3 << 11) | 20) & 0xFu; }
#define XB_SPIN(cond, bar) do { unsigned _sp = 0; while (cond) { __builtin_amdgcn_s_sleep(1); \
    if ((++_sp & 255u) == 0u) { if (xb_ld(&(bar)[XB_TMO])) break; if (_sp > XB_SPIN_CAP) { atomicAdd(&(bar)[XB_TMO], 1u); break; } } } } while (0)

struct XcdBarrier {
    unsigned* bar; unsigned x;
    volatile LAS unsigned* st;
};

__device__ __forceinline__ XcdBarrier xcd_barrier_post(unsigned* bar, volatile LAS unsigned* st, const int tid) {
    XcdBarrier b; b.bar = bar; b.x = xb_xcc_id(); b.st = st;
    if (tid == 0) (void)xb_add(&bar[XB_XCNT(b.x)], 1u);
    return b;
}
__device__ __forceinline__ void xcd_barrier_complete(unsigned* bar, unsigned x, unsigned& nloc, unsigned& nx) {
    const unsigned G = gridDim.x * gridDim.y * gridDim.z;
    unsigned sum, cnt, mine, sp = 0u;
    for (;;) {
        sum = 0u; cnt = 0u; mine = 0u;
#pragma unroll
        for (unsigned j = 0; j < 16; ++j) { const unsigned c = xb_ld(&bar[XB_XCNT(j)]); sum += c; cnt += (c > 0u) ? 1u : 0u; mine = (j == x) ? c : mine; }
        if (sum == G) break;
        __builtin_amdgcn_s_sleep(1);
        if ((++sp & 255u) == 0u) { if (xb_ld(&bar[XB_TMO])) break; if (sp > XB_SPIN_CAP) { atomicAdd(&bar[XB_TMO], 1u); break; } }
    }
    nloc = mine > 0u ? mine : 1u; nx = cnt > 0u ? cnt : 1u;
}

__device__ __forceinline__ void xcd_barrier(const XcdBarrier& b, const int tid) {
    asm volatile("s_waitcnt vmcnt(0)" ::: "memory");
    __syncthreads();
    if (tid == 0) {
        unsigned* bar = b.bar;
        __builtin_amdgcn_s_waitcnt(0);
        unsigned nloc = b.st[0], nx = b.st[1];
        if (nloc == 0u) { xcd_barrier_complete(bar, b.x, nloc, nx); b.st[0] = nloc; b.st[1] = nx; }
        const unsigned old = xb_add(&bar[XB_XSUB(b.x)], 1u);
        const unsigned gen = old / nloc;
        if (old + 1u == (gen + 1u) * nloc) {
            __builtin_amdgcn_fence(__ATOMIC_RELEASE, "agent");
            asm volatile("s_waitcnt vmcnt(0)" ::: "memory");
            const unsigned og = xb_add(&bar[XB_TOP], 1u);
            const unsigned tg = og / nx;
            if (og + 1u == (tg + 1u) * nx) xb_add(&bar[XB_TOPGEN], 1u);
            else XB_SPIN(xb_ld(&bar[XB_TOPGEN]) == tg, bar);
            __builtin_amdgcn_fence(__ATOMIC_ACQUIRE, "agent");
            xb_add(&bar[XB_XGEN(b.x)], 1u);
            asm volatile("s_waitcnt vmcnt(0)" ::: "memory");
        } else {
            XB_SPIN(xb_ld(&bar[XB_XGEN(b.x)]) == gen, bar);
            __builtin_amdgcn_fence(__ATOMIC_ACQUIRE, "agent");
            asm volatile("s_waitcnt vmcnt(0)" ::: "memory");
        }
    }
    __syncthreads();
}
constexpr int NWAVES = 8;
#ifndef MK_N_LAUNCHES
#define MK_N_LAUNCHES 1
#endif
constexpr int NPH_LAYER = 11, NPH = 2 + 2 * NPH_LAYER;
constexpr int N_LAUNCHES = MK_N_LAUNCHES;
static_assert(N_LAUNCHES == 1 || N_LAUNCHES == NPH, "MK_N_LAUNCHES is 1 or NPH");

constexpr int SEQ = 16384, DMODEL = 1024, DIN = 2816, FFD = 2816, NEXP = 8, EDIM = 3584, DEPTH = 2;
constexpr int M = SEQ;
constexpr float LN_EPS = 1e-5f;
constexpr float ALPHA = 1.4142135623730951f;
constexpr int MAXSLOT = 135 * 256;
#ifndef FP8_DENSE
#define FP8_DENSE 0
#endif
#ifndef FP8_MOE
#define FP8_MOE 1
#endif
constexpr float SA_H = 16.0f, SW_UP = 256.0f, S_HID = 8.0f, SW_DN = 512.0f, UP_DESCALE = 1.0f / (16.0f * 256.0f), DN_DESCALE = 1.0f / (8.0f * 512.0f);

constexpr size_t MiB = 1u << 20;
constexpr size_t WS_CTL = 0, CTL_ZERO_BYTES = 1 * MiB;
constexpr size_t WS_SMALL = 1 * MiB;
constexpr size_t SM_MOD = 0, SM_LBS = 49152, SM_LAM = 51200, SM_TOK = 65536, SM_PERM = 327680;
constexpr size_t WS_ROPE = 2 * MiB;
constexpr size_t WS_EXP13 = 6 * MiB, WS_EXP2 = 118 * MiB;
constexpr size_t WS_HPERM = 174 * MiB;
constexpr size_t WS_YSLOT = 174 * MiB;
constexpr size_t WS_HID = 242 * MiB;
constexpr size_t WS_PROJ = 242 * MiB, WS_DHID = 242 * MiB;
constexpr size_t WS_ATTNO = 330 * MiB, WS_HBUF = 330 * MiB;
constexpr size_t WS_MIX = 362 * MiB, WS_HGS = 394 * MiB, WS_HGD = 410 * MiB;
constexpr size_t WS_WIN = 411 * MiB, WS_WOUT = 422 * MiB, WS_FFN13 = 426 * MiB, WS_FFN2 = 437 * MiB;
constexpr size_t WS_END = 479 * MiB;
static_assert(WS_YSLOT + (size_t)MAXSLOT * 1024 * 2 <= WS_HID && WS_HID + (size_t)MAXSLOT * 3584 * 2 <= WS_END && WS_FFN2 + (size_t)1024 * 2816 * 2 <= WS_END, "d_ws map");
constexpr int CW_TMO = 0, CW_CODE = 1;
constexpr int CW_CNT = 64;
constexpr int CW_BAR = 4096;

constexpr int RING_OFF = 0, RING_BYTES = 131072;
constexpr int LDSCTL_OFF = RING_BYTES, MISC_OFF = LDSCTL_OFF + 320;
constexpr int XTRA_OFF = LDSCTL_OFF + 1024;
constexpr int LDS_BYTES = 147456;

__device__ __forceinline__ float bf2f(unsigned short b) { return __uint_as_float((unsigned)b << 16); }
template <int O> __device__ __forceinline__ float swzx(float v) { return __int_as_float(__builtin_amdgcn_ds_swizzle(__float_as_int(v), (O << 10) | 0x1f)); }
__device__ __forceinline__ float wave_sum(float v) {
    v += swzx<1>(v); v += swzx<2>(v); v += swzx<4>(v); v += swzx<8>(v); v += swzx<16>(v);
    auto rr = __builtin_amdgcn_permlane32_swap(__float_as_uint(v), __float_as_uint(v), false, false);
    return __uint_as_float(rr[0]) + __uint_as_float(rr[1]);
}
__device__ __forceinline__ float sigmoid_f(float z) { return __builtin_amdgcn_rcpf(1.0f + __builtin_amdgcn_exp2f(-1.4426950408889634f * z)); }
__device__ __forceinline__ float silu_ff(float a) { return a * sigmoid_f(a); }

struct Args { const float* in[23]; float* out; unsigned char* ws; int ph_lo, ph_hi, li, pad; };
enum { I_X = 0, I_C, I_WADA, I_BADA, I_WIN, I_LAMQK, I_ATTNG, I_HGLB, I_HGG, I_POOLW, I_POOLS, I_WOUT, I_LN1G, I_LN1B, I_LN2G, I_LN2B, I_FW1, I_FW3, I_FW2, I_RW, I_EW1, I_EW3, I_EW2 };

struct Frame {
    LAS unsigned char* lds; volatile LAS unsigned* MISC; gu32* ctl; unsigned char* ws;
    int tid, lane, wave, vcu, G, bid;
};

__device__ const float kInvFreq[32] = {1.f, 0.749894202f, 0.562341332f, 0.421696514f, 0.316227764f, 0.237137392f, 0.177827939f, 0.133352146f, 0.100000001f, 0.0749894157f, 0.0562341288f, 0.0421696492f,
    0.0316227786f, 0.0237137359f, 0.0177827943f, 0.0133352149f, 0.00999999978f, 0.00749894232f, 0.00562341325f, 0.00421696482f, 0.00316227786f, 0.00237137382f, 0.00177827943f, 0.00133352145f,
    0.00100000005f, 0.000749894185f, 0.000562341302f, 0.000421696546f, 0.000316227786f, 0.000237137385f, 0.00017782794f, 0.00013335215f};

template <int KIND> __device__ __forceinline__ int rowmap(int n) {
    if (KIND == 0) { if (n >= 1024) return n; const int d = n & 63; return (n & ~63) + ((d < 32) ? 2 * d : 2 * (d - 32) + 1); }
    if (KIND == 2) return ((n >> 7) << 8) + (n & 127);
    if (KIND == 3) return ((n >> 7) << 8) + 128 + (n & 127);
    return n;
}
template <int KIND> __device__ __forceinline__ void transpose_item(const float* W_, int K, int N, bf16* WT, LAS float* scr, int item, int lane) {
    const GAS float* W = (const GAS float*)W_;
    const int nblk = N / 32, kb = item / nblk, nb = item % nblk, k0 = 64 * kb, n0 = 32 * nb;
#pragma unroll 8
    for (int i = 0; i < 32; ++i) { const int kk = 2 * i + (lane >> 5); scr[kk * 33 + (lane & 31)] = W[(size_t)(k0 + kk) * N + n0 + (lane & 31)]; }
    LDS_WAIT(); asm volatile("" ::: "memory");
    const int c = lane & 7;
#pragma unroll
    for (int j = 0; j < 4; ++j) { const int n = (lane >> 3) + 8 * j; const LAS float* s = scr + (8 * c) * 33 + n;
        v4u o; o.x = pk2(s[0 * 33], s[1 * 33]); o.y = pk2(s[2 * 33], s[3 * 33]); o.z = pk2(s[4 * 33], s[5 * 33]); o.w = pk2(s[6 * 33], s[7 * 33]);
        *(GAS v4u*)(WT + (size_t)rowmap<KIND>(n0 + n) * K + k0 + 8 * c) = o; }
    LDS_WAIT(); asm volatile("" ::: "memory");
}
template <int KIND> __device__ __forceinline__ void transpose_item8(const float* W_, int K, int N, unsigned char* WT, LAS float* scr, int item, int lane, float scale) {
    const GAS float* W = (const GAS float*)W_;
    const int nblk = N / 32, kb = item / nblk, nb = item % nblk, k0 = 64 * kb, n0 = 32 * nb;
#pragma unroll 8
    for (int i = 0; i < 32; ++i) { const int kk = 2 * i + (lane >> 5); scr[kk * 33 + (lane & 31)] = W[(size_t)(k0 + kk) * N + n0 + (lane & 31)]; }
    LDS_WAIT(); asm volatile("" ::: "memory");
    const int c = lane & 7;
#pragma unroll
    for (int j = 0; j < 4; ++j) { const int n = (lane >> 3) + 8 * j; const LAS float* s = scr + (8 * c) * 33 + n;
        pg8::u32x2 o; o.x = pg8::pk4_fp8(s[0 * 33] * scale, s[1 * 33] * scale, s[2 * 33] * scale, s[3 * 33] * scale); o.y = pg8::pk4_fp8(s[4 * 33] * scale, s[5 * 33] * scale, s[6 * 33] * scale, s[7 * 33] * scale);
        *(GAS pg8::u32x2*)(WT + (size_t)rowmap<KIND>(n0 + n) * K + k0 + 8 * c) = o; }
    LDS_WAIT(); asm volatile("" ::: "memory");
}
__device__ __forceinline__ void sincos_acc(float ang, float& s, float& c) {
    const double a = (double)ang; const double n = __builtin_rint(a * 0.63661977236758134308);
    double r = __builtin_fma(-n, 1.57079632679489655800, a); r = __builtin_fma(-n, 6.12323399573676603587e-17, r);
    const double r2 = r * r;
    double sp = -1.0 / 1307674368000.0; sp = sp * r2 + 1.0 / 6227020800.0; sp = sp * r2 - 1.0 / 39916800.0; sp = sp * r2 + 1.0 / 362880.0; sp = sp * r2 - 1.0 / 5040.0; sp = sp * r2 + 1.0 / 120.0; sp = sp * r2 - 1.0 / 6.0;
    const double sr = r + r * r2 * sp;
    double cp = 1.0 / 20922789888000.0; cp = cp * r2 - 1.0 / 87178291200.0; cp = cp * r2 + 1.0 / 479001600.0; cp = cp * r2 - 1.0 / 3628800.0; cp = cp * r2 + 1.0 / 40320.0; cp = cp * r2 - 1.0 / 720.0; cp = cp * r2 + 1.0 / 24.0; cp = cp * r2 - 0.5;
    const double cr = 1.0 + r2 * cp;
    const int q = ((int)n) & 3;
    const double ss = (q == 0) ? sr : (q == 1) ? cr : (q == 2) ? -sr : -cr;
    const double cc = (q == 0) ? cr : (q == 1) ? -sr : (q == 2) ? -cr : sr;
    s = (float)ss; c = (float)cc;
}
__device__ __forceinline__ void p0a_prologue(Frame& F, const Args& A) {
    const int gw = F.vcu * NWAVES + F.wave, NGW = F.G * NWAVES;
    {
        LAS float* red = (LAS float*)(F.lds + XTRA_OFF);
        for (int cb = F.bid; cb < 256; cb += F.G) {
            const int fc = cb * 48 + F.lane; const int l = fc / 6144, j = fc % 6144; float acc = 0.f;
            if (F.lane < 48) {
                const float* w = A.in[I_WADA] + (size_t)l * 1024 * 6144 + j; const float* c = A.in[I_C];
#pragma unroll 8
                for (int k = F.wave * 128; k < F.wave * 128 + 128; ++k) acc += silu_ff(c[k]) * w[(size_t)k * 6144];
            }
            red[F.wave * 64 + F.lane] = acc;
            __syncthreads();
            if (F.wave == 0 && F.lane < 48) { float s = 0.f;
#pragma unroll
                for (int w8 = 0; w8 < 8; ++w8) s += red[w8 * 64 + F.lane];
                ((float*)(F.ws + WS_SMALL + SM_MOD))[fc] = s + A.in[I_BADA][fc]; }
            __syncthreads();
        }
    }
    {
        float* cosT = (float*)(F.ws + WS_ROPE); float* sinT = cosT + (size_t)SEQ * 32;
        for (int idx = F.bid * (NWAVES * 64) + F.tid; idx < SEQ * 32; idx += F.G * NWAVES * 64) {
            const int pos = idx >> 5, i = idx & 31; const float ang = (float)pos * kInvFreq[i]; float s, c; sincos_acc(ang, s, c);
            cosT[idx] = c; sinT[idx] = s; }
    }
    if (F.bid == 0) {
        float* lbs = (float*)(F.ws + WS_SMALL + SM_LBS); float* lam = (float*)(F.ws + WS_SMALL + SM_LAM);
        if (F.tid < 256) { const float a0 = A.in[I_HGLB][F.tid], a1 = A.in[I_HGLB][256 + F.tid]; const float mx = fmaxf(a0, a1); const float e0 = __expf(a0 - mx), e1 = __expf(a1 - mx);
            lbs[F.tid] = 0.f; lbs[256 + F.tid] = e1 / (e0 + e1); }
        if (F.tid >= 256 && F.tid < 258) { const int l = F.tid - 256; const float* q = A.in[I_LAMQK] + l * 256; float s1 = 0.f, s2 = 0.f;
            for (int j = 0; j < 64; ++j) { s1 += q[j] * q[64 + j]; s2 += q[128 + j] * q[192 + j]; }
            const float li = 0.8f - 0.6f * expf(-0.3f * (float)l); lam[l] = expf(s1) - expf(s2) + li; lam[2 + l] = li; }
    }
    LAS float* scr = (LAS float*)(F.lds + RING_OFF + F.wave * 16384);
    constexpr int I_WI = 16 * 88, I_WO = 16 * 32, I_F13 = 16 * 88, I_F2 = 44 * 32, I_E13 = 16 * 112, I_E2 = 56 * 32;
    constexpr int NITEMS = 2 * I_WI + 2 * I_WO + 2 * I_F13 + I_F2 + 16 * I_E13 + 8 * I_E2;
    for (int it = gw; it < NITEMS; it += NGW) {
        int r = it;
        if (r < 2 * I_WI) { const int l = r / I_WI; transpose_item<0>(A.in[I_WIN] + (size_t)l * 1024 * DIN, 1024, DIN, (bf16*)(F.ws + WS_WIN) + (size_t)l * DIN * 1024, scr, r % I_WI, F.lane); continue; } r -= 2 * I_WI;
        if (r < 2 * I_WO) { const int l = r / I_WO; transpose_item<1>(A.in[I_WOUT] + (size_t)l * 1024 * 1024, 1024, 1024, (bf16*)(F.ws + WS_WOUT) + (size_t)l * 1024 * 1024, scr, r % I_WO, F.lane); continue; } r -= 2 * I_WO;
#if FP8_DENSE
        if (r < I_F13) { transpose_item8<2>(A.in[I_FW1], 1024, FFD, F.ws + WS_FFN13, scr, r, F.lane, SW_UP); continue; } r -= I_F13;
        if (r < I_F13) { transpose_item8<3>(A.in[I_FW3], 1024, FFD, F.ws + WS_FFN13, scr, r, F.lane, SW_UP); continue; } r -= I_F13;
        if (r < I_F2) { transpose_item8<1>(A.in[I_FW2], FFD, 1024, F.ws + WS_FFN2, scr, r, F.lane, SW_DN); continue; } r -= I_F2;
#else
        if (r < I_F13) { transpose_item<2>(A.in[I_FW1], 1024, FFD, (bf16*)(F.ws + WS_FFN13), scr, r, F.lane); continue; } r -= I_F13;
        if (r < I_F13) { transpose_item<3>(A.in[I_FW3], 1024, FFD, (bf16*)(F.ws + WS_FFN13), scr, r, F.lane); continue; } r -= I_F13;
        if (r < I_F2) { transpose_item<1>(A.in[I_FW2], FFD, 1024, (bf16*)(F.ws + WS_FFN2), scr, r, F.lane); continue; } r -= I_F2;
#endif
#if FP8_MOE
        if (r < 8 * I_E13) { const int e = r / I_E13; transpose_item8<2>(A.in[I_EW1] + (size_t)e * 1024 * EDIM, 1024, EDIM, F.ws + WS_EXP13 + (size_t)e * 2 * EDIM * 1024, scr, r % I_E13, F.lane, SW_UP); continue; } r -= 8 * I_E13;
        if (r < 8 * I_E13) { const int e = r / I_E13; transpose_item8<3>(A.in[I_EW3] + (size_t)e * 1024 * EDIM, 1024, EDIM, F.ws + WS_EXP13 + (size_t)e * 2 * EDIM * 1024, scr, r % I_E13, F.lane, SW_UP); continue; } r -= 8 * I_E13;
        { const int e = r / I_E2; transpose_item8<1>(A.in[I_EW2] + (size_t)e * EDIM * 1024, EDIM, 1024, F.ws + WS_EXP2 + (size_t)e * 1024 * EDIM, scr, r % I_E2, F.lane, SW_DN); }
#else
        if (r < 8 * I_E13) { const int e = r / I_E13; transpose_item<2>(A.in[I_EW1] + (size_t)e * 1024 * EDIM, 1024, EDIM, (bf16*)(F.ws + WS_EXP13) + (size_t)e * 2 * EDIM * 1024, scr, r % I_E13, F.lane); continue; } r -= 8 * I_E13;
        if (r < 8 * I_E13) { const int e = r / I_E13; transpose_item<3>(A.in[I_EW3] + (size_t)e * 1024 * EDIM, 1024, EDIM, (bf16*)(F.ws + WS_EXP13) + (size_t)e * 2 * EDIM * 1024, scr, r % I_E13, F.lane); continue; } r -= 8 * I_E13;
        { const int e = r / I_E2; transpose_item<1>(A.in[I_EW2] + (size_t)e * EDIM * 1024, EDIM, 1024, (bf16*)(F.ws + WS_EXP2) + (size_t)e * 1024 * EDIM, scr, r % I_E2, F.lane); }
#endif
    }
}

__device__ __forceinline__ void load4(f32x4 (&v)[4], const float* p, int lane) { const GAS f32x4* q = (const GAS f32x4*)p + lane;
#pragma unroll
    for (int j = 0; j < 4; ++j) v[j] = q[64 * j]; }
__device__ __forceinline__ void store_bf16_row(bf16* orow, const f32x4 (&v)[4], int lane) {
    GAS unsigned long long* o8 = (GAS unsigned long long*)orow + lane;
#pragma unroll
    for (int j = 0; j < 4; ++j) o8[64 * j] = (unsigned long long)pk2(v[j].x, v[j].y) | ((unsigned long long)pk2(v[j].z, v[j].w) << 32);
}
__device__ __forceinline__ void store_f32_row(float* orow, const f32x4 (&v)[4], int lane) { GAS f32x4* o = (GAS f32x4*)orow + lane;
#pragma unroll
    for (int j = 0; j < 4; ++j) o[64 * j] = v[j]; }
__device__ __forceinline__ void store_fp8_row(unsigned char* orow, const f32x4 (&v)[4], int lane, float scale) {
    GAS unsigned* o4 = (GAS unsigned*)orow + lane;
#pragma unroll
    for (int j = 0; j < 4; ++j) o4[64 * j] = pg8::pk4_fp8(v[j].x * scale, v[j].y * scale, v[j].z * scale, v[j].w * scale);
}
__device__ __forceinline__ void ln_row(f32x4 (&v)[4], const f32x4 (&g)[4], const f32x4 (&b)[4]) {
    float s = 0.f;
#pragma unroll
    for (int j = 0; j < 4; ++j) s += (v[j].x + v[j].y) + (v[j].z + v[j].w);
    const float mean = wave_sum(s) * (1.f / DMODEL); float s2 = 0.f;
#pragma unroll
    for (int j = 0; j < 4; ++j) { v[j] = v[j] - mean; s2 += (v[j].x * v[j].x + v[j].y * v[j].y) + (v[j].z * v[j].z + v[j].w * v[j].w); }
    const float rstd = 1.f / sqrtf(wave_sum(s2) * (1.f / DMODEL) + LN_EPS);
#pragma unroll
    for (int j = 0; j < 4; ++j) v[j] = v[j] * rstd * g[j] + b[j];
}
__device__ __forceinline__ void p_modulate(Frame& F, const float* x, const float* mod  , bf16* H) {
    const int gw = F.vcu * NWAVES + F.wave, NGW = F.G * NWAVES;
    f32x4 sh[4], sc[4]; load4(sh, mod, F.lane); load4(sc, mod + 1024, F.lane);
    f32x4 nv[4]; if (gw < M) load4(nv, x + (size_t)gw * DMODEL, F.lane);
    for (int m = gw; m < M; m += NGW) { f32x4 v[4];
#pragma unroll
        for (int j = 0; j < 4; ++j) v[j] = nv[j];
        if (m + NGW < M) load4(nv, x + (size_t)(m + NGW) * DMODEL, F.lane);
#pragma unroll
        for (int j = 0; j < 4; ++j) v[j] = v[j] * (sc[j] + 1.0f) + sh[j];
        store_bf16_row(H + (size_t)m * DMODEL, v, F.lane); }
}
template <bool ROUTE, bool H8> __device__ __forceinline__ void p_ln(Frame& F, float* xio, const float* lg, const float* lb, const float* mod, bf16* H, const float* rw) {
    const int gw = F.vcu * NWAVES + F.wave, NGW = F.G * NWAVES;
    f32x4 g[4], b[4], sh[4], sc[4]; load4(g, lg, F.lane); load4(b, lb, F.lane);
    if (mod) { load4(sh, mod, F.lane); load4(sc, mod + 1024, F.lane); }
    LAS float* rwT = (LAS float*)(F.lds + RING_OFF);
    LAS int* lcnt = (LAS int*)(F.lds + RING_OFF + 32768);
    LAS int* rinfo = (LAS int*)(F.lds + RING_OFF + 32768 + 256) + F.wave * 64;
    if (ROUTE) {
        for (int i = F.tid; i < 8192; i += NWAVES * 64) { const int k = i >> 3, e = i & 7; rwT[e * 1024 + k] = rw[i]; }
        if (F.tid < 16) lcnt[F.tid] = 0;
        __syncthreads();
    }
    int nr = 0;
    f32x4 nv[4]; if (gw < M) load4(nv, xio + (size_t)gw * DMODEL, F.lane);
    for (int m = gw; m < M; m += NGW) { f32x4 v[4];
#pragma unroll
        for (int j = 0; j < 4; ++j) v[j] = nv[j];
        if (m + NGW < M) load4(nv, xio + (size_t)(m + NGW) * DMODEL, F.lane);
        ln_row(v, g, b);
        store_f32_row(xio + (size_t)m * DMODEL, v, F.lane);
        if (mod) {
#pragma unroll
            for (int j = 0; j < 4; ++j) v[j] = v[j] * (sc[j] + 1.0f) + sh[j];
            if (H8) store_fp8_row((unsigned char*)H + (size_t)m * DMODEL, v, F.lane, SA_H); else store_bf16_row(H + (size_t)m * DMODEL, v, F.lane);
        }
        if (ROUTE) {
            float lgt[8];
#pragma unroll
            for (int e = 0; e < 8; ++e) { float s = 0.f;
#pragma unroll
                for (int j = 0; j < 4; ++j) { const f32x4 w = *(const LAS f32x4*)(rwT + e * 1024 + 256 * j + 4 * F.lane); s += (v[j].x * w.x + v[j].y * w.y) + (v[j].z * w.z + v[j].w * w.w); }
                lgt[e] = wave_sum(s); }
            int e0 = 0; float v0 = lgt[0];
#pragma unroll
            for (int e = 1; e < 8; ++e) if (lgt[e] > v0) { v0 = lgt[e]; e0 = e; }
            int e1 = -1; float v1 = -INFINITY;
#pragma unroll
            for (int e = 0; e < 8; ++e) if (e != e0 && (e1 < 0 || lgt[e] > v1)) { v1 = lgt[e]; e1 = e; }
            const float g0 = 1.0f / (1.0f + __expf(v1 - v0));
            if (F.lane == 0) { const int p0 = atomicAdd((int*)&lcnt[e0], 1), p1 = atomicAdd((int*)&lcnt[e1], 1);
                rinfo[nr * 8 + 0] = m; rinfo[nr * 8 + 1] = e0; rinfo[nr * 8 + 2] = e1; rinfo[nr * 8 + 3] = p0; rinfo[nr * 8 + 4] = p1; rinfo[nr * 8 + 5] = __float_as_int(g0); }
            ++nr;
        }
    }
    if (ROUTE) {
        __syncthreads();
        if (F.tid < 8) lcnt[8 + F.tid] = (int)__hip_atomic_fetch_add((unsigned*)(F.ctl + CW_CNT + 64 * F.tid), (unsigned)lcnt[F.tid], __ATOMIC_RELAXED, __HIP_MEMORY_SCOPE_AGENT);
        __syncthreads();
        int* perm = (int*)(F.ws + WS_SMALL + SM_PERM); int* tok = (int*)(F.ws + WS_SMALL + SM_TOK);
        if (F.lane == 0) for (int i = 0; i < nr; ++i) { const int m = rinfo[i * 8 + 0], e0 = rinfo[i * 8 + 1], e1 = rinfo[i * 8 + 2];
            const int p0 = lcnt[8 + e0] + rinfo[i * 8 + 3], p1 = lcnt[8 + e1] + rinfo[i * 8 + 4];
            perm[e0 * SEQ + p0] = m; perm[e1 * SEQ + p1] = m;
            tok[m * 4 + 0] = e0 | (e1 << 8); tok[m * 4 + 1] = p0; tok[m * 4 + 2] = p1; tok[m * 4 + 3] = rinfo[i * 8 + 5]; }
    }
}
__device__ __forceinline__ void p_ln_moe(Frame& F, float* xio, const float* lg, const float* lb, const float* g2v) {
    const int gw = F.vcu * NWAVES + F.wave, NGW = F.G * NWAVES;
    f32x4 g[4], b[4], gg[4]; load4(g, lg, F.lane); load4(b, lb, F.lane); load4(gg, g2v, F.lane);
    int tb[8]; { int acc = 0;
#pragma unroll
        for (int e = 0; e < 8; ++e) { tb[e] = acc; acc += ((int)__hip_atomic_load(F.ctl + CW_CNT + 64 * e, RLX_AGENT) + 255) >> 8; } }
    const int* tok = (const int*)(F.ws + WS_SMALL + SM_TOK); const bf16* Y = (const bf16*)(F.ws + WS_YSLOT);
    for (int m = gw; m < M; m += NGW) {
        const int ee = tok[m * 4 + 0], p0 = tok[m * 4 + 1], p1 = tok[m * 4 + 2]; const float g0 = __int_as_float(tok[m * 4 + 3]), g1 = 1.0f - g0;
        const int e0 = ee & 255, e1 = ee >> 8; int t0 = 0, t1 = 0;
#pragma unroll
        for (int e = 0; e < 8; ++e) { t0 = (e0 == e) ? tb[e] : t0; t1 = (e1 == e) ? tb[e] : t1; }
        const size_t s0 = (size_t)(t0 * 256 + p0), s1 = (size_t)(t1 * 256 + p1);
        f32x4 v[4]; load4(v, xio + (size_t)m * DMODEL, F.lane);
        const GAS unsigned long long* y0 = (const GAS unsigned long long*)(Y + s0 * DMODEL) + F.lane; const GAS unsigned long long* y1 = (const GAS unsigned long long*)(Y + s1 * DMODEL) + F.lane;
#pragma unroll
        for (int j = 0; j < 4; ++j) { const unsigned long long a = y0[64 * j], c = y1[64 * j];
            f32x4 f; f.x = g0 * bf2f((unsigned short)a) + g1 * bf2f((unsigned short)c); f.y = g0 * bf2f((unsigned short)(a >> 16)) + g1 * bf2f((unsigned short)(c >> 16));
            f.z = g0 * bf2f((unsigned short)(a >> 32)) + g1 * bf2f((unsigned short)(c >> 32)); f.w = g0 * bf2f((unsigned short)(a >> 48)) + g1 * bf2f((unsigned short)(c >> 48));
            v[j] = v[j] * ALPHA + (gg[j] + 1.0f) * f; }
        ln_row(v, g, b);
        store_f32_row(xio + (size_t)m * DMODEL, v, F.lane);
    }
}

__device__ __forceinline__ void hg_pass1(Frame& F, int l) {
    const bf16* P = (const bf16*)(F.ws + WS_PROJ); const float* lbs = (const float*)(F.ws + WS_SMALL + SM_LBS) + l * 256;
    float* HGS = (float*)(F.ws + WS_HGS); float* HGD = (float*)(F.ws + WS_HGD);
    LAS float* fk = (LAS float*)(F.lds + RING_OFF + F.wave * 16384);
    LAS float* vl = fk + 1024;
    const int kh = F.wave & 1;
    for (int tk = F.bid * 4 + (F.wave >> 1); tk < 1024; tk += F.G * 4) {
        const int c = tk >> 2, h = tk & 3;
        float S[32];
#pragma unroll
        for (int k = 0; k < 32; ++k) S[k] = 0.f;
        float dp = 1.f;
        for (int sb = 0; sb < 4; ++sb) {
            const int row0 = c * 64 + sb * 16;
#pragma unroll
            for (int j = 0; j < 8; ++j) { const int p = j * 64 + F.lane, tt = p >> 5, kk = p & 31, k = h * 64 + kh * 32 + kk;
                const float z = bf2f(P[(size_t)(row0 + tt) * DIN + 1792 + k]); const float lbv = lbs[k];
                const float f = lbv + (1.0f - lbv) * sigmoid_f(z), key = (1.0f - lbv) * sigmoid_f(-z);
                fk[(tt * 32 + kk) * 2] = f; fk[(tt * 32 + kk) * 2 + 1] = key; }
#pragma unroll
            for (int tt = 0; tt < 16; ++tt) vl[tt * 64 + F.lane] = silu_ff(bf2f(P[(size_t)(row0 + tt) * DIN + 2048 + h * 64 + F.lane]));
            for (int tt = 0; tt < 16; ++tt) {
                const float v = vl[tt * 64 + F.lane];
#pragma unroll
                for (int kk = 0; kk < 32; kk += 2) { const f32x4 q = *(const LAS f32x4*)(fk + (tt * 32 + kk) * 2);
                    S[kk] = q.x * S[kk] + q.y * v; S[kk + 1] = q.z * S[kk + 1] + q.w * v; }
            }
            if (F.lane < 32) {
#pragma unroll
                for (int tt = 0; tt < 16; ++tt) dp *= fk[(tt * 32 + F.lane) * 2]; }
        }
        float* Lp = HGS + ((size_t)(c * 4 + h) * 64 + kh * 32) * 64 + F.lane;
#pragma unroll
        for (int k = 0; k < 32; ++k) Lp[k * 64] = S[k];
        if (F.lane < 32) HGD[c * 256 + h * 64 + kh * 32 + F.lane] = dp;
    }
}
__device__ __forceinline__ void hg_pass2(Frame& F) {
    float* HGS = (float*)(F.ws + WS_HGS); const float* HGD = (const float*)(F.ws + WS_HGD);
    if (F.wave == 0) for (int b = F.bid; b < 256; b += F.G) {
        float carry = 0.f;
        for (int c0 = 0; c0 < 256; c0 += 16) { float Lv[16], Dv[16];
#pragma unroll
            for (int u = 0; u < 16; ++u) { Lv[u] = HGS[(size_t)(c0 + u) * 16384 + b * 64 + F.lane]; Dv[u] = HGD[(c0 + u) * 256 + b]; }
#pragma unroll
            for (int u = 0; u < 16; ++u) { HGS[(size_t)(c0 + u) * 16384 + b * 64 + F.lane] = carry; carry = Dv[u] * carry + Lv[u]; }
        }
    }
}
__device__ __forceinline__ void hg_pass3(Frame& F, int l, const float* hgg) {
    const bf16* P = (const bf16*)(F.ws + WS_PROJ); const float* lbs = (const float*)(F.ws + WS_SMALL + SM_LBS) + l * 256;
    const float* HGS = (const float*)(F.ws + WS_HGS); bf16* MIX = (bf16*)(F.ws + WS_MIX);
    LAS float* fk = (LAS float*)(F.lds + RING_OFF + F.wave * 16384);
    LAS float* vl = fk + 2048;
    LAS float* op = fk + 3072;
    LAS float* opp = (LAS float*)(F.lds + RING_OFF + (F.wave ^ 1) * 16384) + 3072;
    const int kh = F.wave & 1; const float gn = hgg[F.lane];
    for (int tk0 = F.bid * 4; tk0 < 1024; tk0 += F.G * 4) {
        const int tk = tk0 + (F.wave >> 1); const int c = tk >> 2, h = tk & 3;
        float S[32];
        { const float* Sp = HGS + ((size_t)(c * 4 + h) * 64 + kh * 32) * 64 + F.lane;
#pragma unroll
          for (int k = 0; k < 32; ++k) S[k] = Sp[k * 64]; }
        for (int sb = 0; sb < 4; ++sb) {
            const int row0 = c * 64 + sb * 16;
#pragma unroll
            for (int j = 0; j < 8; ++j) { const int p = j * 64 + F.lane, tt = p >> 5, kk = p & 31, k = h * 64 + kh * 32 + kk;
                const float z = bf2f(P[(size_t)(row0 + tt) * DIN + 1792 + k]); const float qv = bf2f(P[(size_t)(row0 + tt) * DIN + 1536 + k]); const float lbv = lbs[k];
                const float f = lbv + (1.0f - lbv) * sigmoid_f(z), key = (1.0f - lbv) * sigmoid_f(-z);
                *(LAS f32x4*)(fk + (tt * 32 + kk) * 4) = (f32x4){f, key, qv, 0.f}; }
#pragma unroll
            for (int tt = 0; tt < 16; ++tt) vl[tt * 64 + F.lane] = silu_ff(bf2f(P[(size_t)(row0 + tt) * DIN + 2048 + h * 64 + F.lane]));
            for (int tt = 0; tt < 16; ++tt) {
                const float v = vl[tt * 64 + F.lane]; float o = 0.f;
#pragma unroll
                for (int kk = 0; kk < 32; ++kk) { const f32x4 q = *(const LAS f32x4*)(fk + (tt * 32 + kk) * 4);
                    S[kk] = q.x * S[kk] + q.y * v; o += q.z * S[kk]; }
                op[tt * 64 + F.lane] = o;
            }
            __syncthreads();
#pragma unroll
            for (int t8 = 0; t8 < 8; ++t8) { const int tt = kh * 8 + t8; const float o = op[tt * 64 + F.lane] + opp[tt * 64 + F.lane];
                const float ss = wave_sum(o * o); const float rstd = 1.0f / sqrtf(ss * (1.0f / 64.0f) + LN_EPS);
                const float gt = bf2f(P[(size_t)(row0 + tt) * DIN + 2304 + h * 64 + F.lane]);
                MIX[(size_t)(row0 + tt) * DMODEL + 512 + h * 64 + F.lane] = (bf16)f2bf(o * rstd * gn * silu_ff(gt)); }
            __syncthreads();
        }
    }
}
__device__ __forceinline__ void pool_phase(Frame& F, const float* pw, const float* ps) {
    const bf16* P = (const bf16*)(F.ws + WS_PROJ); bf16* MIX = (bf16*)(F.ws + WS_MIX);
    LAS float* U = (LAS float*)(F.lds + RING_OFF + F.wave * 16384);
    LAS float* PL = U + 2048;
    const int gw = F.vcu * NWAVES + F.wave, NGW = F.G * NWAVES;
    for (int task = gw; task < 4096; task += NGW) {
        const int tg = task >> 2, gi = task & 3, t0 = tg * 16, win = 2 << gi;
        float wcol[64];
#pragma unroll
        for (int c = 0; c < 64; ++c) wcol[c] = pw[(size_t)(gi * 64 + c) * 64 + F.lane];
        const float scl = ps[gi * 64 + F.lane];
        for (int r = 0; r < 31; ++r) { const int t = t0 - 15 + r; U[r * 64 + F.lane] = (t >= 0) ? bf2f(P[(size_t)t * DIN + 2560 + gi * 64 + F.lane]) : 0.f; }
        for (int tt = 0; tt < 16; ++tt) { float s = 0.f;
            for (int j = 0; j < win; ++j) s += U[(15 + tt - j) * 64 + F.lane];
            const int t = t0 + tt; const float cntw = (float)((t + 1 < win) ? (t + 1) : win);
            PL[tt * 64 + F.lane] = s / cntw - U[(15 + tt) * 64 + F.lane]; }
        for (int tt = 0; tt < 16; ++tt) { float acc = 0.f;
#pragma unroll
            for (int c = 0; c < 64; c += 4) { const f32x4 p4 = *(const LAS f32x4*)(PL + tt * 64 + c);
                acc += p4.x * wcol[c]; acc += p4.y * wcol[c + 1]; acc += p4.z * wcol[c + 2]; acc += p4.w * wcol[c + 3]; }
            MIX[(size_t)(t0 + tt) * DMODEL + 768 + gi * 64 + F.lane] = (bf16)f2bf(acc * scl); }
    }
}
__device__ __forceinline__ void moe_gather(Frame& F) {
    const int gw = F.vcu * NWAVES + F.wave, NGW = F.G * NWAVES;
    int cn[8], tb[9]; tb[0] = 0;
#pragma unroll
    for (int e = 0; e < 8; ++e) { cn[e] = (int)__hip_atomic_load(F.ctl + CW_CNT + 64 * e, RLX_AGENT); tb[e + 1] = tb[e] + ((cn[e] + 255) >> 8); }
    const int* perm = (const int*)(F.ws + WS_SMALL + SM_PERM); const bf16* H = (const bf16*)(F.ws + WS_HBUF); bf16* HP = (bf16*)(F.ws + WS_HPERM);
    for (int slot = gw; slot < tb[8] * 256; slot += NGW) {
        const int T = slot >> 8; int e = 0, tbe = 0, ce = cn[0];
#pragma unroll
        for (int j = 1; j < 8; ++j) if (T >= tb[j]) { e = j; tbe = tb[j]; ce = cn[j]; }
        const int pos = ((T - tbe) << 8) + (slot & 255);
        const int tokn = (pos < ce) ? perm[e * SEQ + pos] : 0;
#if FP8_MOE
        const GAS v4u* src = (const GAS v4u*)((const unsigned char*)H + (size_t)tokn * DMODEL) + F.lane; GAS v4u* dst = (GAS v4u*)((unsigned char*)HP + (size_t)slot * DMODEL) + F.lane;
        dst[0] = src[0];
#else
        const GAS v4u* src = (const GAS v4u*)(H + (size_t)tokn * DMODEL) + F.lane; GAS v4u* dst = (GAS v4u*)(HP + (size_t)slot * DMODEL) + F.lane;
        const v4u a = src[0], b = src[64]; dst[0] = a; dst[64] = b;
#endif
    }
}
__device__ __forceinline__ void attn_finalize(Frame& F, int l, const float* ag) {
    const bf16* O1 = (const bf16*)(F.ws + WS_ATTNO); const bf16* O2 = O1 + (size_t)SEQ * 512; bf16* MIX = (bf16*)(F.ws + WS_MIX);
    const float* lamv = (const float*)(F.ws + WS_SMALL + SM_LAM); const float lam = lamv[l], osc = 1.0f - lamv[2 + l];
    const int gw = F.vcu * NWAVES + F.wave, NGW = F.G * NWAVES;
    float gv[8];
#pragma unroll
    for (int j = 0; j < 8; ++j) gv[j] = ag[(F.lane & 15) * 8 + j] * osc;
    v4u na = {0u, 0u, 0u, 0u}, nb = {0u, 0u, 0u, 0u}; if (gw < M) { na = *(const GAS v4u*)(O1 + (size_t)gw * 512 + F.lane * 8); nb = *(const GAS v4u*)(O2 + (size_t)gw * 512 + F.lane * 8); }
    for (int m = gw; m < M; m += NGW) {
        const v4u a = na, b = nb;
        if (m + NGW < M) { na = *(const GAS v4u*)(O1 + (size_t)(m + NGW) * 512 + F.lane * 8); nb = *(const GAS v4u*)(O2 + (size_t)(m + NGW) * 512 + F.lane * 8); }
        float d[8];
        d[0] = __uint_as_float(a.x << 16) - lam * __uint_as_float(b.x << 16); d[1] = __uint_as_float(a.x & 0xffff0000u) - lam * __uint_as_float(b.x & 0xffff0000u);
        d[2] = __uint_as_float(a.y << 16) - lam * __uint_as_float(b.y << 16); d[3] = __uint_as_float(a.y & 0xffff0000u) - lam * __uint_as_float(b.y & 0xffff0000u);
        d[4] = __uint_as_float(a.z << 16) - lam * __uint_as_float(b.z << 16); d[5] = __uint_as_float(a.z & 0xffff0000u) - lam * __uint_as_float(b.z & 0xffff0000u);
        d[6] = __uint_as_float(a.w << 16) - lam * __uint_as_float(b.w << 16); d[7] = __uint_as_float(a.w & 0xffff0000u) - lam * __uint_as_float(b.w & 0xffff0000u);
        float ss = 0.f;
#pragma unroll
        for (int j = 0; j < 8; ++j) ss += d[j] * d[j];
        ss += swzx<1>(ss); ss += swzx<2>(ss); ss += swzx<4>(ss); ss += swzx<8>(ss);
        const float rstd = __builtin_amdgcn_rsqf(ss * (1.0f / 128.0f) + LN_EPS);
        v4u o; o.x = pk2(d[0] * rstd * gv[0], d[1] * rstd * gv[1]); o.y = pk2(d[2] * rstd * gv[2], d[3] * rstd * gv[3]);
        o.z = pk2(d[4] * rstd * gv[4], d[5] * rstd * gv[5]); o.w = pk2(d[6] * rstd * gv[6], d[7] * rstd * gv[7]);
        *(GAS v4u*)(MIX + (size_t)m * DMODEL + F.lane * 8) = o;
    }
}

typedef float f32x16v __attribute__((ext_vector_type(16)));
typedef __bf16 bf16x2v __attribute__((ext_vector_type(2)));
typedef float f32x2v_ __attribute__((ext_vector_type(2)));
typedef short s16x4v __attribute__((ext_vector_type(4)));
__device__ __forceinline__ int crow16(int i, int hh) { return (i & 3) + 8 * (i >> 2) + 4 * hh; }
__device__ __forceinline__ unsigned pkbf(float lo, float hi) { f32x2v_ v = {lo, hi}; bf16x2v b = __builtin_convertvector(v, bf16x2v); return __builtin_bit_cast(unsigned, b); }
__device__ __forceinline__ bf16x8 pk8(const float (&x)[8]) { v4u w; w.x = pkbf(x[0], x[1]); w.y = pkbf(x[2], x[3]); w.z = pkbf(x[4], x[5]); w.w = pkbf(x[6], x[7]); return __builtin_bit_cast(bf16x8, w); }
__device__ __forceinline__ void unpk8(const v4u w, float (&x)[8]) {
    x[0] = __uint_as_float(w.x << 16); x[1] = __uint_as_float(w.x & 0xffff0000u); x[2] = __uint_as_float(w.y << 16); x[3] = __uint_as_float(w.y & 0xffff0000u);
    x[4] = __uint_as_float(w.z << 16); x[5] = __uint_as_float(w.z & 0xffff0000u); x[6] = __uint_as_float(w.w << 16); x[7] = __uint_as_float(w.w & 0xffff0000u); }
#define MFMA32(a, b, c) __builtin_amdgcn_mfma_f32_32x32x16_bf16((a), (b), (c), 0, 0, 0)
constexpr int HG_LDS = 26624, VT_PITCH = 72;
constexpr float HG_CLAMP = 80.0f;

__device__ __forceinline__ void hg_build_vt(LAS bf16* VT, const GAS bf16* P, int row0, int h, int lane) {
    const GAS bf16* vp = P + (size_t)row0 * DIN + 2048 + h * 64 + lane;
    for (int t0 = 0; t0 < 64; t0 += 16) { bf16 vr[16];
#pragma unroll
        for (int j = 0; j < 16; ++j) vr[j] = vp[(size_t)(t0 + j) * DIN];
#pragma unroll
        for (int t8 = 0; t8 < 2; ++t8) { float x[8];
#pragma unroll
            for (int j = 0; j < 8; ++j) x[j] = silu_ff(bf2f(vr[t8 * 8 + j]));
            *(LAS bf16x8*)(VT + lane * VT_PITCH + t0 + t8 * 8) = pk8(x); } }
}
__device__ __forceinline__ void hg_pass1_mfma(Frame& F, int l) {
    const GAS bf16* P = (const GAS bf16*)(F.ws + WS_PROJ); const GAS float* lbs = (const GAS float*)(F.ws + WS_SMALL + SM_LBS) + l * 256;
    GAS float* HGS = (GAS float*)(F.ws + WS_HGS); GAS float* HGD = (GAS float*)(F.ws + WS_HGD);
    if (F.wave >= 4) return;
    LAS bf16* KH = (LAS bf16*)(F.lds + RING_OFF + F.wave * HG_LDS);
    LAS bf16* VT = KH + 64 * VT_PITCH;
    const int lane = F.lane, r = lane & 31, hh = lane >> 5;
    for (int tk = F.bid * 4 + F.wave; tk < 1024; tk += F.G * 4) {
        const int c = tk >> 2, h = tk & 3, row0 = c * 64;
        const float lbv = lbs[h * 64 + lane];
        const GAS bf16* zp = P + (size_t)row0 * DIN + 1792 + h * 64 + lane;
        float b = 0.f;
        for (int t0 = 0; t0 < 64; t0 += 16) { bf16 zr[16];
#pragma unroll
            for (int j = 0; j < 16; ++j) zr[j] = zp[(size_t)(t0 + j) * DIN];
#pragma unroll
            for (int j = 0; j < 16; ++j) { const float f = lbv + (1.0f - lbv) * sigmoid_f(bf2f(zr[j])); b += (0.6931471805599453f * __builtin_amdgcn_logf(fmaxf(f, 1e-30f))); } }
        float bt = 0.f;
        for (int t0 = 0; t0 < 64; t0 += 16) { bf16 zr[16];
#pragma unroll
            for (int j = 0; j < 16; ++j) zr[j] = zp[(size_t)(t0 + j) * DIN];
#pragma unroll
            for (int t8 = 0; t8 < 2; ++t8) { float x[8];
#pragma unroll
                for (int j = 0; j < 8; ++j) { const float z = bf2f(zr[t8 * 8 + j]); const float f = lbv + (1.0f - lbv) * sigmoid_f(z); bt += (0.6931471805599453f * __builtin_amdgcn_logf(fmaxf(f, 1e-30f)));
                    x[j] = (1.0f - lbv) * sigmoid_f(-z) * __expf(b - bt); }
                *(LAS bf16x8*)(KH + lane * VT_PITCH + t0 + t8 * 8) = pk8(x); } }
        HGD[c * 256 + h * 64 + lane] = __expf(b);
        hg_build_vt(VT, P, row0, h, lane);
#pragma unroll
        for (int kb = 0; kb < 2; ++kb)
#pragma unroll
            for (int vb = 0; vb < 2; ++vb) { f32x16v acc = {};
#pragma unroll
                for (int ss = 0; ss < 4; ++ss) { const bf16x8 a = *(const LAS bf16x8*)(KH + (32 * kb + r) * VT_PITCH + 16 * ss + 8 * hh); const bf16x8 bq = *(const LAS bf16x8*)(VT + (32 * vb + r) * VT_PITCH + 16 * ss + 8 * hh);
                    acc = MFMA32(a, bq, acc); }
                GAS float* Lp = HGS + ((size_t)(c * 4 + h) * 64 + 32 * kb) * 64 + 32 * vb + r;
#pragma unroll
                for (int i = 0; i < 16; ++i) Lp[crow16(i, hh) * 64] = acc[i]; }
    }
}
__device__ __forceinline__ void hg_pass3_mfma(Frame& F, int l, const float* hgg) {
    const GAS bf16* P = (const GAS bf16*)(F.ws + WS_PROJ); const GAS float* lbs = (const GAS float*)(F.ws + WS_SMALL + SM_LBS) + l * 256;
    const GAS float* HGS = (const GAS float*)(F.ws + WS_HGS); GAS bf16* MIX = (GAS bf16*)(F.ws + WS_MIX); const GAS float* hgg_g = (const GAS float*)hgg;
    if (F.wave >= 4) return;
    LAS float* BL = (LAS float*)(F.lds + RING_OFF + F.wave * HG_LDS);
    LAS bf16* VT = (LAS bf16*)(BL + 4096);
    LAS float* R1 = (LAS float*)(VT + 64 * VT_PITCH);
    const int lane = F.lane, r = lane & 31, hh = lane >> 5;
    for (int tk = F.bid * 4 + F.wave; tk < 1024; tk += F.G * 4) {
        const int c = tk >> 2, h = tk & 3, row0 = c * 64;
        { const float lbv = lbs[h * 64 + lane]; float b = 0.f; const GAS bf16* zp = P + (size_t)row0 * DIN + 1792 + h * 64 + lane;
          for (int t0 = 0; t0 < 64; t0 += 16) { bf16 zr[16];
#pragma unroll
              for (int j = 0; j < 16; ++j) zr[j] = zp[(size_t)(t0 + j) * DIN];
#pragma unroll
              for (int j = 0; j < 16; ++j) { const float f = lbv + (1.0f - lbv) * sigmoid_f(bf2f(zr[j])); b += (0.6931471805599453f * __builtin_amdgcn_logf(fmaxf(f, 1e-30f))); BL[(t0 + j) * 64 + lane] = b; }
              if (t0 == 16) R1[lane] = b; } }
        hg_build_vt(VT, P, row0, h, lane);
        bf16x8 Qt[2][4], Qh1[4];
#pragma unroll
        for (int tb = 0; tb < 2; ++tb)
#pragma unroll
            for (int ks = 0; ks < 4; ++ks) { const int t = 32 * tb + r, k0 = 16 * ks + 8 * hh; float q[8], e[8];
                unpk8(*(const GAS v4u*)(P + (size_t)(row0 + t) * DIN + 1536 + h * 64 + k0), q);
                const f32x4 b0 = *(const LAS f32x4*)(BL + t * 64 + k0), b1 = *(const LAS f32x4*)(BL + t * 64 + k0 + 4);
                e[0] = b0.x; e[1] = b0.y; e[2] = b0.z; e[3] = b0.w; e[4] = b1.x; e[5] = b1.y; e[6] = b1.z; e[7] = b1.w;
                if (tb == 1) { const f32x4 r0 = *(const LAS f32x4*)(R1 + k0), r1 = *(const LAS f32x4*)(R1 + k0 + 4); const float rr[8] = {r0.x, r0.y, r0.z, r0.w, r1.x, r1.y, r1.z, r1.w}; float qh[8];
#pragma unroll
                    for (int j = 0; j < 8; ++j) { q[j] *= __expf(e[j] - rr[j]); qh[j] = q[j] * __expf(rr[j]); }
                    Qh1[ks] = pk8(qh);
                } else {
#pragma unroll
                    for (int j = 0; j < 8; ++j) q[j] *= __expf(e[j]);
                }
                Qt[tb][ks] = pk8(q); }
        f32x16v X00 = {}, X01 = {}, X11 = {};
#pragma unroll
        for (int ks = 0; ks < 4; ++ks) { const int k0 = 16 * ks + 8 * hh;
            const f32x4 l0 = *(const GAS f32x4*)(lbs + h * 64 + k0), l1 = *(const GAS f32x4*)(lbs + h * 64 + k0 + 4); const float lb8[8] = {l0.x, l0.y, l0.z, l0.w, l1.x, l1.y, l1.z, l1.w};
            const f32x4 r0 = *(const LAS f32x4*)(R1 + k0), r1 = *(const LAS f32x4*)(R1 + k0 + 4); const float rr[8] = {r0.x, r0.y, r0.z, r0.w, r1.x, r1.y, r1.z, r1.w};
            float key[8], bs[8], x0[8], x1[8];
            unpk8(*(const GAS v4u*)(P + (size_t)(row0 + r) * DIN + 1792 + h * 64 + k0), key);
            { const f32x4 b0 = *(const LAS f32x4*)(BL + r * 64 + k0), b1 = *(const LAS f32x4*)(BL + r * 64 + k0 + 4); bs[0] = b0.x; bs[1] = b0.y; bs[2] = b0.z; bs[3] = b0.w; bs[4] = b1.x; bs[5] = b1.y; bs[6] = b1.z; bs[7] = b1.w; }
#pragma unroll
            for (int j = 0; j < 8; ++j) { const float ky = (1.0f - lb8[j]) * sigmoid_f(-key[j]); x0[j] = ky * __expf(fminf(-bs[j], HG_CLAMP)); x1[j] = ky * __expf(rr[j] - bs[j]); }
            X00 = MFMA32(pk8(x0), Qt[0][ks], X00);
            X01 = MFMA32(pk8(x1), Qt[1][ks], X01);
            unpk8(*(const GAS v4u*)(P + (size_t)(row0 + 32 + r) * DIN + 1792 + h * 64 + k0), key);
            { const f32x4 b0 = *(const LAS f32x4*)(BL + (32 + r) * 64 + k0), b1 = *(const LAS f32x4*)(BL + (32 + r) * 64 + k0 + 4); bs[0] = b0.x; bs[1] = b0.y; bs[2] = b0.z; bs[3] = b0.w; bs[4] = b1.x; bs[5] = b1.y; bs[6] = b1.z; bs[7] = b1.w; }
#pragma unroll
            for (int j = 0; j < 8; ++j) { const float ky = (1.0f - lb8[j]) * sigmoid_f(-key[j]); x1[j] = ky * __expf(fminf(rr[j] - bs[j], HG_CLAMP)); }
            X11 = MFMA32(pk8(x1), Qt[1][ks], X11);
        }
#pragma unroll
        for (int i = 0; i < 16; ++i) { const bool keep = crow16(i, hh) <= r; X00[i] = keep ? X00[i] : 0.f; X11[i] = keep ? X11[i] : 0.f; }
        f32x16v O[2][2] = {};
#pragma unroll
        for (int sp = 0; sp < 2; ++sp) {
            float p[8]; bf16x8 P00, P01, P11;
#pragma unroll
            for (int j = 0; j < 8; ++j) p[j] = X00[8 * sp + j]; P00 = pk8(p);
#pragma unroll
            for (int j = 0; j < 8; ++j) p[j] = X01[8 * sp + j]; P01 = pk8(p);
#pragma unroll
            for (int j = 0; j < 8; ++j) p[j] = X11[8 * sp + j]; P11 = pk8(p);
#pragma unroll
            for (int vb = 0; vb < 2; ++vb) {
                const LAS bf16* vrow = VT + (32 * vb + r) * VT_PITCH + 16 * sp + 4 * hh;
                const s16x4v a0 = *(const LAS s16x4v*)(vrow), a1 = *(const LAS s16x4v*)(vrow + 8);
                const s16x4v c0 = *(const LAS s16x4v*)(vrow + 32), c1 = *(const LAS s16x4v*)(vrow + 40);
                const bf16x8 V0 = (bf16x8){a0[0], a0[1], a0[2], a0[3], a1[0], a1[1], a1[2], a1[3]}, V1 = (bf16x8){c0[0], c0[1], c0[2], c0[3], c1[0], c1[1], c1[2], c1[3]};
                O[0][vb] = MFMA32(P00, V0, O[0][vb]);
                O[1][vb] = MFMA32(P01, V0, O[1][vb]);
                O[1][vb] = MFMA32(P11, V1, O[1][vb]);
            }
        }
#pragma unroll
        for (int ks = 0; ks < 4; ++ks)
#pragma unroll
            for (int vb = 0; vb < 2; ++vb) { float sv[8]; const GAS float* Sp = HGS + ((size_t)(c * 4 + h) * 64 + 16 * ks + 8 * hh) * 64 + 32 * vb + r;
#pragma unroll
                for (int j = 0; j < 8; ++j) sv[j] = Sp[j * 64];
                const bf16x8 sf = pk8(sv);
                O[0][vb] = MFMA32(Qt[0][ks], sf, O[0][vb]);
                O[1][vb] = MFMA32(Qh1[ks], sf, O[1][vb]); }
        const float gn0 = hgg_g[r], gn1 = hgg_g[32 + r];
#pragma unroll
        for (int tb = 0; tb < 2; ++tb) {
            bf16 gr[16][2]; float rs[16];
#pragma unroll
            for (int i = 0; i < 16; ++i) { const GAS bf16* gp = P + (size_t)(row0 + 32 * tb + crow16(i, hh)) * DIN + 2304 + h * 64 + r; gr[i][0] = gp[0]; gr[i][1] = gp[32]; }
#pragma unroll
            for (int i = 0; i < 16; ++i) { const float o0 = O[tb][0][i], o1 = O[tb][1][i]; rs[i] = o0 * o0 + o1 * o1; }
#pragma unroll
            for (int i = 0; i < 16; ++i) rs[i] += swzx<1>(rs[i]);
#pragma unroll
            for (int i = 0; i < 16; ++i) rs[i] += swzx<2>(rs[i]);
#pragma unroll
            for (int i = 0; i < 16; ++i) rs[i] += swzx<4>(rs[i]);
#pragma unroll
            for (int i = 0; i < 16; ++i) rs[i] += swzx<8>(rs[i]);
#pragma unroll
            for (int i = 0; i < 16; ++i) rs[i] += swzx<16>(rs[i]);
#pragma unroll
            for (int i = 0; i < 16; ++i) { const int t = 32 * tb + crow16(i, hh); const float rstd = __builtin_amdgcn_rsqf(rs[i] * (1.0f / 64.0f) + LN_EPS);
                GAS bf16* op = MIX + (size_t)(row0 + t) * DMODEL + 512 + h * 64 + r;
                op[0] = (bf16)f2bf(O[tb][0][i] * rstd * gn0 * silu_ff(bf2f(gr[i][0]))); op[32] = (bf16)f2bf(O[tb][1][i] * rstd * gn1 * silu_ff(bf2f(gr[i][1]))); }
        }
    }
}
__device__ __forceinline__ void pool_mfma(Frame& F, const float* pw, const float* ps) {
    const GAS bf16* P = (const GAS bf16*)(F.ws + WS_PROJ); GAS bf16* MIX = (GAS bf16*)(F.ws + WS_MIX); const GAS float* pwg = (const GAS float*)pw; const GAS float* psg = (const GAS float*)ps;
    LAS float* ZL = (LAS float*)(F.lds + RING_OFF + F.wave * 12288);
    const int lane = F.lane, r = lane & 31, hh = lane >> 5, gi = F.wave >> 1, db = F.wave & 1, win = 2 << gi;
    bf16x8 wf[4];
#pragma unroll
    for (int ks = 0; ks < 4; ++ks) { float x[8];
#pragma unroll
        for (int j = 0; j < 8; ++j) x[j] = pwg[(size_t)(gi * 64 + 16 * ks + 8 * hh + j) * 64 + 32 * db + r];
        wf[ks] = pk8(x); }
    const float scl = psg[gi * 64 + 32 * db + r];
    for (int tile = F.bid; tile < SEQ / 64; tile += F.G) {
        const int t0 = tile * 64 - 32;
#pragma unroll
        for (int rt = 0; rt < 3; ++rt) { f32x16v acc = {}; const int t = t0 + 32 * rt + r;
#pragma unroll
            for (int ks = 0; ks < 4; ++ks) { v4u a = {0u, 0u, 0u, 0u}; if (t >= 0) a = *(const GAS v4u*)(P + (size_t)t * DIN + 2560 + gi * 64 + 16 * ks + 8 * hh);
                acc = MFMA32(__builtin_bit_cast(bf16x8, a), wf[ks], acc); }
#pragma unroll
            for (int i = 0; i < 16; ++i) ZL[(32 * rt + crow16(i, hh)) * 32 + r] = acc[i]; }
        const int tl0 = 32 + 32 * hh; float s = 0.f;
        for (int j = 1; j < win; ++j) s += ZL[(tl0 - j) * 32 + r];
        for (int tt = 0; tt < 32; ++tt) { const int tl = tl0 + tt; const float zc = ZL[tl * 32 + r]; s += zc;
            const int tg = t0 + tl; const float cntw = (float)((tg + 1 < win) ? (tg + 1) : win);
            MIX[(size_t)tg * DMODEL + 768 + gi * 64 + 32 * db + r] = (bf16)f2bf((s / cntw - zc) * scl);
            s -= ZL[(tl - win + 1) * 32 + r]; }
    }
}
#ifndef DIS
#define DIS 0
#endif
#ifndef DUP
#define DUP 0
#endif
#ifndef ATTN_B
#define ATTN_B 1
#endif
#ifndef HG_MFMA
#define HG_MFMA 1
#endif
#ifndef POOL_MFMA
#define POOL_MFMA 1
#endif
#if HG_MFMA
#define HG1 hg_pass1_mfma
#define HG3 hg_pass3_mfma
#else
#define HG1 hg_pass1
#define HG3 hg_pass3
#endif
#if POOL_MFMA
#define POOLF pool_mfma
#else
#define POOLF pool_phase
#endif
#define RELOAD_ARGS() do { asm volatile("" : "+s"(argp), "+s"(F.ws), "+s"(F.ctl), "+s"(bar.bar), "+s"(bar.x), "+s"(F.G), "+s"(F.vcu), "+s"(F.bid)); { unsigned z_ = 0u; asm volatile("" : "+s"(z_)); F.lane = (int)__builtin_amdgcn_mbcnt_hi(~0u, __builtin_amdgcn_mbcnt_lo(~0u, z_)); } asm volatile("" : "+v"(F.lane)); F.tid = F.wave * 64 + F.lane; } while (0)
#define args (*argp)
__global__ void __launch_bounds__(NWAVES * 64, 2) mk_fwd(Args args_) {
    const Args* argp = (const Args*)__builtin_amdgcn_kernarg_segment_ptr();
    extern __shared__ __attribute__((aligned(16))) unsigned char lds[];
    Frame F;
    F.lds = (LAS unsigned char*)lds;
    F.MISC = (volatile LAS unsigned*)(F.lds + MISC_OFF);
    F.tid = threadIdx.x; F.lane = F.tid & 63; F.wave = __builtin_amdgcn_readfirstlane(F.tid >> 6);
    F.G = gridDim.x; F.bid = blockIdx.x; { const int bx = blockIdx.x; F.vcu = (F.G % 8 == 0) ? (bx % 8) * (F.G / 8) + bx / 8 : bx; }
    F.ws = args.ws; F.ctl = (gu32*)(args.ws + WS_CTL);
    for (int u = F.tid; u < (LDS_BYTES - LDSCTL_OFF) / 4; u += NWAVES * 64) ((LAS unsigned*)(F.lds + LDSCTL_OFF))[u] = 0u;
    __syncthreads();
    XcdBarrier bar; bar.bar = (unsigned*)(F.ctl + CW_BAR); bar.x = 0; bar.st = nullptr;
    if (N_LAUNCHES == 1) bar = xcd_barrier_post((unsigned*)(F.ctl + CW_BAR), F.MISC + 8, F.tid);
    const int lo = (N_LAUNCHES == 1) ? 0 : args.ph_lo, hi = (N_LAUNCHES == 1) ? NPH : args.ph_hi;
#define IN(k) (lo <= (k) && (k) < hi)
#define SEAM(k) do { if (IN(k) && IN((k) + 1)) xcd_barrier(bar, F.tid); RELOAD_ARGS(); } while (0)
#define MOD ((const float*)(F.ws + WS_SMALL + SM_MOD))
#define HB ((bf16*)(F.ws + WS_HBUF))

    if (IN(0)) {
#if !(DIS&1)
        p0a_prologue(F, args);
#if (DUP&1)
            __syncthreads();
            p0a_prologue(F, args);
#endif

#endif
    } SEAM(0);
    if (IN(1)) { p_modulate(F, args.in[I_X], MOD, HB); } SEAM(1);

    for (int l = 0; l < DEPTH; ++l) {
        const int pb = 2 + NPH_LAYER * l;
#define mod (MOD + l * 6144)
#define xin ((l == 0) ? args.in[I_X] : (const float*)args.out)
        if (IN(pb + 0)) {
            pg8::Gemm g{HB, (const bf16*)(F.ws + WS_WIN) + (size_t)l * DIN * 1024, 1024}; pg8::StaticOrder S; S.init(M, DIN, F.G, F.bid);
            pg8::EpiProj E{(bf16*)(F.ws + WS_PROJ), DIN, (const float*)(F.ws + WS_ROPE), (const float*)(F.ws + WS_ROPE) + (size_t)SEQ * 32, attn_body::C2};
#if !(DIS&2)
            pg8::gemm_phase<pg8::EpiProj, pg8::StaticOrder, true>(F.lds + RING_OFF, g, S, E, F.tid);
#if (DUP&2)
            __syncthreads();
            pg8::gemm_phase<pg8::EpiProj, pg8::StaticOrder, true>(F.lds + RING_OFF, g, S, E, F.tid);
#endif

#endif
        } SEAM(pb + 0);
        if (IN(pb + 1)) {
#if !(DIS&4)
            HG1(F, l);
#if (DUP&4)
            __syncthreads();
            HG1(F, l);
#endif

#endif
            __syncthreads(); RELOAD_ARGS();
#if !(DIS&8)
            POOLF(F, args.in[I_POOLW] + (size_t)l * 4 * 64 * 64, args.in[I_POOLS] + l * 256);
#if (DUP&8)
            __syncthreads();
            POOLF(F, args.in[I_POOLW] + (size_t)l * 4 * 64 * 64, args.in[I_POOLS] + l * 256);
#endif

#endif
        } SEAM(pb + 1);
        if (IN(pb + 3)) {
#if !(DIS&16)
            hg_pass2(F);
#endif
            RELOAD_ARGS();
            const attn_body::bf16* PJ = (const attn_body::bf16*)(F.ws + WS_PROJ); attn_body::bf16* AO = (attn_body::bf16*)(F.ws + WS_ATTNO);
#if ATTN_B
            for (int rep_ = 0; rep_ < ((DUP&32) ? 2 : 1); ++rep_)
            for (int i = 0; i < 2; ++i) { const int j = i * F.G + F.vcu; if (j >= 512) break;
                const int v = j & 255, ii = j >> 8, mpi = v >> 5, s = v & 31; const int qb = (ii == 0) ? s : 63 - s;
                const int h = mpi >> 1, mp = mpi & 1;
#if !(DIS&32)
                attn_body::attn_unit2<8>(F.tid, qb, PJ + mpi * 64, PJ + 512 + mpi * 64, PJ + 1024 + h * 128, AO + (size_t)mp * SEQ * 512 + h * 128, (char*)lds + RING_OFF);
#endif
            }
#else
            for (int rep_ = 0; rep_ < ((DUP&32) ? 2 : 1); ++rep_)
            for (int i = 0; i < 4; ++i) { const int j = i * F.G + F.vcu; if (j >= 1024) break;
                const int v = j & 255, ii = j >> 8, vh = v >> 4, s = v & 15; const int qb = (ii == 0) ? s : (ii == 1) ? 31 - s : (ii == 2) ? 32 + s : 63 - s;
                const int h = vh >> 2, mp = (vh >> 1) & 1, vf = vh & 1;
#if !(DIS&32)
                attn_body::attn_unit<8>(F.tid, qb, PJ + (h * 2 + mp) * 64, PJ + 512 + (h * 2 + mp) * 64, PJ + 1024 + h * 128 + vf * 64, AO + (size_t)mp * SEQ * 512 + h * 128 + vf * 64, (char*)lds + RING_OFF);
#endif
            }
#endif
        } SEAM(pb + 3);
        if (IN(pb + 4)) {
#if !(DIS&64)
            HG3(F, l, args.in[I_HGG] + l * 64);
#if (DUP&64)
            __syncthreads();
            HG3(F, l, args.in[I_HGG] + l * 64);
#endif
#endif
            __syncthreads(); RELOAD_ARGS();
#if !(DIS&128)
            attn_finalize(F, l, args.in[I_ATTNG] + l * 128);
#if (DUP&128)
            __syncthreads();
            attn_finalize(F, l, args.in[I_ATTNG] + l * 128);
#endif

#endif
        } SEAM(pb + 4);
        if (IN(pb + 5)) {
            pg8::Gemm g{(const bf16*)(F.ws + WS_MIX), (const bf16*)(F.ws + WS_WOUT) + (size_t)l * 1024 * 1024, 1024}; pg8::StaticOrder S; S.init(M, DMODEL, F.G, F.bid);
            pg8::EpiResid E{xin, args.out, DMODEL, mod + 2048, ALPHA, 1.0f};
#if !(DIS&256)
            pg8::gemm_phase<pg8::EpiResid, pg8::StaticOrder, false>(F.lds + RING_OFF, g, S, E, F.tid);
#endif
        } SEAM(pb + 5);
        if (IN(pb + 6)) {
#if !(DIS&512)
            if (l & 1) p_ln<true, FP8_MOE != 0>(F, args.out, args.in[I_LN1G] + l * 1024, args.in[I_LN1B] + l * 1024, mod + 3072, HB, args.in[I_RW] + (size_t)(l >> 1) * 1024 * 8);
#endif
#if !(DIS&1024)
            if (!(l & 1)) p_ln<false, FP8_DENSE != 0>(F, args.out, args.in[I_LN1G] + l * 1024, args.in[I_LN1B] + l * 1024, mod + 3072, HB, nullptr);
#endif
        } SEAM(pb + 6);
        if (!(l & 1)) {
            if (IN(pb + 8)) {
#if FP8_DENSE
                pg8::Gemm g{HB, (const bf16*)(F.ws + WS_FFN13), 1024 / 2}; pg8::StaticOrder S; S.init(M, 2 * FFD, F.G, F.bid);
                pg8::EpiSwiglu8 E{F.ws + WS_DHID, FFD, UP_DESCALE, S_HID};
#if !(DIS&2048)
                pg8::gemm_phase<pg8::EpiSwiglu8, pg8::StaticOrder, true, true>(F.lds + RING_OFF, g, S, E, F.tid);
#if (DUP&2048)
            __syncthreads();
            pg8::gemm_phase<pg8::EpiSwiglu8, pg8::StaticOrder, true, true>(F.lds + RING_OFF, g, S, E, F.tid);
#endif

#endif
#else
                pg8::Gemm g{HB, (const bf16*)(F.ws + WS_FFN13), 1024}; pg8::StaticOrder S; S.init(M, 2 * FFD, F.G, F.bid);
                pg8::EpiSwiglu E{(bf16*)(F.ws + WS_DHID), FFD};
#if !(DIS&2048)
                pg8::gemm_phase<pg8::EpiSwiglu, pg8::StaticOrder, true>(F.lds + RING_OFF, g, S, E, F.tid);
#endif
#endif
            } SEAM(pb + 8);
            if (IN(pb + 9)) {
#if FP8_DENSE
                pg8::Gemm g{(const bf16*)(F.ws + WS_DHID), (const bf16*)(F.ws + WS_FFN2), FFD / 2}; pg8::StaticOrder S; S.init(M, DMODEL, F.G, F.bid);
                pg8::EpiResid E{args.out, args.out, DMODEL, mod + 5120, ALPHA, DN_DESCALE};
#if !(DIS&4096)
                pg8::gemm_phase<pg8::EpiResid, pg8::StaticOrder, false, true>(F.lds + RING_OFF, g, S, E, F.tid);
#endif
#else
                pg8::Gemm g{(const bf16*)(F.ws + WS_DHID), (const bf16*)(F.ws + WS_FFN2), FFD}; pg8::StaticOrder S; S.init(M, DMODEL, F.G, F.bid);
                pg8::EpiResid E{args.out, args.out, DMODEL, mod + 5120, ALPHA, 1.0f};
#if !(DIS&4096)
                pg8::gemm_phase<pg8::EpiResid, pg8::StaticOrder, false>(F.lds + RING_OFF, g, S, E, F.tid);
#endif
#endif
            } SEAM(pb + 9);
            if (IN(pb + 10)) {
                p_ln<false, false>(F, args.out, args.in[I_LN2G] + l * 1024, args.in[I_LN2B] + l * 1024, (l + 1 < DEPTH) ? MOD + (l + 1) * 6144 : nullptr, HB, nullptr);
            } SEAM(pb + 10);
        } else {
            const unsigned* cnt = (const unsigned*)(F.ctl + CW_CNT);
            if (IN(pb + 7)) {
#if !(DIS&65536)
                moe_gather(F);
#if (DUP&65536)
            __syncthreads();
            moe_gather(F);
#endif

#endif
            } SEAM(pb + 7);
            if (IN(pb + 8)) {
                pg8::Gemm g{(const bf16*)(F.ws + WS_HPERM), (const bf16*)(F.ws + WS_EXP13), 1024 / 2}; pg8::MoeOrder S; S.init(cnt, 2 * EDIM / 256, F.G, F.bid);
                pg8::EpiSwiglu8 E{F.ws + WS_HID, EDIM, UP_DESCALE, S_HID};
#if !(DIS&8192)
                pg8::gemm_phase<pg8::EpiSwiglu8, pg8::MoeOrder, true, true>(F.lds + RING_OFF, g, S, E, F.tid);
#if (DUP&8192)
            __syncthreads();
            pg8::gemm_phase<pg8::EpiSwiglu8, pg8::MoeOrder, true, true>(F.lds + RING_OFF, g, S, E, F.tid);
#endif

#endif
            } SEAM(pb + 8);
            if (IN(pb + 9)) {
                pg8::Gemm g{(const bf16*)(F.ws + WS_HID), (const bf16*)(F.ws + WS_EXP2), EDIM / 2}; pg8::MoeOrder S; S.init(cnt, DMODEL / 256, F.G, F.bid);
                pg8::EpiBf16 E{(bf16*)(F.ws + WS_YSLOT), DMODEL, DN_DESCALE};
#if !(DIS&16384)
                pg8::gemm_phase<pg8::EpiBf16, pg8::MoeOrder, true, true>(F.lds + RING_OFF, g, S, E, F.tid);
#if (DUP&16384)
            __syncthreads();
            pg8::gemm_phase<pg8::EpiBf16, pg8::MoeOrder, true, true>(F.lds + RING_OFF, g, S, E, F.tid);
#endif

#endif
            } SEAM(pb + 9);
            if (IN(pb + 10)) {
#if !(DIS&32768)
                p_ln_moe(F, args.out, args.in[I_LN2G] + l * 1024, args.in[I_LN2B] + l * 1024, mod + 5120);
#endif
            } SEAM(pb + 10);
        }
    }
#undef IN
#undef SEAM
#undef args
#undef MOD
#undef HB
#undef mod
#undef xin
}

extern "C" void kernel_launch(void* const* d_in, const int* in_sizes, int n_in, void* d_out, int out_size, void* d_ws, size_t ws_size, hipStream_t stream) {
    static int grid = 0;
    if (grid == 0) {
        if (n_in != 23 || in_sizes[0] != M * DMODEL || out_size != M * DMODEL || ws_size < WS_END) { fprintf(stderr, "kernel_launch: unexpected shapes (n_in %d, out %d, ws %zu); nothing launched\n", n_in, out_size, ws_size); grid = -1; return; }
        int dev = 0, cus = 0, per_cu = 0;
        if (hipGetDevice(&dev) != hipSuccess || hipDeviceGetAttribute(&cus, hipDeviceAttributeMultiprocessorCount, dev) != hipSuccess) { grid = -1; return; }
        if (hipFuncSetAttribute((const void*)mk_fwd, hipFuncAttributeMaxDynamicSharedMemorySize, LDS_BYTES) != hipSuccess) { fprintf(stderr, "kernel_launch: hipFuncSetAttribute failed\n"); grid = -1; return; }
        if (hipOccupancyMaxActiveBlocksPerMultiprocessor(&per_cu, (const void*)mk_fwd, NWAVES * 64, LDS_BYTES) != hipSuccess || per_cu < 1) { fprintf(stderr, "kernel_launch: occupancy query says %d\n", per_cu); }
        (void)hipGetLastError();
        grid = cus;
    }
    if (grid < 0) return;
    if (hipMemsetAsync((char*)d_ws + WS_CTL, 0, CTL_ZERO_BYTES, stream) != hipSuccess) return;
    Args a{};
    for (int i = 0; i < 23; ++i) a.in[i] = (const float*)d_in[i];
    a.out = (float*)d_out; a.ws = (unsigned char*)d_ws;
    for (int li = 0; li < N_LAUNCHES; ++li) {
        a.ph_lo = (N_LAUNCHES == 1) ? 0 : li; a.ph_hi = (N_LAUNCHES == 1) ? NPH : li + 1; a.li = li; a.pad = 0;
        hipLaunchKernelGGL(mk_fwd, dim3(grid), dim3(NWAVES * 64), LDS_BYTES, stream, a);
    }
}
```
